# Optimizing an MI355X kernel written in HIP

```python
import jax, jax.numpy as jnp
from jax import lax
import numpy as np

D_MODEL = 1024
BATCH = 8
SEQ = 4096
DEPTH = 4

GRID_W = 64
CTX_LEN = 256
HEAD_DIM = 64
MIX_WIDTH = D_MODEL
CONV_WIDTH_A = D_MODEL // 4
RWKV_WIDTH = 3 * D_MODEL // 8
LRU_WIDTH = MIX_WIDTH - CONV_WIDTH_A - RWKV_WIDTH
RWKV_HEADS = RWKV_WIDTH // HEAD_DIM
LRU_BLOCKS = LRU_WIDTH // HEAD_DIM
W_LORA = 64
A_LORA = 64
G_LORA = 128
RWKV_COLS = 3 * RWKV_WIDTH + W_LORA + A_LORA + G_LORA
IN_COLS = 3 * CONV_WIDTH_A + RWKV_COLS + 2 * LRU_WIDTH
D_FF = 2816
LRU_C = 8.0
LRU_CONV = 4
NORM_EPS = 1e-6
GN_EPS = 64e-5

kernel_name = 'hybrid_conv_rwkv7_rglru_macaron_dit'


def rmsnorm(x, g):
    xf = x.astype(jnp.float32)
    y = xf * lax.rsqrt(jnp.mean(xf * xf, axis=-1, keepdims=True) + NORM_EPS)
    return (y * g.astype(jnp.float32)).astype(x.dtype)


def adaln(cvec, w, b):
    return jnp.split(jax.nn.silu(cvec) @ w + b, 9, axis=-1)


def modulate(h, shift, scale):
    return h * (1.0 + scale) + shift


def macaron_ffn(s, m, g, w_gu, w_down):
    h = modulate(rmsnorm(s, g), m[0], m[1])
    gate, up = jnp.split(h @ w_gu, 2, axis=-1)
    return s + 0.5 * m[2] * ((jax.nn.silu(gate) * up) @ w_down)


def shift_seq(u, o):
    if o == 0:
        return u
    t_len = u.shape[-2]
    pad = [(0, 0)] * u.ndim
    if o > 0:
        pad[-2] = (0, o)
        return jnp.pad(u, pad)[..., o:o + t_len, :]
    pad[-2] = (-o, 0)
    return jnp.pad(u, pad)[..., :t_len, :]


def dwconv(u, w, offsets):
    out = w[0] * shift_seq(u, offsets[0])
    for j in range(1, len(offsets)):
        out = out + w[j] * shift_seq(u, offsets[j])
    return out


def to_col_major(t, rows):
    b, s, ch = t.shape
    return t.reshape(b, rows, GRID_W, ch).transpose(0, 2, 1, 3).reshape(b, s, ch)


def from_col_major(t, rows):
    b, s, ch = t.shape
    return t.reshape(b, GRID_W, rows, ch).transpose(0, 2, 1, 3).reshape(b, s, ch)


def short_conv_mixer(p, conv_w, line_len):
    bg, cg, xin = jnp.split(p, 3, axis=-1)
    u = cg * xin
    b, t_len, ch = u.shape
    u = u.reshape(b, t_len // line_len, line_len, ch)
    y = dwconv(u, conv_w, (-1, 0, 1)).reshape(b, t_len, ch)
    return bg * y


def rwkv_scan(s0, r, w, k, v, kk, a, reverse):
    def step(s, inp):
        r_t, w_t, k_t, v_t, kk_t, a_t = inp
        sa = jnp.einsum('bhvk,bhk->bhv', s, -kk_t)
        s = (s * w_t[:, :, None, :] + sa[..., None] * (kk_t * a_t)[:, :, None, :]
             + v_t[..., None] * k_t[:, :, None, :])
        return s, jnp.einsum('bhvk,bhk->bhv', s, r_t)
    xs = tuple(jnp.moveaxis(t, 1, 0) for t in (r, w, k, v, kk, a))
    s_fin, y = lax.scan(step, s0, xs, reverse=reverse)
    return s_fin, jnp.moveaxis(y, 0, 1)


def rwkv_mixer(p, mu, w0, w2, a0, a2, g2, k_k, k_a, r_k, lnx_g, lnx_b, init):
    dt = p.dtype
    bsz, t_len, _ = p.shape
    R = RWKV_WIDTH
    p = p + mu[0] * (shift_seq(p, -1) - p) + mu[1] * (shift_seq(p, 1) - p)
    r, k, v, dw, da, dg = jnp.split(p, [R, 2 * R, 3 * R, 3 * R + W_LORA, 3 * R + W_LORA + A_LORA], axis=-1)

    def heads(t):
        return t.astype(jnp.float32).reshape(bsz, t_len, RWKV_HEADS, HEAD_DIM)

    g = jax.nn.sigmoid(dg) @ g2
    kk = heads(k * k_k)
    kk = kk * lax.rsqrt(jnp.sum(kk * kk, axis=-1, keepdims=True) + 1e-12)
    rh, vh = heads(r), heads(v)
    rk = r_k.astype(jnp.float32).reshape(RWKV_HEADS, HEAD_DIM)
    tw = jnp.tanh(dw)
    ys, bonuses, finals = [], [], []
    for d in range(2):
        w_log = -jax.nn.softplus(-(w0[d] + tw @ w2[d]).astype(jnp.float32)) - 0.5
        decay = jnp.exp(-jnp.exp(w_log))
        a = jax.nn.sigmoid(a0[d] + da @ a2[d])
        kd = heads(k * (1.0 + (a - 1.0) * k_a))
        s_fin, y = rwkv_scan(init[d], rh, heads(decay), kd, vh, kk, heads(a), reverse=(d == 1))
        ys.append(y)
        bonuses.append(jnp.sum(rh * kd * rk, axis=-1, keepdims=True) * vh)
        finals.append(s_fin)
    y_sum = ys[0] + ys[1]
    mean = jnp.mean(y_sum, axis=-1, keepdims=True)
    var = jnp.mean(jnp.square(y_sum - mean), axis=-1, keepdims=True)
    gn = ((y_sum - mean) * lax.rsqrt(var + GN_EPS)).reshape(bsz, t_len, R) * lnx_g + lnx_b
    out = (gn + (bonuses[0] + bonuses[1]).reshape(bsz, t_len, R)) * g
    return out.astype(dt), (finals[0], finals[1])


def block_diag(u, w):
    b, t_len, _ = u.shape
    ub = u.reshape(b, t_len, LRU_BLOCKS, HEAD_DIM)
    return jnp.einsum('btni,nij->btnj', ub, w).reshape(b, t_len, LRU_WIDTH)


def _lru_combine(e1, e2):
    a1, b1 = e1
    a2, b2 = e2
    return a1 * a2, a2 * b1 + b2


def rglru_mixer(p, conv_w, conv_b, w_r, b_r, w_i, b_i, lam, init):
    dt = p.dtype
    xr, gr = jnp.split(p, 2, axis=-1)
    hs, finals = [], []
    for d, offs in enumerate(((-3, -2, -1, 0), (0, 1, 2, 3))):
        u = dwconv(xr, conv_w[d], offs) + conv_b[d]
        rg = jax.nn.sigmoid(block_diag(u, w_r[d]) + b_r[d])
        ig = jax.nn.sigmoid(block_diag(u, w_i[d]) + b_i[d])
        log_a = -LRU_C * (jax.nn.softplus(-lam[d]) * rg).astype(jnp.float32)
        a = jnp.exp(log_a)
        bterm = jnp.sqrt(-jnp.expm1(2.0 * log_a)) * (ig * u).astype(jnp.float32)
        a_cum, h = lax.associative_scan(_lru_combine, (a, bterm), reverse=(d == 1), axis=1)
        h = h + a_cum * init[d][:, None, :]
        hs.append(h)
        finals.append(h[:, -1] if d == 0 else h[:, 0])
    out = jax.nn.gelu(gr) * (hs[0] + hs[1]).astype(dt)
    return out, (finals[0], finals[1])


def token_mixers(p, line_len, conv_a, rwkv_params, lru_params, rwkv_init, lru_init):
    pa, pb, pc = jnp.split(p, [3 * CONV_WIDTH_A, 3 * CONV_WIDTH_A + RWKV_COLS], axis=-1)
    ya = short_conv_mixer(pa, conv_a, line_len)
    yb, rwkv_fin = rwkv_mixer(pb, *rwkv_params, rwkv_init)
    yc, lru_fin = rglru_mixer(pc, *lru_params, lru_init)
    return jnp.concatenate([ya, yb, yc], axis=-1), rwkv_fin, lru_fin


def setup_inputs(seed: int = 0) -> dict:
    key = jax.random.key(seed)
    ks = iter(jax.random.split(key, 48))
    L, D, R, LW = DEPTH, D_MODEL, RWKV_WIDTH, LRU_WIDTH

    def nrm(shape, scale):
        return jax.random.normal(next(ks), shape, jnp.float32) * scale

    def uni(shape, lo, hi):
        return jax.random.uniform(next(ks), shape, jnp.float32, lo, hi)

    lam_a = uni((L, 2, LW), 0.9, 0.999)
    return {
        'x': nrm((BATCH, SEQ, D), 1.0),
        'c': nrm((BATCH, D), 1.0),
        'ctx': nrm((BATCH, CTX_LEN, D), 1.0),
        'c_ctx': nrm((D,), 1.0),
        'w_mod': nrm((L, D, 9 * D), 0.5 * D ** -0.5),
        'b_mod': nrm((L, 9 * D), 0.01),
        'g_ffn1': 1.0 + nrm((L, D), 0.05),
        'w_gu1': nrm((L, D, 2 * D_FF), D ** -0.5),
        'w_down1': nrm((L, D_FF, D), D_FF ** -0.5),
        'g_mix': 1.0 + nrm((L, D), 0.05),
        'w_in': nrm((L, D, IN_COLS), D ** -0.5),
        'conv_a': nrm((L, 3, CONV_WIDTH_A), 3 ** -0.5),
        'rwkv_mu': uni((L, 2, RWKV_COLS), 0.0, 0.5),
        'rwkv_w0': uni((L, 2, R), -4.0, 1.0),
        'rwkv_w2': nrm((L, 2, W_LORA, R), 0.5 * W_LORA ** -0.5),
        'rwkv_a0': nrm((L, 2, R), 0.5),
        'rwkv_a2': nrm((L, 2, A_LORA, R), 0.5 * A_LORA ** -0.5),
        'rwkv_g2': nrm((L, G_LORA, R), G_LORA ** -0.5),
        'rwkv_kk': 0.85 + nrm((L, R), 0.05),
        'rwkv_ka': 1.0 + nrm((L, R), 0.05),
        'rwkv_rk': nrm((L, R), 0.1),
        'rwkv_lnx_g': 1.0 + nrm((L, R), 0.05),
        'rwkv_lnx_b': nrm((L, R), 0.01),
        'lru_conv_w': nrm((L, 2, LRU_CONV, LW), LRU_CONV ** -0.5),
        'lru_conv_b': nrm((L, 2, LW), 0.01),
        'lru_w_r': nrm((L, 2, LRU_BLOCKS, HEAD_DIM, HEAD_DIM), HEAD_DIM ** -0.5),
        'lru_b_r': nrm((L, 2, LW), 0.01),
        'lru_w_i': nrm((L, 2, LRU_BLOCKS, HEAD_DIM, HEAD_DIM), HEAD_DIM ** -0.5),
        'lru_b_i': nrm((L, 2, LW), 0.01),
        'lru_lam': jnp.log(lam_a) - jnp.log1p(-lam_a),
        'w_out': nrm((L, MIX_WIDTH, D), MIX_WIDTH ** -0.5),
        'g_ffn2': 1.0 + nrm((L, D), 0.05),
        'w_gu2': nrm((L, D, 2 * D_FF), D ** -0.5),
        'w_down2': nrm((L, D_FF, D), D_FF ** -0.5),
        'g_final': 1.0 + nrm((D,), 0.05),
    }


def reference(x, c, ctx, c_ctx, w_mod, b_mod, g_ffn1, w_gu1, w_down1, g_mix, w_in, conv_a,
              rwkv_mu, rwkv_w0, rwkv_w2, rwkv_a0, rwkv_a2, rwkv_g2, rwkv_kk, rwkv_ka, rwkv_rk,
              rwkv_lnx_g, rwkv_lnx_b, lru_conv_w, lru_conv_b, lru_w_r, lru_b_r, lru_w_i, lru_b_i,
              lru_lam, w_out, g_ffn2, w_gu2, w_down2, g_final):
    bsz = x.shape[0]
    rows = x.shape[1] // GRID_W
    s_ctx = ctx
    for l in range(DEPTH):
        last = l == DEPTH - 1
        m_lat = [t[:, None, :] for t in adaln(c, w_mod[l], b_mod[l])]
        m_ctx = adaln(c_ctx, w_mod[l], b_mod[l])
        x = macaron_ffn(x, m_lat[0:3], g_ffn1[l], w_gu1[l], w_down1[l])
        s_ctx = macaron_ffn(s_ctx, m_ctx[0:3], g_ffn1[l], w_gu1[l], w_down1[l])
        p_ctx = modulate(rmsnorm(s_ctx, g_mix[l]), m_ctx[3], m_ctx[4]) @ w_in[l]
        p_lat = modulate(rmsnorm(x, g_mix[l]), m_lat[3], m_lat[4]) @ w_in[l]
        col_major = l % 2 == 1
        if col_major:
            p_lat = to_col_major(p_lat, rows)
        line_len = rows if col_major else GRID_W
        rwkv_p = (rwkv_mu[l], rwkv_w0[l], rwkv_w2[l], rwkv_a0[l], rwkv_a2[l], rwkv_g2[l],
                  rwkv_kk[l], rwkv_ka[l], rwkv_rk[l], rwkv_lnx_g[l], rwkv_lnx_b[l])
        lru_p = (lru_conv_w[l], lru_conv_b[l], lru_w_r[l], lru_b_r[l], lru_w_i[l], lru_b_i[l], lru_lam[l])
        rwkv_zero = jnp.zeros((bsz, RWKV_HEADS, HEAD_DIM, HEAD_DIM), jnp.float32)
        lru_zero = jnp.zeros((bsz, LRU_WIDTH), jnp.float32)
        y_ctx, rwkv_fin, lru_fin = token_mixers(p_ctx, s_ctx.shape[1], conv_a[l], rwkv_p, lru_p,
                                                (rwkv_zero, rwkv_zero), (lru_zero, lru_zero))
        y_lat, _, _ = token_mixers(p_lat, line_len, conv_a[l], rwkv_p, lru_p, rwkv_fin, lru_fin)
        if col_major:
            y_lat = from_col_major(y_lat, rows)
        x = x + m_lat[5] * (y_lat @ w_out[l])
        x = macaron_ffn(x, m_lat[6:9], g_ffn2[l], w_gu2[l], w_down2[l])
        if not last:
            s_ctx = s_ctx + m_ctx[5] * (y_ctx @ w_out[l])
            s_ctx = macaron_ffn(s_ctx, m_ctx[6:9], g_ffn2[l], w_gu2[l], w_down2[l])
    return rmsnorm(x, g_final)
```

```cpp
#include <hip/hip_runtime.h>
#include <hip/hip_cooperative_groups.h>
#include <cstdio>
#include <cstdint>
namespace cg = cooperative_groups;
namespace pg8 {
#define PG8_LAS __attribute__((address_space(3)))
typedef unsigned short bf16_t;
typedef short bf16x8 __attribute__((ext_vector_type(8)));
typedef float f32x4 __attribute__((ext_vector_type(4)));
typedef unsigned u32x4 __attribute__((ext_vector_type(4)));
constexpr int BM = 256, BK = 64, HALF = 128, HTB = HALF * BK * 2  , STAGE_BYTES = 8 * HTB, NXCD = 8, WGM = 8;

__host__ __device__ __forceinline__ int lds_byte(int r, int c) { const int st = (r >> 4) * 2 + (c >> 5), rr = r & 15, cc = c & 31, ob = rr * 64 + cc * 2; return st * 1024 + (ob ^ (((ob >> 9) & 1) << 5)); }
__host__ __device__ __forceinline__ void stage_rc(int b, int& R, int& C) { const int st = b / 1024, sb = b % 1024, swz = sb ^ (((sb >> 9) & 1) << 5); R = (st >> 1) * 16 + swz / 64; C = (st & 1) * 32 + (swz % 64) / 2; }
__host__ __device__ __forceinline__ int perm32(int rho) { const int n = rho >> 4, i = rho & 15; return 8 * (i >> 2) + 4 * n + (i & 3); }

struct Unit { int pm, pn; };
struct Gemm { const bf16_t* A; const bf16_t* Bt; int M, N, K; };

struct StaticOrder {
    int nM, nN, nwg, G, c;
    __host__ __device__ void init(int M, int N, int G_, int c_) { nM = M / BM; nN = N / BM; nwg = nM * nN; G = G_; c = c_; }
    __host__ __device__ bool next(int i, Unit& u) const {
        const long L = (long)i * G + c; if (L >= nwg) return false;
        int wgid = (int)L; { const int q = nwg / NXCD, r = nwg % NXCD, xcd = wgid % NXCD, off = wgid / NXCD; wgid = (xcd < r ? xcd * (q + 1) : r * (q + 1) + (xcd - r) * q) + off; }
        const int nig = WGM * nN, gid = wgid / nig, fm = gid * WGM, gsz = (nM - fm) < WGM ? (nM - fm) : WGM;
        u.pm = fm + ((wgid % nig) % gsz); u.pn = (wgid % nig) / gsz; return true;
    }
    __device__ __forceinline__ void a_ready(const Unit&) const {}
    __device__ __forceinline__ void done(const Unit&) const {}
};

template <class Epi, class Sched, bool ALIGN_EPI = false, bool SP2 = false>
__device__ __forceinline__ void gemm_phase(PG8_LAS unsigned char* lds, const Gemm g, const Sched& S, const Epi& E, const int tid) {
    const int wid = __builtin_amdgcn_readfirstlane(tid >> 6), lane = tid & 63, wr = wid >> 2, wc = wid & 3, fr = lane & 15, fq = lane >> 4;
    const int K = g.K, nt = K / BK;
    unsigned voffA[2], voffB[2];
#pragma unroll
    for (int i = 0; i < 2; ++i) { int R, C; stage_rc(tid * 16 + i * 8192, R, C); const int Rb = Epi::PERM ? ((R & ~31) + perm32(R & 31)) : R;
        voffA[i] = (unsigned)(R * K + C) * 2u; voffB[i] = (unsigned)(Rb * K + C) * 2u; }
    const size_t kstep = (size_t)(BK * 2);
    const size_t hstep = (size_t)HALF * K * 2;
    const size_t tstep = 2 * hstep;
    const unsigned ldsw = (unsigned)wid * 1024u;
    const int aoff = lds_byte(wr * 64 + fr, fq * 8), boff = lds_byte(wc * 32 + fr, fq * 8);
#define PG8_SA(b, h) (((b) * 2 + (h)) * HTB)
#define PG8_SB(b, h) ((4 + (b) * 2 + (h)) * HTB)
#define PG8_STAGE(bufoff, gbase, voff) do { _Pragma("unroll") for (int _i = 0; _i < 2; ++_i) \
        __builtin_amdgcn_global_load_lds((const unsigned*)((const char*)(gbase) + (voff)[_i]), (PG8_LAS unsigned*)(lds + (bufoff) + ldsw + _i * 8192), 16, 0, 0); } while (0)
#define PG8_LDA(dst, b, h) do { _Pragma("unroll") for (int m = 0; m < 4; ++m) _Pragma("unroll") for (int k = 0; k < 2; ++k) dst[m][k] = *(const PG8_LAS bf16x8*)(lds + PG8_SA(b, h) + aoff + m * 2048 + k * 1024); } while (0)
#define PG8_LDB(dst, b, h) do { _Pragma("unroll") for (int n = 0; n < 2; ++n) _Pragma("unroll") for (int k = 0; k < 2; ++k) dst[n][k] = *(const PG8_LAS bf16x8*)(lds + PG8_SB(b, h) + boff + n * 2048 + k * 1024); } while (0)
#define PG8_MMA(ai, bj, At, Bt) do { __builtin_amdgcn_s_setprio(1); _Pragma("unroll") for (int m = 0; m < 4; ++m) _Pragma("unroll") for (int n = 0; n < 2; ++n) _Pragma("unroll") for (int k = 0; k < 2; ++k) \
        acc[ai][bj][m][n] = __builtin_amdgcn_mfma_f32_16x16x32_bf16(Bt[n][k], At[m][k], acc[ai][bj][m][n], 0, 0, 0); __builtin_amdgcn_s_setprio(0); } while (0)
#define PG8_WAIT_V(n) asm volatile("s_waitcnt vmcnt(" #n ")" ::: "memory")
#define PG8_WAIT_L(n) asm volatile("s_waitcnt lgkmcnt(" #n ")" ::: "memory")
#define PG8_BAR __builtin_amdgcn_s_barrier()
#define PG8_SCHED __builtin_amdgcn_sched_barrier(0)
    Unit cur, nxt; int ui = 0;
    if (!S.next(0, cur)) return;
    f32x4 acc[2][2][4][2];
#pragma unroll
    for (int a = 0; a < 2; ++a)
#pragma unroll
        for (int b = 0; b < 2; ++b)
#pragma unroll
            for (int m = 0; m < 4; ++m)
#pragma unroll
                for (int n = 0; n < 2; ++n) acc[a][b][m][n] = (f32x4){0.f, 0.f, 0.f, 0.f};
    bf16x8 At[4][2], B0[2][2], B1[2][2];
    const char* cA = (const char*)g.A + (size_t)cur.pm * tstep; const char* cB = (const char*)g.Bt + (size_t)cur.pn * tstep;
    S.a_ready(cur);
    if constexpr (SP2) {
        PG8_STAGE(PG8_SB(0, 0), cB, voffB); PG8_STAGE(PG8_SB(0, 1), cB + hstep, voffB); PG8_STAGE(PG8_SA(0, 0), cA, voffA); PG8_STAGE(PG8_SA(0, 1), cA + hstep, voffA);
        if (wr == 1) PG8_BAR;
        PG8_WAIT_V(2); PG8_BAR;
        PG8_STAGE(PG8_SB(1, 0), cB + kstep, voffB); PG8_STAGE(PG8_SA(1, 0), cA + kstep, voffA); PG8_STAGE(PG8_SB(1, 1), cB + hstep + kstep, voffB);
        PG8_WAIT_V(6); PG8_BAR;
    } else {
        PG8_STAGE(PG8_SB(0, 0), cB, voffB); PG8_STAGE(PG8_SA(0, 0), cA, voffA); PG8_STAGE(PG8_SB(0, 1), cB + hstep, voffB); PG8_STAGE(PG8_SA(0, 1), cA + hstep, voffA);
        if (wr == 1) PG8_BAR;
        PG8_WAIT_V(4); PG8_BAR;
        PG8_STAGE(PG8_SB(1, 0), cB + kstep, voffB); PG8_STAGE(PG8_SA(1, 0), cA + kstep, voffA); PG8_STAGE(PG8_SB(1, 1), cB + hstep + kstep, voffB);
        PG8_WAIT_V(6); PG8_BAR;
    }
    for (;;) {
        const bool has_next = S.next(ui + 1, nxt);
        const char* nA = has_next ? (const char*)g.A + (size_t)nxt.pm * tstep : cA; const char* nB = has_next ? (const char*)g.Bt + (size_t)nxt.pn * tstep : cB;
        for (int t = 0; t < nt; t += 2) {
            const bool last = (t == nt - 2);
            const char* a1 = cA + (size_t)(t + 1) * kstep;
            const char* a2 = last ? nA : cA + (size_t)(t + 2) * kstep; const char* b2 = last ? nB : cB + (size_t)(t + 2) * kstep;
            const char* a3 = a2 + kstep; const char* b3 = b2 + kstep;
            if (last && has_next) S.a_ready(nxt);
            if constexpr (SP2) {
            PG8_LDB(B0, 0, 0); PG8_LDB(B1, 0, 1); PG8_SCHED; PG8_LDA(At, 0, 0); PG8_STAGE(PG8_SA(1, 1), a1 + hstep, voffA);
            PG8_WAIT_V(8); PG8_WAIT_L(0); PG8_BAR; PG8_MMA(0, 0, At, B0); PG8_MMA(0, 1, At, B1); PG8_BAR; PG8_SCHED;
            PG8_LDA(At, 0, 1); PG8_STAGE(PG8_SB(0, 0), b2, voffB); PG8_STAGE(PG8_SB(0, 1), b2 + hstep, voffB); PG8_STAGE(PG8_SA(0, 0), a2, voffA);
            PG8_WAIT_V(8); PG8_WAIT_L(0); PG8_BAR; PG8_MMA(1, 0, At, B0); PG8_MMA(1, 1, At, B1); PG8_BAR; PG8_SCHED;
            PG8_LDB(B0, 1, 0); PG8_LDB(B1, 1, 1); PG8_SCHED; PG8_LDA(At, 1, 0); PG8_STAGE(PG8_SA(0, 1), a2 + hstep, voffA);
            PG8_WAIT_V(8); PG8_WAIT_L(0); PG8_BAR; PG8_MMA(0, 0, At, B0); PG8_MMA(0, 1, At, B1); PG8_BAR; PG8_SCHED;
            PG8_LDA(At, 1, 1); PG8_STAGE(PG8_SB(1, 0), b3, voffB); PG8_STAGE(PG8_SB(1, 1), b3 + hstep, voffB); PG8_STAGE(PG8_SA(1, 0), a3, voffA);
            PG8_WAIT_V(8); PG8_WAIT_L(0); PG8_BAR; PG8_MMA(1, 0, At, B0); PG8_MMA(1, 1, At, B1); PG8_BAR; PG8_SCHED;
            } else {
            PG8_LDB(B0, 0, 0); PG8_SCHED; PG8_LDA(At, 0, 0); PG8_STAGE(PG8_SA(1, 1), a1 + hstep, voffA);
            PG8_WAIT_L(8); PG8_BAR; PG8_WAIT_L(0); PG8_MMA(0, 0, At, B0); PG8_BAR; PG8_SCHED;
            PG8_LDB(B1, 0, 1); PG8_STAGE(PG8_SB(0, 0), b2, voffB);
            PG8_BAR; PG8_WAIT_L(0); PG8_MMA(0, 1, At, B1); PG8_BAR;
            PG8_LDA(At, 0, 1); PG8_STAGE(PG8_SA(0, 0), a2, voffA);
            PG8_BAR; PG8_WAIT_L(0); PG8_MMA(1, 0, At, B0); PG8_BAR; PG8_SCHED;
            PG8_STAGE(PG8_SB(0, 1), b2 + hstep, voffB);
            PG8_WAIT_V(6); PG8_BAR; PG8_MMA(1, 1, At, B1); PG8_BAR;
            PG8_LDB(B0, 1, 0); PG8_SCHED; PG8_LDA(At, 1, 0); PG8_STAGE(PG8_SA(0, 1), a2 + hstep, voffA);
            PG8_WAIT_L(8); PG8_BAR; PG8_WAIT_L(0); PG8_MMA(0, 0, At, B0); PG8_BAR; PG8_SCHED;
            PG8_LDB(B1, 1, 1); PG8_STAGE(PG8_SB(1, 0), b3, voffB);
            PG8_BAR; PG8_WAIT_L(0); PG8_MMA(0, 1, At, B1); PG8_BAR;
            PG8_LDA(At, 1, 1); PG8_STAGE(PG8_SA(1, 0), a3, voffA);
            PG8_BAR; PG8_WAIT_L(0); PG8_MMA(1, 0, At, B0); PG8_BAR; PG8_SCHED;
            PG8_STAGE(PG8_SB(1, 1), b3 + hstep, voffB);
            PG8_WAIT_V(6); PG8_BAR; PG8_MMA(1, 1, At, B1); PG8_BAR;
            }
        }
        if constexpr (ALIGN_EPI) { if (wr == 0) PG8_BAR; }
        if constexpr (!Epi::AFTER_DRAIN) { E(acc, cur, wr, wc, fr, fq); S.done(cur); }
        if (!has_next) break;
#pragma unroll
        for (int a = 0; a < 2; ++a)
#pragma unroll
            for (int b = 0; b < 2; ++b)
#pragma unroll
                for (int m = 0; m < 4; ++m)
#pragma unroll
                    for (int n = 0; n < 2; ++n) acc[a][b][m][n] = (f32x4){0.f, 0.f, 0.f, 0.f};
        cur = nxt; cA = nA; cB = nB; ++ui;
        if constexpr (ALIGN_EPI) { if (wr == 1) PG8_BAR; }
    }
    PG8_WAIT_V(0);
    if constexpr (!ALIGN_EPI) { if (wr == 0) PG8_BAR; }
    PG8_BAR;
    if constexpr (Epi::AFTER_DRAIN) { E.fused(acc, cur, wr, wc, fr, fq, lds, wid, lane); S.done(cur); }
#undef PG8_SA
#undef PG8_SB
#undef PG8_STAGE
#undef PG8_LDA
#undef PG8_LDB
#undef PG8_MMA
#undef PG8_WAIT_V
#undef PG8_WAIT_L
#undef PG8_BAR
#undef PG8_SCHED
}
}
#define LAS __attribute__((address_space(3)))
typedef unsigned short bf16;
typedef unsigned v4u __attribute__((ext_vector_type(4)));
typedef unsigned v2u __attribute__((ext_vector_type(2)));
typedef float f32x4 __attribute__((ext_vector_type(4)));
typedef float f32x2 __attribute__((ext_vector_type(2)));

constexpr int D = 1024, NB = 8, SEQ = 4096, CTX = 256, DEPTH = 4, DFF = 2816;
constexpr int MLAT = NB * SEQ, MCTX = NB * CTX, MTOT = MLAT + MCTX;
constexpr int INC = 2944, INCP = 3072;
constexpr int RW = 384, LW = 384, RC = 1408;
constexpr int QLEN = CTX + SEQ;
constexpr int PC_BG = 0, PC_CG = 256, PC_XIN = 512, PC_RW = 768, PC_XR = 2176, PC_GR = 2560;
constexpr int PC_Y = 768;
constexpr int NWAVES = 8, NTHR = 512;
constexpr int LDS_BYTES = 147456;

constexpr size_t MiB = 1u << 20;
constexpr size_t WS_MODS = 0, WS_XRCTX = 2 * MiB, WS_WT = 10 * MiB, WS_H = 52 * MiB, WS_A = 120 * MiB, WS_B = 324 * MiB;
constexpr size_t SC_ELEMS = (size_t)NB * QLEN * RW;
constexpr size_t WS_END = WS_B + 9 * SC_ELEMS * 2 + (size_t)NB * QLEN * 128 * 2;
static_assert(WS_END <= 600 * MiB, "workspace map");
static_assert(WS_A + (size_t)MTOT * INCP * 2 <= WS_B, "P fits");
constexpr size_t WT_GU1 = 0, WT_DOWN1 = WT_GU1 + (size_t)2 * DFF * D, WT_IN = WT_DOWN1 + (size_t)D * DFF, WT_OUT = WT_IN + (size_t)INCP * D,
                 WT_GU2 = WT_OUT + (size_t)D * D, WT_DOWN2 = WT_GU2 + (size_t)2 * DFF * D, WT_TOTAL = WT_DOWN2 + (size_t)D * DFF;
static_assert(WS_WT + WT_TOTAL * 2 <= WS_H, "weights fit");

enum { I_X = 0, I_C, I_CTX, I_CCTX, I_WMOD, I_BMOD, I_GFFN1, I_WGU1, I_WDOWN1, I_GMIX, I_WIN, I_CONVA, I_MU, I_W0, I_W2, I_A0, I_A2, I_G2, I_KK, I_KA, I_RK,
       I_LNG, I_LNB, I_LCW, I_LCB, I_LWR, I_LBR, I_LWI, I_LBI, I_LAM, I_WOUT, I_GFFN2, I_WGU2, I_WDOWN2, I_GFINAL, N_IN };

struct Args { const float* in[N_IN]; float* out; unsigned char* ws; int ph_lo, ph_hi; };
typedef const __attribute__((address_space(4))) Args* CArgsP;

__device__ __forceinline__ float bf2f(unsigned h) { return __builtin_bit_cast(float, h << 16); }
__device__ __forceinline__ unsigned f2bf(float f) { unsigned u = __builtin_bit_cast(unsigned, f); return (u + 0x7fffu + ((u >> 16) & 1u)) >> 16; }
__device__ __forceinline__ unsigned pk2(float lo, float hi) { return f2bf(lo) | (f2bf(hi) << 16); }
__device__ __forceinline__ void unpack8(v4u p, float* o) {
    o[0] = __builtin_bit_cast(float, p.x << 16); o[1] = __builtin_bit_cast(float, p.x & 0xffff0000u);
    o[2] = __builtin_bit_cast(float, p.y << 16); o[3] = __builtin_bit_cast(float, p.y & 0xffff0000u);
    o[4] = __builtin_bit_cast(float, p.z << 16); o[5] = __builtin_bit_cast(float, p.z & 0xffff0000u);
    o[6] = __builtin_bit_cast(float, p.w << 16); o[7] = __builtin_bit_cast(float, p.w & 0xffff0000u);
}
__device__ __forceinline__ v4u pack8(const float* v) { v4u o; o.x = pk2(v[0], v[1]); o.y = pk2(v[2], v[3]); o.z = pk2(v[4], v[5]); o.w = pk2(v[6], v[7]); return o; }
template <int CTRL> __device__ __forceinline__ float dppf(float v) { return __builtin_bit_cast(float, __builtin_amdgcn_update_dpp(0, __builtin_bit_cast(int, v), CTRL, 0xF, 0xF, true)); }
__device__ __forceinline__ float wave_sum(float v) {
    v += dppf<0xB1>(v); v += dppf<0x4E>(v); v += dppf<0x141>(v); v += dppf<0x140>(v);
    const float a = __builtin_bit_cast(float, __builtin_amdgcn_readlane(__builtin_bit_cast(int, v), 0)), b = __builtin_bit_cast(float, __builtin_amdgcn_readlane(__builtin_bit_cast(int, v), 16));
    const float c = __builtin_bit_cast(float, __builtin_amdgcn_readlane(__builtin_bit_cast(int, v), 32)), d = __builtin_bit_cast(float, __builtin_amdgcn_readlane(__builtin_bit_cast(int, v), 48));
    return (a + b) + (c + d);
}
__device__ __forceinline__ float sigmoidf_(float x) { return 1.0f / (1.0f + __expf(-x)); }
__device__ __forceinline__ float siluf_(float x) { return x / (1.0f + __expf(-x)); }
__device__ __forceinline__ float softplusf_(float z) { return fmaxf(z, 0.f) + log1pf(__expf(-fabsf(z))); }
__device__ __forceinline__ float gelu_tanh(float x) { const float u = 0.7978845608028654f * (x + 0.044715f * x * x * x); return 0.5f * x * (1.0f + tanhf(u)); }
__device__ __forceinline__ float reduce8(float x) { x += dppf<0xB1>(x); x += dppf<0x4E>(x); x += dppf<0x141>(x); return x; }
__device__ __forceinline__ int row_of(int b, int q, int odd) {
    if (q < CTX) return MLAT + b * CTX + q;
    const int s = q - CTX; const int t = odd ? (((s & 63) << 6) | (s >> 6)) : s;
    return b * SEQ + t;
}

struct EpiSwiGLU {
    static constexpr bool PERM = true, AFTER_DRAIN = false;
    bf16* O;
    __device__ __forceinline__ void operator()(const pg8::f32x4 (&acc)[2][2][4][2], const pg8::Unit& u, int wr, int wc, int fr, int fq) const {
        const int row0 = u.pm * 256 + wr * 64 + fr, col0 = u.pn * 128 + wc * 32 + 8 * fq;
#pragma unroll
        for (int ai = 0; ai < 2; ++ai)
#pragma unroll
            for (int m = 0; m < 4; ++m) {
                float o[8];
#pragma unroll
                for (int n = 0; n < 2; ++n)
#pragma unroll
                    for (int j = 0; j < 4; ++j) { const float g = acc[ai][0][m][n][j], up = acc[ai][1][m][n][j]; o[n * 4 + j] = siluf_(g) * up; }
                *(v4u*)(O + (size_t)(row0 + ai * 128 + m * 16) * DFF + col0) = pack8(o);
            }
    }
};
struct EpiP {
    static constexpr bool PERM = true, AFTER_DRAIN = false;
    bf16* O; int ldc;
    __device__ __forceinline__ void operator()(const pg8::f32x4 (&acc)[2][2][4][2], const pg8::Unit& u, int wr, int wc, int fr, int fq) const {
        const int row0 = u.pm * 256 + wr * 64 + fr, col0 = u.pn * 256 + wc * 32 + 8 * fq;
#pragma unroll
        for (int ai = 0; ai < 2; ++ai)
#pragma unroll
            for (int m = 0; m < 4; ++m)
#pragma unroll
                for (int bj = 0; bj < 2; ++bj) {
                    float o[8];
#pragma unroll
                    for (int n = 0; n < 2; ++n)
#pragma unroll
                        for (int j = 0; j < 4; ++j) o[n * 4 + j] = acc[ai][bj][m][n][j];
                    *(v4u*)(O + (size_t)(row0 + ai * 128 + m * 16) * ldc + col0 + bj * 128) = pack8(o);
                }
    }
};
struct EpiResid {
    static constexpr bool PERM = true, AFTER_DRAIN = false;
    const float* res_lat; const float* res_ctx; float* dst_lat; float* dst_ctx; const float* gate; float coef;
    __device__ __forceinline__ void operator()(const pg8::f32x4 (&acc)[2][2][4][2], const pg8::Unit& u, int wr, int wc, int fr, int fq) const {
        const int rowbase = u.pm * 256; const bool isctx = rowbase >= MLAT;
        const int b = isctx ? 8 : (rowbase >> 12);
        const float* res = isctx ? res_ctx + (size_t)(rowbase - MLAT) * D : res_lat + (size_t)rowbase * D;
        float* dst = isctx ? dst_ctx + (size_t)(rowbase - MLAT) * D : dst_lat + (size_t)rowbase * D;
#pragma unroll
        for (int bj = 0; bj < 2; ++bj) {
            const int col = u.pn * 256 + bj * 128 + wc * 32 + 8 * fq;
            const f32x4 g0 = *(const f32x4*)(gate + (size_t)b * 9216 + col) * coef, g1 = *(const f32x4*)(gate + (size_t)b * 9216 + col + 4) * coef;
#pragma unroll
            for (int ai = 0; ai < 2; ++ai)
#pragma unroll
                for (int m = 0; m < 4; ++m) {
                    const size_t off = (size_t)(ai * 128 + wr * 64 + m * 16 + fr) * D + col;
                    const f32x4 r0 = *(const f32x4*)(res + off), r1 = *(const f32x4*)(res + off + 4);
                    *(f32x4*)(dst + off) = r0 + g0 * acc[ai][bj][m][0];
                    *(f32x4*)(dst + off + 4) = r1 + g1 * acc[ai][bj][m][1];
                }
        }
    }
};
struct WS {
    float* mods; float* xrctx; bf16* wt; bf16* H; bf16* P; bf16* ACT;
    bf16 *scb, *sc_r, *sc_v, *sc_kk, *dgs;
};
__device__ __forceinline__ WS make_ws(unsigned char* ws) {
    WS w; w.mods = (float*)(ws + WS_MODS); w.xrctx = (float*)(ws + WS_XRCTX); w.wt = (bf16*)(ws + WS_WT); w.H = (bf16*)(ws + WS_H); w.P = (bf16*)(ws + WS_A); w.ACT = (bf16*)(ws + WS_A);
    bf16* b = (bf16*)(ws + WS_B);
    w.scb = b; w.sc_r = b; w.sc_v = b + SC_ELEMS; w.sc_kk = b + 2 * SC_ELEMS; w.dgs = b + 9 * SC_ELEMS;
    return w;
}

__device__ __forceinline__ void mods_phase(const int bx, const int G, CArgsP A, const WS& W, LAS unsigned char* lds, int tid, int lane, int wave) {
    LAS float* sl = (LAS float*)lds;
    LAS float* part = sl + 9 * 1024;
    const float* c = A->in[I_C]; const float* cctx = A->in[I_CCTX];
    for (int i = tid; i < 9216; i += NTHR) { const int r = i >> 10, k = i & 1023; const float v = r < 8 ? c[r * 1024 + k] : cctx[k]; sl[i] = siluf_(v); }
    __syncthreads();
    for (int item = bx; item < 288; item += G) {
        const int l = item / 72, cgp = item % 72;
        const float* Wp = A->in[I_WMOD] + (size_t)l * 1024 * 9216 + cgp * 128 + lane * 2;
        float acc[9][2];
#pragma unroll
        for (int r = 0; r < 9; ++r) { acc[r][0] = 0.f; acc[r][1] = 0.f; }
#pragma unroll 8
        for (int kk = 0; kk < 128; ++kk) {
            const int k = wave * 128 + kk;
            const f32x2 w = *(const f32x2*)(Wp + (size_t)k * 9216);
#pragma unroll
            for (int r = 0; r < 9; ++r) { const float s = sl[r * 1024 + k]; acc[r][0] += s * w.x; acc[r][1] += s * w.y; }
        }
#pragma unroll
        for (int r = 0; r < 9; ++r) { part[(wave * 9 + r) * 128 + lane * 2] = acc[r][0]; part[(wave * 9 + r) * 128 + lane * 2 + 1] = acc[r][1]; }
        __syncthreads();
        for (int o = tid; o < 1152; o += NTHR) {
            const int r = o >> 7, cc = o & 127; float s = A->in[I_BMOD][l * 9216 + cgp * 128 + cc];
#pragma unroll
            for (int w8 = 0; w8 < 8; ++w8) s += part[(w8 * 9 + r) * 128 + cc];
            W.mods[(size_t)(l * 9 + r) * 9216 + cgp * 128 + cc] = s;
        }
        __syncthreads();
    }
}

__device__ __forceinline__ void transpose_item(const float* Wsrc, int K, int N, bf16* WT, int kb, int n0, int drow0, LAS float* scr, int lane) {
    const int k0 = 64 * kb;
#pragma unroll 8
    for (int i = 0; i < 32; ++i) { const int kk = 2 * i + (lane >> 5); scr[kk * 33 + (lane & 31)] = Wsrc[(size_t)(k0 + kk) * N + n0 + (lane & 31)]; }
    asm volatile("s_waitcnt lgkmcnt(0)" ::: "memory");
    const int c = lane & 7;
#pragma unroll
    for (int j = 0; j < 4; ++j) { const int n = (lane >> 3) + 8 * j; const LAS float* s = scr + (8 * c) * 33 + n;
        v4u o; o.x = pk2(s[0 * 33], s[1 * 33]); o.y = pk2(s[2 * 33], s[3 * 33]); o.z = pk2(s[4 * 33], s[5 * 33]); o.w = pk2(s[6 * 33], s[7 * 33]);
        *(v4u*)(WT + (size_t)(drow0 + n) * K + k0 + 8 * c) = o; }
    asm volatile("s_waitcnt lgkmcnt(0)" ::: "memory");
}
__device__ __forceinline__ int gu_drow(int n0) { return n0 < DFF ? 256 * (n0 >> 7) + (n0 & 127) : 256 * ((n0 - DFF) >> 7) + 128 + ((n0 - DFF) & 127); }
__device__ __forceinline__ void convert_phase(const int bx, const int G, CArgsP A, const WS& W, int l, LAS unsigned char* lds, int lane, int wave) {
    LAS float* scr = (LAS float*)(lds + wave * 16384);
    const int gw = bx * NWAVES + wave, NGW = G * NWAVES;
    constexpr int I_GU = (D / 64) * (2 * DFF / 32), I_DN = (DFF / 64) * (D / 32), I_IN = (D / 64) * (INC / 32), I_OUT = (D / 64) * (D / 32);
    constexpr int NITEMS = 2 * I_GU + 2 * I_DN + I_IN + I_OUT;
    for (int it = gw; it < NITEMS; it += NGW) {
        int r = it;
        if (r < I_GU) { const int nblk = 2 * DFF / 32, kb = r / nblk, n0 = (r % nblk) * 32; transpose_item(A->in[I_WGU1] + (size_t)l * D * 2 * DFF, D, 2 * DFF, W.wt + WT_GU1, kb, n0, gu_drow(n0), scr, lane); continue; } r -= I_GU;
        if (r < I_GU) { const int nblk = 2 * DFF / 32, kb = r / nblk, n0 = (r % nblk) * 32; transpose_item(A->in[I_WGU2] + (size_t)l * D * 2 * DFF, D, 2 * DFF, W.wt + WT_GU2, kb, n0, gu_drow(n0), scr, lane); continue; } r -= I_GU;
        if (r < I_DN) { const int nblk = D / 32, kb = r / nblk, n0 = (r % nblk) * 32; transpose_item(A->in[I_WDOWN1] + (size_t)l * DFF * D, DFF, D, W.wt + WT_DOWN1, kb, n0, n0, scr, lane); continue; } r -= I_DN;
        if (r < I_DN) { const int nblk = D / 32, kb = r / nblk, n0 = (r % nblk) * 32; transpose_item(A->in[I_WDOWN2] + (size_t)l * DFF * D, DFF, D, W.wt + WT_DOWN2, kb, n0, n0, scr, lane); continue; } r -= I_DN;
        if (r < I_IN) { const int nblk = INC / 32, kb = r / nblk, n0 = (r % nblk) * 32; transpose_item(A->in[I_WIN] + (size_t)l * D * INC, D, INC, W.wt + WT_IN, kb, n0, n0, scr, lane); continue; } r -= I_IN;
        { const int nblk = D / 32, kb = r / nblk, n0 = (r % nblk) * 32; transpose_item(A->in[I_WOUT] + (size_t)l * D * D, D, D, W.wt + WT_OUT, kb, n0, n0, scr, lane); }
    }
}

__device__ __forceinline__ void norm_phase(const int bx, const int G, const float* lat, const float* ctxp, const float* g, const float* mods_l, int ishift, int iscale, bf16* H, int nrows, int lane, int wave) {
    const int gw = bx * NWAVES + wave, NGW = G * NWAVES;
    for (int r = gw; r < nrows; r += NGW) {
        const float* xr = r < MLAT ? lat + (size_t)r * D : ctxp + (size_t)(r - MLAT) * D;
        const int b = r < MLAT ? (r >> 12) : 8;
        const float* sh = mods_l + (size_t)b * 9216 + ishift * 1024; const float* sc = mods_l + (size_t)b * 9216 + iscale * 1024;
        f32x4 v[4]; float s = 0.f;
#pragma unroll
        for (int j = 0; j < 4; ++j) { v[j] = *(const f32x4*)(xr + (lane + 64 * j) * 4); s += (v[j].x * v[j].x + v[j].y * v[j].y) + (v[j].z * v[j].z + v[j].w * v[j].w); }
        s = wave_sum(s);
        const float rstd = rsqrtf(s * (1.0f / D) + 1e-6f);
#pragma unroll
        for (int j = 0; j < 4; ++j) {
            const int col = (lane + 64 * j) * 4;
            const f32x4 gg = *(const f32x4*)(g + col), s4 = *(const f32x4*)(sh + col), c4 = *(const f32x4*)(sc + col);
            const f32x4 h = (v[j] * rstd) * gg * (c4 + 1.0f) + s4;
            v2u o; o.x = pk2(h.x, h.y); o.y = pk2(h.z, h.w);
            *(v2u*)(H + (size_t)r * D + col) = o;
        }
    }
}
__device__ __forceinline__ void final_norm_phase(const int bx, const int G, float* xo, const float* g, int lane, int wave) {
    const int gw = bx * NWAVES + wave, NGW = G * NWAVES;
    for (int r = gw; r < MLAT; r += NGW) {
        float* xr = xo + (size_t)r * D;
        f32x4 v[4]; float s = 0.f;
#pragma unroll
        for (int j = 0; j < 4; ++j) { v[j] = *(const f32x4*)(xr + (lane + 64 * j) * 4); s += (v[j].x * v[j].x + v[j].y * v[j].y) + (v[j].z * v[j].z + v[j].w * v[j].w); }
        s = wave_sum(s);
        const float rstd = rsqrtf(s * (1.0f / D) + 1e-6f);
#pragma unroll
        for (int j = 0; j < 4; ++j) { const int col = (lane + 64 * j) * 4; const f32x4 gg = *(const f32x4*)(g + col); *(f32x4*)(xr + col) = (v[j] * rstd) * gg; }
    }
}

__device__ __forceinline__ void pre_phase(const int bx, const int G, CArgsP A, const WS& W, int l, LAS unsigned char* lds, int tid, int lane, int wave) {
    LAS float* k_s = (LAS float*)lds;
    LAS float* kk_s = k_s + 16 * 384;
    LAS float* lw = kk_s + 16 * 384;
    LAS float* la = lw + 16 * 64;
    const int odd = l & 1;
    const float* mu0 = A->in[I_MU] + (size_t)l * 2 * RC; const float* mu1 = mu0 + RC;
    const float* kkp = A->in[I_KK] + l * RW; const float* kap = A->in[I_KA] + l * RW;
    for (int tile = bx; tile < NB * (QLEN / 16); tile += G) {
        const int b = tile / (QLEN / 16), q0 = (tile % (QLEN / 16)) * 16;
        const int seq_lo = q0 < CTX ? 0 : CTX, seq_hi = q0 < CTX ? CTX : QLEN;
        for (int it = tid; it < 16 * 176; it += NTHR) {
            const int i = it / 176, col = (it % 176) * 8, q = q0 + i;
            const size_t pos = (size_t)b * QLEN + q;
            float cur[8], prv[8], nxt[8], ps[8];
            unpack8(*(const v4u*)(W.P + (size_t)row_of(b, q, odd) * INCP + PC_RW + col), cur);
            if (q - 1 >= seq_lo) unpack8(*(const v4u*)(W.P + (size_t)row_of(b, q - 1, odd) * INCP + PC_RW + col), prv);
            else {
#pragma unroll
                for (int e = 0; e < 8; ++e) prv[e] = 0.f; }
            if (q + 1 < seq_hi) unpack8(*(const v4u*)(W.P + (size_t)row_of(b, q + 1, odd) * INCP + PC_RW + col), nxt);
            else {
#pragma unroll
                for (int e = 0; e < 8; ++e) nxt[e] = 0.f; }
#pragma unroll
            for (int e = 0; e < 8; ++e) ps[e] = cur[e] + mu0[col + e] * (prv[e] - cur[e]) + mu1[col + e] * (nxt[e] - cur[e]);
            if (col < 384) *(v4u*)(W.sc_r + pos * RW + col) = pack8(ps);
            else if (col < 768) {
#pragma unroll
                for (int e = 0; e < 8; ++e) k_s[i * 384 + col - 384 + e] = ps[e]; }
            else if (col < 1152) *(v4u*)(W.sc_v + pos * RW + (col - 768)) = pack8(ps);
            else if (col < 1216) {
#pragma unroll
                for (int e = 0; e < 8; ++e) lw[i * 64 + col - 1152 + e] = tanhf(ps[e]); }
            else if (col < 1280) {
#pragma unroll
                for (int e = 0; e < 8; ++e) la[i * 64 + col - 1216 + e] = ps[e]; }
            else *(v4u*)(W.dgs + pos * 128 + (col - 1280)) = pack8(ps);
        }
        __syncthreads();
        for (int it = wave; it < 96; it += NWAVES) {
            const int i = it / 6, h = it % 6, c = h * 64 + lane;
            const float val = k_s[i * 384 + c] * kkp[c];
            const float ss = wave_sum(val * val);
            const float kk = val * rsqrtf(ss + 1e-12f);
            kk_s[i * 384 + c] = kk;
            W.sc_kk[((size_t)b * QLEN + q0 + i) * RW + c] = (bf16)f2bf(kk);
        }
        __syncthreads();
        for (int itc = 0; itc < 3; ++itc) {
            const int item = tid + NTHR * itc, c = item % 384, rest = item / 384, d = rest & 1, tg = rest >> 1;
            const float* W2 = A->in[I_W2] + ((size_t)(l * 2 + d) * 64) * RW + c;
            const float* A2 = A->in[I_A2] + ((size_t)(l * 2 + d) * 64) * RW + c;
            float accw[8], acca[8];
#pragma unroll
            for (int t = 0; t < 8; ++t) { accw[t] = 0.f; acca[t] = 0.f; }
#pragma unroll 2
            for (int k4 = 0; k4 < 16; ++k4) {
                float w2v[4], a2v[4];
#pragma unroll
                for (int e = 0; e < 4; ++e) { w2v[e] = W2[(size_t)(k4 * 4 + e) * RW]; a2v[e] = A2[(size_t)(k4 * 4 + e) * RW]; }
#pragma unroll
                for (int t = 0; t < 8; ++t) {
                    const f32x4 x = *(const LAS f32x4*)(lw + (tg * 8 + t) * 64 + k4 * 4);
                    const f32x4 y = *(const LAS f32x4*)(la + (tg * 8 + t) * 64 + k4 * 4);
                    accw[t] += x.x * w2v[0] + x.y * w2v[1] + x.z * w2v[2] + x.w * w2v[3];
                    acca[t] += y.x * a2v[0] + y.y * a2v[1] + y.z * a2v[2] + y.w * a2v[3];
                }
            }
            const float w0v = A->in[I_W0][(l * 2 + d) * RW + c], a0v = A->in[I_A0][(l * 2 + d) * RW + c], kav = kap[c];
#pragma unroll
            for (int t = 0; t < 8; ++t) {
                const int i = tg * 8 + t; const size_t pos = (size_t)b * QLEN + q0 + i;
                const float wl = w0v + accw[t];
                const float w_log = -softplusf_(-wl) - 0.5f;
                const float omw = -expm1f(-__expf(w_log));
                const float a = sigmoidf_(a0v + acca[t]);
                const float kv = k_s[i * 384 + c];
                const float kd = kv * (1.0f + (a - 1.0f) * kav);
                const float bb = kk_s[i * 384 + c] * a;
                (W.scb + (size_t)(7 + d) * SC_ELEMS)[pos * RW + c] = (bf16)f2bf(omw);
                (W.scb + (size_t)(3 + d) * SC_ELEMS)[pos * RW + c] = (bf16)f2bf(kd);
                (W.scb + (size_t)(5 + d) * SC_ELEMS)[pos * RW + c] = (bf16)f2bf(bb);
            }
        }
        __syncthreads();
    }
}
__device__ __forceinline__ int q_of_step(int n, int d) { return d == 0 ? n : (n < CTX ? CTX - 1 - n : QLEN + CTX - 1 - n); }
constexpr int RCH = 32, RNCH = QLEN / RCH;
__device__ __forceinline__ void rwkv_scan_phase(const WS& W, int l, int blk, LAS unsigned char* lds, int tid, int lane, int wave) {
    const int b = blk / 12, rem = blk % 12, h = rem >> 1, d = rem & 1, odd = l & 1;
    LAS float* buf = (LAS float*)lds;
    LAS float* ybuf = buf + 2 * RCH * 384;
    const bf16* s_omw = W.scb + (size_t)(7 + d) * SC_ELEMS; const bf16* s_b = W.scb + (size_t)(5 + d) * SC_ELEMS; const bf16* s_kd = W.scb + (size_t)(3 + d) * SC_ELEMS;
    const int rg = lane >> 3, j = lane & 7, row = wave * 8 + rg;
    v4u pre[3];
#define RW_LOAD(c) do { _Pragma("unroll") for (int jj = 0; jj < 3; ++jj) { const int p = tid + NTHR * jj, i = p / 48, r48 = p % 48, vec = r48 >> 3, part = r48 & 7; \
        const int q = q_of_step((c) * RCH + i, d); const size_t pos = (size_t)b * QLEN + q; \
        const bf16* base = vec == 0 ? s_omw : vec == 1 ? s_b : vec == 2 ? s_kd : vec == 3 ? W.sc_kk : vec == 4 ? W.sc_r : W.sc_v; \
        pre[jj] = *(const v4u*)(base + pos * RW + h * 64 + part * 8); } } while (0)
#define RW_STORE(c) do { _Pragma("unroll") for (int jj = 0; jj < 3; ++jj) { const int p = tid + NTHR * jj, i = p / 48, r48 = p % 48, vec = r48 >> 3, part = r48 & 7; \
        float f[8]; unpack8(pre[jj], f); if (vec == 0) { _Pragma("unroll") for (int e = 0; e < 8; ++e) f[e] = 1.0f - f[e]; } \
        LAS float* dst = buf + (((c) & 1) * RCH + i) * 384 + vec * 64 + part * 8; \
        *(LAS f32x4*)dst = (f32x4){f[0], f[1], f[2], f[3]}; *(LAS f32x4*)(dst + 4) = (f32x4){f[4], f[5], f[6], f[7]}; } } while (0)
    f32x2 S[4];
#pragma unroll
    for (int e = 0; e < 4; ++e) S[e] = (f32x2){0.f, 0.f};
    RW_LOAD(0); RW_STORE(0);
    __syncthreads();
    for (int c = 0; c < RNCH; ++c) {
        if (c + 1 < RNCH) RW_LOAD(c + 1);
        const LAS float* cur = buf + (c & 1) * RCH * 384;
#pragma unroll 4
        for (int i = 0; i < RCH; ++i) {
            const LAS f32x4* bp = (const LAS f32x4*)(cur + i * 384 + j * 8);
            const f32x4 w0 = bp[0], w1 = bp[1], b0 = bp[16], b1 = bp[17], d0 = bp[32], d1 = bp[33], k0 = bp[48], k1 = bp[49], r0 = bp[64], r1 = bp[65];
            const float vv = cur[i * 384 + 320 + row];
            f32x2 t0 = S[0] * (f32x2){k0.x, k0.y} + S[1] * (f32x2){k0.z, k0.w};
            f32x2 t1 = S[2] * (f32x2){k1.x, k1.y} + S[3] * (f32x2){k1.z, k1.w};
            t0 = t0 + t1;
            const float sa = -reduce8(t0.x + t0.y);
            const f32x2 vv2 = (f32x2){vv, vv}, sa2 = (f32x2){sa, sa};
            S[0] = S[0] * (f32x2){w0.x, w0.y} + vv2 * (f32x2){d0.x, d0.y} + sa2 * (f32x2){b0.x, b0.y};
            S[1] = S[1] * (f32x2){w0.z, w0.w} + vv2 * (f32x2){d0.z, d0.w} + sa2 * (f32x2){b0.z, b0.w};
            S[2] = S[2] * (f32x2){w1.x, w1.y} + vv2 * (f32x2){d1.x, d1.y} + sa2 * (f32x2){b1.x, b1.y};
            S[3] = S[3] * (f32x2){w1.z, w1.w} + vv2 * (f32x2){d1.z, d1.w} + sa2 * (f32x2){b1.z, b1.w};
            f32x2 y0 = S[0] * (f32x2){r0.x, r0.y} + S[1] * (f32x2){r0.z, r0.w};
            f32x2 y1 = S[2] * (f32x2){r1.x, r1.y} + S[3] * (f32x2){r1.z, r1.w};
            y0 = y0 + y1;
            const float yv = reduce8(y0.x + y0.y);
            if (j == 0) ybuf[i * 64 + row] = yv;
        }
        __syncthreads();
        {
            const int i = tid >> 4, r4 = (tid & 15) * 4;
            const int q = q_of_step(c * RCH + i, d);
            const f32x4 yv = *(const LAS f32x4*)(ybuf + i * 64 + r4);
            v2u o; o.x = pk2(yv.x, yv.y); o.y = pk2(yv.z, yv.w);
            *(v2u*)(W.P + (size_t)row_of(b, q, odd) * INCP + PC_Y + d * RW + h * 64 + r4) = o;
        }
        if (c + 1 < RNCH) RW_STORE(c + 1);
        __syncthreads();
    }
#undef RW_LOAD
#undef RW_STORE
}

__device__ __forceinline__ void lru_scan_phase(CArgsP A, const WS& W, int l, int idx, LAS unsigned char* lds, int tid, int lane, int wave) {
    const int b = idx / 12, rem = idx % 12, n = rem >> 1, d = rem & 1, odd = l & 1;
    LAS float* xs = (LAS float*)lds;
    LAS float* us = xs + 68 * 64;
    LAS float* gs = us + 64 * 64;
    const int c = tid & 63;
    float cw[4];
#pragma unroll
    for (int jj = 0; jj < 4; ++jj) cw[jj] = A->in[I_LCW][((size_t)(l * 2 + d) * 4 + jj) * LW + n * 64 + c];
    const float cb = A->in[I_LCB][(l * 2 + d) * LW + n * 64 + c];
    const float sp = softplusf_(-A->in[I_LAM][(l * 2 + d) * LW + n * 64 + c]);
    const int cgi = tid & 127, jcol = cgi & 63, g = cgi >> 6, tg = tid >> 7;
    const float* Wsrc = (g ? A->in[I_LWI] : A->in[I_LWR]) + ((size_t)((l * 2 + d) * 6 + n) * 64) * 64 + jcol;
    float Wg[64];
#pragma unroll
    for (int i = 0; i < 64; ++i) Wg[i] = Wsrc[i * 64];
    const float gbias = (g ? A->in[I_LBI] : A->in[I_LBR])[(l * 2 + d) * LW + n * 64 + jcol];
    float hstate = 0.f;
    v4u pre[2];
#define LRU_LOAD(ch) do { const int n0 = (ch) * 64; const int qlo_ = d == 0 ? n0 : q_of_step(n0, 1) - 63; const int qb_ = d == 0 ? qlo_ - 3 : qlo_; \
        const int slo_ = qlo_ < CTX ? 0 : CTX, shi_ = qlo_ < CTX ? CTX : QLEN; \
        _Pragma("unroll") for (int jj = 0; jj < 2; ++jj) { const int p = tid + NTHR * jj; const int t = p >> 3, part = p & 7, q = qb_ + t; \
            pre[jj] = (v4u){0u, 0u, 0u, 0u}; \
            if (t < 67 && q >= slo_ && q < shi_) pre[jj] = *(const v4u*)(W.P + (size_t)row_of(b, q, odd) * INCP + PC_XR + n * 64 + part * 8); } } while (0)
    LRU_LOAD(0);
    for (int ch = 0; ch < QLEN / 64; ++ch) {
        const int n0 = ch * 64; const int qlo = d == 0 ? n0 : q_of_step(n0, 1) - 63;
#pragma unroll
        for (int jj = 0; jj < 2; ++jj) { const int p = tid + NTHR * jj; const int t = p >> 3, part = p & 7;
            if (t < 67) { float f[8]; unpack8(pre[jj], f); LAS float* dst = xs + t * 64 + part * 8;
                *(LAS f32x4*)dst = (f32x4){f[0], f[1], f[2], f[3]}; *(LAS f32x4*)(dst + 4) = (f32x4){f[4], f[5], f[6], f[7]}; } }
        __syncthreads();
        if (ch + 1 < QLEN / 64) LRU_LOAD(ch + 1);
#pragma unroll
        for (int k = 0; k < 8; ++k) { const int t = (tid >> 6) + 8 * k;
            us[t * 64 + c] = cb + cw[0] * xs[t * 64 + c] + cw[1] * xs[(t + 1) * 64 + c] + cw[2] * xs[(t + 2) * 64 + c] + cw[3] * xs[(t + 3) * 64 + c]; }
        __syncthreads();
        {
            float acc[16];
#pragma unroll
            for (int t = 0; t < 16; ++t) acc[t] = gbias;
#pragma unroll
            for (int i4 = 0; i4 < 16; ++i4)
#pragma unroll
                for (int t = 0; t < 16; ++t) { const f32x4 u4 = *(const LAS f32x4*)(us + (tg * 16 + t) * 64 + i4 * 4);
                    acc[t] += u4.x * Wg[i4 * 4] + u4.y * Wg[i4 * 4 + 1] + u4.z * Wg[i4 * 4 + 2] + u4.w * Wg[i4 * 4 + 3]; }
#pragma unroll
            for (int t = 0; t < 16; ++t) gs[(g * 64 + tg * 16 + t) * 64 + jcol] = sigmoidf_(acc[t]);
        }
        __syncthreads();
#pragma unroll
        for (int k = 0; k < 8; ++k) { const int t = (tid >> 6) + 8 * k;
            const float rgv = gs[t * 64 + c], igv = gs[(64 + t) * 64 + c], u = us[t * 64 + c];
            const float log_a = -8.0f * sp * rgv;
            const float a = __expf(log_a);
            const float bt = sqrtf(-expm1f(2.0f * log_a)) * (igv * u);
            gs[t * 64 + c] = a; gs[(64 + t) * 64 + c] = bt; }
        __syncthreads();
        if (wave == 0) {
#pragma unroll 8
            for (int s = 0; s < 64; ++s) { const int t = d == 0 ? s : 63 - s;
                hstate = gs[t * 64 + lane] * hstate + gs[(64 + t) * 64 + lane];
                W.H[(size_t)row_of(b, qlo + t, odd) * D + d * LW + n * 64 + lane] = (bf16)f2bf(hstate); }
        }
        __syncthreads();
    }
#undef LRU_LOAD
}

__device__ __forceinline__ void post_phase(const int bx, const int G, CArgsP A, const WS& W, int l, LAS unsigned char* lds, int tid, int lane, int wave) {
    LAS float* hs = (LAS float*)lds;
    LAS float* sg = hs + 16 * 384;
    LAS float* g_s = sg + 16 * 128;
    const int odd = l & 1;
    const float* cwa = A->in[I_CONVA] + (size_t)l * 3 * 256;
    const float* g2 = A->in[I_G2] + (size_t)l * 128 * RW;
    const float* rk = A->in[I_RK] + l * RW; const float* lng = A->in[I_LNG] + l * RW; const float* lnb = A->in[I_LNB] + l * RW;
    bf16* Y = W.H;
    for (int tile = bx; tile < NB * (QLEN / 16); tile += G) {
        const int b = tile / (QLEN / 16), q0 = (tile % (QLEN / 16)) * 16;
        for (int it = tid; it < 16 * 48; it += NTHR) { const int i = it / 48, col = (it % 48) * 8; const size_t row = row_of(b, q0 + i, odd);
            float h0[8], h1[8]; unpack8(*(const v4u*)(W.H + row * D + col), h0); unpack8(*(const v4u*)(W.H + row * D + LW + col), h1);
#pragma unroll
            for (int e = 0; e < 8; ++e) hs[i * 384 + col + e] = h0[e] + h1[e]; }
        for (int it = tid; it < 16 * 16; it += NTHR) { const int i = it >> 4, col = (it & 15) * 8; float f[8]; unpack8(*(const v4u*)(W.dgs + ((size_t)b * QLEN + q0 + i) * 128 + col), f);
#pragma unroll
            for (int e = 0; e < 8; ++e) sg[i * 128 + col + e] = sigmoidf_(f[e]); }
        __syncthreads();
        for (int item = tid; item < 768; item += NTHR) { const int c = item % 384, tg = item / 384;
            float acc[8];
#pragma unroll
            for (int t = 0; t < 8; ++t) acc[t] = 0.f;
#pragma unroll 2
            for (int k4 = 0; k4 < 32; ++k4) { float gv[4];
#pragma unroll
                for (int e = 0; e < 4; ++e) gv[e] = g2[(size_t)(k4 * 4 + e) * RW + c];
#pragma unroll
                for (int t = 0; t < 8; ++t) { const f32x4 x = *(const LAS f32x4*)(sg + (tg * 8 + t) * 128 + k4 * 4); acc[t] += x.x * gv[0] + x.y * gv[1] + x.z * gv[2] + x.w * gv[3]; } }
#pragma unroll
            for (int t = 0; t < 8; ++t) g_s[(tg * 8 + t) * 384 + c] = acc[t]; }
        __syncthreads();
        for (int it = tid; it < 16 * 32; it += NTHR) { const int i = it >> 5, col = (it & 31) * 8, q = q0 + i;
            int lo, hi; if (q < CTX) { lo = 0; hi = CTX; } else { lo = CTX + ((q - CTX) & ~63); hi = lo + 64; }
            const size_t row = row_of(b, q, odd);
            float bg[8], cgv[8], xv[8], y[8];
            unpack8(*(const v4u*)(W.P + row * INCP + PC_BG + col), bg); unpack8(*(const v4u*)(W.P + row * INCP + PC_CG + col), cgv); unpack8(*(const v4u*)(W.P + row * INCP + PC_XIN + col), xv);
#pragma unroll
            for (int e = 0; e < 8; ++e) y[e] = cwa[256 + col + e] * (cgv[e] * xv[e]);
            if (q - 1 >= lo) { const size_t r2 = row_of(b, q - 1, odd); unpack8(*(const v4u*)(W.P + r2 * INCP + PC_CG + col), cgv); unpack8(*(const v4u*)(W.P + r2 * INCP + PC_XIN + col), xv);
#pragma unroll
                for (int e = 0; e < 8; ++e) y[e] += cwa[col + e] * (cgv[e] * xv[e]); }
            if (q + 1 < hi) { const size_t r2 = row_of(b, q + 1, odd); unpack8(*(const v4u*)(W.P + r2 * INCP + PC_CG + col), cgv); unpack8(*(const v4u*)(W.P + r2 * INCP + PC_XIN + col), xv);
#pragma unroll
                for (int e = 0; e < 8; ++e) y[e] += cwa[512 + col + e] * (cgv[e] * xv[e]); }
#pragma unroll
            for (int e = 0; e < 8; ++e) y[e] *= bg[e];
            *(v4u*)(Y + row * D + col) = pack8(y); }
        for (int it = wave; it < 96; it += NWAVES) { const int i = it / 6, h = it % 6, c = h * 64 + lane, q = q0 + i;
            const size_t row = row_of(b, q, odd), pos = (size_t)b * QLEN + q;
            const float ys = bf2f(W.P[row * INCP + PC_Y + c]) + bf2f(W.P[row * INCP + PC_Y + RW + c]);
            const float mean = wave_sum(ys) * (1.0f / 64.0f); const float dv = ys - mean;
            const float var = wave_sum(dv * dv) * (1.0f / 64.0f);
            const float gn = dv * rsqrtf(var + 64e-5f) * lng[c] + lnb[c];
            const float r = bf2f(W.sc_r[pos * RW + c]), v = bf2f(W.sc_v[pos * RW + c]);
            const float kd = bf2f((W.scb + (size_t)3 * SC_ELEMS)[pos * RW + c]) + bf2f((W.scb + (size_t)4 * SC_ELEMS)[pos * RW + c]);
            const float bon = wave_sum(r * kd * rk[c]);
            Y[row * D + 256 + c] = (bf16)f2bf((gn + bon * v) * g_s[i * 384 + c]); }
        for (int it = tid; it < 16 * 48; it += NTHR) { const int i = it / 48, col = (it % 48) * 8; const size_t row = row_of(b, q0 + i, odd);
            float gr[8], o[8]; unpack8(*(const v4u*)(W.P + row * INCP + PC_GR + col), gr);
#pragma unroll
            for (int e = 0; e < 8; ++e) o[e] = gelu_tanh(gr[e]) * hs[i * 384 + col + e];
            *(v4u*)(Y + row * D + 640 + col) = pack8(o); }
        __syncthreads();
    }
}

constexpr int PH_PER_LAYER = 12, N_PHASES = 1 + DEPTH * PH_PER_LAYER + 1;
__global__ void __launch_bounds__(NTHR, 2) fwd_megakernel(Args A0) {
    extern __shared__ __attribute__((aligned(16))) unsigned char lds_raw[];
    LAS unsigned char* lds = (LAS unsigned char*)lds_raw;
    cg::grid_group grid = cg::this_grid();
    const int ph_lo = A0.ph_lo, ph_hi = A0.ph_hi;
    const int wave0 = __builtin_amdgcn_readfirstlane((int)threadIdx.x >> 6);
    for (int ph = ph_lo; ph < ph_hi; ++ph) {
        CArgsP A = (CArgsP)__builtin_amdgcn_kernarg_segment_ptr();
        asm volatile("" : "+s"(A) :: "memory");
        int G = gridDim.x, bx = blockIdx.x, wave = wave0, lane;
        asm volatile("v_mbcnt_lo_u32_b32 %0, -1, 0\n\tv_mbcnt_hi_u32_b32 %0, -1, %0" : "=v"(lane));
        asm volatile("" : "+s"(G), "+s"(bx), "+s"(wave));
        const int tid = wave * 64 + lane;
        const WS W = make_ws(A->ws);
        if (ph == 0) { mods_phase(bx, G, A, W, lds, tid, lane, wave); convert_phase(bx, G, A, W, 0, lds, lane, wave); }
        else if (ph == N_PHASES - 1) final_norm_phase(bx, G, A->out, A->in[I_GFINAL], lane, wave);
        else {
            const int l = (ph - 1) / PH_PER_LAYER, s = (ph - 1) % PH_PER_LAYER; const bool last = (l == DEPTH - 1);
            const float* mods_l = W.mods + (size_t)l * 9 * 9216;
            const float* xlat = A->out; const float* xctx = W.xrctx;
            if (s == 0) {
                if (l > 0) convert_phase(bx, G, A, W, l, lds, lane, wave);
                norm_phase(bx, G, l == 0 ? A->in[I_X] : xlat, l == 0 ? A->in[I_CTX] : xctx, A->in[I_GFFN1] + l * D, mods_l, 0, 1, W.H, MTOT, lane, wave);
            } else if (s == 1 || s == 10) {
                pg8::Gemm g{W.H, W.wt + (s == 1 ? WT_GU1 : WT_GU2), (s == 10 && last) ? MLAT : MTOT, 2 * DFF, D}; pg8::StaticOrder S; S.init(g.M, g.N, G, bx);
                EpiSwiGLU E{W.ACT};
                pg8::gemm_phase<EpiSwiGLU, pg8::StaticOrder, true, true>(lds, g, S, E, tid);
            } else if (s == 2 || s == 8 || s == 11) {
                pg8::Gemm g{s == 8 ? W.H : W.ACT, W.wt + (s == 2 ? WT_DOWN1 : s == 8 ? WT_OUT : WT_DOWN2), (s != 2 && last) ? MLAT : MTOT, D, s == 8 ? D : DFF};
                pg8::StaticOrder S; S.init(g.M, g.N, G, bx);
                const bool first = (l == 0 && s == 2);
                EpiResid E{first ? A->in[I_X] : xlat, first ? A->in[I_CTX] : xctx, A->out, W.xrctx, mods_l + (s == 2 ? 2 : s == 8 ? 5 : 8) * 1024, s == 8 ? 1.0f : 0.5f};
                pg8::gemm_phase<EpiResid, pg8::StaticOrder, true, true>(lds, g, S, E, tid);
            } else if (s == 3) {
                norm_phase(bx, G, xlat, xctx, A->in[I_GMIX] + l * D, mods_l, 3, 4, W.H, MTOT, lane, wave);
            } else if (s == 4) {
                pg8::Gemm g{W.H, W.wt + WT_IN, MTOT, INCP, D}; pg8::StaticOrder S; S.init(g.M, g.N, G, bx);
                EpiP E{W.P, INCP};
                pg8::gemm_phase<EpiP, pg8::StaticOrder, true, true>(lds, g, S, E, tid);
            } else if (s == 5) {
                pre_phase(bx, G, A, W, l, lds, tid, lane, wave);
            } else if (s == 6) {
                for (int u = bx; u < 192; u += G) {
                    if (u < 96) rwkv_scan_phase(W, l, u, lds, tid, lane, wave); else lru_scan_phase(A, W, l, u - 96, lds, tid, lane, wave);
                    __syncthreads();
                }
            } else if (s == 7) {
                post_phase(bx, G, A, W, l, lds, tid, lane, wave);
            } else if (s == 9) {
                norm_phase(bx, G, xlat, xctx, A->in[I_GFFN2] + l * D, mods_l, 6, 7, W.H, last ? MLAT : MTOT, lane, wave);
            }
        }
        if (ph + 1 < ph_hi) grid.sync();
    }
}

#ifndef MK_MULTI
#define MK_MULTI 0
#endif
extern "C" void kernel_launch(void* const* d_in, const int* in_sizes, int n_in, void* d_out, int out_size, void* d_ws, size_t ws_size, hipStream_t stream) {
    static int grid = 0;
    if (grid == 0) {
        if (n_in != N_IN || out_size != MLAT * D || ws_size < WS_END) { fprintf(stderr, "kernel_launch: unexpected shapes (n_in %d out %d ws %zu)\n", n_in, out_size, ws_size); grid = -1; return; }
        int dev = 0, cus = 0, per_cu = 0;
        (void)hipGetDevice(&dev); (void)hipDeviceGetAttribute(&cus, hipDeviceAttributeMultiprocessorCount, dev);
        if (hipFuncSetAttribute((const void*)fwd_megakernel, hipFuncAttributeMaxDynamicSharedMemorySize, LDS_BYTES) != hipSuccess) { fprintf(stderr, "kernel_launch: hipFuncSetAttribute failed\n"); grid = -1; return; }
        if (hipOccupancyMaxActiveBlocksPerMultiprocessor(&per_cu, (const void*)fwd_megakernel, NTHR, LDS_BYTES) != hipSuccess || per_cu < 1) { fprintf(stderr, "kernel_launch: occupancy query says %d\n", per_cu); per_cu = 1; }
        (void)hipGetLastError();
        grid = cus * 1;
        if (grid <= 0) grid = 256;
    }
    if (grid < 0) return;
    Args a{};
    for (int i = 0; i < N_IN; ++i) a.in[i] = (const float*)d_in[i];
    a.out = (float*)d_out; a.ws = (unsigned char*)d_ws;
#if MK_MULTI
    for (int ph = 0; ph < N_PHASES; ++ph) { a.ph_lo = ph; a.ph_hi = ph + 1; hipLaunchKernelGGL(fwd_megakernel, dim3(grid), dim3(NTHR), LDS_BYTES, stream, a); }
#else
    a.ph_lo = 0; a.ph_hi = N_PHASES;
    void* args[] = {&a};
    hipError_t e = hipLaunchCooperativeKernel((const void*)fwd_megakernel, dim3(grid), dim3(NTHR), args, LDS_BYTES, stream);
    if (e != hipSuccess) fprintf(stderr, "kernel_launch: cooperative launch failed: %s (grid %d)\n", hipGetErrorString(e), grid);
#endif
}
```

```cpp
#include <hip/hip_runtime.h>
#include <hip/hip_cooperative_groups.h>
#include <cstdio>
#include <cstdint>
namespace cg = cooperative_groups;
namespace pg8 {
#define PG8_LAS __attribute__((address_space(3)))
typedef unsigned short bf16_t;
typedef short bf16x8 __attribute__((ext_vector_type(8)));
typedef float f32x4 __attribute__((ext_vector_type(4)));
typedef unsigned u32x4 __attribute__((ext_vector_type(4)));
constexpr int BM = 256, BK = 64, HALF = 128, HTB = HALF * BK * 2  , STAGE_BYTES = 8 * HTB, NXCD = 8, WGM = 8;

__host__ __device__ __forceinline__ int lds_byte(int r, int c) { const int st = (r >> 4) * 2 + (c >> 5), rr = r & 15, cc = c & 31, ob = rr * 64 + cc * 2; return st * 1024 + (ob ^ (((ob >> 9) & 1) << 5)); }
__host__ __device__ __forceinline__ void stage_rc(int b, int& R, int& C) { const int st = b / 1024, sb = b % 1024, swz = sb ^ (((sb >> 9) & 1) << 5); R = (st >> 1) * 16 + swz / 64; C = (st & 1) * 32 + (swz % 64) / 2; }
__host__ __device__ __forceinline__ int perm32(int rho) { const int n = rho >> 4, i = rho & 15; return 8 * (i >> 2) + 4 * n + (i & 3); }

struct Unit { int pm, pn; };
struct Gemm { const bf16_t* A; const bf16_t* Bt; int M, N, K; };

struct StaticOrder {
    int nM, nN, nwg, G, c;
    __host__ __device__ void init(int M, int N, int G_, int c_) { nM = M / BM; nN = N / BM; nwg = nM * nN; G = G_; c = c_; }
    __host__ __device__ bool next(int i, Unit& u) const {
        const long L = (long)i * G + c; if (L >= nwg) return false;
        int wgid = (int)L; { const int q = nwg / NXCD, r = nwg % NXCD, xcd = wgid % NXCD, off = wgid / NXCD; wgid = (xcd < r ? xcd * (q + 1) : r * (q + 1) + (xcd - r) * q) + off; }
        const int nig = WGM * nN, gid = wgid / nig, fm = gid * WGM, gsz = (nM - fm) < WGM ? (nM - fm) : WGM;
        u.pm = fm + ((wgid % nig) % gsz); u.pn = (wgid % nig) / gsz; return true;
    }
    __device__ __forceinline__ void a_ready(const Unit&) const {}
    __device__ __forceinline__ void done(const Unit&) const {}
};

template <class Epi, class Sched, bool ALIGN_EPI = false, bool SP2 = false>
__device__ __forceinline__ void gemm_phase(PG8_LAS unsigned char* lds, const Gemm g, const Sched& S, const Epi& E, const int tid) {
    const int wid = __builtin_amdgcn_readfirstlane(tid >> 6), lane = tid & 63, wr = wid >> 2, wc = wid & 3, fr = lane & 15, fq = lane >> 4;
    const int K = g.K, nt = K / BK;
    unsigned voffA[2], voffB[2];
#pragma unroll
    for (int i = 0; i < 2; ++i) { int R, C; stage_rc(tid * 16 + i * 8192, R, C); const int Rb = Epi::PERM ? ((R & ~31) + perm32(R & 31)) : R;
        voffA[i] = (unsigned)(R * K + C) * 2u; voffB[i] = (unsigned)(Rb * K + C) * 2u; }
    const size_t kstep = (size_t)(BK * 2);
    const size_t hstep = (size_t)HALF * K * 2;
    const size_t tstep = 2 * hstep;
    const unsigned ldsw = (unsigned)wid * 1024u;
    const int aoff = lds_byte(wr * 64 + fr, fq * 8), boff = lds_byte(wc * 32 + fr, fq * 8);
#define PG8_SA(b, h) (((b) * 2 + (h)) * HTB)
#define PG8_SB(b, h) ((4 + (b) * 2 + (h)) * HTB)
#define PG8_STAGE(bufoff, gbase, voff) do { _Pragma("unroll") for (int _i = 0; _i < 2; ++_i) \
        __builtin_amdgcn_global_load_lds((const unsigned*)((const char*)(gbase) + (voff)[_i]), (PG8_LAS unsigned*)(lds + (bufoff) + ldsw + _i * 8192), 16, 0, 0); } while (0)
#define PG8_LDA(dst, b, h) do { _Pragma("unroll") for (int m = 0; m < 4; ++m) _Pragma("unroll") for (int k = 0; k < 2; ++k) dst[m][k] = *(const PG8_LAS bf16x8*)(lds + PG8_SA(b, h) + aoff + m * 2048 + k * 1024); } while (0)
#define PG8_LDB(dst, b, h) do { _Pragma("unroll") for (int n = 0; n < 2; ++n) _Pragma("unroll") for (int k = 0; k < 2; ++k) dst[n][k] = *(const PG8_LAS bf16x8*)(lds + PG8_SB(b, h) + boff + n * 2048 + k * 1024); } while (0)
#define PG8_MMA(ai, bj, At, Bt) do { __builtin_amdgcn_s_setprio(1); _Pragma("unroll") for (int m = 0; m < 4; ++m) _Pragma("unroll") for (int n = 0; n < 2; ++n) _Pragma("unroll") for (int k = 0; k < 2; ++k) \
        acc[ai][bj][m][n] = __builtin_amdgcn_mfma_f32_16x16x32_bf16(Bt[n][k], At[m][k], acc[ai][bj][m][n], 0, 0, 0); __builtin_amdgcn_s_setprio(0); } while (0)
#define PG8_WAIT_V(n) asm volatile("s_waitcnt vmcnt(" #n ")" ::: "memory")
#define PG8_WAIT_L(n) asm volatile("s_waitcnt lgkmcnt(" #n ")" ::: "memory")
#define PG8_BAR __builtin_amdgcn_s_barrier()
#define PG8_SCHED __builtin_amdgcn_sched_barrier(0)
    Unit cur, nxt; int ui = 0;
    if (!S.next(0, cur)) return;
    f32x4 acc[2][2][4][2];
#pragma unroll
    for (int a = 0; a < 2; ++a)
#pragma unroll
        for (int b = 0; b < 2; ++b)
#pragma unroll
            for (int m = 0; m < 4; ++m)
#pragma unroll
                for (int n = 0; n < 2; ++n) acc[a][b][m][n] = (f32x4){0.f, 0.f, 0.f, 0.f};
    bf16x8 At[4][2], B0[2][2], B1[2][2];
    const char* cA = (const char*)g.A + (size_t)cur.pm * tstep; const char* cB = (const char*)g.Bt + (size_t)cur.pn * tstep;
    S.a_ready(cur);
    if constexpr (SP2) {
        PG8_STAGE(PG8_SB(0, 0), cB, voffB); PG8_STAGE(PG8_SB(0, 1), cB + hstep, voffB); PG8_STAGE(PG8_SA(0, 0), cA, voffA); PG8_STAGE(PG8_SA(0, 1), cA + hstep, voffA);
        if (wr == 1) PG8_BAR;
        PG8_WAIT_V(2); PG8_BAR;
        PG8_STAGE(PG8_SB(1, 0), cB + kstep, voffB); PG8_STAGE(PG8_SA(1, 0), cA + kstep, voffA); PG8_STAGE(PG8_SB(1, 1), cB + hstep + kstep, voffB);
        PG8_WAIT_V(6); PG8_BAR;
    } else {
        PG8_STAGE(PG8_SB(0, 0), cB, voffB); PG8_STAGE(PG8_SA(0, 0), cA, voffA); PG8_STAGE(PG8_SB(0, 1), cB + hstep, voffB); PG8_STAGE(PG8_SA(0, 1), cA + hstep, voffA);
        if (wr == 1) PG8_BAR;
        PG8_WAIT_V(4); PG8_BAR;
        PG8_STAGE(PG8_SB(1, 0), cB + kstep, voffB); PG8_STAGE(PG8_SA(1, 0), cA + kstep, voffA); PG8_STAGE(PG8_SB(1, 1), cB + hstep + kstep, voffB);
        PG8_WAIT_V(6); PG8_BAR;
    }
    for (;;) {
        const bool has_next = S.next(ui + 1, nxt);
        const char* nA = has_next ? (const char*)g.A + (size_t)nxt.pm * tstep : cA; const char* nB = has_next ? (const char*)g.Bt + (size_t)nxt.pn * tstep : cB;
        for (int t = 0; t < nt; t += 2) {
            const bool last = (t == nt - 2);
            const char* a1 = cA + (size_t)(t + 1) * kstep;
            const char* a2 = last ? nA : cA + (size_t)(t + 2) * kstep; const char* b2 = last ? nB : cB + (size_t)(t + 2) * kstep;
            const char* a3 = a2 + kstep; const char* b3 = b2 + kstep;
            if (last && has_next) S.a_ready(nxt);
            if constexpr (SP2) {
            PG8_LDB(B0, 0, 0); PG8_LDB(B1, 0, 1); PG8_SCHED; PG8_LDA(At, 0, 0); PG8_STAGE(PG8_SA(1, 1), a1 + hstep, voffA);
            PG8_WAIT_V(8); PG8_WAIT_L(0); PG8_BAR; PG8_MMA(0, 0, At, B0); PG8_MMA(0, 1, At, B1); PG8_BAR; PG8_SCHED;
            PG8_LDA(At, 0, 1); PG8_STAGE(PG8_SB(0, 0), b2, voffB); PG8_STAGE(PG8_SB(0, 1), b2 + hstep, voffB); PG8_STAGE(PG8_SA(0, 0), a2, voffA);
            PG8_WAIT_V(8); PG8_WAIT_L(0); PG8_BAR; PG8_MMA(1, 0, At, B0); PG8_MMA(1, 1, At, B1); PG8_BAR; PG8_SCHED;
            PG8_LDB(B0, 1, 0); PG8_LDB(B1, 1, 1); PG8_SCHED; PG8_LDA(At, 1, 0); PG8_STAGE(PG8_SA(0, 1), a2 + hstep, voffA);
            PG8_WAIT_V(8); PG8_WAIT_L(0); PG8_BAR; PG8_MMA(0, 0, At, B0); PG8_MMA(0, 1, At, B1); PG8_BAR; PG8_SCHED;
            PG8_LDA(At, 1, 1); PG8_STAGE(PG8_SB(1, 0), b3, voffB); PG8_STAGE(PG8_SB(1, 1), b3 + hstep, voffB); PG8_STAGE(PG8_SA(1, 0), a3, voffA);
            PG8_WAIT_V(8); PG8_WAIT_L(0); PG8_BAR; PG8_MMA(1, 0, At, B0); PG8_MMA(1, 1, At, B1); PG8_BAR; PG8_SCHED;
            } else {
            PG8_LDB(B0, 0, 0); PG8_SCHED; PG8_LDA(At, 0, 0); PG8_STAGE(PG8_SA(1, 1), a1 + hstep, voffA);
            PG8_WAIT_L(8); PG8_BAR; PG8_WAIT_L(0); PG8_MMA(0, 0, At, B0); PG8_BAR; PG8_SCHED;
            PG8_LDB(B1, 0, 1); PG8_STAGE(PG8_SB(0, 0), b2, voffB);
            PG8_BAR; PG8_WAIT_L(0); PG8_MMA(0, 1, At, B1); PG8_BAR;
            PG8_LDA(At, 0, 1); PG8_STAGE(PG8_SA(0, 0), a2, voffA);
            PG8_BAR; PG8_WAIT_L(0); PG8_MMA(1, 0, At, B0); PG8_BAR; PG8_SCHED;
            PG8_STAGE(PG8_SB(0, 1), b2 + hstep, voffB);
            PG8_WAIT_V(6); PG8_BAR; PG8_MMA(1, 1, At, B1); PG8_BAR;
            PG8_LDB(B0, 1, 0); PG8_SCHED; PG8_LDA(At, 1, 0); PG8_STAGE(PG8_SA(0, 1), a2 + hstep, voffA);
            PG8_WAIT_L(8); PG8_BAR; PG8_WAIT_L(0); PG8_MMA(0, 0, At, B0); PG8_BAR; PG8_SCHED;
            PG8_LDB(B1, 1, 1); PG8_STAGE(PG8_SB(1, 0), b3, voffB);
            PG8_BAR; PG8_WAIT_L(0); PG8_MMA(0, 1, At, B1); PG8_BAR;
            PG8_LDA(At, 1, 1); PG8_STAGE(PG8_SA(1, 0), a3, voffA);
            PG8_BAR; PG8_WAIT_L(0); PG8_MMA(1, 0, At, B0); PG8_BAR; PG8_SCHED;
            PG8_STAGE(PG8_SB(1, 1), b3 + hstep, voffB);
            PG8_WAIT_V(6); PG8_BAR; PG8_MMA(1, 1, At, B1); PG8_BAR;
            }
        }
        if constexpr (ALIGN_EPI) { if (wr == 0) PG8_BAR; }
        if constexpr (!Epi::AFTER_DRAIN) { E(acc, cur, wr, wc, fr, fq); S.done(cur); }
        if (!has_next) break;
#pragma unroll
        for (int a = 0; a < 2; ++a)
#pragma unroll
            for (int b = 0; b < 2; ++b)
#pragma unroll
                for (int m = 0; m < 4; ++m)
#pragma unroll
                    for (int n = 0; n < 2; ++n) acc[a][b][m][n] = (f32x4){0.f, 0.f, 0.f, 0.f};
        cur = nxt; cA = nA; cB = nB; ++ui;
        if constexpr (ALIGN_EPI) { if (wr == 1) PG8_BAR; }
    }
    PG8_WAIT_V(0);
    if constexpr (!ALIGN_EPI) { if (wr == 0) PG8_BAR; }
    PG8_BAR;
    if constexpr (Epi::AFTER_DRAIN) { E.fused(acc, cur, wr, wc, fr, fq, lds, wid, lane); S.done(cur); }
#undef PG8_SA
#undef PG8_SB
#undef PG8_STAGE
#undef PG8_LDA
#undef PG8_LDB
#undef PG8_MMA
#undef PG8_WAIT_V
#undef PG8_WAIT_L
#undef PG8_BAR
#undef PG8_SCHED
}
}
#define LAS __attribute__((address_space(3)))
typedef unsigned short bf16;
typedef unsigned v4u __attribute__((ext_vector_type(4)));
typedef unsigned v2u __attribute__((ext_vector_type(2)));
typedef float f32x4 __attribute__((ext_vector_type(4)));
typedef float f32x2 __attribute__((ext_vector_type(2)));

constexpr int D = 1024, NB = 8, SEQ = 4096, CTX = 256, DEPTH = 4, DFF = 2816;
constexpr int MLAT = NB * SEQ, MCTX = NB * CTX, MTOT = MLAT + MCTX;
constexpr int INC = 2944, INCP = 3072;
constexpr int RW = 384, LW = 384, RC = 1408;
constexpr int QLEN = CTX + SEQ;
constexpr int PC_BG = 0, PC_CG = 256, PC_XIN = 512, PC_RW = 768, PC_XR = 2176, PC_GR = 2560;
constexpr int PC_Y = 768;
constexpr int PC_G = 1536;
constexpr int LORA_N = 2048, LORA_K = 256;
constexpr int NWAVES = 8, NTHR = 512;
constexpr int LDS_BYTES = 147456;

constexpr size_t MiB = 1u << 20;
constexpr size_t WS_MODS = 0, WS_XRCTX = 2 * MiB, WS_WT = 10 * MiB, WS_H = 52 * MiB, WS_A = 120 * MiB, WS_B = 324 * MiB;
constexpr size_t SC_ELEMS = (size_t)NB * QLEN * RW;
constexpr size_t WS_END = WS_B + 9 * SC_ELEMS * 2 + (size_t)NB * QLEN * 128 * 2;
static_assert(WS_END <= 600 * MiB, "workspace map");
static_assert(WS_A + (size_t)MTOT * INCP * 2 <= WS_B, "P fits");
constexpr size_t WT_GU1 = 0, WT_DOWN1 = WT_GU1 + (size_t)2 * DFF * D, WT_IN = WT_DOWN1 + (size_t)D * DFF, WT_OUT = WT_IN + (size_t)INCP * D,
                 WT_GU2 = WT_OUT + (size_t)D * D, WT_DOWN2 = WT_GU2 + (size_t)2 * DFF * D, WT_TOTAL = WT_DOWN2 + (size_t)D * DFF;
constexpr size_t WT_LORA = WT_TOTAL;
static_assert(WS_WT + (WT_TOTAL + (size_t)LORA_N * LORA_K) * 2 <= WS_H, "weights fit");
constexpr size_t HB_AP = 0, HB_KT = (size_t)MTOT * LORA_K * 2;
static_assert(HB_KT + (size_t)MTOT * RW * 2 <= WS_A - WS_H, "H region overlay");

enum { I_X = 0, I_C, I_CTX, I_CCTX, I_WMOD, I_BMOD, I_GFFN1, I_WGU1, I_WDOWN1, I_GMIX, I_WIN, I_CONVA, I_MU, I_W0, I_W2, I_A0, I_A2, I_G2, I_KK, I_KA, I_RK,
       I_LNG, I_LNB, I_LCW, I_LCB, I_LWR, I_LBR, I_LWI, I_LBI, I_LAM, I_WOUT, I_GFFN2, I_WGU2, I_WDOWN2, I_GFINAL, N_IN };

struct Args { const float* in[N_IN]; float* out; unsigned char* ws; int ph_lo, ph_hi; };
typedef const __attribute__((address_space(4))) Args* CArgsP;

__device__ __forceinline__ float bf2f(unsigned h) { return __builtin_bit_cast(float, h << 16); }
__device__ __forceinline__ unsigned f2bf(float f) { unsigned u = __builtin_bit_cast(unsigned, f); return (u + 0x7fffu + ((u >> 16) & 1u)) >> 16; }
__device__ __forceinline__ unsigned pk2(float lo, float hi) { return f2bf(lo) | (f2bf(hi) << 16); }
__device__ __forceinline__ void unpack8(v4u p, float* o) {
    o[0] = __builtin_bit_cast(float, p.x << 16); o[1] = __builtin_bit_cast(float, p.x & 0xffff0000u);
    o[2] = __builtin_bit_cast(float, p.y << 16); o[3] = __builtin_bit_cast(float, p.y & 0xffff0000u);
    o[4] = __builtin_bit_cast(float, p.z << 16); o[5] = __builtin_bit_cast(float, p.z & 0xffff0000u);
    o[6] = __builtin_bit_cast(float, p.w << 16); o[7] = __builtin_bit_cast(float, p.w & 0xffff0000u);
}
__device__ __forceinline__ v4u pack8(const float* v) { v4u o; o.x = pk2(v[0], v[1]); o.y = pk2(v[2], v[3]); o.z = pk2(v[4], v[5]); o.w = pk2(v[6], v[7]); return o; }
template <int CTRL> __device__ __forceinline__ float dppf(float v) { return __builtin_bit_cast(float, __builtin_amdgcn_update_dpp(0, __builtin_bit_cast(int, v), CTRL, 0xF, 0xF, true)); }
__device__ __forceinline__ float wave_sum(float v) {
    v += dppf<0xB1>(v); v += dppf<0x4E>(v); v += dppf<0x141>(v); v += dppf<0x140>(v);
    const float a = __builtin_bit_cast(float, __builtin_amdgcn_readlane(__builtin_bit_cast(int, v), 0)), b = __builtin_bit_cast(float, __builtin_amdgcn_readlane(__builtin_bit_cast(int, v), 16));
    const float c = __builtin_bit_cast(float, __builtin_amdgcn_readlane(__builtin_bit_cast(int, v), 32)), d = __builtin_bit_cast(float, __builtin_amdgcn_readlane(__builtin_bit_cast(int, v), 48));
    return (a + b) + (c + d);
}
__device__ __forceinline__ float sigmoidf_(float x) { return 1.0f / (1.0f + __expf(-x)); }
__device__ __forceinline__ float siluf_(float x) { return x / (1.0f + __expf(-x)); }
__device__ __forceinline__ float softplusf_(float z) { return fmaxf(z, 0.f) + log1pf(__expf(-fabsf(z))); }
__device__ __forceinline__ float gelu_tanh(float x) { const float u = 0.7978845608028654f * (x + 0.044715f * x * x * x); return 0.5f * x * (1.0f + tanhf(u)); }
__device__ __forceinline__ float reduce16(float x) { x += dppf<0xB1>(x); x += dppf<0x4E>(x); x += dppf<0x141>(x); x += dppf<0x140>(x); return x; }
__device__ __forceinline__ float reduce8(float x) { x += dppf<0xB1>(x); x += dppf<0x4E>(x); x += dppf<0x141>(x); return x; }
__device__ __forceinline__ int row_of(int b, int q, int odd) {
    if (q < CTX) return MLAT + b * CTX + q;
    const int s = q - CTX; const int t = odd ? (((s & 63) << 6) | (s >> 6)) : s;
    return b * SEQ + t;
}

struct EpiSwiGLU {
    static constexpr bool PERM = true, AFTER_DRAIN = false;
    bf16* O;
    __device__ __forceinline__ void operator()(const pg8::f32x4 (&acc)[2][2][4][2], const pg8::Unit& u, int wr, int wc, int fr, int fq) const {
        const int row0 = u.pm * 256 + wr * 64 + fr, col0 = u.pn * 128 + wc * 32 + 8 * fq;
#pragma unroll
        for (int ai = 0; ai < 2; ++ai)
#pragma unroll
            for (int m = 0; m < 4; ++m) {
                float o[8];
#pragma unroll
                for (int n = 0; n < 2; ++n)
#pragma unroll
                    for (int j = 0; j < 4; ++j) { const float g = acc[ai][0][m][n][j], up = acc[ai][1][m][n][j]; o[n * 4 + j] = siluf_(g) * up; }
                *(v4u*)(O + (size_t)(row0 + ai * 128 + m * 16) * DFF + col0) = pack8(o);
            }
    }
};
struct EpiP {
    static constexpr bool PERM = true, AFTER_DRAIN = false;
    bf16* O; int ldc;
    __device__ __forceinline__ void operator()(const pg8::f32x4 (&acc)[2][2][4][2], const pg8::Unit& u, int wr, int wc, int fr, int fq) const {
        const int row0 = u.pm * 256 + wr * 64 + fr, col0 = u.pn * 256 + wc * 32 + 8 * fq;
#pragma unroll
        for (int ai = 0; ai < 2; ++ai)
#pragma unroll
            for (int m = 0; m < 4; ++m)
#pragma unroll
                for (int bj = 0; bj < 2; ++bj) {
                    float o[8];
#pragma unroll
                    for (int n = 0; n < 2; ++n)
#pragma unroll
                        for (int j = 0; j < 4; ++j) o[n * 4 + j] = acc[ai][bj][m][n][j];
                    *(v4u*)(O + (size_t)(row0 + ai * 128 + m * 16) * ldc + col0 + bj * 128) = pack8(o);
                }
    }
};
struct EpiResid {
    static constexpr bool PERM = true, AFTER_DRAIN = false;
    const float* res_lat; const float* res_ctx; float* dst_lat; float* dst_ctx; const float* gate; float coef;
    __device__ __forceinline__ void operator()(const pg8::f32x4 (&acc)[2][2][4][2], const pg8::Unit& u, int wr, int wc, int fr, int fq) const {
        const int rowbase = u.pm * 256; const bool isctx = rowbase >= MLAT;
        const int b = isctx ? 8 : (rowbase >> 12);
        const float* res = isctx ? res_ctx + (size_t)(rowbase - MLAT) * D : res_lat + (size_t)rowbase * D;
        float* dst = isctx ? dst_ctx + (size_t)(rowbase - MLAT) * D : dst_lat + (size_t)rowbase * D;
#pragma unroll
        for (int bj = 0; bj < 2; ++bj) {
            const int col = u.pn * 256 + bj * 128 + wc * 32 + 8 * fq;
            const f32x4 g0 = *(const f32x4*)(gate + (size_t)b * 9216 + col) * coef, g1 = *(const f32x4*)(gate + (size_t)b * 9216 + col + 4) * coef;
#pragma unroll
            for (int ai = 0; ai < 2; ++ai)
#pragma unroll
                for (int m = 0; m < 4; ++m) {
                    const size_t off = (size_t)(ai * 128 + wr * 64 + m * 16 + fr) * D + col;
                    const f32x4 r0 = *(const f32x4*)(res + off), r1 = *(const f32x4*)(res + off + 4);
                    *(f32x4*)(dst + off) = r0 + g0 * acc[ai][bj][m][0];
                    *(f32x4*)(dst + off + 4) = r1 + g1 * acc[ai][bj][m][1];
                }
        }
    }
};

struct EpiLora {
    static constexpr bool PERM = true, AFTER_DRAIN = false;
    const float* w0; const float* a0; const float* ka; const bf16* kt; const bf16* kk; bf16* scb; bf16* P; int odd;
    __device__ __forceinline__ void operator()(const pg8::f32x4 (&acc)[2][2][4][2], const pg8::Unit& u, int wr, int wc, int fr, int fq) const {
        asm volatile("" : "+v"(fr), "+v"(fq));
#pragma unroll
        for (int bj = 0; bj < 2; ++bj) {
            const int half = __builtin_amdgcn_readfirstlane(u.pn * 2 + bj), kind = half / 3, c = (half - kind * 3) * 128 + wc * 32 + 8 * fq;
            if (kind >= 5) continue;
#pragma unroll
            for (int ai = 0; ai < 2; ++ai)
#pragma unroll
                for (int m = 0; m < 4; ++m) {
                    const int pos = u.pm * 256 + ai * 128 + wr * 64 + m * 16 + fr;
                    float v[8];
#pragma unroll
                    for (int n = 0; n < 2; ++n)
#pragma unroll
                        for (int j = 0; j < 4; ++j) v[n * 4 + j] = acc[ai][bj][m][n][j];
                    if (kind < 2) {
                        const f32x4 q0 = *(const f32x4*)(w0 + kind * 384 + c), q1 = *(const f32x4*)(w0 + kind * 384 + c + 4);
                        const float p0[8] = {q0.x, q0.y, q0.z, q0.w, q1.x, q1.y, q1.z, q1.w};
#pragma unroll
                        for (int e = 0; e < 8; ++e) { const float wl = p0[e] + v[e]; const float sp = fmaxf(-wl, 0.f) + __logf(1.0f + __expf(-fabsf(wl)));
                            v[e] = 1.0f - __expf(-__expf(-sp - 0.5f)); }
                        *(v4u*)(scb + (size_t)(7 + kind) * SC_ELEMS + (size_t)pos * RW + c) = pack8(v);
                    } else if (kind < 4) {
                        const f32x4 q0 = *(const f32x4*)(a0 + (kind - 2) * 384 + c), q1 = *(const f32x4*)(a0 + (kind - 2) * 384 + c + 4);
                        const float p0[8] = {q0.x, q0.y, q0.z, q0.w, q1.x, q1.y, q1.z, q1.w};
#pragma unroll
                        for (int e = 0; e < 8; ++e) v[e] = sigmoidf_(p0[e] + v[e]);
                        {   float kkv[8]; unpack8(*(const v4u*)(kk + (size_t)pos * RW + c), kkv);
#pragma unroll
                            for (int e = 0; e < 8; ++e) kkv[e] *= v[e];
                            *(v4u*)(scb + (size_t)(5 + kind - 2) * SC_ELEMS + (size_t)pos * RW + c) = pack8(kkv); }
                        {   float kv[8]; unpack8(*(const v4u*)(kt + (size_t)pos * RW + c), kv);
                            const f32x4 r0 = *(const f32x4*)(ka + c), r1 = *(const f32x4*)(ka + c + 4);
                            const float p1[8] = {r0.x, r0.y, r0.z, r0.w, r1.x, r1.y, r1.z, r1.w};
#pragma unroll
                            for (int e = 0; e < 8; ++e) kv[e] *= (1.0f + (v[e] - 1.0f) * p1[e]);
                            *(v4u*)(scb + (size_t)(3 + kind - 2) * SC_ELEMS + (size_t)pos * RW + c) = pack8(kv); }
                    } else {
                        const int b = pos / QLEN, q = pos - b * QLEN;
                        *(v4u*)(P + (size_t)row_of(b, q, odd) * INCP + PC_G + c) = pack8(v);
                    }
                    asm volatile("" ::: "memory");
                }
        }
    }
};
struct WS {
    float* mods; float* xrctx; bf16* wt; bf16* H; bf16* P; bf16* ACT;
    bf16 *scb, *sc_r, *sc_v, *sc_kk, *dgs;
};
__device__ __forceinline__ WS make_ws(unsigned char* ws) {
    WS w; w.mods = (float*)(ws + WS_MODS); w.xrctx = (float*)(ws + WS_XRCTX); w.wt = (bf16*)(ws + WS_WT); w.H = (bf16*)(ws + WS_H); w.P = (bf16*)(ws + WS_A); w.ACT = (bf16*)(ws + WS_A);
    bf16* b = (bf16*)(ws + WS_B);
    w.scb = b; w.sc_r = b; w.sc_v = b + SC_ELEMS; w.sc_kk = b + 2 * SC_ELEMS; w.dgs = b + 9 * SC_ELEMS;
    return w;
}

__device__ __forceinline__ void mods_phase(const int bx, const int G, CArgsP A, const WS& W, LAS unsigned char* lds, int tid, int lane, int wave) {
    LAS float* sl = (LAS float*)lds;
    LAS float* part = sl + 9 * 1024;
    const float* c = A->in[I_C]; const float* cctx = A->in[I_CCTX];
    for (int i = tid; i < 9216; i += NTHR) { const int r = i >> 10, k = i & 1023; const float v = r < 8 ? c[r * 1024 + k] : cctx[k]; sl[i] = siluf_(v); }
    __syncthreads();
    for (int item = bx; item < 288; item += G) {
        const int l = item / 72, cgp = item % 72;
        const float* Wp = A->in[I_WMOD] + (size_t)l * 1024 * 9216 + cgp * 128 + lane * 2;
        float acc[9][2];
#pragma unroll
        for (int r = 0; r < 9; ++r) { acc[r][0] = 0.f; acc[r][1] = 0.f; }
#pragma unroll 8
        for (int kk = 0; kk < 128; ++kk) {
            const int k = wave * 128 + kk;
            const f32x2 w = *(const f32x2*)(Wp + (size_t)k * 9216);
#pragma unroll
            for (int r = 0; r < 9; ++r) { const float s = sl[r * 1024 + k]; acc[r][0] += s * w.x; acc[r][1] += s * w.y; }
        }
#pragma unroll
        for (int r = 0; r < 9; ++r) { part[(wave * 9 + r) * 128 + lane * 2] = acc[r][0]; part[(wave * 9 + r) * 128 + lane * 2 + 1] = acc[r][1]; }
        __syncthreads();
        for (int o = tid; o < 1152; o += NTHR) {
            const int r = o >> 7, cc = o & 127; float s = A->in[I_BMOD][l * 9216 + cgp * 128 + cc];
#pragma unroll
            for (int w8 = 0; w8 < 8; ++w8) s += part[(w8 * 9 + r) * 128 + cc];
            W.mods[(size_t)(l * 9 + r) * 9216 + cgp * 128 + cc] = s;
        }
        __syncthreads();
    }
}

__device__ __forceinline__ void transpose_item(const float* Wsrc, int K, int N, bf16* WT, int kb, int n0, int drow0, LAS float* scr, int lane) {
    const int k0 = 64 * kb;
#pragma unroll 8
    for (int i = 0; i < 32; ++i) { const int kk = 2 * i + (lane >> 5); scr[kk * 33 + (lane & 31)] = Wsrc[(size_t)(k0 + kk) * N + n0 + (lane & 31)]; }
    asm volatile("s_waitcnt lgkmcnt(0)" ::: "memory");
    const int c = lane & 7;
#pragma unroll
    for (int j = 0; j < 4; ++j) { const int n = (lane >> 3) + 8 * j; const LAS float* s = scr + (8 * c) * 33 + n;
        v4u o; o.x = pk2(s[0 * 33], s[1 * 33]); o.y = pk2(s[2 * 33], s[3 * 33]); o.z = pk2(s[4 * 33], s[5 * 33]); o.w = pk2(s[6 * 33], s[7 * 33]);
        *(v4u*)(WT + (size_t)(drow0 + n) * K + k0 + 8 * c) = o; }
    asm volatile("s_waitcnt lgkmcnt(0)" ::: "memory");
}
__device__ __forceinline__ int gu_drow(int n0) { return n0 < DFF ? 256 * (n0 >> 7) + (n0 & 127) : 256 * ((n0 - DFF) >> 7) + 128 + ((n0 - DFF) & 127); }
__device__ __forceinline__ void convert_phase(const int bx, const int G, CArgsP A, const WS& W, int l, LAS unsigned char* lds, int lane, int wave) {
    LAS float* scr = (LAS float*)(lds + wave * 16384);
    const int gw = bx * NWAVES + wave, NGW = G * NWAVES;
    constexpr int I_GU = (D / 64) * (2 * DFF / 32), I_DN = (DFF / 64) * (D / 32), I_IN = (D / 64) * (INC / 32), I_OUT = (D / 64) * (D / 32);
    constexpr int NITEMS = 2 * I_GU + 2 * I_DN + I_IN + I_OUT;
    for (int it = gw; it < NITEMS; it += NGW) {
        int r = it;
        if (r < I_GU) { const int nblk = 2 * DFF / 32, kb = r / nblk, n0 = (r % nblk) * 32; transpose_item(A->in[I_WGU1] + (size_t)l * D * 2 * DFF, D, 2 * DFF, W.wt + WT_GU1, kb, n0, gu_drow(n0), scr, lane); continue; } r -= I_GU;
        if (r < I_GU) { const int nblk = 2 * DFF / 32, kb = r / nblk, n0 = (r % nblk) * 32; transpose_item(A->in[I_WGU2] + (size_t)l * D * 2 * DFF, D, 2 * DFF, W.wt + WT_GU2, kb, n0, gu_drow(n0), scr, lane); continue; } r -= I_GU;
        if (r < I_DN) { const int nblk = D / 32, kb = r / nblk, n0 = (r % nblk) * 32; transpose_item(A->in[I_WDOWN1] + (size_t)l * DFF * D, DFF, D, W.wt + WT_DOWN1, kb, n0, n0, scr, lane); continue; } r -= I_DN;
        if (r < I_DN) { const int nblk = D / 32, kb = r / nblk, n0 = (r % nblk) * 32; transpose_item(A->in[I_WDOWN2] + (size_t)l * DFF * D, DFF, D, W.wt + WT_DOWN2, kb, n0, n0, scr, lane); continue; } r -= I_DN;
        if (r < I_IN) { const int nblk = INC / 32, kb = r / nblk, n0 = (r % nblk) * 32; transpose_item(A->in[I_WIN] + (size_t)l * D * INC, D, INC, W.wt + WT_IN, kb, n0, n0, scr, lane); continue; } r -= I_IN;
        { const int nblk = D / 32, kb = r / nblk, n0 = (r % nblk) * 32; transpose_item(A->in[I_WOUT] + (size_t)l * D * D, D, D, W.wt + WT_OUT, kb, n0, n0, scr, lane); }
    }
    for (int idx = (bx * NWAVES + wave) * 64 + lane; idx < LORA_N * LORA_K; idx += G * NTHR) {
        const int n = idx % LORA_N, k = idx / LORA_N, kind = n / 384, c = n - kind * 384;
        float v = 0.f;
        if (kind < 2) { if (k < 64) v = A->in[I_W2][((size_t)(l * 2 + kind) * 64 + k) * RW + c]; }
        else if (kind < 4) { if (k >= 64 && k < 128) v = A->in[I_A2][((size_t)(l * 2 + kind - 2) * 64 + (k - 64)) * RW + c]; }
        else if (kind == 4) { if (k >= 128) v = A->in[I_G2][((size_t)l * 128 + (k - 128)) * RW + c]; }
        W.wt[WT_LORA + (size_t)n * LORA_K + k] = (bf16)f2bf(v);
    }
}

__device__ __forceinline__ void norm_phase(const int bx, const int G, const float* lat, const float* ctxp, const float* g, const float* mods_l, int ishift, int iscale, bf16* H, int nrows, int lane, int wave) {
    const int gw = bx * NWAVES + wave, NGW = G * NWAVES;
    for (int r = gw; r < nrows; r += NGW) {
        const float* xr = r < MLAT ? lat + (size_t)r * D : ctxp + (size_t)(r - MLAT) * D;
        const int b = r < MLAT ? (r >> 12) : 8;
        const float* sh = mods_l + (size_t)b * 9216 + ishift * 1024; const float* sc = mods_l + (size_t)b * 9216 + iscale * 1024;
        f32x4 v[4]; float s = 0.f;
#pragma unroll
        for (int j = 0; j < 4; ++j) { v[j] = *(const f32x4*)(xr + (lane + 64 * j) * 4); s += (v[j].x * v[j].x + v[j].y * v[j].y) + (v[j].z * v[j].z + v[j].w * v[j].w); }
        s = wave_sum(s);
        const float rstd = rsqrtf(s * (1.0f / D) + 1e-6f);
#pragma unroll
        for (int j = 0; j < 4; ++j) {
            const int col = (lane + 64 * j) * 4;
            const f32x4 gg = *(const f32x4*)(g + col), s4 = *(const f32x4*)(sh + col), c4 = *(const f32x4*)(sc + col);
            const f32x4 h = (v[j] * rstd) * gg * (c4 + 1.0f) + s4;
            v2u o; o.x = pk2(h.x, h.y); o.y = pk2(h.z, h.w);
            *(v2u*)(H + (size_t)r * D + col) = o;
        }
    }
}
__device__ __forceinline__ void final_norm_phase(const int bx, const int G, float* xo, const float* g, int lane, int wave) {
    const int gw = bx * NWAVES + wave, NGW = G * NWAVES;
    for (int r = gw; r < MLAT; r += NGW) {
        float* xr = xo + (size_t)r * D;
        f32x4 v[4]; float s = 0.f;
#pragma unroll
        for (int j = 0; j < 4; ++j) { v[j] = *(const f32x4*)(xr + (lane + 64 * j) * 4); s += (v[j].x * v[j].x + v[j].y * v[j].y) + (v[j].z * v[j].z + v[j].w * v[j].w); }
        s = wave_sum(s);
        const float rstd = rsqrtf(s * (1.0f / D) + 1e-6f);
#pragma unroll
        for (int j = 0; j < 4; ++j) { const int col = (lane + 64 * j) * 4; const f32x4 gg = *(const f32x4*)(g + col); *(f32x4*)(xr + col) = (v[j] * rstd) * gg; }
    }
}

__device__ __forceinline__ void pre_phase(const int bx, const int G, CArgsP A, const WS& W, int l, LAS unsigned char* lds, int tid, int lane, int wave) {
    LAS float* k_s = (LAS float*)lds;
    const int odd = l & 1;
    const float* mu0 = A->in[I_MU] + (size_t)l * 2 * RC; const float* mu1 = mu0 + RC;
    const float* kkp = A->in[I_KK] + l * RW;
    bf16* AP = (bf16*)((unsigned char*)W.H + HB_AP); bf16* KT = (bf16*)((unsigned char*)W.H + HB_KT);
    for (int tile = bx; tile < NB * (QLEN / 16); tile += G) {
        const int b = tile / (QLEN / 16), q0 = (tile % (QLEN / 16)) * 16;
        const int seq_lo = q0 < CTX ? 0 : CTX, seq_hi = q0 < CTX ? CTX : QLEN;
        for (int it = tid; it < 16 * 176; it += NTHR) {
            const int i = it / 176, col = (it % 176) * 8, q = q0 + i;
            const size_t pos = (size_t)b * QLEN + q;
            float cur[8], prv[8], nxt[8], ps[8];
            unpack8(*(const v4u*)(W.P + (size_t)row_of(b, q, odd) * INCP + PC_RW + col), cur);
            if (q - 1 >= seq_lo) unpack8(*(const v4u*)(W.P + (size_t)row_of(b, q - 1, odd) * INCP + PC_RW + col), prv);
            else {
#pragma unroll
                for (int e = 0; e < 8; ++e) prv[e] = 0.f; }
            if (q + 1 < seq_hi) unpack8(*(const v4u*)(W.P + (size_t)row_of(b, q + 1, odd) * INCP + PC_RW + col), nxt);
            else {
#pragma unroll
                for (int e = 0; e < 8; ++e) nxt[e] = 0.f; }
#pragma unroll
            for (int e = 0; e < 8; ++e) ps[e] = cur[e] + mu0[col + e] * (prv[e] - cur[e]) + mu1[col + e] * (nxt[e] - cur[e]);
            if (col < 384) *(v4u*)(W.sc_r + pos * RW + col) = pack8(ps);
            else if (col < 768) {
#pragma unroll
                for (int e = 0; e < 8; ++e) k_s[i * 384 + col - 384 + e] = ps[e];
                *(v4u*)(KT + pos * RW + (col - 384)) = pack8(ps); }
            else if (col < 1152) *(v4u*)(W.sc_v + pos * RW + (col - 768)) = pack8(ps);
            else if (col < 1216) {
#pragma unroll
                for (int e = 0; e < 8; ++e) ps[e] = tanhf(ps[e]);
                *(v4u*)(AP + pos * LORA_K + (col - 1152)) = pack8(ps); }
            else if (col < 1280) *(v4u*)(AP + pos * LORA_K + 64 + (col - 1216)) = pack8(ps);
            else {
#pragma unroll
                for (int e = 0; e < 8; ++e) ps[e] = sigmoidf_(ps[e]);
                *(v4u*)(AP + pos * LORA_K + 128 + (col - 1280)) = pack8(ps); }
        }
        __syncthreads();
        for (int it = wave; it < 96; it += NWAVES) {
            const int i = it / 6, h = it % 6, c = h * 64 + lane;
            const float val = k_s[i * 384 + c] * kkp[c];
            const float ss = wave_sum(val * val);
            W.sc_kk[((size_t)b * QLEN + q0 + i) * RW + c] = (bf16)f2bf(val * rsqrtf(ss + 1e-12f));
        }
        __syncthreads();
    }
}

__device__ __forceinline__ int q_of_step(int n, int d) { return d == 0 ? n : (n < CTX ? CTX - 1 - n : QLEN + CTX - 1 - n); }
constexpr int RCH = 32, RNCH = QLEN / RCH;
__device__ __forceinline__ void rwkv_scan_phase(const WS& W, int l, int blk, LAS unsigned char* lds, int tid, int lane, int wave) {
    const int b = blk / 12, rem = blk % 12, h = rem >> 1, d = rem & 1, odd = l & 1;
    LAS float* buf = (LAS float*)lds;
    LAS float* ybuf = buf + 2 * RCH * 384;
    const bf16* s_omw = W.scb + (size_t)(7 + d) * SC_ELEMS; const bf16* s_b = W.scb + (size_t)(5 + d) * SC_ELEMS; const bf16* s_kd = W.scb + (size_t)(3 + d) * SC_ELEMS;
    const int rg = lane >> 4, j = lane & 15, rowA = wave * 8 + rg, rowB = rowA + 4;
    v4u pre[3];
#define RW_LOAD(c) do { _Pragma("unroll") for (int jj = 0; jj < 3; ++jj) { const int p = tid + NTHR * jj, i = p / 48, r48 = p % 48, vec = r48 >> 3, part = r48 & 7; \
        const int q = q_of_step((c) * RCH + i, d); const size_t pos = (size_t)b * QLEN + q; \
        const bf16* base = vec == 0 ? s_omw : vec == 1 ? s_b : vec == 2 ? s_kd : vec == 3 ? W.sc_kk : vec == 4 ? W.sc_r : W.sc_v; \
        pre[jj] = *(const v4u*)(base + pos * RW + h * 64 + part * 8); } } while (0)
#define RW_STORE(c) do { _Pragma("unroll") for (int jj = 0; jj < 3; ++jj) { const int p = tid + NTHR * jj, i = p / 48, r48 = p % 48, vec = r48 >> 3, part = r48 & 7; \
        float f[8]; unpack8(pre[jj], f); if (vec == 0) { _Pragma("unroll") for (int e = 0; e < 8; ++e) f[e] = 1.0f - f[e]; } \
        LAS float* dst = buf + (((c) & 1) * RCH + i) * 384 + vec * 64 + part * 8; \
        *(LAS f32x4*)dst = (f32x4){f[0], f[1], f[2], f[3]}; *(LAS f32x4*)(dst + 4) = (f32x4){f[4], f[5], f[6], f[7]}; } } while (0)
    f32x2 SA[2], SB[2];
#pragma unroll
    for (int e = 0; e < 2; ++e) { SA[e] = (f32x2){0.f, 0.f}; SB[e] = (f32x2){0.f, 0.f}; }
    RW_LOAD(0); RW_STORE(0);
    __syncthreads();
    for (int c = 0; c < RNCH; ++c) {
        if (c + 1 < RNCH) RW_LOAD(c + 1);
        const LAS float* cur = buf + (c & 1) * RCH * 384;
#pragma unroll 4
        for (int i = 0; i < RCH; ++i) {
            const LAS f32x4* bp = (const LAS f32x4*)(cur + i * 384 + j * 4);
            const f32x4 w = bp[0], bb = bp[16], kd = bp[32], kk = bp[48], r = bp[64];
            const float va = cur[i * 384 + 320 + rowA], vb = cur[i * 384 + 320 + rowB];
            const f32x2 kk0 = (f32x2){kk.x, kk.y}, kk1 = (f32x2){kk.z, kk.w};
            const f32x2 ta = SA[0] * kk0 + SA[1] * kk1, tb = SB[0] * kk0 + SB[1] * kk1;
            const float saA = -reduce16(ta.x + ta.y), saB = -reduce16(tb.x + tb.y);
            const f32x2 w0 = (f32x2){w.x, w.y}, w1 = (f32x2){w.z, w.w}, b0 = (f32x2){bb.x, bb.y}, b1 = (f32x2){bb.z, bb.w}, d0 = (f32x2){kd.x, kd.y}, d1 = (f32x2){kd.z, kd.w};
            const f32x2 va2 = (f32x2){va, va}, vb2 = (f32x2){vb, vb}, sa2 = (f32x2){saA, saA}, sb2 = (f32x2){saB, saB};
            SA[0] = SA[0] * w0 + va2 * d0 + sa2 * b0; SA[1] = SA[1] * w1 + va2 * d1 + sa2 * b1;
            SB[0] = SB[0] * w0 + vb2 * d0 + sb2 * b0; SB[1] = SB[1] * w1 + vb2 * d1 + sb2 * b1;
            const f32x2 r0 = (f32x2){r.x, r.y}, r1 = (f32x2){r.z, r.w};
            const f32x2 ya = SA[0] * r0 + SA[1] * r1, yb = SB[0] * r0 + SB[1] * r1;
            const float yA = reduce16(ya.x + ya.y), yB = reduce16(yb.x + yb.y);
            if (j == 0) { ybuf[i * 64 + rowA] = yA; ybuf[i * 64 + rowB] = yB; }
        }
        __syncthreads();
        {
            const int i = tid >> 4, r4 = (tid & 15) * 4;
            const int q = q_of_step(c * RCH + i, d);
            const f32x4 yv = *(const LAS f32x4*)(ybuf + i * 64 + r4);
            v2u o; o.x = pk2(yv.x, yv.y); o.y = pk2(yv.z, yv.w);
            *(v2u*)(W.P + (size_t)row_of(b, q, odd) * INCP + PC_Y + d * RW + h * 64 + r4) = o;
        }
        if (c + 1 < RNCH) RW_STORE(c + 1);
        __syncthreads();
    }
#undef RW_LOAD
#undef RW_STORE
}

__device__ __forceinline__ void lru_scan_phase(CArgsP A, const WS& W, int l, int idx, LAS unsigned char* lds, int tid, int lane, int wave) {
    const int b = idx / 12, rem = idx % 12, n = rem >> 1, d = rem & 1, odd = l & 1;
    LAS float* xs = (LAS float*)lds;
    LAS float* us = xs + 68 * 64;
    LAS float* gs = us + 64 * 64;
    LAS bf16* ub = (LAS bf16*)(gs + 2 * 64 * 64);
    const int c = tid & 63;
    float cw[4];
#pragma unroll
    for (int jj = 0; jj < 4; ++jj) cw[jj] = A->in[I_LCW][((size_t)(l * 2 + d) * 4 + jj) * LW + n * 64 + c];
    const float cb = A->in[I_LCB][(l * 2 + d) * LW + n * 64 + c];
    const float sp = softplusf_(-A->in[I_LAM][(l * 2 + d) * LW + n * 64 + c]);
    const int g = wave >> 2, jcol = (wave & 3) * 16 + (lane & 15), quad = lane >> 4;
    const float* Wsrc = (g ? A->in[I_LWI] : A->in[I_LWR]) + ((size_t)((l * 2 + d) * 6 + n) * 64) * 64 + jcol;
    pg8::bf16x8 bfrag[2];
#pragma unroll
    for (int ks = 0; ks < 2; ++ks)
#pragma unroll
        for (int jj = 0; jj < 8; ++jj) bfrag[ks][jj] = (short)f2bf(Wsrc[(size_t)(ks * 32 + quad * 8 + jj) * 64]);
    const float gbias = (g ? A->in[I_LBI] : A->in[I_LBR])[(l * 2 + d) * LW + n * 64 + jcol];
    float hstate = 0.f;
    v4u pre[2];
#define LRU_LOAD(ch) do { const int n0 = (ch) * 64; const int qlo_ = d == 0 ? n0 : q_of_step(n0, 1) - 63; const int qb_ = d == 0 ? qlo_ - 3 : qlo_; \
        const int slo_ = qlo_ < CTX ? 0 : CTX, shi_ = qlo_ < CTX ? CTX : QLEN; \
        _Pragma("unroll") for (int jj = 0; jj < 2; ++jj) { const int p = tid + NTHR * jj; const int t = p >> 3, part = p & 7, q = qb_ + t; \
            pre[jj] = (v4u){0u, 0u, 0u, 0u}; \
            if (t < 67 && q >= slo_ && q < shi_) pre[jj] = *(const v4u*)(W.P + (size_t)row_of(b, q, odd) * INCP + PC_XR + n * 64 + part * 8); } } while (0)
    LRU_LOAD(0);
    for (int ch = 0; ch < QLEN / 64; ++ch) {
        const int n0 = ch * 64; const int qlo = d == 0 ? n0 : q_of_step(n0, 1) - 63;
#pragma unroll
        for (int jj = 0; jj < 2; ++jj) { const int p = tid + NTHR * jj; const int t = p >> 3, part = p & 7;
            if (t < 67) { float f[8]; unpack8(pre[jj], f); LAS float* dst = xs + t * 64 + part * 8;
                *(LAS f32x4*)dst = (f32x4){f[0], f[1], f[2], f[3]}; *(LAS f32x4*)(dst + 4) = (f32x4){f[4], f[5], f[6], f[7]}; } }
        __syncthreads();
        if (ch + 1 < QLEN / 64) LRU_LOAD(ch + 1);
#pragma unroll
        for (int k = 0; k < 8; ++k) { const int t = (tid >> 6) + 8 * k;
            const float uv = cb + cw[0] * xs[t * 64 + c] + cw[1] * xs[(t + 1) * 64 + c] + cw[2] * xs[(t + 2) * 64 + c] + cw[3] * xs[(t + 3) * 64 + c];
            us[t * 64 + c] = uv; ub[t * 72 + c] = (bf16)f2bf(uv); }
        __syncthreads();
#pragma unroll
        for (int rt = 0; rt < 4; ++rt) {
            pg8::f32x4 acc = {0.f, 0.f, 0.f, 0.f};
#pragma unroll
            for (int ks = 0; ks < 2; ++ks) {
                const pg8::bf16x8 afrag = *(const LAS pg8::bf16x8*)(ub + (rt * 16 + (lane & 15)) * 72 + ks * 32 + quad * 8);
                acc = __builtin_amdgcn_mfma_f32_16x16x32_bf16(afrag, bfrag[ks], acc, 0, 0, 0);
            }
#pragma unroll
            for (int jj = 0; jj < 4; ++jj) gs[(g * 64 + rt * 16 + quad * 4 + jj) * 64 + jcol] = sigmoidf_(acc[jj] + gbias);
        }
        __syncthreads();
#pragma unroll
        for (int k = 0; k < 8; ++k) { const int t = (tid >> 6) + 8 * k;
            const float rgv = gs[t * 64 + c], igv = gs[(64 + t) * 64 + c], u = us[t * 64 + c];
            const float log_a = -8.0f * sp * rgv;
            const float a = __expf(log_a);
            const float bt = sqrtf(-expm1f(2.0f * log_a)) * (igv * u);
            gs[t * 64 + c] = a; gs[(64 + t) * 64 + c] = bt; }
        __syncthreads();
        if (wave == 0) {
#pragma unroll 8
            for (int s = 0; s < 64; ++s) { const int t = d == 0 ? s : 63 - s;
                hstate = gs[t * 64 + lane] * hstate + gs[(64 + t) * 64 + lane];
                W.H[(size_t)row_of(b, qlo + t, odd) * D + d * LW + n * 64 + lane] = (bf16)f2bf(hstate); }
        }
        __syncthreads();
    }
#undef LRU_LOAD
}

__device__ __forceinline__ void post_phase(const int bx, const int G, CArgsP A, const WS& W, int l, LAS unsigned char* lds, int tid, int lane, int wave) {
    LAS float* hs = (LAS float*)lds;
    const int odd = l & 1;
    const float* cwa = A->in[I_CONVA] + (size_t)l * 3 * 256;
    const float* rk = A->in[I_RK] + l * RW; const float* lng = A->in[I_LNG] + l * RW; const float* lnb = A->in[I_LNB] + l * RW;
    bf16* Y = W.H;
    for (int tile = bx; tile < NB * (QLEN / 16); tile += G) {
        const int b = tile / (QLEN / 16), q0 = (tile % (QLEN / 16)) * 16;
        for (int it = tid; it < 16 * 48; it += NTHR) { const int i = it / 48, col = (it % 48) * 8; const size_t row = row_of(b, q0 + i, odd);
            float h0[8], h1[8]; unpack8(*(const v4u*)(W.H + row * D + col), h0); unpack8(*(const v4u*)(W.H + row * D + LW + col), h1);
#pragma unroll
            for (int e = 0; e < 8; ++e) hs[i * 384 + col + e] = h0[e] + h1[e]; }
        __syncthreads();
        for (int it = tid; it < 16 * 32; it += NTHR) { const int i = it >> 5, col = (it & 31) * 8, q = q0 + i;
            int lo, hi; if (q < CTX) { lo = 0; hi = CTX; } else { lo = CTX + ((q - CTX) & ~63); hi = lo + 64; }
            const size_t row = row_of(b, q, odd);
            float bg[8], cgv[8], xv[8], y[8];
            unpack8(*(const v4u*)(W.P + row * INCP + PC_BG + col), bg); unpack8(*(const v4u*)(W.P + row * INCP + PC_CG + col), cgv); unpack8(*(const v4u*)(W.P + row * INCP + PC_XIN + col), xv);
#pragma unroll
            for (int e = 0; e < 8; ++e) y[e] = cwa[256 + col + e] * (cgv[e] * xv[e]);
            if (q - 1 >= lo) { const size_t r2 = row_of(b, q - 1, odd); unpack8(*(const v4u*)(W.P + r2 * INCP + PC_CG + col), cgv); unpack8(*(const v4u*)(W.P + r2 * INCP + PC_XIN + col), xv);
#pragma unroll
                for (int e = 0; e < 8; ++e) y[e] += cwa[col + e] * (cgv[e] * xv[e]); }
            if (q + 1 < hi) { const size_t r2 = row_of(b, q + 1, odd); unpack8(*(const v4u*)(W.P + r2 * INCP + PC_CG + col), cgv); unpack8(*(const v4u*)(W.P + r2 * INCP + PC_XIN + col), xv);
#pragma unroll
                for (int e = 0; e < 8; ++e) y[e] += cwa[512 + col + e] * (cgv[e] * xv[e]); }
#pragma unroll
            for (int e = 0; e < 8; ++e) y[e] *= bg[e];
            *(v4u*)(Y + row * D + col) = pack8(y); }
        for (int it = wave; it < 96; it += NWAVES) { const int i = it / 6, h = it % 6, c = h * 64 + lane, q = q0 + i;
            const size_t row = row_of(b, q, odd), pos = (size_t)b * QLEN + q;
            const float ys = bf2f(W.P[row * INCP + PC_Y + c]) + bf2f(W.P[row * INCP + PC_Y + RW + c]);
            const float mean = wave_sum(ys) * (1.0f / 64.0f); const float dv = ys - mean;
            const float var = wave_sum(dv * dv) * (1.0f / 64.0f);
            const float gn = dv * rsqrtf(var + 64e-5f) * lng[c] + lnb[c];
            const float r = bf2f(W.sc_r[pos * RW + c]), v = bf2f(W.sc_v[pos * RW + c]);
            const float kd = bf2f((W.scb + (size_t)3 * SC_ELEMS)[pos * RW + c]) + bf2f((W.scb + (size_t)4 * SC_ELEMS)[pos * RW + c]);
            const float bon = wave_sum(r * kd * rk[c]);
            Y[row * D + 256 + c] = (bf16)f2bf((gn + bon * v) * bf2f(W.P[row * INCP + PC_G + c])); }
        for (int it = tid; it < 16 * 48; it += NTHR) { const int i = it / 48, col = (it % 48) * 8; const size_t row = row_of(b, q0 + i, odd);
            float gr[8], o[8]; unpack8(*(const v4u*)(W.P + row * INCP + PC_GR + col), gr);
#pragma unroll
            for (int e = 0; e < 8; ++e) o[e] = gelu_tanh(gr[e]) * hs[i * 384 + col + e];
            *(v4u*)(Y + row * D + 640 + col) = pack8(o); }
        __syncthreads();
    }
}

constexpr int PH_PER_LAYER = 13, N_PHASES = 1 + DEPTH * PH_PER_LAYER + 1;
__global__ void __launch_bounds__(NTHR, 2) fwd_megakernel(Args A0) {
    extern __shared__ __attribute__((aligned(16))) unsigned char lds_raw[];
    LAS unsigned char* lds = (LAS unsigned char*)lds_raw;
    cg::grid_group grid = cg::this_grid();
    const int ph_lo = A0.ph_lo, ph_hi = A0.ph_hi;
    const int wave0 = __builtin_amdgcn_readfirstlane((int)threadIdx.x >> 6);
    bool rep_done = false; (void)rep_done;
    for (int ph = ph_lo; ph < ph_hi; ++ph) {
        CArgsP A = (CArgsP)__builtin_amdgcn_kernarg_segment_ptr();
        asm volatile("" : "+s"(A) :: "memory");
        int G = gridDim.x, bx = blockIdx.x, wave = wave0;
        asm volatile("" : "+s"(G), "+s"(bx), "+s"(wave));
#define IDS() int lane; asm volatile("v_mbcnt_lo_u32_b32 %0, -1, 0\n\tv_mbcnt_hi_u32_b32 %0, -1, %0" : "=v"(lane)); const int tid = wave * 64 + lane; (void)tid
        const WS W = make_ws(A->ws);
        if (ph == 0) { IDS(); mods_phase(bx, G, A, W, lds, tid, lane, wave); convert_phase(bx, G, A, W, 0, lds, lane, wave); }
        else if (ph == N_PHASES - 1) { IDS(); final_norm_phase(bx, G, A->out, A->in[I_GFINAL], lane, wave); }
        else {
            const int l = (ph - 1) / PH_PER_LAYER, s = (ph - 1) % PH_PER_LAYER; const bool last = (l == DEPTH - 1);
            const float* mods_l = W.mods + (size_t)l * 9 * 9216;
            const float* xlat = A->out; const float* xctx = W.xrctx;
            if (s == 0) { IDS();
                if (l > 0) convert_phase(bx, G, A, W, l, lds, lane, wave);
                norm_phase(bx, G, l == 0 ? A->in[I_X] : xlat, l == 0 ? A->in[I_CTX] : xctx, A->in[I_GFFN1] + l * D, mods_l, 0, 1, W.H, MTOT, lane, wave);
            } else if (s == 1 || s == 11) { IDS();
                pg8::Gemm g{W.H, W.wt + (s == 1 ? WT_GU1 : WT_GU2), (s == 11 && last) ? MLAT : MTOT, 2 * DFF, D}; pg8::StaticOrder S; S.init(g.M, g.N, G, bx);
                EpiSwiGLU E{W.ACT};
                pg8::gemm_phase<EpiSwiGLU, pg8::StaticOrder, true, true>(lds, g, S, E, tid);
            } else if (s == 2 || s == 9 || s == 12) { IDS();
                pg8::Gemm g{s == 9 ? W.H : W.ACT, W.wt + (s == 2 ? WT_DOWN1 : s == 9 ? WT_OUT : WT_DOWN2), (s != 2 && last) ? MLAT : MTOT, D, s == 9 ? D : DFF};
                pg8::StaticOrder S; S.init(g.M, g.N, G, bx);
                const bool first = (l == 0 && s == 2);
                EpiResid E{first ? A->in[I_X] : xlat, first ? A->in[I_CTX] : xctx, A->out, W.xrctx, mods_l + (s == 2 ? 2 : s == 9 ? 5 : 8) * 1024, s == 9 ? 1.0f : 0.5f};
                pg8::gemm_phase<EpiResid, pg8::StaticOrder, true, true>(lds, g, S, E, tid);
            } else if (s == 3) { IDS();
                norm_phase(bx, G, xlat, xctx, A->in[I_GMIX] + l * D, mods_l, 3, 4, W.H, MTOT, lane, wave);
            } else if (s == 4) { IDS();
                pg8::Gemm g{W.H, W.wt + WT_IN, MTOT, INCP, D}; pg8::StaticOrder S; S.init(g.M, g.N, G, bx);
                EpiP E{W.P, INCP};
                pg8::gemm_phase<EpiP, pg8::StaticOrder, true, true>(lds, g, S, E, tid);
            } else if (s == 5) { IDS();
                pre_phase(bx, G, A, W, l, lds, tid, lane, wave);
            } else if (s == 6) { IDS();
                int Kl = LORA_K, Nl = LORA_N; asm volatile("" : "+s"(Kl), "+s"(Nl));
                pg8::Gemm g{(const bf16*)((const unsigned char*)W.H + HB_AP), W.wt + WT_LORA, MTOT, Nl, Kl}; pg8::StaticOrder S; S.init(g.M, g.N, G, bx);
                EpiLora E{A->in[I_W0] + l * 2 * RW, A->in[I_A0] + l * 2 * RW, A->in[I_KA] + l * RW, (const bf16*)((const unsigned char*)W.H + HB_KT), W.sc_kk, W.scb, W.P, l & 1};
                pg8::gemm_phase<EpiLora, pg8::StaticOrder, true, true>(lds, g, S, E, tid);
            } else if (s == 7) { IDS();
                for (int u = bx; u < 192; u += G) {
                    if (u < 96) rwkv_scan_phase(W, l, u, lds, tid, lane, wave); else lru_scan_phase(A, W, l, u - 96, lds, tid, lane, wave);
                    __syncthreads();
                }
            } else if (s == 8) { IDS();
                post_phase(bx, G, A, W, l, lds, tid, lane, wave);
            } else if (s == 10) { IDS();
                norm_phase(bx, G, xlat, xctx, A->in[I_GFFN2] + l * D, mods_l, 6, 7, W.H, last ? MLAT : MTOT, lane, wave);
            }
        }
#ifdef PROBE_REP_S
        if (ph > 0 && ph < N_PHASES - 1 && ((ph - 1) % PH_PER_LAYER) == PROBE_REP_S && !rep_done) { rep_done = true; grid.sync(); --ph; continue; }
        rep_done = false;
#endif
        if (ph + 1 < ph_hi) grid.sync();
    }
}

#ifndef MK_MULTI
#define MK_MULTI 0
#endif
extern "C" void kernel_launch(void* const* d_in, const int* in_sizes, int n_in, void* d_out, int out_size, void* d_ws, size_t ws_size, hipStream_t stream) {
    static int grid = 0;
    if (grid == 0) {
        if (n_in != N_IN || out_size != MLAT * D || ws_size < WS_END) { fprintf(stderr, "kernel_launch: unexpected shapes (n_in %d out %d ws %zu)\n", n_in, out_size, ws_size); grid = -1; return; }
        int dev = 0, cus = 0, per_cu = 0;
        (void)hipGetDevice(&dev); (void)hipDeviceGetAttribute(&cus, hipDeviceAttributeMultiprocessorCount, dev);
        if (hipFuncSetAttribute((const void*)fwd_megakernel, hipFuncAttributeMaxDynamicSharedMemorySize, LDS_BYTES) != hipSuccess) { fprintf(stderr, "kernel_launch: hipFuncSetAttribute failed\n"); grid = -1; return; }
        if (hipOccupancyMaxActiveBlocksPerMultiprocessor(&per_cu, (const void*)fwd_megakernel, NTHR, LDS_BYTES) != hipSuccess || per_cu < 1) { fprintf(stderr, "kernel_launch: occupancy query says %d\n", per_cu); per_cu = 1; }
        (void)hipGetLastError();
        grid = cus * 1;
        if (grid <= 0) grid = 256;
    }
    if (grid < 0) return;
    Args a{};
    for (int i = 0; i < N_IN; ++i) a.in[i] = (const float*)d_in[i];
    a.out = (float*)d_out; a.ws = (unsigned char*)d_ws;
#if MK_MULTI
    for (int ph = 0; ph < N_PHASES; ++ph) { a.ph_lo = ph; a.ph_hi = ph + 1; hipLaunchKernelGGL(fwd_megakernel, dim3(grid), dim3(NTHR), LDS_BYTES, stream, a); }
#else
    a.ph_lo = 0; a.ph_hi = N_PHASES;
    void* args[] = {&a};
    hipError_t e = hipLaunchCooperativeKernel((const void*)fwd_megakernel, dim3(grid), dim3(NTHR), args, LDS_BYTES, stream);
    if (e != hipSuccess) fprintf(stderr, "kernel_launch: cooperative launch failed: %s (grid %d)\n", hipGetErrorString(e), grid);
#endif
}
```

```cpp
#include <hip/hip_runtime.h>
#include <hip/hip_cooperative_groups.h>
#include <cstdio>
#include <cstdint>
namespace cg = cooperative_groups;
namespace pg8 {
#define PG8_LAS __attribute__((address_space(3)))
typedef unsigned short bf16_t;
typedef short bf16x8 __attribute__((ext_vector_type(8)));
typedef float f32x4 __attribute__((ext_vector_type(4)));
typedef unsigned u32x4 __attribute__((ext_vector_type(4)));
constexpr int BM = 256, BK = 64, HALF = 128, HTB = HALF * BK * 2  , STAGE_BYTES = 8 * HTB, NXCD = 8, WGM = 8;

__host__ __device__ __forceinline__ int lds_byte(int r, int c) { const int st = (r >> 4) * 2 + (c >> 5), rr = r & 15, cc = c & 31, ob = rr * 64 + cc * 2; return st * 1024 + (ob ^ (((ob >> 9) & 1) << 5)); }
__host__ __device__ __forceinline__ void stage_rc(int b, int& R, int& C) { const int st = b / 1024, sb = b % 1024, swz = sb ^ (((sb >> 9) & 1) << 5); R = (st >> 1) * 16 + swz / 64; C = (st & 1) * 32 + (swz % 64) / 2; }
__host__ __device__ __forceinline__ int perm32(int rho) { const int n = rho >> 4, i = rho & 15; return 8 * (i >> 2) + 4 * n + (i & 3); }

struct Unit { int pm, pn; };
struct Gemm { const bf16_t* A; const bf16_t* Bt; int M, N, K; };

struct StaticOrder {
    int nM, nN, nwg, G, c;
    __host__ __device__ void init(int M, int N, int G_, int c_) { nM = M / BM; nN = N / BM; nwg = nM * nN; G = G_; c = c_; }
    __host__ __device__ bool next(int i, Unit& u) const {
        const long L = (long)i * G + c; if (L >= nwg) return false;
        int wgid = (int)L; { const int q = nwg / NXCD, r = nwg % NXCD, xcd = wgid % NXCD, off = wgid / NXCD; wgid = (xcd < r ? xcd * (q + 1) : r * (q + 1) + (xcd - r) * q) + off; }
        const int nig = WGM * nN, gid = wgid / nig, fm = gid * WGM, gsz = (nM - fm) < WGM ? (nM - fm) : WGM;
        u.pm = fm + ((wgid % nig) % gsz); u.pn = (wgid % nig) / gsz; return true;
    }
    __device__ __forceinline__ void a_ready(const Unit&) const {}
    __device__ __forceinline__ void done(const Unit&) const {}
};

template <class Epi, class Sched, bool ALIGN_EPI = false, bool SP2 = false>
__device__ __forceinline__ void gemm_phase(PG8_LAS unsigned char* lds, const Gemm g, const Sched& S, const Epi& E, const int tid) {
    const int wid = __builtin_amdgcn_readfirstlane(tid >> 6), lane = tid & 63, wr = wid >> 2, wc = wid & 3, fr = lane & 15, fq = lane >> 4;
    const int K = g.K, nt = K / BK;
    unsigned voffA[2], voffB[2];
#pragma unroll
    for (int i = 0; i < 2; ++i) { int R, C; stage_rc(tid * 16 + i * 8192, R, C); const int Rb = Epi::PERM ? ((R & ~31) + perm32(R & 31)) : R;
        voffA[i] = (unsigned)(R * K + C) * 2u; voffB[i] = (unsigned)(Rb * K + C) * 2u; }
    const size_t kstep = (size_t)(BK * 2);
    const size_t hstep = (size_t)HALF * K * 2;
    const size_t tstep = 2 * hstep;
    const unsigned ldsw = (unsigned)wid * 1024u;
    const int aoff = lds_byte(wr * 64 + fr, fq * 8), boff = lds_byte(wc * 32 + fr, fq * 8);
#define PG8_SA(b, h) (((b) * 2 + (h)) * HTB)
#define PG8_SB(b, h) ((4 + (b) * 2 + (h)) * HTB)
#define PG8_STAGE(bufoff, gbase, voff) do { _Pragma("unroll") for (int _i = 0; _i < 2; ++_i) \
        __builtin_amdgcn_global_load_lds((const unsigned*)((const char*)(gbase) + (voff)[_i]), (PG8_LAS unsigned*)(lds + (bufoff) + ldsw + _i * 8192), 16, 0, 0); } while (0)
#define PG8_LDA(dst, b, h) do { _Pragma("unroll") for (int m = 0; m < 4; ++m) _Pragma("unroll") for (int k = 0; k < 2; ++k) dst[m][k] = *(const PG8_LAS bf16x8*)(lds + PG8_SA(b, h) + aoff + m * 2048 + k * 1024); } while (0)
#define PG8_LDB(dst, b, h) do { _Pragma("unroll") for (int n = 0; n < 2; ++n) _Pragma("unroll") for (int k = 0; k < 2; ++k) dst[n][k] = *(const PG8_LAS bf16x8*)(lds + PG8_SB(b, h) + boff + n * 2048 + k * 1024); } while (0)
#define PG8_MMA(ai, bj, At, Bt) do { __builtin_amdgcn_s_setprio(1); _Pragma("unroll") for (int m = 0; m < 4; ++m) _Pragma("unroll") for (int n = 0; n < 2; ++n) _Pragma("unroll") for (int k = 0; k < 2; ++k) \
        acc[ai][bj][m][n] = __builtin_amdgcn_mfma_f32_16x16x32_bf16(Bt[n][k], At[m][k], acc[ai][bj][m][n], 0, 0, 0); __builtin_amdgcn_s_setprio(0); } while (0)
#define PG8_WAIT_V(n) asm volatile("s_waitcnt vmcnt(" #n ")" ::: "memory")
#define PG8_WAIT_L(n) asm volatile("s_waitcnt lgkmcnt(" #n ")" ::: "memory")
#define PG8_BAR __builtin_amdgcn_s_barrier()
#define PG8_SCHED __builtin_amdgcn_sched_barrier(0)
    Unit cur, nxt; int ui = 0;
    if (!S.next(0, cur)) return;
    f32x4 acc[2][2][4][2];
#pragma unroll
    for (int a = 0; a < 2; ++a)
#pragma unroll
        for (int b = 0; b < 2; ++b)
#pragma unroll
            for (int m = 0; m < 4; ++m)
#pragma unroll
                for (int n = 0; n < 2; ++n) acc[a][b][m][n] = (f32x4){0.f, 0.f, 0.f, 0.f};
    bf16x8 At[4][2], B0[2][2], B1[2][2];
    const char* cA = (const char*)g.A + (size_t)cur.pm * tstep; const char* cB = (const char*)g.Bt + (size_t)cur.pn * tstep;
    S.a_ready(cur);
    if constexpr (SP2) {
        PG8_STAGE(PG8_SB(0, 0), cB, voffB); PG8_STAGE(PG8_SB(0, 1), cB + hstep, voffB); PG8_STAGE(PG8_SA(0, 0), cA, voffA); PG8_STAGE(PG8_SA(0, 1), cA + hstep, voffA);
        if (wr == 1) PG8_BAR;
        PG8_WAIT_V(2); PG8_BAR;
        PG8_STAGE(PG8_SB(1, 0), cB + kstep, voffB); PG8_STAGE(PG8_SA(1, 0), cA + kstep, voffA); PG8_STAGE(PG8_SB(1, 1), cB + hstep + kstep, voffB);
        PG8_WAIT_V(6); PG8_BAR;
    } else {
        PG8_STAGE(PG8_SB(0, 0), cB, voffB); PG8_STAGE(PG8_SA(0, 0), cA, voffA); PG8_STAGE(PG8_SB(0, 1), cB + hstep, voffB); PG8_STAGE(PG8_SA(0, 1), cA + hstep, voffA);
        if (wr == 1) PG8_BAR;
        PG8_WAIT_V(4); PG8_BAR;
        PG8_STAGE(PG8_SB(1, 0), cB + kstep, voffB); PG8_STAGE(PG8_SA(1, 0), cA + kstep, voffA); PG8_STAGE(PG8_SB(1, 1), cB + hstep + kstep, voffB);
        PG8_WAIT_V(6); PG8_BAR;
    }
    for (;;) {
        const bool has_next = S.next(ui + 1, nxt);
        const char* nA = has_next ? (const char*)g.A + (size_t)nxt.pm * tstep : cA; const char* nB = has_next ? (const char*)g.Bt + (size_t)nxt.pn * tstep : cB;
        for (int t = 0; t < nt; t += 2) {
            const bool last = (t == nt - 2);
            const char* a1 = cA + (size_t)(t + 1) * kstep;
            const char* a2 = last ? nA : cA + (size_t)(t + 2) * kstep; const char* b2 = last ? nB : cB + (size_t)(t + 2) * kstep;
            const char* a3 = a2 + kstep; const char* b3 = b2 + kstep;
            if (last && has_next) S.a_ready(nxt);
            if constexpr (SP2) {
            PG8_LDB(B0, 0, 0); PG8_LDB(B1, 0, 1); PG8_SCHED; PG8_LDA(At, 0, 0); PG8_STAGE(PG8_SA(1, 1), a1 + hstep, voffA);
            PG8_WAIT_V(8); PG8_WAIT_L(0); PG8_BAR; PG8_MMA(0, 0, At, B0); PG8_MMA(0, 1, At, B1); PG8_BAR; PG8_SCHED;
            PG8_LDA(At, 0, 1); PG8_STAGE(PG8_SB(0, 0), b2, voffB); PG8_STAGE(PG8_SB(0, 1), b2 + hstep, voffB); PG8_STAGE(PG8_SA(0, 0), a2, voffA);
            PG8_WAIT_V(8); PG8_WAIT_L(0); PG8_BAR; PG8_MMA(1, 0, At, B0); PG8_MMA(1, 1, At, B1); PG8_BAR; PG8_SCHED;
            PG8_LDB(B0, 1, 0); PG8_LDB(B1, 1, 1); PG8_SCHED; PG8_LDA(At, 1, 0); PG8_STAGE(PG8_SA(0, 1), a2 + hstep, voffA);
            PG8_WAIT_V(8); PG8_WAIT_L(0); PG8_BAR; PG8_MMA(0, 0, At, B0); PG8_MMA(0, 1, At, B1); PG8_BAR; PG8_SCHED;
            PG8_LDA(At, 1, 1); PG8_STAGE(PG8_SB(1, 0), b3, voffB); PG8_STAGE(PG8_SB(1, 1), b3 + hstep, voffB); PG8_STAGE(PG8_SA(1, 0), a3, voffA);
            PG8_WAIT_V(8); PG8_WAIT_L(0); PG8_BAR; PG8_MMA(1, 0, At, B0); PG8_MMA(1, 1, At, B1); PG8_BAR; PG8_SCHED;
            } else {
            PG8_LDB(B0, 0, 0); PG8_SCHED; PG8_LDA(At, 0, 0); PG8_STAGE(PG8_SA(1, 1), a1 + hstep, voffA);
            PG8_WAIT_L(8); PG8_BAR; PG8_WAIT_L(0); PG8_MMA(0, 0, At, B0); PG8_BAR; PG8_SCHED;
            PG8_LDB(B1, 0, 1); PG8_STAGE(PG8_SB(0, 0), b2, voffB);
            PG8_BAR; PG8_WAIT_L(0); PG8_MMA(0, 1, At, B1); PG8_BAR;
            PG8_LDA(At, 0, 1); PG8_STAGE(PG8_SA(0, 0), a2, voffA);
            PG8_BAR; PG8_WAIT_L(0); PG8_MMA(1, 0, At, B0); PG8_BAR; PG8_SCHED;
            PG8_STAGE(PG8_SB(0, 1), b2 + hstep, voffB);
            PG8_WAIT_V(6); PG8_BAR; PG8_MMA(1, 1, At, B1); PG8_BAR;
            PG8_LDB(B0, 1, 0); PG8_SCHED; PG8_LDA(At, 1, 0); PG8_STAGE(PG8_SA(0, 1), a2 + hstep, voffA);
            PG8_WAIT_L(8); PG8_BAR; PG8_WAIT_L(0); PG8_MMA(0, 0, At, B0); PG8_BAR; PG8_SCHED;
            PG8_LDB(B1, 1, 1); PG8_STAGE(PG8_SB(1, 0), b3, voffB);
            PG8_BAR; PG8_WAIT_L(0); PG8_MMA(0, 1, At, B1); PG8_BAR;
            PG8_LDA(At, 1, 1); PG8_STAGE(PG8_SA(1, 0), a3, voffA);
            PG8_BAR; PG8_WAIT_L(0); PG8_MMA(1, 0, At, B0); PG8_BAR; PG8_SCHED;
            PG8_STAGE(PG8_SB(1, 1), b3 + hstep, voffB);
            PG8_WAIT_V(6); PG8_BAR; PG8_MMA(1, 1, At, B1); PG8_BAR;
            }
        }
        if constexpr (ALIGN_EPI) { if (wr == 0) PG8_BAR; }
        if constexpr (!Epi::AFTER_DRAIN) { E(acc, cur, wr, wc, fr, fq); S.done(cur); }
        if (!has_next) break;
#pragma unroll
        for (int a = 0; a < 2; ++a)
#pragma unroll
            for (int b = 0; b < 2; ++b)
#pragma unroll
                for (int m = 0; m < 4; ++m)
#pragma unroll
                    for (int n = 0; n < 2; ++n) acc[a][b][m][n] = (f32x4){0.f, 0.f, 0.f, 0.f};
        cur = nxt; cA = nA; cB = nB; ++ui;
        if constexpr (ALIGN_EPI) { if (wr == 1) PG8_BAR; }
    }
    PG8_WAIT_V(0);
    if constexpr (!ALIGN_EPI) { if (wr == 0) PG8_BAR; }
    PG8_BAR;
    if constexpr (Epi::AFTER_DRAIN) { E.fused(acc, cur, wr, wc, fr, fq, lds, wid, lane); S.done(cur); }
#undef PG8_SA
#undef PG8_SB
#undef PG8_STAGE
#undef PG8_LDA
#undef PG8_LDB
#undef PG8_MMA
#undef PG8_WAIT_V
#undef PG8_WAIT_L
#undef PG8_BAR
#undef PG8_SCHED
}
}
#define LAS __attribute__((address_space(3)))
typedef unsigned short bf16;
typedef unsigned v4u __attribute__((ext_vector_type(4)));
typedef unsigned v2u __attribute__((ext_vector_type(2)));
typedef float f32x4 __attribute__((ext_vector_type(4)));
typedef float f32x2 __attribute__((ext_vector_type(2)));

constexpr int D = 1024, NB = 8, SEQ = 4096, CTX = 256, DEPTH = 4, DFF = 2816;
constexpr int MLAT = NB * SEQ, MCTX = NB * CTX, MTOT = MLAT + MCTX;
constexpr int INC = 2944, INCP = 3072;
constexpr int RW = 384, LW = 384, RC = 1408;
constexpr int QLEN = CTX + SEQ;
constexpr int PC_BG = 0, PC_CG = 256, PC_XIN = 512, PC_RW = 768, PC_XR = 2176, PC_GR = 2560;
constexpr int PC_Y = 768;
constexpr int PC_G = 1536;
constexpr int LORA_N = 2048, LORA_K = 256;
constexpr int NWAVES = 8, NTHR = 512;
constexpr int LDS_BYTES = 147456;

constexpr size_t MiB = 1u << 20;
constexpr size_t WS_BAR = 1536 * 1024, WS_BAR_BYTES = 16384;
constexpr size_t WS_MODS = 0, WS_XRCTX = 2 * MiB, WS_WT = 10 * MiB, WS_H = 52 * MiB, WS_A = 120 * MiB, WS_B = 324 * MiB;
constexpr size_t SC_ELEMS = (size_t)NB * QLEN * RW;
constexpr size_t WS_END = WS_B + 9 * SC_ELEMS * 2 + (size_t)NB * QLEN * 128 * 2;
static_assert(WS_END <= 600 * MiB, "workspace map");
static_assert(WS_A + (size_t)MTOT * INCP * 2 <= WS_B, "P fits");
constexpr size_t WT_GU1 = 0, WT_DOWN1 = WT_GU1 + (size_t)2 * DFF * D, WT_IN = WT_DOWN1 + (size_t)D * DFF, WT_OUT = WT_IN + (size_t)INCP * D,
                 WT_GU2 = WT_OUT + (size_t)D * D, WT_DOWN2 = WT_GU2 + (size_t)2 * DFF * D, WT_TOTAL = WT_DOWN2 + (size_t)D * DFF;
constexpr size_t WT_LORA = WT_TOTAL;
static_assert(WS_WT + (WT_TOTAL + (size_t)LORA_N * LORA_K) * 2 <= WS_H, "weights fit");
constexpr size_t HB_AP = 0, HB_KT = (size_t)MTOT * LORA_K * 2;
static_assert(HB_KT + (size_t)MTOT * RW * 2 <= WS_A - WS_H, "H region overlay");

enum { I_X = 0, I_C, I_CTX, I_CCTX, I_WMOD, I_BMOD, I_GFFN1, I_WGU1, I_WDOWN1, I_GMIX, I_WIN, I_CONVA, I_MU, I_W0, I_W2, I_A0, I_A2, I_G2, I_KK, I_KA, I_RK,
       I_LNG, I_LNB, I_LCW, I_LCB, I_LWR, I_LBR, I_LWI, I_LBI, I_LAM, I_WOUT, I_GFFN2, I_WGU2, I_WDOWN2, I_GFINAL, N_IN };

struct Args { const float* in[N_IN]; float* out; unsigned char* ws; int ph_lo, ph_hi; };
typedef const __attribute__((address_space(4))) Args* CArgsP;

__device__ __forceinline__ float bf2f(unsigned h) { return __builtin_bit_cast(float, h << 16); }
__device__ __forceinline__ unsigned f2bf(float f) { unsigned u = __builtin_bit_cast(unsigned, f); return (u + 0x7fffu + ((u >> 16) & 1u)) >> 16; }
__device__ __forceinline__ unsigned pk2(float lo, float hi) { return f2bf(lo) | (f2bf(hi) << 16); }
__device__ __forceinline__ void unpack8(v4u p, float* o) {
    o[0] = __builtin_bit_cast(float, p.x << 16); o[1] = __builtin_bit_cast(float, p.x & 0xffff0000u);
    o[2] = __builtin_bit_cast(float, p.y << 16); o[3] = __builtin_bit_cast(float, p.y & 0xffff0000u);
    o[4] = __builtin_bit_cast(float, p.z << 16); o[5] = __builtin_bit_cast(float, p.z & 0xffff0000u);
    o[6] = __builtin_bit_cast(float, p.w << 16); o[7] = __builtin_bit_cast(float, p.w & 0xffff0000u);
}
__device__ __forceinline__ v4u pack8(const float* v) { v4u o; o.x = pk2(v[0], v[1]); o.y = pk2(v[2], v[3]); o.z = pk2(v[4], v[5]); o.w = pk2(v[6], v[7]); return o; }
template <int CTRL> __device__ __forceinline__ float dppf(float v) { return __builtin_bit_cast(float, __builtin_amdgcn_update_dpp(0, __builtin_bit_cast(int, v), CTRL, 0xF, 0xF, true)); }
__device__ __forceinline__ float wave_sum(float v) {
    v += dppf<0xB1>(v); v += dppf<0x4E>(v); v += dppf<0x141>(v); v += dppf<0x140>(v);
    const float a = __builtin_bit_cast(float, __builtin_amdgcn_readlane(__builtin_bit_cast(int, v), 0)), b = __builtin_bit_cast(float, __builtin_amdgcn_readlane(__builtin_bit_cast(int, v), 16));
    const float c = __builtin_bit_cast(float, __builtin_amdgcn_readlane(__builtin_bit_cast(int, v), 32)), d = __builtin_bit_cast(float, __builtin_amdgcn_readlane(__builtin_bit_cast(int, v), 48));
    return (a + b) + (c + d);
}
__device__ __forceinline__ float sigmoidf_(float x) { return 1.0f / (1.0f + __expf(-x)); }
__device__ __forceinline__ float siluf_(float x) { return x / (1.0f + __expf(-x)); }
__device__ __forceinline__ float softplusf_(float z) { return fmaxf(z, 0.f) + log1pf(__expf(-fabsf(z))); }
__device__ __forceinline__ float gelu_tanh(float x) { const float u = 0.7978845608028654f * (x + 0.044715f * x * x * x); return 0.5f * x * (1.0f + tanhf(u)); }
__device__ __forceinline__ float reduce16(float x) { x += dppf<0xB1>(x); x += dppf<0x4E>(x); x += dppf<0x141>(x); x += dppf<0x140>(x); return x; }
__device__ __forceinline__ float reduce8(float x) { x += dppf<0xB1>(x); x += dppf<0x4E>(x); x += dppf<0x141>(x); return x; }
__device__ __forceinline__ int row_of(int b, int q, int odd) {
    if (q < CTX) return MLAT + b * CTX + q;
    const int s = q - CTX; const int t = odd ? (((s & 63) << 6) | (s >> 6)) : s;
    return b * SEQ + t;
}

struct EpiSwiGLU {
    static constexpr bool PERM = true, AFTER_DRAIN = false;
    bf16* O;
    __device__ __forceinline__ void operator()(const pg8::f32x4 (&acc)[2][2][4][2], const pg8::Unit& u, int wr, int wc, int fr, int fq) const {
        const int row0 = u.pm * 256 + wr * 64 + fr, col0 = u.pn * 128 + wc * 32 + 8 * fq;
#pragma unroll
        for (int ai = 0; ai < 2; ++ai)
#pragma unroll
            for (int m = 0; m < 4; ++m) {
                float o[8];
#pragma unroll
                for (int n = 0; n < 2; ++n)
#pragma unroll
                    for (int j = 0; j < 4; ++j) { const float g = acc[ai][0][m][n][j], up = acc[ai][1][m][n][j]; o[n * 4 + j] = siluf_(g) * up; }
                *(v4u*)(O + (size_t)(row0 + ai * 128 + m * 16) * DFF + col0) = pack8(o);
            }
    }
};
struct EpiP {
    static constexpr bool PERM = true, AFTER_DRAIN = false;
    bf16* O; int ldc;
    __device__ __forceinline__ void operator()(const pg8::f32x4 (&acc)[2][2][4][2], const pg8::Unit& u, int wr, int wc, int fr, int fq) const {
        const int row0 = u.pm * 256 + wr * 64 + fr, col0 = u.pn * 256 + wc * 32 + 8 * fq;
#pragma unroll
        for (int ai = 0; ai < 2; ++ai)
#pragma unroll
            for (int m = 0; m < 4; ++m)
#pragma unroll
                for (int bj = 0; bj < 2; ++bj) {
                    float o[8];
#pragma unroll
                    for (int n = 0; n < 2; ++n)
#pragma unroll
                        for (int j = 0; j < 4; ++j) o[n * 4 + j] = acc[ai][bj][m][n][j];
                    *(v4u*)(O + (size_t)(row0 + ai * 128 + m * 16) * ldc + col0 + bj * 128) = pack8(o);
                }
    }
};
struct EpiResid {
    static constexpr bool PERM = true, AFTER_DRAIN = false;
    const float* res_lat; const float* res_ctx; float* dst_lat; float* dst_ctx; const float* gate; float coef;
    __device__ __forceinline__ void operator()(const pg8::f32x4 (&acc)[2][2][4][2], const pg8::Unit& u, int wr, int wc, int fr, int fq) const {
        const int rowbase = u.pm * 256; const bool isctx = rowbase >= MLAT;
        const int b = isctx ? 8 : (rowbase >> 12);
        const float* res = isctx ? res_ctx + (size_t)(rowbase - MLAT) * D : res_lat + (size_t)rowbase * D;
        float* dst = isctx ? dst_ctx + (size_t)(rowbase - MLAT) * D : dst_lat + (size_t)rowbase * D;
#pragma unroll
        for (int bj = 0; bj < 2; ++bj) {
            const int col = u.pn * 256 + bj * 128 + wc * 32 + 8 * fq;
            const f32x4 g0 = *(const f32x4*)(gate + (size_t)b * 9216 + col) * coef, g1 = *(const f32x4*)(gate + (size_t)b * 9216 + col + 4) * coef;
#pragma unroll
            for (int ai = 0; ai < 2; ++ai)
#pragma unroll
                for (int m = 0; m < 4; ++m) {
                    const size_t off = (size_t)(ai * 128 + wr * 64 + m * 16 + fr) * D + col;
                    const f32x4 r0 = *(const f32x4*)(res + off), r1 = *(const f32x4*)(res + off + 4);
                    *(f32x4*)(dst + off) = r0 + g0 * acc[ai][bj][m][0];
                    *(f32x4*)(dst + off + 4) = r1 + g1 * acc[ai][bj][m][1];
                }
        }
    }
};

struct EpiLora {
    static constexpr bool PERM = true, AFTER_DRAIN = false;
    const float* w0; const float* a0; const float* ka; const bf16* kt; const bf16* kk; bf16* scb; bf16* P; int odd;
    __device__ __forceinline__ void operator()(const pg8::f32x4 (&acc)[2][2][4][2], const pg8::Unit& u, int wr, int wc, int fr, int fq) const {
        asm volatile("" : "+v"(fr), "+v"(fq));
#pragma unroll
        for (int bj = 0; bj < 2; ++bj) {
            const int half = __builtin_amdgcn_readfirstlane(u.pn * 2 + bj), kind = half / 3, c = (half - kind * 3) * 128 + wc * 32 + 8 * fq;
            if (kind >= 5) continue;
#pragma unroll
            for (int ai = 0; ai < 2; ++ai)
#pragma unroll
                for (int m = 0; m < 4; ++m) {
                    const int pos = u.pm * 256 + ai * 128 + wr * 64 + m * 16 + fr;
                    float v[8];
#pragma unroll
                    for (int n = 0; n < 2; ++n)
#pragma unroll
                        for (int j = 0; j < 4; ++j) v[n * 4 + j] = acc[ai][bj][m][n][j];
                    if (kind < 2) {
                        const f32x4 q0 = *(const f32x4*)(w0 + kind * 384 + c), q1 = *(const f32x4*)(w0 + kind * 384 + c + 4);
                        const float p0[8] = {q0.x, q0.y, q0.z, q0.w, q1.x, q1.y, q1.z, q1.w};
#pragma unroll
                        for (int e = 0; e < 8; ++e) { const float wl = p0[e] + v[e]; const float sp = fmaxf(-wl, 0.f) + __logf(1.0f + __expf(-fabsf(wl)));
                            v[e] = 1.0f - __expf(-__expf(-sp - 0.5f)); }
                        *(v4u*)(scb + (size_t)(7 + kind) * SC_ELEMS + (size_t)pos * RW + c) = pack8(v);
                    } else if (kind < 4) {
                        const f32x4 q0 = *(const f32x4*)(a0 + (kind - 2) * 384 + c), q1 = *(const f32x4*)(a0 + (kind - 2) * 384 + c + 4);
                        const float p0[8] = {q0.x, q0.y, q0.z, q0.w, q1.x, q1.y, q1.z, q1.w};
#pragma unroll
                        for (int e = 0; e < 8; ++e) v[e] = sigmoidf_(p0[e] + v[e]);
                        {   float kkv[8]; unpack8(*(const v4u*)(kk + (size_t)pos * RW + c), kkv);
#pragma unroll
                            for (int e = 0; e < 8; ++e) kkv[e] *= v[e];
                            *(v4u*)(scb + (size_t)(5 + kind - 2) * SC_ELEMS + (size_t)pos * RW + c) = pack8(kkv); }
                        {   float kv[8]; unpack8(*(const v4u*)(kt + (size_t)pos * RW + c), kv);
                            const f32x4 r0 = *(const f32x4*)(ka + c), r1 = *(const f32x4*)(ka + c + 4);
                            const float p1[8] = {r0.x, r0.y, r0.z, r0.w, r1.x, r1.y, r1.z, r1.w};
#pragma unroll
                            for (int e = 0; e < 8; ++e) kv[e] *= (1.0f + (v[e] - 1.0f) * p1[e]);
                            *(v4u*)(scb + (size_t)(3 + kind - 2) * SC_ELEMS + (size_t)pos * RW + c) = pack8(kv); }
                    } else {
                        const int b = pos / QLEN, q = pos - b * QLEN;
                        *(v4u*)(P + (size_t)row_of(b, q, odd) * INCP + PC_G + c) = pack8(v);
                    }
                    asm volatile("" ::: "memory");
                }
        }
    }
};
struct WS {
    float* mods; float* xrctx; bf16* wt; bf16* H; bf16* P; bf16* ACT;
    bf16 *scb, *sc_r, *sc_v, *sc_kk, *dgs;
};
__device__ __forceinline__ WS make_ws(unsigned char* ws) {
    WS w; w.mods = (float*)(ws + WS_MODS); w.xrctx = (float*)(ws + WS_XRCTX); w.wt = (bf16*)(ws + WS_WT); w.H = (bf16*)(ws + WS_H); w.P = (bf16*)(ws + WS_A); w.ACT = (bf16*)(ws + WS_A);
    bf16* b = (bf16*)(ws + WS_B);
    w.scb = b; w.sc_r = b; w.sc_v = b + SC_ELEMS; w.sc_kk = b + 2 * SC_ELEMS; w.dgs = b + 9 * SC_ELEMS;
    return w;
}

__device__ __forceinline__ void mods_phase(const int bx, const int G, CArgsP A, const WS& W, LAS unsigned char* lds, int tid, int lane, int wave) {
    LAS float* sl = (LAS float*)lds;
    LAS float* part = sl + 9 * 1024;
    const float* c = A->in[I_C]; const float* cctx = A->in[I_CCTX];
    for (int i = tid; i < 9216; i += NTHR) { const int r = i >> 10, k = i & 1023; const float v = r < 8 ? c[r * 1024 + k] : cctx[k]; sl[i] = siluf_(v); }
    __syncthreads();
    for (int item = bx; item < 288; item += G) {
        const int l = item / 72, cgp = item % 72;
        const float* Wp = A->in[I_WMOD] + (size_t)l * 1024 * 9216 + cgp * 128 + lane * 2;
        float acc[9][2];
#pragma unroll
        for (int r = 0; r < 9; ++r) { acc[r][0] = 0.f; acc[r][1] = 0.f; }
#pragma unroll 8
        for (int kk = 0; kk < 128; ++kk) {
            const int k = wave * 128 + kk;
            const f32x2 w = *(const f32x2*)(Wp + (size_t)k * 9216);
#pragma unroll
            for (int r = 0; r < 9; ++r) { const float s = sl[r * 1024 + k]; acc[r][0] += s * w.x; acc[r][1] += s * w.y; }
        }
#pragma unroll
        for (int r = 0; r < 9; ++r) { part[(wave * 9 + r) * 128 + lane * 2] = acc[r][0]; part[(wave * 9 + r) * 128 + lane * 2 + 1] = acc[r][1]; }
        __syncthreads();
        for (int o = tid; o < 1152; o += NTHR) {
            const int r = o >> 7, cc = o & 127; float s = A->in[I_BMOD][l * 9216 + cgp * 128 + cc];
#pragma unroll
            for (int w8 = 0; w8 < 8; ++w8) s += part[(w8 * 9 + r) * 128 + cc];
            W.mods[(size_t)(l * 9 + r) * 9216 + cgp * 128 + cc] = s;
        }
        __syncthreads();
    }
}

__device__ __forceinline__ void transpose_item(const float* Wsrc, int K, int N, bf16* WT, int kb, int n0, int drow0, LAS float* scr, int lane) {
    const int k0 = 64 * kb;
#pragma unroll 8
    for (int i = 0; i < 32; ++i) { const int kk = 2 * i + (lane >> 5); scr[kk * 33 + (lane & 31)] = Wsrc[(size_t)(k0 + kk) * N + n0 + (lane & 31)]; }
    asm volatile("s_waitcnt lgkmcnt(0)" ::: "memory");
    const int c = lane & 7;
#pragma unroll
    for (int j = 0; j < 4; ++j) { const int n = (lane >> 3) + 8 * j; const LAS float* s = scr + (8 * c) * 33 + n;
        v4u o; o.x = pk2(s[0 * 33], s[1 * 33]); o.y = pk2(s[2 * 33], s[3 * 33]); o.z = pk2(s[4 * 33], s[5 * 33]); o.w = pk2(s[6 * 33], s[7 * 33]);
        *(v4u*)(WT + (size_t)(drow0 + n) * K + k0 + 8 * c) = o; }
    asm volatile("s_waitcnt lgkmcnt(0)" ::: "memory");
}
__device__ __forceinline__ int gu_drow(int n0) { return n0 < DFF ? 256 * (n0 >> 7) + (n0 & 127) : 256 * ((n0 - DFF) >> 7) + 128 + ((n0 - DFF) & 127); }
__device__ __forceinline__ void convert_phase(const int bx, const int G, CArgsP A, const WS& W, int l, LAS unsigned char* lds, int lane, int wave) {
    LAS float* scr = (LAS float*)(lds + wave * 16384);
    const int gw = bx * NWAVES + wave, NGW = G * NWAVES;
    constexpr int I_GU = (D / 64) * (2 * DFF / 32), I_DN = (DFF / 64) * (D / 32), I_IN = (D / 64) * (INC / 32), I_OUT = (D / 64) * (D / 32);
    constexpr int NITEMS = 2 * I_GU + 2 * I_DN + I_IN + I_OUT;
    for (int it = gw; it < NITEMS; it += NGW) {
        int r = it;
        if (r < I_GU) { const int nblk = 2 * DFF / 32, kb = r / nblk, n0 = (r % nblk) * 32; transpose_item(A->in[I_WGU1] + (size_t)l * D * 2 * DFF, D, 2 * DFF, W.wt + WT_GU1, kb, n0, gu_drow(n0), scr, lane); continue; } r -= I_GU;
        if (r < I_GU) { const int nblk = 2 * DFF / 32, kb = r / nblk, n0 = (r % nblk) * 32; transpose_item(A->in[I_WGU2] + (size_t)l * D * 2 * DFF, D, 2 * DFF, W.wt + WT_GU2, kb, n0, gu_drow(n0), scr, lane); continue; } r -= I_GU;
        if (r < I_DN) { const int nblk = D / 32, kb = r / nblk, n0 = (r % nblk) * 32; transpose_item(A->in[I_WDOWN1] + (size_t)l * DFF * D, DFF, D, W.wt + WT_DOWN1, kb, n0, n0, scr, lane); continue; } r -= I_DN;
        if (r < I_DN) { const int nblk = D / 32, kb = r / nblk, n0 = (r % nblk) * 32; transpose_item(A->in[I_WDOWN2] + (size_t)l * DFF * D, DFF, D, W.wt + WT_DOWN2, kb, n0, n0, scr, lane); continue; } r -= I_DN;
        if (r < I_IN) { const int nblk = INC / 32, kb = r / nblk, n0 = (r % nblk) * 32; transpose_item(A->in[I_WIN] + (size_t)l * D * INC, D, INC, W.wt + WT_IN, kb, n0, n0, scr, lane); continue; } r -= I_IN;
        { const int nblk = D / 32, kb = r / nblk, n0 = (r % nblk) * 32; transpose_item(A->in[I_WOUT] + (size_t)l * D * D, D, D, W.wt + WT_OUT, kb, n0, n0, scr, lane); }
    }
    for (int idx = (bx * NWAVES + wave) * 64 + lane; idx < LORA_N * LORA_K; idx += G * NTHR) {
        const int n = idx % LORA_N, k = idx / LORA_N, kind = n / 384, c = n - kind * 384;
        float v = 0.f;
        if (kind < 2) { if (k < 64) v = A->in[I_W2][((size_t)(l * 2 + kind) * 64 + k) * RW + c]; }
        else if (kind < 4) { if (k >= 64 && k < 128) v = A->in[I_A2][((size_t)(l * 2 + kind - 2) * 64 + (k - 64)) * RW + c]; }
        else if (kind == 4) { if (k >= 128) v = A->in[I_G2][((size_t)l * 128 + (k - 128)) * RW + c]; }
        W.wt[WT_LORA + (size_t)n * LORA_K + k] = (bf16)f2bf(v);
    }
}

__device__ __forceinline__ void norm_phase(const int bx, const int G, const float* lat, const float* ctxp, const float* g, const float* mods_l, int ishift, int iscale, bf16* H, int nrows, int lane, int wave) {
    const int gw = bx * NWAVES + wave, NGW = G * NWAVES;
    for (int r = gw; r < nrows; r += NGW) {
        const float* xr = r < MLAT ? lat + (size_t)r * D : ctxp + (size_t)(r - MLAT) * D;
        const int b = r < MLAT ? (r >> 12) : 8;
        const float* sh = mods_l + (size_t)b * 9216 + ishift * 1024; const float* sc = mods_l + (size_t)b * 9216 + iscale * 1024;
        f32x4 v[4]; float s = 0.f;
#pragma unroll
        for (int j = 0; j < 4; ++j) { v[j] = *(const f32x4*)(xr + (lane + 64 * j) * 4); s += (v[j].x * v[j].x + v[j].y * v[j].y) + (v[j].z * v[j].z + v[j].w * v[j].w); }
        s = wave_sum(s);
        const float rstd = rsqrtf(s * (1.0f / D) + 1e-6f);
#pragma unroll
        for (int j = 0; j < 4; ++j) {
            const int col = (lane + 64 * j) * 4;
            const f32x4 gg = *(const f32x4*)(g + col), s4 = *(const f32x4*)(sh + col), c4 = *(const f32x4*)(sc + col);
            const f32x4 h = (v[j] * rstd) * gg * (c4 + 1.0f) + s4;
            v2u o; o.x = pk2(h.x, h.y); o.y = pk2(h.z, h.w);
            *(v2u*)(H + (size_t)r * D + col) = o;
        }
    }
}
__device__ __forceinline__ void final_norm_phase(const int bx, const int G, float* xo, const float* g, int lane, int wave) {
    const int gw = bx * NWAVES + wave, NGW = G * NWAVES;
    for (int r = gw; r < MLAT; r += NGW) {
        float* xr = xo + (size_t)r * D;
        f32x4 v[4]; float s = 0.f;
#pragma unroll
        for (int j = 0; j < 4; ++j) { v[j] = *(const f32x4*)(xr + (lane + 64 * j) * 4); s += (v[j].x * v[j].x + v[j].y * v[j].y) + (v[j].z * v[j].z + v[j].w * v[j].w); }
        s = wave_sum(s);
        const float rstd = rsqrtf(s * (1.0f / D) + 1e-6f);
#pragma unroll
        for (int j = 0; j < 4; ++j) { const int col = (lane + 64 * j) * 4; const f32x4 gg = *(const f32x4*)(g + col); *(f32x4*)(xr + col) = (v[j] * rstd) * gg; }
    }
}

__device__ __forceinline__ void pre_phase(const int bx, const int G, CArgsP A, const WS& W, int l, LAS unsigned char* lds, int tid, int lane, int wave) {
    LAS float* k_s = (LAS float*)lds;
    const int odd = l & 1;
    const float* mu0 = A->in[I_MU] + (size_t)l * 2 * RC; const float* mu1 = mu0 + RC;
    const float* kkp = A->in[I_KK] + l * RW;
    bf16* AP = (bf16*)((unsigned char*)W.H + HB_AP); bf16* KT = (bf16*)((unsigned char*)W.H + HB_KT);
    for (int tile = bx; tile < NB * (QLEN / 16); tile += G) {
        const int b = tile / (QLEN / 16), q0 = (tile % (QLEN / 16)) * 16;
        const int seq_lo = q0 < CTX ? 0 : CTX, seq_hi = q0 < CTX ? CTX : QLEN;
        for (int it = tid; it < 16 * 176; it += NTHR) {
            const int i = it / 176, col = (it % 176) * 8, q = q0 + i;
            const size_t pos = (size_t)b * QLEN + q;
            float cur[8], prv[8], nxt[8], ps[8];
            unpack8(*(const v4u*)(W.P + (size_t)row_of(b, q, odd) * INCP + PC_RW + col), cur);
            if (q - 1 >= seq_lo) unpack8(*(const v4u*)(W.P + (size_t)row_of(b, q - 1, odd) * INCP + PC_RW + col), prv);
            else {
#pragma unroll
                for (int e = 0; e < 8; ++e) prv[e] = 0.f; }
            if (q + 1 < seq_hi) unpack8(*(const v4u*)(W.P + (size_t)row_of(b, q + 1, odd) * INCP + PC_RW + col), nxt);
            else {
#pragma unroll
                for (int e = 0; e < 8; ++e) nxt[e] = 0.f; }
#pragma unroll
            for (int e = 0; e < 8; ++e) ps[e] = cur[e] + mu0[col + e] * (prv[e] - cur[e]) + mu1[col + e] * (nxt[e] - cur[e]);
            if (col < 384) *(v4u*)(W.sc_r + pos * RW + col) = pack8(ps);
            else if (col < 768) {
#pragma unroll
                for (int e = 0; e < 8; ++e) k_s[i * 384 + col - 384 + e] = ps[e];
                *(v4u*)(KT + pos * RW + (col - 384)) = pack8(ps); }
            else if (col < 1152) *(v4u*)(W.sc_v + pos * RW + (col - 768)) = pack8(ps);
            else if (col < 1216) {
#pragma unroll
                for (int e = 0; e < 8; ++e) ps[e] = tanhf(ps[e]);
                *(v4u*)(AP + pos * LORA_K + (col - 1152)) = pack8(ps); }
            else if (col < 1280) *(v4u*)(AP + pos * LORA_K + 64 + (col - 1216)) = pack8(ps);
            else {
#pragma unroll
                for (int e = 0; e < 8; ++e) ps[e] = sigmoidf_(ps[e]);
                *(v4u*)(AP + pos * LORA_K + 128 + (col - 1280)) = pack8(ps); }
        }
        __syncthreads();
        for (int it = wave; it < 96; it += NWAVES) {
            const int i = it / 6, h = it % 6, c = h * 64 + lane;
            const float val = k_s[i * 384 + c] * kkp[c];
            const float ss = wave_sum(val * val);
            W.sc_kk[((size_t)b * QLEN + q0 + i) * RW + c] = (bf16)f2bf(val * rsqrtf(ss + 1e-12f));
        }
        __syncthreads();
    }
}

__device__ __forceinline__ int q_of_step(int n, int d) { return d == 0 ? n : (n < CTX ? CTX - 1 - n : QLEN + CTX - 1 - n); }
constexpr int RCH = 32, RNCH = QLEN / RCH;
__device__ __forceinline__ void rwkv_scan_phase(const WS& W, int l, int blk, LAS unsigned char* lds, int tid, int lane, int wave) {
    const int item = blk >> 1, half = blk & 1;
    const int b = item / 12, rem = item % 12, h = rem >> 1, d = rem & 1, odd = l & 1;
    LAS float* buf = (LAS float*)lds;
    LAS float* ybuf = buf + 2 * RCH * 384;
    const bf16* s_omw = W.scb + (size_t)(7 + d) * SC_ELEMS; const bf16* s_b = W.scb + (size_t)(5 + d) * SC_ELEMS; const bf16* s_kd = W.scb + (size_t)(3 + d) * SC_ELEMS;
    const int rg = lane >> 4, j = lane & 15, rloc = wave * 4 + rg, row = half * 32 + rloc;
    v4u pre[3];
#define RW_LOAD(c) do { _Pragma("unroll") for (int jj = 0; jj < 3; ++jj) { const int p = tid + NTHR * jj, i = p / 48, r48 = p % 48, vec = r48 >> 3, part = r48 & 7; \
        const int q = q_of_step((c) * RCH + i, d); const size_t pos = (size_t)b * QLEN + q; \
        const bf16* base = vec == 0 ? s_omw : vec == 1 ? s_b : vec == 2 ? s_kd : vec == 3 ? W.sc_kk : vec == 4 ? W.sc_r : W.sc_v; \
        pre[jj] = *(const v4u*)(base + pos * RW + h * 64 + part * 8); } } while (0)
#define RW_STORE(c) do { _Pragma("unroll") for (int jj = 0; jj < 3; ++jj) { const int p = tid + NTHR * jj, i = p / 48, r48 = p % 48, vec = r48 >> 3, part = r48 & 7; \
        float f[8]; unpack8(pre[jj], f); if (vec == 0) { _Pragma("unroll") for (int e = 0; e < 8; ++e) f[e] = 1.0f - f[e]; } \
        LAS float* dst = buf + (((c) & 1) * RCH + i) * 384 + vec * 64 + part * 8; \
        *(LAS f32x4*)dst = (f32x4){f[0], f[1], f[2], f[3]}; *(LAS f32x4*)(dst + 4) = (f32x4){f[4], f[5], f[6], f[7]}; } } while (0)
    f32x2 S0 = (f32x2){0.f, 0.f}, S1 = (f32x2){0.f, 0.f};
    RW_LOAD(0); RW_STORE(0);
    __syncthreads();
    for (int c = 0; c < RNCH; ++c) {
        if (c + 1 < RNCH) RW_LOAD(c + 1);
        const LAS float* cur = buf + (c & 1) * RCH * 384;
#pragma unroll 4
        for (int i = 0; i < RCH; ++i) {
            const LAS f32x4* bp = (const LAS f32x4*)(cur + i * 384 + j * 4);
            const f32x4 w = bp[0], bb = bp[16], kd = bp[32], kk = bp[48], r = bp[64];
            const float va = cur[i * 384 + 320 + row];
            const f32x2 ta = S0 * (f32x2){kk.x, kk.y} + S1 * (f32x2){kk.z, kk.w};
            const float sa = -reduce16(ta.x + ta.y);
            const f32x2 va2 = (f32x2){va, va}, sa2 = (f32x2){sa, sa};
            S0 = S0 * (f32x2){w.x, w.y} + va2 * (f32x2){kd.x, kd.y} + sa2 * (f32x2){bb.x, bb.y};
            S1 = S1 * (f32x2){w.z, w.w} + va2 * (f32x2){kd.z, kd.w} + sa2 * (f32x2){bb.z, bb.w};
            const f32x2 ya = S0 * (f32x2){r.x, r.y} + S1 * (f32x2){r.z, r.w};
            const float yv = reduce16(ya.x + ya.y);
            if (j == 0) ybuf[i * 32 + rloc] = yv;
        }
        __syncthreads();
        if (tid < 256) {
            const int i = tid >> 3, r4 = (tid & 7) * 4;
            const int q = q_of_step(c * RCH + i, d);
            const f32x4 yv = *(const LAS f32x4*)(ybuf + i * 32 + r4);
            v2u o; o.x = pk2(yv.x, yv.y); o.y = pk2(yv.z, yv.w);
            *(v2u*)(W.P + (size_t)row_of(b, q, odd) * INCP + PC_Y + d * RW + h * 64 + half * 32 + r4) = o;
        }
        if (c + 1 < RNCH) RW_STORE(c + 1);
        __syncthreads();
    }
#undef RW_LOAD
#undef RW_STORE
}

__device__ __forceinline__ void lru_scan_phase(CArgsP A, const WS& W, int l, int idx, LAS unsigned char* lds, int tid, int lane, int wave) {
    const int b = idx / 6, n = idx % 6, odd = l & 1;
    LAS float* gs = (LAS float*)lds;
    LAS float* xs = gs;
    LAS float* us = gs + 4 * 4096;
    LAS bf16* ub = (LAS bf16*)(us + 2 * 4096);
    const int c = tid & 63;
    float cw[2][4], cb[2], sp[2];
#pragma unroll
    for (int dd = 0; dd < 2; ++dd) {
#pragma unroll
        for (int jj = 0; jj < 4; ++jj) cw[dd][jj] = A->in[I_LCW][((size_t)(l * 2 + dd) * 4 + jj) * LW + n * 64 + c];
        cb[dd] = A->in[I_LCB][(l * 2 + dd) * LW + n * 64 + c];
        sp[dd] = softplusf_(-A->in[I_LAM][(l * 2 + dd) * LW + n * 64 + c]);
    }
    const int g = wave >> 2, jcol = (wave & 3) * 16 + (lane & 15), quad = lane >> 4;
    pg8::bf16x8 bfrag[2][2]; float gbias[2];
#pragma unroll
    for (int dd = 0; dd < 2; ++dd) {
        const float* Wsrc = (g ? A->in[I_LWI] : A->in[I_LWR]) + ((size_t)((l * 2 + dd) * 6 + n) * 64) * 64 + jcol;
#pragma unroll
        for (int ks = 0; ks < 2; ++ks)
#pragma unroll
            for (int jj = 0; jj < 8; ++jj) bfrag[dd][ks][jj] = (short)f2bf(Wsrc[(size_t)(ks * 32 + quad * 8 + jj) * 64]);
        gbias[dd] = (g ? A->in[I_LBI] : A->in[I_LBR])[(l * 2 + dd) * LW + n * 64 + jcol];
    }
    float hstate = 0.f;
    v4u pre[2][2];
#define LRU_LOAD(ch) do { _Pragma("unroll") for (int dd = 0; dd < 2; ++dd) { const int n0 = (ch) * 64; const int qlo_ = dd == 0 ? n0 : q_of_step(n0, 1) - 63; const int qb_ = dd == 0 ? qlo_ - 3 : qlo_; \
        const int slo_ = qlo_ < CTX ? 0 : CTX, shi_ = qlo_ < CTX ? CTX : QLEN; \
        _Pragma("unroll") for (int jj = 0; jj < 2; ++jj) { const int p = tid + NTHR * jj; const int t = p >> 3, part = p & 7, q = qb_ + t; \
            pre[dd][jj] = (v4u){0u, 0u, 0u, 0u}; \
            if (t < 67 && q >= slo_ && q < shi_) pre[dd][jj] = *(const v4u*)(W.P + (size_t)row_of(b, q, odd) * INCP + PC_XR + n * 64 + part * 8); } } } while (0)
    LRU_LOAD(0);
    for (int ch = 0; ch < QLEN / 64; ++ch) {
        const int n0 = ch * 64;
#pragma unroll
        for (int dd = 0; dd < 2; ++dd)
#pragma unroll
            for (int jj = 0; jj < 2; ++jj) { const int p = tid + NTHR * jj; const int t = p >> 3, part = p & 7;
                if (t < 67) { float f[8]; unpack8(pre[dd][jj], f); LAS float* dst = xs + dd * 68 * 64 + t * 64 + part * 8;
                    *(LAS f32x4*)dst = (f32x4){f[0], f[1], f[2], f[3]}; *(LAS f32x4*)(dst + 4) = (f32x4){f[4], f[5], f[6], f[7]}; } }
        __syncthreads();
        if (ch + 1 < QLEN / 64) LRU_LOAD(ch + 1);
#pragma unroll
        for (int k = 0; k < 16; ++k) { const int dd = k >> 3, t = (tid >> 6) + 8 * (k & 7); const LAS float* x = xs + dd * 68 * 64;
            const float uv = cb[dd] + cw[dd][0] * x[t * 64 + c] + cw[dd][1] * x[(t + 1) * 64 + c] + cw[dd][2] * x[(t + 2) * 64 + c] + cw[dd][3] * x[(t + 3) * 64 + c];
            us[dd * 4096 + t * 64 + c] = uv; ub[dd * 64 * 72 + t * 72 + c] = (bf16)f2bf(uv); }
        __syncthreads();
#pragma unroll
        for (int dd = 0; dd < 2; ++dd)
#pragma unroll
            for (int rt = 0; rt < 4; ++rt) {
                pg8::f32x4 acc = {0.f, 0.f, 0.f, 0.f};
#pragma unroll
                for (int ks = 0; ks < 2; ++ks) {
                    const pg8::bf16x8 afrag = *(const LAS pg8::bf16x8*)(ub + dd * 64 * 72 + (rt * 16 + (lane & 15)) * 72 + ks * 32 + quad * 8);
                    acc = __builtin_amdgcn_mfma_f32_16x16x32_bf16(afrag, bfrag[dd][ks], acc, 0, 0, 0);
                }
#pragma unroll
                for (int jj = 0; jj < 4; ++jj) gs[((dd * 2 + g) * 64 + rt * 16 + quad * 4 + jj) * 64 + jcol] = sigmoidf_(acc[jj] + gbias[dd]);
            }
        __syncthreads();
#pragma unroll
        for (int k = 0; k < 16; ++k) { const int dd = k >> 3, t = (tid >> 6) + 8 * (k & 7);
            LAS float* ga = gs + (dd * 2) * 4096 + t * 64 + c; LAS float* gb = ga + 4096;
            const float rgv = *ga, igv = *gb, u = us[dd * 4096 + t * 64 + c];
            const float log_a = -8.0f * sp[dd] * rgv;
            const float a = __expf(log_a);
            const float bt = sqrtf(fmaxf(1.0f - a * a, 0.f)) * (igv * u);
            *ga = a; *gb = bt; }
        __syncthreads();
        if (wave < 2) {
            const int dd = wave; const int qlo = dd == 0 ? n0 : q_of_step(n0, 1) - 63;
            const LAS float* ga = gs + (dd * 2) * 4096 + lane;
#pragma unroll 8
            for (int s = 0; s < 64; ++s) { const int t = dd == 0 ? s : 63 - s;
                hstate = ga[t * 64] * hstate + ga[4096 + t * 64];
                W.H[(size_t)row_of(b, qlo + t, odd) * D + dd * LW + n * 64 + lane] = (bf16)f2bf(hstate); }
        }
        __syncthreads();
    }
#undef LRU_LOAD
}

__device__ __forceinline__ void post_phase(const int bx, const int G, CArgsP A, const WS& W, int l, LAS unsigned char* lds, int tid, int lane, int wave) {
    LAS float* hs = (LAS float*)lds;
    const int odd = l & 1;
    const float* cwa = A->in[I_CONVA] + (size_t)l * 3 * 256;
    const float* rk = A->in[I_RK] + l * RW; const float* lng = A->in[I_LNG] + l * RW; const float* lnb = A->in[I_LNB] + l * RW;
    bf16* Y = W.H;
    for (int tile = bx; tile < NB * (QLEN / 16); tile += G) {
        const int b = tile / (QLEN / 16), q0 = (tile % (QLEN / 16)) * 16;
        for (int it = tid; it < 16 * 48; it += NTHR) { const int i = it / 48, col = (it % 48) * 8; const size_t row = row_of(b, q0 + i, odd);
            float h0[8], h1[8]; unpack8(*(const v4u*)(W.H + row * D + col), h0); unpack8(*(const v4u*)(W.H + row * D + LW + col), h1);
#pragma unroll
            for (int e = 0; e < 8; ++e) hs[i * 384 + col + e] = h0[e] + h1[e]; }
        __syncthreads();
        for (int it = tid; it < 16 * 32; it += NTHR) { const int i = it >> 5, col = (it & 31) * 8, q = q0 + i;
            int lo, hi; if (q < CTX) { lo = 0; hi = CTX; } else { lo = CTX + ((q - CTX) & ~63); hi = lo + 64; }
            const size_t row = row_of(b, q, odd);
            float bg[8], cgv[8], xv[8], y[8];
            unpack8(*(const v4u*)(W.P + row * INCP + PC_BG + col), bg); unpack8(*(const v4u*)(W.P + row * INCP + PC_CG + col), cgv); unpack8(*(const v4u*)(W.P + row * INCP + PC_XIN + col), xv);
#pragma unroll
            for (int e = 0; e < 8; ++e) y[e] = cwa[256 + col + e] * (cgv[e] * xv[e]);
            if (q - 1 >= lo) { const size_t r2 = row_of(b, q - 1, odd); unpack8(*(const v4u*)(W.P + r2 * INCP + PC_CG + col), cgv); unpack8(*(const v4u*)(W.P + r2 * INCP + PC_XIN + col), xv);
#pragma unroll
                for (int e = 0; e < 8; ++e) y[e] += cwa[col + e] * (cgv[e] * xv[e]); }
            if (q + 1 < hi) { const size_t r2 = row_of(b, q + 1, odd); unpack8(*(const v4u*)(W.P + r2 * INCP + PC_CG + col), cgv); unpack8(*(const v4u*)(W.P + r2 * INCP + PC_XIN + col), xv);
#pragma unroll
                for (int e = 0; e < 8; ++e) y[e] += cwa[512 + col + e] * (cgv[e] * xv[e]); }
#pragma unroll
            for (int e = 0; e < 8; ++e) y[e] *= bg[e];
            *(v4u*)(Y + row * D + col) = pack8(y); }
        for (int it = wave; it < 96; it += NWAVES) { const int i = it / 6, h = it % 6, c = h * 64 + lane, q = q0 + i;
            const size_t row = row_of(b, q, odd), pos = (size_t)b * QLEN + q;
            const float ys = bf2f(W.P[row * INCP + PC_Y + c]) + bf2f(W.P[row * INCP + PC_Y + RW + c]);
            const float mean = wave_sum(ys) * (1.0f / 64.0f); const float dv = ys - mean;
            const float var = wave_sum(dv * dv) * (1.0f / 64.0f);
            const float gn = dv * rsqrtf(var + 64e-5f) * lng[c] + lnb[c];
            const float r = bf2f(W.sc_r[pos * RW + c]), v = bf2f(W.sc_v[pos * RW + c]);
            const float kd = bf2f((W.scb + (size_t)3 * SC_ELEMS)[pos * RW + c]) + bf2f((W.scb + (size_t)4 * SC_ELEMS)[pos * RW + c]);
            const float bon = wave_sum(r * kd * rk[c]);
            Y[row * D + 256 + c] = (bf16)f2bf((gn + bon * v) * bf2f(W.P[row * INCP + PC_G + c])); }
        for (int it = tid; it < 16 * 48; it += NTHR) { const int i = it / 48, col = (it % 48) * 8; const size_t row = row_of(b, q0 + i, odd);
            float gr[8], o[8]; unpack8(*(const v4u*)(W.P + row * INCP + PC_GR + col), gr);
#pragma unroll
            for (int e = 0; e < 8; ++e) o[e] = gelu_tanh(gr[e]) * hs[i * 384 + col + e];
            *(v4u*)(Y + row * D + 640 + col) = pack8(o); }
        __syncthreads();
    }
}

#define XB_TMO      128
#define XB_XCNT(j)  (256  + 64 * (j))
#define XB_XSUB(j)  (1280 + 64 * (j))
#define XB_XGEN(j)  (2304 + 64 * (j))
#define XB_TOP      3328
#define XB_TOPGEN   3392
#define XCD_BAR_WORDS 3456
#define XB_SPIN_CAP (1u << 18)

__device__ __forceinline__ unsigned xb_ld(unsigned* p)              { return __hip_atomic_load(p, __ATOMIC_RELAXED, __HIP_MEMORY_SCOPE_AGENT); }
__device__ __forceinline__ unsigned xb_add(unsigned* p, unsigned v) { return __hip_atomic_fetch_add(p, v, __ATOMIC_RELAXED, __HIP_MEMORY_SCOPE_AGENT); }
__device__ __forceinline__ unsigned xb_xcc_id() { return (unsigned)__builtin_amdgcn_s_getreg((3 << 11) | 20) & 0xFu; }
#define XB_SPIN(cond, bar) do { unsigned _sp = 0; while (cond) { __builtin_amdgcn_s_sleep(1); \
    if ((++_sp & 255u) == 0u) { if (xb_ld(&(bar)[XB_TMO])) break; if (_sp > XB_SPIN_CAP) { atomicAdd(&(bar)[XB_TMO], 1u); break; } } } } while (0)

struct XcdBarrier {
    unsigned* bar; unsigned x;
    volatile LAS unsigned* st;
};

__device__ __forceinline__ XcdBarrier xcd_barrier_post(unsigned* bar, volatile LAS unsigned* st) {
    XcdBarrier b; b.bar = bar; b.x = xb_xcc_id(); b.st = st;
    if (threadIdx.x == 0) (void)xb_add(&bar[XB_XCNT(b.x)], 1u);
    return b;
}
__device__ __forceinline__ void xcd_barrier_complete(unsigned* bar, unsigned x, unsigned& nloc, unsigned& nx) {
    const unsigned G = gridDim.x * gridDim.y * gridDim.z;
    unsigned sum, cnt, mine, sp = 0u;
    for (;;) {
        sum = 0u; cnt = 0u; mine = 0u;
#pragma unroll
        for (unsigned j = 0; j < 16; ++j) { const unsigned c = xb_ld(&bar[XB_XCNT(j)]); sum += c; cnt += (c > 0u) ? 1u : 0u; mine = (j == x) ? c : mine; }
        if (sum == G) break;
        __builtin_amdgcn_s_sleep(1);
        if ((++sp & 255u) == 0u) { if (xb_ld(&bar[XB_TMO])) break; if (sp > XB_SPIN_CAP) { atomicAdd(&bar[XB_TMO], 1u); break; } }
    }
    nloc = mine > 0u ? mine : 1u; nx = cnt > 0u ? cnt : 1u;
}

__device__ __forceinline__ void xcd_barrier(const XcdBarrier& b) {
    asm volatile("s_waitcnt vmcnt(0)" ::: "memory");
    __syncthreads();
    if (threadIdx.x == 0) {
        unsigned* bar = b.bar;
        __builtin_amdgcn_s_waitcnt(0);
        unsigned nloc = b.st[0], nx = b.st[1];
        if (nloc == 0u) { xcd_barrier_complete(bar, b.x, nloc, nx); b.st[0] = nloc; b.st[1] = nx; }
        const unsigned old = xb_add(&bar[XB_XSUB(b.x)], 1u);
        const unsigned gen = old / nloc;
        if (old + 1u == (gen + 1u) * nloc) {
            __builtin_amdgcn_fence(__ATOMIC_RELEASE, "agent");
            asm volatile("s_waitcnt vmcnt(0)" ::: "memory");
            const unsigned og = xb_add(&bar[XB_TOP], 1u);
            const unsigned tg = og / nx;
            if (og + 1u == (tg + 1u) * nx) xb_add(&bar[XB_TOPGEN], 1u);
            else XB_SPIN(xb_ld(&bar[XB_TOPGEN]) == tg, bar);
            __builtin_amdgcn_fence(__ATOMIC_ACQUIRE, "agent");
            xb_add(&bar[XB_XGEN(b.x)], 1u);
            asm volatile("s_waitcnt vmcnt(0)" ::: "memory");
        } else {
            XB_SPIN(xb_ld(&bar[XB_XGEN(b.x)]) == gen, bar);
            __builtin_amdgcn_fence(__ATOMIC_ACQUIRE, "agent");
            asm volatile("s_waitcnt vmcnt(0)" ::: "memory");
        }
    }
    __syncthreads();
}

constexpr int PH_PER_LAYER = 13, N_PHASES = 1 + DEPTH * PH_PER_LAYER + 1;
__global__ void __launch_bounds__(NTHR, 2) fwd_megakernel(Args A0) {
    extern __shared__ __attribute__((aligned(16))) unsigned char lds_raw[];
    LAS unsigned char* lds = (LAS unsigned char*)lds_raw;
    cg::grid_group grid = cg::this_grid();
    const int ph_lo = A0.ph_lo, ph_hi = A0.ph_hi;
    volatile LAS unsigned* bst = (volatile LAS unsigned*)(lds + 131072);
    if (threadIdx.x < 2) bst[threadIdx.x] = 0u;
    __syncthreads();
    const XcdBarrier xbar = xcd_barrier_post((unsigned*)(A0.ws + WS_BAR), bst);
    const int wave0 = __builtin_amdgcn_readfirstlane((int)threadIdx.x >> 6);
    bool rep_done = false; (void)rep_done;
    for (int ph = ph_lo; ph < ph_hi; ++ph) {
        CArgsP A = (CArgsP)__builtin_amdgcn_kernarg_segment_ptr();
        asm volatile("" : "+s"(A) :: "memory");
        int G = gridDim.x, bx = blockIdx.x, wave = wave0;
        asm volatile("" : "+s"(G), "+s"(bx), "+s"(wave));
#define IDS() int lane; asm volatile("v_mbcnt_lo_u32_b32 %0, -1, 0\n\tv_mbcnt_hi_u32_b32 %0, -1, %0" : "=v"(lane)); const int tid = wave * 64 + lane; (void)tid
        const WS W = make_ws(A->ws);
        if (ph == 0) { IDS(); mods_phase(bx, G, A, W, lds, tid, lane, wave); convert_phase(bx, G, A, W, 0, lds, lane, wave); }
        else if (ph == N_PHASES - 1) { IDS(); final_norm_phase(bx, G, A->out, A->in[I_GFINAL], lane, wave); }
        else {
            const int l = (ph - 1) / PH_PER_LAYER, s = (ph - 1) % PH_PER_LAYER; const bool last = (l == DEPTH - 1);
            const float* mods_l = W.mods + (size_t)l * 9 * 9216;
            const float* xlat = A->out; const float* xctx = W.xrctx;
            if (s == 0) { IDS();
                if (l > 0) convert_phase(bx, G, A, W, l, lds, lane, wave);
                norm_phase(bx, G, l == 0 ? A->in[I_X] : xlat, l == 0 ? A->in[I_CTX] : xctx, A->in[I_GFFN1] + l * D, mods_l, 0, 1, W.H, MTOT, lane, wave);
            } else if (s == 1 || s == 11) { IDS();
                pg8::Gemm g{W.H, W.wt + (s == 1 ? WT_GU1 : WT_GU2), (s == 11 && last) ? MLAT : MTOT, 2 * DFF, D}; pg8::StaticOrder S; S.init(g.M, g.N, G, bx);
                EpiSwiGLU E{W.ACT};
                pg8::gemm_phase<EpiSwiGLU, pg8::StaticOrder, true, true>(lds, g, S, E, tid);
            } else if (s == 2 || s == 9 || s == 12) { IDS();
                pg8::Gemm g{s == 9 ? W.H : W.ACT, W.wt + (s == 2 ? WT_DOWN1 : s == 9 ? WT_OUT : WT_DOWN2), (s != 2 && last) ? MLAT : MTOT, D, s == 9 ? D : DFF};
                pg8::StaticOrder S; S.init(g.M, g.N, G, bx);
                const bool first = (l == 0 && s == 2);
                EpiResid E{first ? A->in[I_X] : xlat, first ? A->in[I_CTX] : xctx, A->out, W.xrctx, mods_l + (s == 2 ? 2 : s == 9 ? 5 : 8) * 1024, s == 9 ? 1.0f : 0.5f};
                pg8::gemm_phase<EpiResid, pg8::StaticOrder, true, true>(lds, g, S, E, tid);
            } else if (s == 3) { IDS();
                norm_phase(bx, G, xlat, xctx, A->in[I_GMIX] + l * D, mods_l, 3, 4, W.H, MTOT, lane, wave);
            } else if (s == 4) { IDS();
                pg8::Gemm g{W.H, W.wt + WT_IN, MTOT, INCP, D}; pg8::StaticOrder S; S.init(g.M, g.N, G, bx);
                EpiP E{W.P, INCP};
                pg8::gemm_phase<EpiP, pg8::StaticOrder, true, true>(lds, g, S, E, tid);
            } else if (s == 5) { IDS();
                pre_phase(bx, G, A, W, l, lds, tid, lane, wave);
            } else if (s == 6) { IDS();
                int Kl = LORA_K, Nl = LORA_N; asm volatile("" : "+s"(Kl), "+s"(Nl));
                pg8::Gemm g{(const bf16*)((const unsigned char*)W.H + HB_AP), W.wt + WT_LORA, MTOT, Nl, Kl}; pg8::StaticOrder S; S.init(g.M, g.N, G, bx);
                EpiLora E{A->in[I_W0] + l * 2 * RW, A->in[I_A0] + l * 2 * RW, A->in[I_KA] + l * RW, (const bf16*)((const unsigned char*)W.H + HB_KT), W.sc_kk, W.scb, W.P, l & 1};
                pg8::gemm_phase<EpiLora, pg8::StaticOrder, true, true>(lds, g, S, E, tid);
            } else if (s == 7) { IDS();
                for (int u = bx; u < 240; u += G) {
                    if (u < 192) rwkv_scan_phase(W, l, u, lds, tid, lane, wave); else lru_scan_phase(A, W, l, u - 192, lds, tid, lane, wave);
                    __syncthreads();
                }
            } else if (s == 8) { IDS();
                post_phase(bx, G, A, W, l, lds, tid, lane, wave);
            } else if (s == 10) { IDS();
                norm_phase(bx, G, xlat, xctx, A->in[I_GFFN2] + l * D, mods_l, 6, 7, W.H, last ? MLAT : MTOT, lane, wave);
            }
        }
#ifdef PROBE_REP_S
        if (ph > 0 && ph < N_PHASES - 1 && ((ph - 1) % PH_PER_LAYER) == PROBE_REP_S && !rep_done) { rep_done = true; grid.sync(); --ph; continue; }
        rep_done = false;
#endif
        if (ph + 1 < ph_hi) { if (ph == ph_lo) grid.sync(); else xcd_barrier(xbar); }
    }
}

#ifndef MK_MULTI
#define MK_MULTI 0
#endif
extern "C" void kernel_launch(void* const* d_in, const int* in_sizes, int n_in, void* d_out, int out_size, void* d_ws, size_t ws_size, hipStream_t stream) {
    static int grid = 0;
    if (grid == 0) {
        if (n_in != N_IN || out_size != MLAT * D || ws_size < WS_END) { fprintf(stderr, "kernel_launch: unexpected shapes (n_in %d out %d ws %zu)\n", n_in, out_size, ws_size); grid = -1; return; }
        int dev = 0, cus = 0, per_cu = 0;
        (void)hipGetDevice(&dev); (void)hipDeviceGetAttribute(&cus, hipDeviceAttributeMultiprocessorCount, dev);
        if (hipFuncSetAttribute((const void*)fwd_megakernel, hipFuncAttributeMaxDynamicSharedMemorySize, LDS_BYTES) != hipSuccess) { fprintf(stderr, "kernel_launch: hipFuncSetAttribute failed\n"); grid = -1; return; }
        if (hipOccupancyMaxActiveBlocksPerMultiprocessor(&per_cu, (const void*)fwd_megakernel, NTHR, LDS_BYTES) != hipSuccess || per_cu < 1) { fprintf(stderr, "kernel_launch: occupancy query says %d\n", per_cu); per_cu = 1; }
        (void)hipGetLastError();
        grid = cus * 1;
        if (grid <= 0) grid = 256;
    }
    if (grid < 0) return;
    if (hipMemsetAsync((unsigned char*)d_ws + WS_BAR, 0, WS_BAR_BYTES, stream) != hipSuccess) { fprintf(stderr, "kernel_launch: memset of the barrier words failed\n"); return; }
    Args a{};
    for (int i = 0; i < N_IN; ++i) a.in[i] = (const float*)d_in[i];
    a.out = (float*)d_out; a.ws = (unsigned char*)d_ws;
#if MK_MULTI
    for (int ph = 0; ph < N_PHASES; ++ph) { a.ph_lo = ph; a.ph_hi = ph + 1; hipLaunchKernelGGL(fwd_megakernel, dim3(grid), dim3(NTHR), LDS_BYTES, stream, a); }
#else
    a.ph_lo = 0; a.ph_hi = N_PHASES;
    void* args[] = {&a};
    hipError_t e = hipLaunchCooperativeKernel((const void*)fwd_megakernel, dim3(grid), dim3(NTHR), args, LDS_BYTES, stream);
    if (e != hipSuccess) fprintf(stderr, "kernel_launch: cooperative launch failed: %s (grid %d)\n", hipGetErrorString(e), grid);
#endif
}
```

```cpp
#include <hip/hip_runtime.h>
#include <hip/hip_cooperative_groups.h>
#include <cstdio>
#include <cstdint>
namespace cg = cooperative_groups;
namespace pg8 {
#define PG8_LAS __attribute__((address_space(3)))
typedef unsigned short bf16_t;
typedef short bf16x8 __attribute__((ext_vector_type(8)));
typedef float f32x4 __attribute__((ext_vector_type(4)));
typedef unsigned u32x4 __attribute__((ext_vector_type(4)));
constexpr int BM = 256, BK = 64, HALF = 128, HTB = HALF * BK * 2  , STAGE_BYTES = 8 * HTB, NXCD = 8, WGM = 8;

__host__ __device__ __forceinline__ int lds_byte(int r, int c) { const int st = (r >> 4) * 2 + (c >> 5), rr = r & 15, cc = c & 31, ob = rr * 64 + cc * 2; return st * 1024 + (ob ^ (((ob >> 9) & 1) << 5)); }
__host__ __device__ __forceinline__ void stage_rc(int b, int& R, int& C) { const int st = b / 1024, sb = b % 1024, swz = sb ^ (((sb >> 9) & 1) << 5); R = (st >> 1) * 16 + swz / 64; C = (st & 1) * 32 + (swz % 64) / 2; }
__host__ __device__ __forceinline__ int perm32(int rho) { const int n = rho >> 4, i = rho & 15; return 8 * (i >> 2) + 4 * n + (i & 3); }

struct Unit { int pm, pn; };
struct Gemm { const bf16_t* A; const bf16_t* Bt; int M, N, K; };

struct StaticOrder {
    int nM, nN, nwg, G, c;
    __host__ __device__ void init(int M, int N, int G_, int c_) { nM = M / BM; nN = N / BM; nwg = nM * nN; G = G_; c = c_; }
    __host__ __device__ bool next(int i, Unit& u) const {
        const long L = (long)i * G + c; if (L >= nwg) return false;
        int wgid = (int)L; { const int q = nwg / NXCD, r = nwg % NXCD, xcd = wgid % NXCD, off = wgid / NXCD; wgid = (xcd < r ? xcd * (q + 1) : r * (q + 1) + (xcd - r) * q) + off; }
        const int nig = WGM * nN, gid = wgid / nig, fm = gid * WGM, gsz = (nM - fm) < WGM ? (nM - fm) : WGM;
        u.pm = fm + ((wgid % nig) % gsz); u.pn = (wgid % nig) / gsz; return true;
    }
    __device__ __forceinline__ void a_ready(const Unit&) const {}
    __device__ __forceinline__ void done(const Unit&) const {}
};

template <class Epi, class Sched, bool ALIGN_EPI = false, bool SP2 = false>
__device__ __forceinline__ void gemm_phase(PG8_LAS unsigned char* lds, const Gemm g, const Sched& S, const Epi& E, const int tid) {
    const int wid = __builtin_amdgcn_readfirstlane(tid >> 6), lane = tid & 63, wr = wid >> 2, wc = wid & 3, fr = lane & 15, fq = lane >> 4;
    const int K = g.K, nt = K / BK;
    unsigned voffA[2], voffB[2];
#pragma unroll
    for (int i = 0; i < 2; ++i) { int R, C; stage_rc(tid * 16 + i * 8192, R, C); const int Rb = Epi::PERM ? ((R & ~31) + perm32(R & 31)) : R;
        voffA[i] = (unsigned)(R * K + C) * 2u; voffB[i] = (unsigned)(Rb * K + C) * 2u; }
    const size_t kstep = (size_t)(BK * 2);
    const size_t hstep = (size_t)HALF * K * 2;
    const size_t tstep = 2 * hstep;
    const unsigned ldsw = (unsigned)wid * 1024u;
    const int aoff = lds_byte(wr * 64 + fr, fq * 8), boff = lds_byte(wc * 32 + fr, fq * 8);
#define PG8_SA(b, h) (((b) * 2 + (h)) * HTB)
#define PG8_SB(b, h) ((4 + (b) * 2 + (h)) * HTB)
#define PG8_STAGE(bufoff, gbase, voff) do { _Pragma("unroll") for (int _i = 0; _i < 2; ++_i) \
        __builtin_amdgcn_global_load_lds((const unsigned*)((const char*)(gbase) + (voff)[_i]), (PG8_LAS unsigned*)(lds + (bufoff) + ldsw + _i * 8192), 16, 0, 0); } while (0)
#define PG8_LDA(dst, b, h) do { _Pragma("unroll") for (int m = 0; m < 4; ++m) _Pragma("unroll") for (int k = 0; k < 2; ++k) dst[m][k] = *(const PG8_LAS bf16x8*)(lds + PG8_SA(b, h) + aoff + m * 2048 + k * 1024); } while (0)
#define PG8_LDB(dst, b, h) do { _Pragma("unroll") for (int n = 0; n < 2; ++n) _Pragma("unroll") for (int k = 0; k < 2; ++k) dst[n][k] = *(const PG8_LAS bf16x8*)(lds + PG8_SB(b, h) + boff + n * 2048 + k * 1024); } while (0)
#define PG8_MMA(ai, bj, At, Bt) do { __builtin_amdgcn_s_setprio(1); _Pragma("unroll") for (int m = 0; m < 4; ++m) _Pragma("unroll") for (int n = 0; n < 2; ++n) _Pragma("unroll") for (int k = 0; k < 2; ++k) \
        acc[ai][bj][m][n] = __builtin_amdgcn_mfma_f32_16x16x32_bf16(Bt[n][k], At[m][k], acc[ai][bj][m][n], 0, 0, 0); __builtin_amdgcn_s_setprio(0); } while (0)
#define PG8_WAIT_V(n) asm volatile("s_waitcnt vmcnt(" #n ")" ::: "memory")
#define PG8_WAIT_L(n) asm volatile("s_waitcnt lgkmcnt(" #n ")" ::: "memory")
#define PG8_BAR __builtin_amdgcn_s_barrier()
#define PG8_SCHED __builtin_amdgcn_sched_barrier(0)
    Unit cur, nxt; int ui = 0;
    if (!S.next(0, cur)) return;
    f32x4 acc[2][2][4][2];
#pragma unroll
    for (int a = 0; a < 2; ++a)
#pragma unroll
        for (int b = 0; b < 2; ++b)
#pragma unroll
            for (int m = 0; m < 4; ++m)
#pragma unroll
                for (int n = 0; n < 2; ++n) acc[a][b][m][n] = (f32x4){0.f, 0.f, 0.f, 0.f};
    bf16x8 At[4][2], B0[2][2], B1[2][2];
    const char* cA = (const char*)g.A + (size_t)cur.pm * tstep; const char* cB = (const char*)g.Bt + (size_t)cur.pn * tstep;
    S.a_ready(cur);
    if constexpr (SP2) {
        PG8_STAGE(PG8_SB(0, 0), cB, voffB); PG8_STAGE(PG8_SB(0, 1), cB + hstep, voffB); PG8_STAGE(PG8_SA(0, 0), cA, voffA); PG8_STAGE(PG8_SA(0, 1), cA + hstep, voffA);
        if (wr == 1) PG8_BAR;
        PG8_WAIT_V(2); PG8_BAR;
        PG8_STAGE(PG8_SB(1, 0), cB + kstep, voffB); PG8_STAGE(PG8_SA(1, 0), cA + kstep, voffA); PG8_STAGE(PG8_SB(1, 1), cB + hstep + kstep, voffB);
        PG8_WAIT_V(6); PG8_BAR;
    } else {
        PG8_STAGE(PG8_SB(0, 0), cB, voffB); PG8_STAGE(PG8_SA(0, 0), cA, voffA); PG8_STAGE(PG8_SB(0, 1), cB + hstep, voffB); PG8_STAGE(PG8_SA(0, 1), cA + hstep, voffA);
        if (wr == 1) PG8_BAR;
        PG8_WAIT_V(4); PG8_BAR;
        PG8_STAGE(PG8_SB(1, 0), cB + kstep, voffB); PG8_STAGE(PG8_SA(1, 0), cA + kstep, voffA); PG8_STAGE(PG8_SB(1, 1), cB + hstep + kstep, voffB);
        PG8_WAIT_V(6); PG8_BAR;
    }
    for (;;) {
        const bool has_next = S.next(ui + 1, nxt);
        const char* nA = has_next ? (const char*)g.A + (size_t)nxt.pm * tstep : cA; const char* nB = has_next ? (const char*)g.Bt + (size_t)nxt.pn * tstep : cB;
        for (int t = 0; t < nt; t += 2) {
            const bool last = (t == nt - 2);
            const char* a1 = cA + (size_t)(t + 1) * kstep;
            const char* a2 = last ? nA : cA + (size_t)(t + 2) * kstep; const char* b2 = last ? nB : cB + (size_t)(t + 2) * kstep;
            const char* a3 = a2 + kstep; const char* b3 = b2 + kstep;
            if (last && has_next) S.a_ready(nxt);
            if constexpr (SP2) {
            PG8_LDB(B0, 0, 0); PG8_LDB(B1, 0, 1); PG8_SCHED; PG8_LDA(At, 0, 0); PG8_STAGE(PG8_SA(1, 1), a1 + hstep, voffA);
            PG8_WAIT_V(8); PG8_WAIT_L(0); PG8_BAR; PG8_MMA(0, 0, At, B0); PG8_MMA(0, 1, At, B1); PG8_BAR; PG8_SCHED;
            PG8_LDA(At, 0, 1); PG8_STAGE(PG8_SB(0, 0), b2, voffB); PG8_STAGE(PG8_SB(0, 1), b2 + hstep, voffB); PG8_STAGE(PG8_SA(0, 0), a2, voffA);
            PG8_WAIT_V(8); PG8_WAIT_L(0); PG8_BAR; PG8_MMA(1, 0, At, B0); PG8_MMA(1, 1, At, B1); PG8_BAR; PG8_SCHED;
            PG8_LDB(B0, 1, 0); PG8_LDB(B1, 1, 1); PG8_SCHED; PG8_LDA(At, 1, 0); PG8_STAGE(PG8_SA(0, 1), a2 + hstep, voffA);
            PG8_WAIT_V(8); PG8_WAIT_L(0); PG8_BAR; PG8_MMA(0, 0, At, B0); PG8_MMA(0, 1, At, B1); PG8_BAR; PG8_SCHED;
            PG8_LDA(At, 1, 1); PG8_STAGE(PG8_SB(1, 0), b3, voffB); PG8_STAGE(PG8_SB(1, 1), b3 + hstep, voffB); PG8_STAGE(PG8_SA(1, 0), a3, voffA);
            PG8_WAIT_V(8); PG8_WAIT_L(0); PG8_BAR; PG8_MMA(1, 0, At, B0); PG8_MMA(1, 1, At, B1); PG8_BAR; PG8_SCHED;
            } else {
            PG8_LDB(B0, 0, 0); PG8_SCHED; PG8_LDA(At, 0, 0); PG8_STAGE(PG8_SA(1, 1), a1 + hstep, voffA);
            PG8_WAIT_L(8); PG8_BAR; PG8_WAIT_L(0); PG8_MMA(0, 0, At, B0); PG8_BAR; PG8_SCHED;
            PG8_LDB(B1, 0, 1); PG8_STAGE(PG8_SB(0, 0), b2, voffB);
            PG8_BAR; PG8_WAIT_L(0); PG8_MMA(0, 1, At, B1); PG8_BAR;
            PG8_LDA(At, 0, 1); PG8_STAGE(PG8_SA(0, 0), a2, voffA);
            PG8_BAR; PG8_WAIT_L(0); PG8_MMA(1, 0, At, B0); PG8_BAR; PG8_SCHED;
            PG8_STAGE(PG8_SB(0, 1), b2 + hstep, voffB);
            PG8_WAIT_V(6); PG8_BAR; PG8_MMA(1, 1, At, B1); PG8_BAR;
            PG8_LDB(B0, 1, 0); PG8_SCHED; PG8_LDA(At, 1, 0); PG8_STAGE(PG8_SA(0, 1), a2 + hstep, voffA);
            PG8_WAIT_L(8); PG8_BAR; PG8_WAIT_L(0); PG8_MMA(0, 0, At, B0); PG8_BAR; PG8_SCHED;
            PG8_LDB(B1, 1, 1); PG8_STAGE(PG8_SB(1, 0), b3, voffB);
            PG8_BAR; PG8_WAIT_L(0); PG8_MMA(0, 1, At, B1); PG8_BAR;
            PG8_LDA(At, 1, 1); PG8_STAGE(PG8_SA(1, 0), a3, voffA);
            PG8_BAR; PG8_WAIT_L(0); PG8_MMA(1, 0, At, B0); PG8_BAR; PG8_SCHED;
            PG8_STAGE(PG8_SB(1, 1), b3 + hstep, voffB);
            PG8_WAIT_V(6); PG8_BAR; PG8_MMA(1, 1, At, B1); PG8_BAR;
            }
        }
        if constexpr (ALIGN_EPI) { if (wr == 0) PG8_BAR; }
        if constexpr (!Epi::AFTER_DRAIN) { E(acc, cur, wr, wc, fr, fq); S.done(cur); }
        if (!has_next) break;
#pragma unroll
        for (int a = 0; a < 2; ++a)
#pragma unroll
            for (int b = 0; b < 2; ++b)
#pragma unroll
                for (int m = 0; m < 4; ++m)
#pragma unroll
                    for (int n = 0; n < 2; ++n) acc[a][b][m][n] = (f32x4){0.f, 0.f, 0.f, 0.f};
        cur = nxt; cA = nA; cB = nB; ++ui;
        if constexpr (ALIGN_EPI) { if (wr == 1) PG8_BAR; }
    }
    PG8_WAIT_V(0);
    if constexpr (!ALIGN_EPI) { if (wr == 0) PG8_BAR; }
    PG8_BAR;
    if constexpr (Epi::AFTER_DRAIN) { E.fused(acc, cur, wr, wc, fr, fq, lds, wid, lane); S.done(cur); }
#undef PG8_SA
#undef PG8_SB
#undef PG8_STAGE
#undef PG8_LDA
#undef PG8_LDB
#undef PG8_MMA
#undef PG8_WAIT_V
#undef PG8_WAIT_L
#undef PG8_BAR
#undef PG8_SCHED
}
}
#define LAS __attribute__((address_space(3)))
typedef unsigned short bf16;
typedef unsigned v4u __attribute__((ext_vector_type(4)));
typedef unsigned v2u __attribute__((ext_vector_type(2)));
typedef float f32x4 __attribute__((ext_vector_type(4)));
typedef float f32x2 __attribute__((ext_vector_type(2)));

constexpr int D = 1024, NB = 8, SEQ = 4096, CTX = 256, DEPTH = 4, DFF = 2816;
constexpr int MLAT = NB * SEQ, MCTX = NB * CTX, MTOT = MLAT + MCTX;
constexpr int INC = 2944, INCP = 3072;
constexpr int RW = 384, LW = 384, RC = 1408;
constexpr int QLEN = CTX + SEQ;
constexpr int PC_BG = 0, PC_CG = 256, PC_XIN = 512, PC_RW = 768, PC_XR = 2176, PC_GR = 2560;
constexpr int PC_Y = 768;
constexpr int PC_G = 1536;
constexpr int LORA_N = 2048, LORA_K = 256;
constexpr int NWAVES = 8, NTHR = 512;
constexpr int LDS_BYTES = 147456;

constexpr size_t MiB = 1u << 20;
constexpr size_t WS_BAR = 1536 * 1024, WS_BAR_BYTES = 16384;
constexpr size_t WS_MODS = 0, WS_XRCTX = 2 * MiB, WS_WT = 10 * MiB, WS_H = 52 * MiB, WS_A = 120 * MiB, WS_B = 324 * MiB;
constexpr size_t SC_ELEMS = (size_t)NB * QLEN * RW;
constexpr size_t WS_END = WS_B + 9 * SC_ELEMS * 2 + (size_t)NB * QLEN * 128 * 2;
static_assert(WS_END <= 600 * MiB, "workspace map");
static_assert(WS_A + (size_t)MTOT * INCP * 2 <= WS_B, "P fits");
constexpr size_t WT_GU1 = 0, WT_DOWN1 = WT_GU1 + (size_t)2 * DFF * D, WT_IN = WT_DOWN1 + (size_t)D * DFF, WT_OUT = WT_IN + (size_t)INCP * D,
                 WT_GU2 = WT_OUT + (size_t)D * D, WT_DOWN2 = WT_GU2 + (size_t)2 * DFF * D, WT_TOTAL = WT_DOWN2 + (size_t)D * DFF;
constexpr size_t WT_LORA = WT_TOTAL;
static_assert(WS_WT + (WT_TOTAL + (size_t)LORA_N * LORA_K) * 2 <= WS_H, "weights fit");
constexpr size_t HB_AP = 0, HB_KT = (size_t)MTOT * LORA_K * 2;
static_assert(HB_KT + (size_t)MTOT * RW * 2 <= WS_A - WS_H, "H region overlay");

enum { I_X = 0, I_C, I_CTX, I_CCTX, I_WMOD, I_BMOD, I_GFFN1, I_WGU1, I_WDOWN1, I_GMIX, I_WIN, I_CONVA, I_MU, I_W0, I_W2, I_A0, I_A2, I_G2, I_KK, I_KA, I_RK,
       I_LNG, I_LNB, I_LCW, I_LCB, I_LWR, I_LBR, I_LWI, I_LBI, I_LAM, I_WOUT, I_GFFN2, I_WGU2, I_WDOWN2, I_GFINAL, N_IN };

struct Args { const float* in[N_IN]; float* out; unsigned char* ws; int ph_lo, ph_hi; };
typedef const __attribute__((address_space(4))) Args* CArgsP;

__device__ __forceinline__ float bf2f(unsigned h) { return __builtin_bit_cast(float, h << 16); }
__device__ __forceinline__ unsigned f2bf(float f) { unsigned u = __builtin_bit_cast(unsigned, f); return (u + 0x7fffu + ((u >> 16) & 1u)) >> 16; }
__device__ __forceinline__ unsigned pk2(float lo, float hi) { return f2bf(lo) | (f2bf(hi) << 16); }
__device__ __forceinline__ void unpack8(v4u p, float* o) {
    o[0] = __builtin_bit_cast(float, p.x << 16); o[1] = __builtin_bit_cast(float, p.x & 0xffff0000u);
    o[2] = __builtin_bit_cast(float, p.y << 16); o[3] = __builtin_bit_cast(float, p.y & 0xffff0000u);
    o[4] = __builtin_bit_cast(float, p.z << 16); o[5] = __builtin_bit_cast(float, p.z & 0xffff0000u);
    o[6] = __builtin_bit_cast(float, p.w << 16); o[7] = __builtin_bit_cast(float, p.w & 0xffff0000u);
}
__device__ __forceinline__ v4u pack8(const float* v) { v4u o; o.x = pk2(v[0], v[1]); o.y = pk2(v[2], v[3]); o.z = pk2(v[4], v[5]); o.w = pk2(v[6], v[7]); return o; }
template <int CTRL> __device__ __forceinline__ float dppf(float v) { return __builtin_bit_cast(float, __builtin_amdgcn_update_dpp(0, __builtin_bit_cast(int, v), CTRL, 0xF, 0xF, true)); }
__device__ __forceinline__ float wave_sum(float v) {
    v += dppf<0xB1>(v); v += dppf<0x4E>(v); v += dppf<0x141>(v); v += dppf<0x140>(v);
    const float a = __builtin_bit_cast(float, __builtin_amdgcn_readlane(__builtin_bit_cast(int, v), 0)), b = __builtin_bit_cast(float, __builtin_amdgcn_readlane(__builtin_bit_cast(int, v), 16));
    const float c = __builtin_bit_cast(float, __builtin_amdgcn_readlane(__builtin_bit_cast(int, v), 32)), d = __builtin_bit_cast(float, __builtin_amdgcn_readlane(__builtin_bit_cast(int, v), 48));
    return (a + b) + (c + d);
}
__device__ __forceinline__ float sigmoidf_(float x) { return 1.0f / (1.0f + __expf(-x)); }
__device__ __forceinline__ float siluf_(float x) { return x / (1.0f + __expf(-x)); }
__device__ __forceinline__ float softplusf_(float z) { return fmaxf(z, 0.f) + log1pf(__expf(-fabsf(z))); }
__device__ __forceinline__ float tanh_fast(float x) { const float e = __expf(2.0f * fminf(fmaxf(x, -15.f), 15.f)); return 1.0f - 2.0f * __builtin_amdgcn_rcpf(e + 1.0f); }
__device__ __forceinline__ float gelu_tanh(float x) { const float u = 0.7978845608028654f * (x + 0.044715f * x * x * x); return 0.5f * x * (1.0f + tanh_fast(u)); }
__device__ __forceinline__ float reduce16(float x) { x += dppf<0xB1>(x); x += dppf<0x4E>(x); x += dppf<0x141>(x); x += dppf<0x140>(x); return x; }
__device__ __forceinline__ float reduce8(float x) { x += dppf<0xB1>(x); x += dppf<0x4E>(x); x += dppf<0x141>(x); return x; }
__device__ __forceinline__ int row_of(int b, int q, int odd) {
    if (q < CTX) return MLAT + b * CTX + q;
    const int s = q - CTX; const int t = odd ? (((s & 63) << 6) | (s >> 6)) : s;
    return b * SEQ + t;
}

struct EpiSwiGLU {
    static constexpr bool PERM = true, AFTER_DRAIN = false;
    bf16* O;
    __device__ __forceinline__ void operator()(const pg8::f32x4 (&acc)[2][2][4][2], const pg8::Unit& u, int wr, int wc, int fr, int fq) const {
        const int row0 = u.pm * 256 + wr * 64 + fr, col0 = u.pn * 128 + wc * 32 + 8 * fq;
#pragma unroll
        for (int ai = 0; ai < 2; ++ai)
#pragma unroll
            for (int m = 0; m < 4; ++m) {
                float o[8];
#pragma unroll
                for (int n = 0; n < 2; ++n)
#pragma unroll
                    for (int j = 0; j < 4; ++j) { const float g = acc[ai][0][m][n][j], up = acc[ai][1][m][n][j]; o[n * 4 + j] = siluf_(g) * up; }
                *(v4u*)(O + (size_t)(row0 + ai * 128 + m * 16) * DFF + col0) = pack8(o);
            }
    }
};
struct EpiP {
    static constexpr bool PERM = true, AFTER_DRAIN = false;
    bf16* O; int ldc;
    __device__ __forceinline__ void operator()(const pg8::f32x4 (&acc)[2][2][4][2], const pg8::Unit& u, int wr, int wc, int fr, int fq) const {
        const int row0 = u.pm * 256 + wr * 64 + fr, col0 = u.pn * 256 + wc * 32 + 8 * fq;
#pragma unroll
        for (int ai = 0; ai < 2; ++ai)
#pragma unroll
            for (int m = 0; m < 4; ++m)
#pragma unroll
                for (int bj = 0; bj < 2; ++bj) {
                    float o[8];
#pragma unroll
                    for (int n = 0; n < 2; ++n)
#pragma unroll
                        for (int j = 0; j < 4; ++j) o[n * 4 + j] = acc[ai][bj][m][n][j];
                    *(v4u*)(O + (size_t)(row0 + ai * 128 + m * 16) * ldc + col0 + bj * 128) = pack8(o);
                }
    }
};
struct EpiResid {
    static constexpr bool PERM = true, AFTER_DRAIN = false;
    const float* res_lat; const float* res_ctx; float* dst_lat; float* dst_ctx; const float* gate; float coef;
    __device__ __forceinline__ void operator()(const pg8::f32x4 (&acc)[2][2][4][2], const pg8::Unit& u, int wr, int wc, int fr, int fq) const {
        const int rowbase = u.pm * 256; const bool isctx = rowbase >= MLAT;
        const int b = isctx ? 8 : (rowbase >> 12);
        const float* res = isctx ? res_ctx + (size_t)(rowbase - MLAT) * D : res_lat + (size_t)rowbase * D;
        float* dst = isctx ? dst_ctx + (size_t)(rowbase - MLAT) * D : dst_lat + (size_t)rowbase * D;
#pragma unroll
        for (int bj = 0; bj < 2; ++bj) {
            const int col = u.pn * 256 + bj * 128 + wc * 32 + 8 * fq;
            const f32x4 g0 = *(const f32x4*)(gate + (size_t)b * 9216 + col) * coef, g1 = *(const f32x4*)(gate + (size_t)b * 9216 + col + 4) * coef;
#pragma unroll
            for (int ai = 0; ai < 2; ++ai)
#pragma unroll
                for (int m = 0; m < 4; ++m) {
                    const size_t off = (size_t)(ai * 128 + wr * 64 + m * 16 + fr) * D + col;
                    const f32x4 r0 = *(const f32x4*)(res + off), r1 = *(const f32x4*)(res + off + 4);
                    *(f32x4*)(dst + off) = r0 + g0 * acc[ai][bj][m][0];
                    *(f32x4*)(dst + off + 4) = r1 + g1 * acc[ai][bj][m][1];
                }
        }
    }
};

struct EpiLora {
    static constexpr bool PERM = true, AFTER_DRAIN = false;
    const float* w0; const float* a0; const float* ka; const bf16* kt; const bf16* kk; bf16* scb; bf16* P; int odd;
    __device__ __forceinline__ void operator()(const pg8::f32x4 (&acc)[2][2][4][2], const pg8::Unit& u, int wr, int wc, int fr, int fq) const {
        asm volatile("" : "+v"(fr), "+v"(fq));
#pragma unroll
        for (int bj = 0; bj < 2; ++bj) {
            const int half = __builtin_amdgcn_readfirstlane(u.pn * 2 + bj), kind = half / 3, c = (half - kind * 3) * 128 + wc * 32 + 8 * fq;
            if (kind >= 5) continue;
#pragma unroll
            for (int ai = 0; ai < 2; ++ai)
#pragma unroll
                for (int m = 0; m < 4; ++m) {
                    const int pos = u.pm * 256 + ai * 128 + wr * 64 + m * 16 + fr;
                    float v[8];
#pragma unroll
                    for (int n = 0; n < 2; ++n)
#pragma unroll
                        for (int j = 0; j < 4; ++j) v[n * 4 + j] = acc[ai][bj][m][n][j];
                    if (kind < 2) {
                        const f32x4 q0 = *(const f32x4*)(w0 + kind * 384 + c), q1 = *(const f32x4*)(w0 + kind * 384 + c + 4);
                        const float p0[8] = {q0.x, q0.y, q0.z, q0.w, q1.x, q1.y, q1.z, q1.w};
#pragma unroll
                        for (int e = 0; e < 8; ++e) { const float wl = p0[e] + v[e]; const float sp = fmaxf(-wl, 0.f) + __logf(1.0f + __expf(-fabsf(wl)));
                            v[e] = 1.0f - __expf(-__expf(-sp - 0.5f)); }
                        *(v4u*)(scb + (size_t)(7 + kind) * SC_ELEMS + (size_t)pos * RW + c) = pack8(v);
                    } else if (kind < 4) {
                        const f32x4 q0 = *(const f32x4*)(a0 + (kind - 2) * 384 + c), q1 = *(const f32x4*)(a0 + (kind - 2) * 384 + c + 4);
                        const float p0[8] = {q0.x, q0.y, q0.z, q0.w, q1.x, q1.y, q1.z, q1.w};
#pragma unroll
                        for (int e = 0; e < 8; ++e) v[e] = sigmoidf_(p0[e] + v[e]);
                        {   float kkv[8]; unpack8(*(const v4u*)(kk + (size_t)pos * RW + c), kkv);
#pragma unroll
                            for (int e = 0; e < 8; ++e) kkv[e] *= v[e];
                            *(v4u*)(scb + (size_t)(5 + kind - 2) * SC_ELEMS + (size_t)pos * RW + c) = pack8(kkv); }
                        {   float kv[8]; unpack8(*(const v4u*)(kt + (size_t)pos * RW + c), kv);
                            const f32x4 r0 = *(const f32x4*)(ka + c), r1 = *(const f32x4*)(ka + c + 4);
                            const float p1[8] = {r0.x, r0.y, r0.z, r0.w, r1.x, r1.y, r1.z, r1.w};
#pragma unroll
                            for (int e = 0; e < 8; ++e) kv[e] *= (1.0f + (v[e] - 1.0f) * p1[e]);
                            *(v4u*)(scb + (size_t)(3 + kind - 2) * SC_ELEMS + (size_t)pos * RW + c) = pack8(kv); }
                    } else {
                        const int b = pos / QLEN, q = pos - b * QLEN;
                        *(v4u*)(P + (size_t)row_of(b, q, odd) * INCP + PC_G + c) = pack8(v);
                    }
                    asm volatile("" ::: "memory");
                }
        }
    }
};
struct WS {
    float* mods; float* xrctx; bf16* wt; bf16* H; bf16* P; bf16* ACT;
    bf16 *scb, *sc_r, *sc_v, *sc_kk, *dgs;
};
__device__ __forceinline__ WS make_ws(unsigned char* ws) {
    WS w; w.mods = (float*)(ws + WS_MODS); w.xrctx = (float*)(ws + WS_XRCTX); w.wt = (bf16*)(ws + WS_WT); w.H = (bf16*)(ws + WS_H); w.P = (bf16*)(ws + WS_A); w.ACT = (bf16*)(ws + WS_A);
    bf16* b = (bf16*)(ws + WS_B);
    w.scb = b; w.sc_r = b; w.sc_v = b + SC_ELEMS; w.sc_kk = b + 2 * SC_ELEMS; w.dgs = b + 9 * SC_ELEMS;
    return w;
}

__device__ __forceinline__ void mods_phase(const int bx, const int G, CArgsP A, const WS& W, LAS unsigned char* lds, int tid, int lane, int wave) {
    LAS float* sl = (LAS float*)lds;
    LAS float* part = sl + 9 * 1024;
    const float* c = A->in[I_C]; const float* cctx = A->in[I_CCTX];
    for (int i = tid; i < 9216; i += NTHR) { const int r = i >> 10, k = i & 1023; const float v = r < 8 ? c[r * 1024 + k] : cctx[k]; sl[i] = siluf_(v); }
    __syncthreads();
    for (int item = bx; item < 288; item += G) {
        const int l = item / 72, cgp = item % 72;
        const float* Wp = A->in[I_WMOD] + (size_t)l * 1024 * 9216 + cgp * 128 + lane * 2;
        float acc[9][2];
#pragma unroll
        for (int r = 0; r < 9; ++r) { acc[r][0] = 0.f; acc[r][1] = 0.f; }
#pragma unroll 8
        for (int kk = 0; kk < 128; ++kk) {
            const int k = wave * 128 + kk;
            const f32x2 w = *(const f32x2*)(Wp + (size_t)k * 9216);
#pragma unroll
            for (int r = 0; r < 9; ++r) { const float s = sl[r * 1024 + k]; acc[r][0] += s * w.x; acc[r][1] += s * w.y; }
        }
#pragma unroll
        for (int r = 0; r < 9; ++r) { part[(wave * 9 + r) * 128 + lane * 2] = acc[r][0]; part[(wave * 9 + r) * 128 + lane * 2 + 1] = acc[r][1]; }
        __syncthreads();
        for (int o = tid; o < 1152; o += NTHR) {
            const int r = o >> 7, cc = o & 127; float s = A->in[I_BMOD][l * 9216 + cgp * 128 + cc];
#pragma unroll
            for (int w8 = 0; w8 < 8; ++w8) s += part[(w8 * 9 + r) * 128 + cc];
            W.mods[(size_t)(l * 9 + r) * 9216 + cgp * 128 + cc] = s;
        }
        __syncthreads();
    }
}

__device__ __forceinline__ void transpose_item(const float* Wsrc, int K, int N, bf16* WT, int kb, int n0, int drow0, LAS float* scr, int lane) {
    const int k0 = 64 * kb;
#pragma unroll 8
    for (int i = 0; i < 32; ++i) { const int kk = 2 * i + (lane >> 5); scr[kk * 33 + (lane & 31)] = Wsrc[(size_t)(k0 + kk) * N + n0 + (lane & 31)]; }
    asm volatile("s_waitcnt lgkmcnt(0)" ::: "memory");
    const int c = lane & 7;
#pragma unroll
    for (int j = 0; j < 4; ++j) { const int n = (lane >> 3) + 8 * j; const LAS float* s = scr + (8 * c) * 33 + n;
        v4u o; o.x = pk2(s[0 * 33], s[1 * 33]); o.y = pk2(s[2 * 33], s[3 * 33]); o.z = pk2(s[4 * 33], s[5 * 33]); o.w = pk2(s[6 * 33], s[7 * 33]);
        *(v4u*)(WT + (size_t)(drow0 + n) * K + k0 + 8 * c) = o; }
    asm volatile("s_waitcnt lgkmcnt(0)" ::: "memory");
}
__device__ __forceinline__ int gu_drow(int n0) { return n0 < DFF ? 256 * (n0 >> 7) + (n0 & 127) : 256 * ((n0 - DFF) >> 7) + 128 + ((n0 - DFF) & 127); }
__device__ __forceinline__ void convert_phase(const int bx, const int G, CArgsP A, const WS& W, int l, LAS unsigned char* lds, int lane, int wave) {
    LAS float* scr = (LAS float*)(lds + wave * 16384);
    const int gw = bx * NWAVES + wave, NGW = G * NWAVES;
    constexpr int I_GU = (D / 64) * (2 * DFF / 32), I_DN = (DFF / 64) * (D / 32), I_IN = (D / 64) * (INC / 32), I_OUT = (D / 64) * (D / 32);
    constexpr int NITEMS = 2 * I_GU + 2 * I_DN + I_IN + I_OUT;
    for (int it = gw; it < NITEMS; it += NGW) {
        int r = it;
        if (r < I_GU) { const int nblk = 2 * DFF / 32, kb = r / nblk, n0 = (r % nblk) * 32; transpose_item(A->in[I_WGU1] + (size_t)l * D * 2 * DFF, D, 2 * DFF, W.wt + WT_GU1, kb, n0, gu_drow(n0), scr, lane); continue; } r -= I_GU;
        if (r < I_GU) { const int nblk = 2 * DFF / 32, kb = r / nblk, n0 = (r % nblk) * 32; transpose_item(A->in[I_WGU2] + (size_t)l * D * 2 * DFF, D, 2 * DFF, W.wt + WT_GU2, kb, n0, gu_drow(n0), scr, lane); continue; } r -= I_GU;
        if (r < I_DN) { const int nblk = D / 32, kb = r / nblk, n0 = (r % nblk) * 32; transpose_item(A->in[I_WDOWN1] + (size_t)l * DFF * D, DFF, D, W.wt + WT_DOWN1, kb, n0, n0, scr, lane); continue; } r -= I_DN;
        if (r < I_DN) { const int nblk = D / 32, kb = r / nblk, n0 = (r % nblk) * 32; transpose_item(A->in[I_WDOWN2] + (size_t)l * DFF * D, DFF, D, W.wt + WT_DOWN2, kb, n0, n0, scr, lane); continue; } r -= I_DN;
        if (r < I_IN) { const int nblk = INC / 32, kb = r / nblk, n0 = (r % nblk) * 32; transpose_item(A->in[I_WIN] + (size_t)l * D * INC, D, INC, W.wt + WT_IN, kb, n0, n0, scr, lane); continue; } r -= I_IN;
        { const int nblk = D / 32, kb = r / nblk, n0 = (r % nblk) * 32; transpose_item(A->in[I_WOUT] + (size_t)l * D * D, D, D, W.wt + WT_OUT, kb, n0, n0, scr, lane); }
    }
    for (int idx = (bx * NWAVES + wave) * 64 + lane; idx < LORA_N * LORA_K; idx += G * NTHR) {
        const int n = idx % LORA_N, k = idx / LORA_N, kind = n / 384, c = n - kind * 384;
        float v = 0.f;
        if (kind < 2) { if (k < 64) v = A->in[I_W2][((size_t)(l * 2 + kind) * 64 + k) * RW + c]; }
        else if (kind < 4) { if (k >= 64 && k < 128) v = A->in[I_A2][((size_t)(l * 2 + kind - 2) * 64 + (k - 64)) * RW + c]; }
        else if (kind == 4) { if (k >= 128) v = A->in[I_G2][((size_t)l * 128 + (k - 128)) * RW + c]; }
        W.wt[WT_LORA + (size_t)n * LORA_K + k] = (bf16)f2bf(v);
    }
}

__device__ __forceinline__ void norm_phase(const int bx, const int G, const float* lat, const float* ctxp, const float* g, const float* mods_l, int ishift, int iscale, bf16* H, int nrows, int lane, int wave) {
    const int gw = bx * NWAVES + wave, NGW = G * NWAVES;
    for (int r = gw; r < nrows; r += NGW) {
        const float* xr = r < MLAT ? lat + (size_t)r * D : ctxp + (size_t)(r - MLAT) * D;
        const int b = r < MLAT ? (r >> 12) : 8;
        const float* sh = mods_l + (size_t)b * 9216 + ishift * 1024; const float* sc = mods_l + (size_t)b * 9216 + iscale * 1024;
        f32x4 v[4]; float s = 0.f;
#pragma unroll
        for (int j = 0; j < 4; ++j) { v[j] = *(const f32x4*)(xr + (lane + 64 * j) * 4); s += (v[j].x * v[j].x + v[j].y * v[j].y) + (v[j].z * v[j].z + v[j].w * v[j].w); }
        s = wave_sum(s);
        const float rstd = rsqrtf(s * (1.0f / D) + 1e-6f);
#pragma unroll
        for (int j = 0; j < 4; ++j) {
            const int col = (lane + 64 * j) * 4;
            const f32x4 gg = *(const f32x4*)(g + col), s4 = *(const f32x4*)(sh + col), c4 = *(const f32x4*)(sc + col);
            const f32x4 h = (v[j] * rstd) * gg * (c4 + 1.0f) + s4;
            v2u o; o.x = pk2(h.x, h.y); o.y = pk2(h.z, h.w);
            *(v2u*)(H + (size_t)r * D + col) = o;
        }
    }
}
__device__ __forceinline__ void final_norm_phase(const int bx, const int G, float* xo, const float* g, int lane, int wave) {
    const int gw = bx * NWAVES + wave, NGW = G * NWAVES;
    for (int r = gw; r < MLAT; r += NGW) {
        float* xr = xo + (size_t)r * D;
        f32x4 v[4]; float s = 0.f;
#pragma unroll
        for (int j = 0; j < 4; ++j) { v[j] = *(const f32x4*)(xr + (lane + 64 * j) * 4); s += (v[j].x * v[j].x + v[j].y * v[j].y) + (v[j].z * v[j].z + v[j].w * v[j].w); }
        s = wave_sum(s);
        const float rstd = rsqrtf(s * (1.0f / D) + 1e-6f);
#pragma unroll
        for (int j = 0; j < 4; ++j) { const int col = (lane + 64 * j) * 4; const f32x4 gg = *(const f32x4*)(g + col); *(f32x4*)(xr + col) = (v[j] * rstd) * gg; }
    }
}

__device__ __forceinline__ void pre_item(int it, int& i, int& col) {
    if (it < 2304) { const int seg = it / 768, r = it - seg * 768; i = r / 48; col = seg * 384 + (r % 48) * 8; }
    else if (it < 2560) { const int r = it - 2304; i = (r & 127) >> 3; col = 1152 + (r >> 7) * 64 + (r & 7) * 8; }
    else { const int r = it - 2560; i = r >> 4; col = 1280 + (r & 15) * 8; }
}
__device__ __forceinline__ void pre_phase(const int bx, const int G, CArgsP A, const WS& W, int l, LAS unsigned char* lds, int tid, int lane, int wave) {
    LAS float* k_s = (LAS float*)lds;
    const int odd = l & 1;
    const float* mu0 = A->in[I_MU] + (size_t)l * 2 * RC; const float* mu1 = mu0 + RC;
    const float* kkp = A->in[I_KK] + l * RW;
    bf16* AP = (bf16*)((unsigned char*)W.H + HB_AP); bf16* KT = (bf16*)((unsigned char*)W.H + HB_KT);
    for (int tile = bx; tile < NB * (QLEN / 16); tile += G) {
        const int b = tile / (QLEN / 16), q0 = (tile % (QLEN / 16)) * 16;
        const int seq_lo = q0 < CTX ? 0 : CTX, seq_hi = q0 < CTX ? CTX : QLEN;
        for (int pass = 0; pass < 2; ++pass) {
            v4u rc[3], rp[3], rn[3];
#pragma unroll
            for (int u = 0; u < 3; ++u) { const int it0 = tid + NTHR * (pass * 3 + u), it = it0 < 16 * 176 ? it0 : 16 * 176 - 1;
                int i, col; pre_item(it, i, col); const int q = q0 + i;
                const int qp = q - 1 >= seq_lo ? q - 1 : q, qn = q + 1 < seq_hi ? q + 1 : q;
                rc[u] = *(const v4u*)(W.P + (size_t)row_of(b, q, odd) * INCP + PC_RW + col);
                rp[u] = *(const v4u*)(W.P + (size_t)row_of(b, qp, odd) * INCP + PC_RW + col);
                rn[u] = *(const v4u*)(W.P + (size_t)row_of(b, qn, odd) * INCP + PC_RW + col); }
#pragma unroll
            for (int u = 0; u < 3; ++u) { const int it0 = tid + NTHR * (pass * 3 + u);
                if (it0 < 16 * 176) {
                    int i, col; pre_item(it0, i, col); const int q = q0 + i;
                    const size_t pos = (size_t)b * QLEN + q;
                    float cur[8], prv[8], nxt[8], ps[8];
                    unpack8(rc[u], cur); unpack8(rp[u], prv); unpack8(rn[u], nxt);
                    const float mp = q - 1 >= seq_lo ? 1.f : 0.f, mn = q + 1 < seq_hi ? 1.f : 0.f;
#pragma unroll
                    for (int e = 0; e < 8; ++e) ps[e] = cur[e] + mu0[col + e] * (prv[e] * mp - cur[e]) + mu1[col + e] * (nxt[e] * mn - cur[e]);
                    if (col < 384) *(v4u*)(W.sc_r + pos * RW + col) = pack8(ps);
                    else if (col < 768) {
#pragma unroll
                        for (int e = 0; e < 8; ++e) k_s[i * 384 + col - 384 + e] = ps[e];
                        *(v4u*)(KT + pos * RW + (col - 384)) = pack8(ps); }
                    else if (col < 1152) *(v4u*)(W.sc_v + pos * RW + (col - 768)) = pack8(ps);
                    else if (col < 1216) {
#pragma unroll
                        for (int e = 0; e < 8; ++e) ps[e] = tanh_fast(ps[e]);
                        *(v4u*)(AP + pos * LORA_K + (col - 1152)) = pack8(ps); }
                    else if (col < 1280) *(v4u*)(AP + pos * LORA_K + 64 + (col - 1216)) = pack8(ps);
                    else {
#pragma unroll
                        for (int e = 0; e < 8; ++e) ps[e] = sigmoidf_(ps[e]);
                        *(v4u*)(AP + pos * LORA_K + 128 + (col - 1280)) = pack8(ps); }
                }
            }
        }
        __syncthreads();
        for (int it = wave; it < 96; it += NWAVES) {
            const int i = it / 6, h = it % 6, c = h * 64 + lane;
            const float val = k_s[i * 384 + c] * kkp[c];
            const float ss = wave_sum(val * val);
            W.sc_kk[((size_t)b * QLEN + q0 + i) * RW + c] = (bf16)f2bf(val * rsqrtf(ss + 1e-12f));
        }
        __syncthreads();
    }
}

__device__ __forceinline__ int q_of_step(int n, int d) { return d == 0 ? n : (n < CTX ? CTX - 1 - n : QLEN + CTX - 1 - n); }
constexpr int RCH = 32, RNCH = QLEN / RCH;
__device__ __forceinline__ void rwkv_scan_phase(const WS& W, int l, int blk, LAS unsigned char* lds, int tid, int lane, int wave) {
    const int item = blk >> 1, half = blk & 1;
    const int b = item / 12, rem = item % 12, h = rem >> 1, d = rem & 1, odd = l & 1;
    LAS float* buf = (LAS float*)lds;
    LAS float* ybuf = buf + 2 * RCH * 384;
    const bf16* s_omw = W.scb + (size_t)(7 + d) * SC_ELEMS; const bf16* s_b = W.scb + (size_t)(5 + d) * SC_ELEMS; const bf16* s_kd = W.scb + (size_t)(3 + d) * SC_ELEMS;
    const int rg = lane >> 4, j = lane & 15, rlA = (wave & 3) * 8 + rg, rlB = rlA + 4, rowA = half * 32 + rlA, rowB = half * 32 + rlB;
    v4u pre[3];
#define RW_LOAD(c) do { _Pragma("unroll") for (int jj = 0; jj < 3; ++jj) { const int p = tid + NTHR * jj, i = p / 48, r48 = p % 48, vec = r48 >> 3, part = r48 & 7; \
        const int q = q_of_step((c) * RCH + i, d); const size_t pos = (size_t)b * QLEN + q; \
        const bf16* base = vec == 0 ? s_omw : vec == 1 ? s_b : vec == 2 ? s_kd : vec == 3 ? W.sc_kk : vec == 4 ? W.sc_r : W.sc_v; \
        pre[jj] = *(const v4u*)(base + pos * RW + h * 64 + part * 8); } } while (0)
#define RW_STORE(c) do { _Pragma("unroll") for (int jj = 0; jj < 3; ++jj) { const int p = tid + NTHR * jj, i = p / 48, r48 = p % 48, vec = r48 >> 3, part = r48 & 7; \
        float f[8]; unpack8(pre[jj], f); if (vec == 0) { _Pragma("unroll") for (int e = 0; e < 8; ++e) f[e] = 1.0f - f[e]; } \
        LAS float* dst = buf + (((c) & 1) * RCH + i) * 384 + vec * 64 + part * 8; \
        *(LAS f32x4*)dst = (f32x4){f[0], f[1], f[2], f[3]}; *(LAS f32x4*)(dst + 4) = (f32x4){f[4], f[5], f[6], f[7]}; } } while (0)
    f32x2 SA0 = (f32x2){0.f, 0.f}, SA1 = SA0, SB0 = SA0, SB1 = SA0;
    RW_LOAD(0); RW_STORE(0);
    __syncthreads();
    for (int c = 0; c < RNCH; ++c) {
        if (c + 1 < RNCH) RW_LOAD(c + 1);
        const LAS float* cur = buf + (c & 1) * RCH * 384;
        if (wave < 4) {
        float ykA, ykB;
#define RW_LD(X, i_) do { const int ii_ = (i_) < RCH ? (i_) : RCH - 1; const LAS f32x4* bp_ = (const LAS f32x4*)(cur + ii_ * 384 + j * 4); \
        X##w = bp_[0]; X##b = bp_[16]; X##d = bp_[32]; X##k = bp_[48]; X##r = bp_[64]; X##va = cur[ii_ * 384 + 320 + rowA]; X##vb = cur[ii_ * 384 + 320 + rowB]; } while (0)
#define RW_CP(X, s_) do { \
        const f32x2 k0_ = (f32x2){X##k.x, X##k.y}, k1_ = (f32x2){X##k.z, X##k.w}; \
        const f32x2 ta_ = SA0 * k0_ + SA1 * k1_, tb_ = SB0 * k0_ + SB1 * k1_; \
        const float saA_ = -reduce16(ta_.x + ta_.y), saB_ = -reduce16(tb_.x + tb_.y); \
        const f32x2 w0_ = (f32x2){X##w.x, X##w.y}, w1_ = (f32x2){X##w.z, X##w.w}, b0_ = (f32x2){X##b.x, X##b.y}, b1_ = (f32x2){X##b.z, X##b.w}, d0_ = (f32x2){X##d.x, X##d.y}, d1_ = (f32x2){X##d.z, X##d.w}; \
        const f32x2 va2_ = (f32x2){X##va, X##va}, vb2_ = (f32x2){X##vb, X##vb}, sa2_ = (f32x2){saA_, saA_}, sb2_ = (f32x2){saB_, saB_}; \
        SA0 = SA0 * w0_ + va2_ * d0_ + sa2_ * b0_; SA1 = SA1 * w1_ + va2_ * d1_ + sa2_ * b1_; \
        SB0 = SB0 * w0_ + vb2_ * d0_ + sb2_ * b0_; SB1 = SB1 * w1_ + vb2_ * d1_ + sb2_ * b1_; \
        const f32x2 r0_ = (f32x2){X##r.x, X##r.y}, r1_ = (f32x2){X##r.z, X##r.w}; \
        const f32x2 ya_ = SA0 * r0_ + SA1 * r1_, yb_ = SB0 * r0_ + SB1 * r1_; \
        const float yA_ = reduce16(ya_.x + ya_.y), yB_ = reduce16(yb_.x + yb_.y); \
        ykA = ((s_) == j) ? yA_ : ykA; ykB = ((s_) == j) ? yB_ : ykB; } while (0)
        f32x4 Aw, Ab, Ad, Ak, Ar, Bw, Bb, Bd, Bk, Br; float Ava, Avb, Bva, Bvb;
        RW_LD(A, 0);
#pragma unroll 1
        for (int g = 0; g < 2; ++g) {
            ykA = 0.f; ykB = 0.f;
#pragma unroll
            for (int s2 = 0; s2 < 16; s2 += 2) {
                const int i = g * 16 + s2;
                RW_LD(B, i + 1);
                __builtin_amdgcn_sched_barrier(0);
                RW_CP(A, s2);
                __builtin_amdgcn_sched_barrier(0);
                RW_LD(A, i + 2);
                __builtin_amdgcn_sched_barrier(0);
                RW_CP(B, s2 + 1);
                __builtin_amdgcn_sched_barrier(0);
            }
            ybuf[(g * 16 + j) * 32 + rlA] = ykA; ybuf[(g * 16 + j) * 32 + rlB] = ykB;
        }
#undef RW_LD
#undef RW_CP
        }
        __syncthreads();
        if (tid < 256) {
            const int i = tid >> 3, r4 = (tid & 7) * 4;
            const int q = q_of_step(c * RCH + i, d);
            const f32x4 yv = *(const LAS f32x4*)(ybuf + i * 32 + r4);
            v2u o; o.x = pk2(yv.x, yv.y); o.y = pk2(yv.z, yv.w);
            *(v2u*)(W.P + (size_t)row_of(b, q, odd) * INCP + PC_Y + d * RW + h * 64 + half * 32 + r4) = o;
        }
        if (c + 1 < RNCH) RW_STORE(c + 1);
        __syncthreads();
    }
#undef RW_LOAD
#undef RW_STORE
}

__device__ __forceinline__ void lru_scan_phase(CArgsP A, const WS& W, int l, int idx, LAS unsigned char* lds, int tid, int lane, int wave) {
    const int b = idx / 6, n = idx % 6, odd = l & 1;
    LAS float* gs = (LAS float*)lds;
    LAS float* xs = gs;
    LAS float* us = gs + 4 * 4096;
    LAS bf16* ub = (LAS bf16*)(us + 2 * 4096);
    const int c = tid & 63;
    float cw[2][4], cb[2], sp[2];
#pragma unroll
    for (int dd = 0; dd < 2; ++dd) {
#pragma unroll
        for (int jj = 0; jj < 4; ++jj) cw[dd][jj] = A->in[I_LCW][((size_t)(l * 2 + dd) * 4 + jj) * LW + n * 64 + c];
        cb[dd] = A->in[I_LCB][(l * 2 + dd) * LW + n * 64 + c];
        sp[dd] = softplusf_(-A->in[I_LAM][(l * 2 + dd) * LW + n * 64 + c]);
    }
    const int g = wave >> 2, jcol = (wave & 3) * 16 + (lane & 15), quad = lane >> 4;
    pg8::bf16x8 bfrag[2][2]; float gbias[2];
#pragma unroll
    for (int dd = 0; dd < 2; ++dd) {
        const float* Wsrc = (g ? A->in[I_LWI] : A->in[I_LWR]) + ((size_t)((l * 2 + dd) * 6 + n) * 64) * 64 + jcol;
#pragma unroll
        for (int ks = 0; ks < 2; ++ks)
#pragma unroll
            for (int jj = 0; jj < 8; ++jj) bfrag[dd][ks][jj] = (short)f2bf(Wsrc[(size_t)(ks * 32 + quad * 8 + jj) * 64]);
        gbias[dd] = (g ? A->in[I_LBI] : A->in[I_LBR])[(l * 2 + dd) * LW + n * 64 + jcol];
    }
    float hstate = 0.f;
    v4u pre[2][2];
#define LRU_LOAD(ch) do { _Pragma("unroll") for (int dd = 0; dd < 2; ++dd) { const int n0 = (ch) * 64; const int qlo_ = dd == 0 ? n0 : q_of_step(n0, 1) - 63; const int qb_ = dd == 0 ? qlo_ - 3 : qlo_; \
        const int slo_ = qlo_ < CTX ? 0 : CTX, shi_ = qlo_ < CTX ? CTX : QLEN; \
        _Pragma("unroll") for (int jj = 0; jj < 2; ++jj) { const int p = tid + NTHR * jj; const int t = p >> 3, part = p & 7, q = qb_ + t; \
            pre[dd][jj] = (v4u){0u, 0u, 0u, 0u}; \
            if (t < 67 && q >= slo_ && q < shi_) pre[dd][jj] = *(const v4u*)(W.P + (size_t)row_of(b, q, odd) * INCP + PC_XR + n * 64 + part * 8); } } } while (0)
    LRU_LOAD(0);
    const int tid_o = tid, lane_o = lane;
    for (int ch = 0; ch < QLEN / 64; ++ch) {
        const int n0 = ch * 64;
        int tid = tid_o, lane = lane_o; asm volatile("" : "+v"(tid), "+v"(lane));
        const int c = tid & 63, jcol = (wave & 3) * 16 + (lane & 15), quad = lane >> 4;
#pragma unroll
        for (int dd = 0; dd < 2; ++dd)
#pragma unroll
            for (int jj = 0; jj < 2; ++jj) { const int p = tid + NTHR * jj; const int t = p >> 3, part = p & 7;
                if (t < 67) { float f[8]; unpack8(pre[dd][jj], f); LAS float* dst = xs + dd * 68 * 64 + t * 64 + part * 8;
                    *(LAS f32x4*)dst = (f32x4){f[0], f[1], f[2], f[3]}; *(LAS f32x4*)(dst + 4) = (f32x4){f[4], f[5], f[6], f[7]}; } }
        __syncthreads();
        if (ch + 1 < QLEN / 64) LRU_LOAD(ch + 1);
#pragma unroll
        for (int k = 0; k < 16; ++k) { const int dd = k >> 3, t = (tid >> 6) + 8 * (k & 7); const LAS float* x = xs + dd * 68 * 64;
            const float uv = cb[dd] + cw[dd][0] * x[t * 64 + c] + cw[dd][1] * x[(t + 1) * 64 + c] + cw[dd][2] * x[(t + 2) * 64 + c] + cw[dd][3] * x[(t + 3) * 64 + c];
            us[dd * 4096 + t * 64 + c] = uv; ub[dd * 64 * 72 + t * 72 + c] = (bf16)f2bf(uv); }
        __syncthreads();
#pragma unroll
        for (int dd = 0; dd < 2; ++dd)
#pragma unroll
            for (int rt = 0; rt < 4; ++rt) {
                pg8::f32x4 acc = {0.f, 0.f, 0.f, 0.f};
#pragma unroll
                for (int ks = 0; ks < 2; ++ks) {
                    const pg8::bf16x8 afrag = *(const LAS pg8::bf16x8*)(ub + dd * 64 * 72 + (rt * 16 + (lane & 15)) * 72 + ks * 32 + quad * 8);
                    acc = __builtin_amdgcn_mfma_f32_16x16x32_bf16(afrag, bfrag[dd][ks], acc, 0, 0, 0);
                }
#pragma unroll
                for (int jj = 0; jj < 4; ++jj) gs[((dd * 2 + g) * 64 + rt * 16 + quad * 4 + jj) * 64 + jcol] = sigmoidf_(acc[jj] + gbias[dd]);
            }
        __syncthreads();
#pragma unroll
        for (int k = 0; k < 16; ++k) { const int dd = k >> 3, t = (tid >> 6) + 8 * (k & 7);
            LAS float* ga = gs + (dd * 2) * 4096 + t * 64 + c; LAS float* gb = ga + 4096;
            const float rgv = *ga, igv = *gb, u = us[dd * 4096 + t * 64 + c];
            const float log_a = -8.0f * sp[dd] * rgv;
            const float a = __expf(log_a);
            const float bt = sqrtf(fmaxf(1.0f - a * a, 0.f)) * (igv * u);
            *ga = a; *gb = bt; }
        __syncthreads();
        if (wave < 2) {
            const int dd = wave; const int qlo = dd == 0 ? n0 : q_of_step(n0, 1) - 63;
            const LAS float* ga = gs + (dd * 2) * 4096 + lane;
#pragma unroll 8
            for (int s = 0; s < 64; ++s) { const int t = dd == 0 ? s : 63 - s;
                hstate = ga[t * 64] * hstate + ga[4096 + t * 64];
                W.H[(size_t)row_of(b, qlo + t, odd) * D + dd * LW + n * 64 + lane] = (bf16)f2bf(hstate); }
        }
        __syncthreads();
    }
#undef LRU_LOAD
}

__device__ __forceinline__ void post_phase(const int bx, const int G, CArgsP A, const WS& W, int l, LAS unsigned char* lds, int tid, int lane, int wave) {
    LAS float* hs = (LAS float*)lds;
    const int odd = l & 1;
    const float* cwa = A->in[I_CONVA] + (size_t)l * 3 * 256;
    const float* rk = A->in[I_RK] + l * RW; const float* lng = A->in[I_LNG] + l * RW; const float* lnb = A->in[I_LNB] + l * RW;
    bf16* Y = W.H;
    for (int tile = bx; tile < NB * (QLEN / 16); tile += G) {
        const int b = tile / (QLEN / 16), q0 = (tile % (QLEN / 16)) * 16;
        for (int it = tid; it < 16 * 48; it += NTHR) { const int i = it / 48, col = (it % 48) * 8; const size_t row = row_of(b, q0 + i, odd);
            float h0[8], h1[8]; unpack8(*(const v4u*)(W.H + row * D + col), h0); unpack8(*(const v4u*)(W.H + row * D + LW + col), h1);
#pragma unroll
            for (int e = 0; e < 8; ++e) hs[i * 384 + col + e] = h0[e] + h1[e]; }
        __syncthreads();
        for (int it = tid; it < 16 * 32; it += NTHR) { const int i = it >> 5, col = (it & 31) * 8, q = q0 + i;
            int lo, hi; if (q < CTX) { lo = 0; hi = CTX; } else { lo = CTX + ((q - CTX) & ~63); hi = lo + 64; }
            const size_t row = row_of(b, q, odd);
            float bg[8], cgv[8], xv[8], y[8];
            unpack8(*(const v4u*)(W.P + row * INCP + PC_BG + col), bg); unpack8(*(const v4u*)(W.P + row * INCP + PC_CG + col), cgv); unpack8(*(const v4u*)(W.P + row * INCP + PC_XIN + col), xv);
#pragma unroll
            for (int e = 0; e < 8; ++e) y[e] = cwa[256 + col + e] * (cgv[e] * xv[e]);
            if (q - 1 >= lo) { const size_t r2 = row_of(b, q - 1, odd); unpack8(*(const v4u*)(W.P + r2 * INCP + PC_CG + col), cgv); unpack8(*(const v4u*)(W.P + r2 * INCP + PC_XIN + col), xv);
#pragma unroll
                for (int e = 0; e < 8; ++e) y[e] += cwa[col + e] * (cgv[e] * xv[e]); }
            if (q + 1 < hi) { const size_t r2 = row_of(b, q + 1, odd); unpack8(*(const v4u*)(W.P + r2 * INCP + PC_CG + col), cgv); unpack8(*(const v4u*)(W.P + r2 * INCP + PC_XIN + col), xv);
#pragma unroll
                for (int e = 0; e < 8; ++e) y[e] += cwa[512 + col + e] * (cgv[e] * xv[e]); }
#pragma unroll
            for (int e = 0; e < 8; ++e) y[e] *= bg[e];
            *(v4u*)(Y + row * D + col) = pack8(y); }
        for (int k0 = 0; k0 < 12; k0 += 4) {
            float ys[4], rr[4], vv[4], kd[4], gg[4]; size_t rows[4];
#pragma unroll
            for (int u = 0; u < 4; ++u) { const int it = wave + 8 * (k0 + u), i = it / 6, h = it % 6, c = h * 64 + lane, q = q0 + i;
                const size_t row = row_of(b, q, odd), pos = (size_t)b * QLEN + q; rows[u] = row;
                ys[u] = bf2f(W.P[row * INCP + PC_Y + c]) + bf2f(W.P[row * INCP + PC_Y + RW + c]);
                rr[u] = bf2f(W.sc_r[pos * RW + c]); vv[u] = bf2f(W.sc_v[pos * RW + c]);
                kd[u] = bf2f((W.scb + (size_t)3 * SC_ELEMS)[pos * RW + c]) + bf2f((W.scb + (size_t)4 * SC_ELEMS)[pos * RW + c]);
                gg[u] = bf2f(W.P[row * INCP + PC_G + c]); }
#pragma unroll
            for (int u = 0; u < 4; ++u) { const int it = wave + 8 * (k0 + u), h = it % 6, c = h * 64 + lane;
                const float mean = wave_sum(ys[u]) * (1.0f / 64.0f); const float dv = ys[u] - mean;
                const float var = wave_sum(dv * dv) * (1.0f / 64.0f);
                const float gn = dv * rsqrtf(var + 64e-5f) * lng[c] + lnb[c];
                const float bon = wave_sum(rr[u] * kd[u] * rk[c]);
                Y[rows[u] * D + 256 + c] = (bf16)f2bf((gn + bon * vv[u]) * gg[u]); }
        }
        for (int it = tid; it < 16 * 48; it += NTHR) { const int i = it / 48, col = (it % 48) * 8; const size_t row = row_of(b, q0 + i, odd);
            float gr[8], o[8]; unpack8(*(const v4u*)(W.P + row * INCP + PC_GR + col), gr);
#pragma unroll
            for (int e = 0; e < 8; ++e) o[e] = gelu_tanh(gr[e]) * hs[i * 384 + col + e];
            *(v4u*)(Y + row * D + 640 + col) = pack8(o); }
        __syncthreads();
    }
}

#define XB_TMO      128
#define XB_XCNT(j)  (256  + 64 * (j))
#define XB_XSUB(j)  (1280 + 64 * (j))
#define XB_XGEN(j)  (2304 + 64 * (j))
#define XB_TOP      3328
#define XB_TOPGEN   3392
#define XCD_BAR_WORDS 3456
#define XB_SPIN_CAP (1u << 18)

__device__ __forceinline__ unsigned xb_ld(unsigned* p)              { return __hip_atomic_load(p, __ATOMIC_RELAXED, __HIP_MEMORY_SCOPE_AGENT); }
__device__ __forceinline__ unsigned xb_add(unsigned* p, unsigned v) { return __hip_atomic_fetch_add(p, v, __ATOMIC_RELAXED, __HIP_MEMORY_SCOPE_AGENT); }
__device__ __forceinline__ unsigned xb_xcc_id() { return (unsigned)__builtin_amdgcn_s_getreg((3 << 11) | 20) & 0xFu; }
#define XB_SPIN(cond, bar) do { unsigned _sp = 0; while (cond) { __builtin_amdgcn_s_sleep(1); \
    if ((++_sp & 255u) == 0u) { if (xb_ld(&(bar)[XB_TMO])) break; if (_sp > XB_SPIN_CAP) { atomicAdd(&(bar)[XB_TMO], 1u); break; } } } } while (0)

struct XcdBarrier {
    unsigned* bar; unsigned x;
    volatile LAS unsigned* st;
};

__device__ __forceinline__ XcdBarrier xcd_barrier_post(unsigned* bar, volatile LAS unsigned* st) {
    XcdBarrier b; b.bar = bar; b.x = xb_xcc_id(); b.st = st;
    if (threadIdx.x == 0) (void)xb_add(&bar[XB_XCNT(b.x)], 1u);
    return b;
}
__device__ __forceinline__ void xcd_barrier_complete(unsigned* bar, unsigned x, unsigned& nloc, unsigned& nx) {
    const unsigned G = gridDim.x * gridDim.y * gridDim.z;
    unsigned sum, cnt, mine, sp = 0u;
    for (;;) {
        sum = 0u; cnt = 0u; mine = 0u;
#pragma unroll
        for (unsigned j = 0; j < 16; ++j) { const unsigned c = xb_ld(&bar[XB_XCNT(j)]); sum += c; cnt += (c > 0u) ? 1u : 0u; mine = (j == x) ? c : mine; }
        if (sum == G) break;
        __builtin_amdgcn_s_sleep(1);
        if ((++sp & 255u) == 0u) { if (xb_ld(&bar[XB_TMO])) break; if (sp > XB_SPIN_CAP) { atomicAdd(&bar[XB_TMO], 1u); break; } }
    }
    nloc = mine > 0u ? mine : 1u; nx = cnt > 0u ? cnt : 1u;
}

__device__ __forceinline__ void xcd_barrier(const XcdBarrier& b) {
    asm volatile("s_waitcnt vmcnt(0)" ::: "memory");
    __syncthreads();
    if (threadIdx.x == 0) {
        unsigned* bar = b.bar;
        __builtin_amdgcn_s_waitcnt(0);
        unsigned nloc = b.st[0], nx = b.st[1];
        if (nloc == 0u) { xcd_barrier_complete(bar, b.x, nloc, nx); b.st[0] = nloc; b.st[1] = nx; }
        const unsigned old = xb_add(&bar[XB_XSUB(b.x)], 1u);
        const unsigned gen = old / nloc;
        if (old + 1u == (gen + 1u) * nloc) {
            __builtin_amdgcn_fence(__ATOMIC_RELEASE, "agent");
            asm volatile("s_waitcnt vmcnt(0)" ::: "memory");
            const unsigned og = xb_add(&bar[XB_TOP], 1u);
            const unsigned tg = og / nx;
            if (og + 1u == (tg + 1u) * nx) xb_add(&bar[XB_TOPGEN], 1u);
            else XB_SPIN(xb_ld(&bar[XB_TOPGEN]) == tg, bar);
            __builtin_amdgcn_fence(__ATOMIC_ACQUIRE, "agent");
            xb_add(&bar[XB_XGEN(b.x)], 1u);
            asm volatile("s_waitcnt vmcnt(0)" ::: "memory");
        } else {
            XB_SPIN(xb_ld(&bar[XB_XGEN(b.x)]) == gen, bar);
            __builtin_amdgcn_fence(__ATOMIC_ACQUIRE, "agent");
            asm volatile("s_waitcnt vmcnt(0)" ::: "memory");
        }
    }
    __syncthreads();
}

constexpr int PH_PER_LAYER = 13, N_PHASES = 1 + DEPTH * PH_PER_LAYER + 1;
__global__ void __launch_bounds__(NTHR, 2) fwd_megakernel(Args A0) {
    extern __shared__ __attribute__((aligned(16))) unsigned char lds_raw[];
    LAS unsigned char* lds = (LAS unsigned char*)lds_raw;
    cg::grid_group grid = cg::this_grid();
    const int ph_lo = A0.ph_lo, ph_hi = A0.ph_hi;
    volatile LAS unsigned* bst = (volatile LAS unsigned*)(lds + 131072);
    if (threadIdx.x < 2) bst[threadIdx.x] = 0u;
    __syncthreads();
    const XcdBarrier xbar = xcd_barrier_post((unsigned*)(A0.ws + WS_BAR), bst);
    const int wave0 = __builtin_amdgcn_readfirstlane((int)threadIdx.x >> 6);
    bool rep_done = false; (void)rep_done;
    for (int ph = ph_lo; ph < ph_hi; ++ph) {
        CArgsP A = (CArgsP)__builtin_amdgcn_kernarg_segment_ptr();
        asm volatile("" : "+s"(A) :: "memory");
        int G = gridDim.x, bx = blockIdx.x, wave = wave0;
        asm volatile("" : "+s"(G), "+s"(bx), "+s"(wave));
#define IDS() int lane; asm volatile("v_mbcnt_lo_u32_b32 %0, -1, 0\n\tv_mbcnt_hi_u32_b32 %0, -1, %0" : "=v"(lane)); const int tid = wave * 64 + lane; (void)tid
        const WS W = make_ws(A->ws);
        if (ph == 0) { IDS(); mods_phase(bx, G, A, W, lds, tid, lane, wave); convert_phase(bx, G, A, W, 0, lds, lane, wave); }
        else if (ph == N_PHASES - 1) { IDS(); final_norm_phase(bx, G, A->out, A->in[I_GFINAL], lane, wave); }
        else {
            const int l = (ph - 1) / PH_PER_LAYER, s = (ph - 1) % PH_PER_LAYER; const bool last = (l == DEPTH - 1);
            const float* mods_l = W.mods + (size_t)l * 9 * 9216;
            const float* xlat = A->out; const float* xctx = W.xrctx;
            if (s == 0) { IDS();
                if (l > 0) convert_phase(bx, G, A, W, l, lds, lane, wave);
                norm_phase(bx, G, l == 0 ? A->in[I_X] : xlat, l == 0 ? A->in[I_CTX] : xctx, A->in[I_GFFN1] + l * D, mods_l, 0, 1, W.H, MTOT, lane, wave);
            } else if (s == 1 || s == 11) { IDS();
                pg8::Gemm g{W.H, W.wt + (s == 1 ? WT_GU1 : WT_GU2), (s == 11 && last) ? MLAT : MTOT, 2 * DFF, D}; pg8::StaticOrder S; S.init(g.M, g.N, G, bx);
                EpiSwiGLU E{W.ACT};
                pg8::gemm_phase<EpiSwiGLU, pg8::StaticOrder, true, true>(lds, g, S, E, tid);
            } else if (s == 2 || s == 9 || s == 12) { IDS();
                pg8::Gemm g{s == 9 ? W.H : W.ACT, W.wt + (s == 2 ? WT_DOWN1 : s == 9 ? WT_OUT : WT_DOWN2), (s != 2 && last) ? MLAT : MTOT, D, s == 9 ? D : DFF};
                pg8::StaticOrder S; S.init(g.M, g.N, G, bx);
                const bool first = (l == 0 && s == 2);
                EpiResid E{first ? A->in[I_X] : xlat, first ? A->in[I_CTX] : xctx, A->out, W.xrctx, mods_l + (s == 2 ? 2 : s == 9 ? 5 : 8) * 1024, s == 9 ? 1.0f : 0.5f};
                pg8::gemm_phase<EpiResid, pg8::StaticOrder, true, true>(lds, g, S, E, tid);
            } else if (s == 3) { IDS();
                norm_phase(bx, G, xlat, xctx, A->in[I_GMIX] + l * D, mods_l, 3, 4, W.H, MTOT, lane, wave);
            } else if (s == 4) { IDS();
                pg8::Gemm g{W.H, W.wt + WT_IN, MTOT, INCP, D}; pg8::StaticOrder S; S.init(g.M, g.N, G, bx);
                EpiP E{W.P, INCP};
                pg8::gemm_phase<EpiP, pg8::StaticOrder, true, true>(lds, g, S, E, tid);
            } else if (s == 5) { IDS();
                pre_phase(bx, G, A, W, l, lds, tid, lane, wave);
            } else if (s == 6) { IDS();
                int Kl = LORA_K, Nl = LORA_N; asm volatile("" : "+s"(Kl), "+s"(Nl));
                pg8::Gemm g{(const bf16*)((const unsigned char*)W.H + HB_AP), W.wt + WT_LORA, MTOT, Nl, Kl}; pg8::StaticOrder S; S.init(g.M, g.N, G, bx);
                EpiLora E{A->in[I_W0] + l * 2 * RW, A->in[I_A0] + l * 2 * RW, A->in[I_KA] + l * RW, (const bf16*)((const unsigned char*)W.H + HB_KT), W.sc_kk, W.scb, W.P, l & 1};
                pg8::gemm_phase<EpiLora, pg8::StaticOrder, true, true>(lds, g, S, E, tid);
            } else if (s == 7) { IDS();
                for (int u = bx; u < 240; u += G) {
                    if (u < 192) rwkv_scan_phase(W, l, u, lds, tid, lane, wave); else lru_scan_phase(A, W, l, u - 192, lds, tid, lane, wave);
                    __syncthreads();
                }
            } else if (s == 8) { IDS();
                post_phase(bx, G, A, W, l, lds, tid, lane, wave);
            } else if (s == 10) { IDS();
                norm_phase(bx, G, xlat, xctx, A->in[I_GFFN2] + l * D, mods_l, 6, 7, W.H, last ? MLAT : MTOT, lane, wave);
            }
        }
#ifdef PROBE_REP_S
        if (ph > 0 && ph < N_PHASES - 1 && ((ph - 1) % PH_PER_LAYER) == PROBE_REP_S && !rep_done) { rep_done = true; grid.sync(); --ph; continue; }
        rep_done = false;
#endif
        if (ph + 1 < ph_hi) { if (ph == ph_lo) grid.sync(); else xcd_barrier(xbar); }
    }
}

#ifndef MK_MULTI
#define MK_MULTI 0
#endif
extern "C" void kernel_launch(void* const* d_in, const int* in_sizes, int n_in, void* d_out, int out_size, void* d_ws, size_t ws_size, hipStream_t stream) {
    static int grid = 0;
    if (grid == 0) {
        if (n_in != N_IN || out_size != MLAT * D || ws_size < WS_END) { fprintf(stderr, "kernel_launch: unexpected shapes (n_in %d out %d ws %zu)\n", n_in, out_size, ws_size); grid = -1; return; }
        int dev = 0, cus = 0, per_cu = 0;
        (void)hipGetDevice(&dev); (void)hipDeviceGetAttribute(&cus, hipDeviceAttributeMultiprocessorCount, dev);
        if (hipFuncSetAttribute((const void*)fwd_megakernel, hipFuncAttributeMaxDynamicSharedMemorySize, LDS_BYTES) != hipSuccess) { fprintf(stderr, "kernel_launch: hipFuncSetAttribute failed\n"); grid = -1; return; }
        if (hipOccupancyMaxActiveBlocksPerMultiprocessor(&per_cu, (const void*)fwd_megakernel, NTHR, LDS_BYTES) != hipSuccess || per_cu < 1) { fprintf(stderr, "kernel_launch: occupancy query says %d\n", per_cu); per_cu = 1; }
        (void)hipGetLastError();
        grid = cus * 1;
        if (grid <= 0) grid = 256;
    }
    if (grid < 0) return;
    if (hipMemsetAsync((unsigned char*)d_ws + WS_BAR, 0, WS_BAR_BYTES, stream) != hipSuccess) { fprintf(stderr, "kernel_launch: memset of the barrier words failed\n"); return; }
    Args a{};
    for (int i = 0; i < N_IN; ++i) a.in[i] = (const float*)d_in[i];
    a.out = (float*)d_out; a.ws = (unsigned char*)d_ws;
#if MK_MULTI
    for (int ph = 0; ph < N_PHASES; ++ph) { a.ph_lo = ph; a.ph_hi = ph + 1; hipLaunchKernelGGL(fwd_megakernel, dim3(grid), dim3(NTHR), LDS_BYTES, stream, a); }
#else
    a.ph_lo = 0; a.ph_hi = N_PHASES;
    void* args[] = {&a};
    hipError_t e = hipLaunchCooperativeKernel((const void*)fwd_megakernel, dim3(grid), dim3(NTHR), args, LDS_BYTES, stream);
    if (e != hipSuccess) fprintf(stderr, "kernel_launch: cooperative launch failed: %s (grid %d)\n", hipGetErrorString(e), grid);
#endif
}
```

```cpp
#include <hip/hip_runtime.h>
#include <hip/hip_cooperative_groups.h>
#include <cstdio>
#include <cstdint>
namespace cg = cooperative_groups;
namespace pg8 {
#define PG8_LAS __attribute__((address_space(3)))
typedef unsigned short bf16_t;
typedef short bf16x8 __attribute__((ext_vector_type(8)));
typedef float f32x4 __attribute__((ext_vector_type(4)));
typedef unsigned u32x4 __attribute__((ext_vector_type(4)));
constexpr int BM = 256, BK = 64, HALF = 128, HTB = HALF * BK * 2  , STAGE_BYTES = 8 * HTB, NXCD = 8, WGM = 8;

__host__ __device__ __forceinline__ int lds_byte(int r, int c) { const int st = (r >> 4) * 2 + (c >> 5), rr = r & 15, cc = c & 31, ob = rr * 64 + cc * 2; return st * 1024 + (ob ^ (((ob >> 9) & 1) << 5)); }
__host__ __device__ __forceinline__ void stage_rc(int b, int& R, int& C) { const int st = b / 1024, sb = b % 1024, swz = sb ^ (((sb >> 9) & 1) << 5); R = (st >> 1) * 16 + swz / 64; C = (st & 1) * 32 + (swz % 64) / 2; }
__host__ __device__ __forceinline__ int perm32(int rho) { const int n = rho >> 4, i = rho & 15; return 8 * (i >> 2) + 4 * n + (i & 3); }

struct Unit { int pm, pn; };
struct Gemm { const bf16_t* A; const bf16_t* Bt; int M, N, K; };

struct StaticOrder {
    int nM, nN, nwg, G, c;
    __host__ __device__ void init(int M, int N, int G_, int c_) { nM = M / BM; nN = N / BM; nwg = nM * nN; G = G_; c = c_; }
    __host__ __device__ bool next(int i, Unit& u) const {
        const long L = (long)i * G + c; if (L >= nwg) return false;
        int wgid = (int)L; { const int q = nwg / NXCD, r = nwg % NXCD, xcd = wgid % NXCD, off = wgid / NXCD; wgid = (xcd < r ? xcd * (q + 1) : r * (q + 1) + (xcd - r) * q) + off; }
        const int nig = WGM * nN, gid = wgid / nig, fm = gid * WGM, gsz = (nM - fm) < WGM ? (nM - fm) : WGM;
        u.pm = fm + ((wgid % nig) % gsz); u.pn = (wgid % nig) / gsz; return true;
    }
    __device__ __forceinline__ void a_ready(const Unit&) const {}
    __device__ __forceinline__ void done(const Unit&) const {}
};

template <class Epi, class Sched, bool ALIGN_EPI = false, bool SP2 = false>
__device__ __forceinline__ void gemm_phase(PG8_LAS unsigned char* lds, const Gemm g, const Sched& S, const Epi& E, const int tid) {
    const int wid = __builtin_amdgcn_readfirstlane(tid >> 6), lane = tid & 63, wr = wid >> 2, wc = wid & 3, fr = lane & 15, fq = lane >> 4;
    const int K = g.K, nt = K / BK;
    unsigned voffA[2], voffB[2];
#pragma unroll
    for (int i = 0; i < 2; ++i) { int R, C; stage_rc(tid * 16 + i * 8192, R, C); const int Rb = Epi::PERM ? ((R & ~31) + perm32(R & 31)) : R;
        voffA[i] = (unsigned)(R * K + C) * 2u; voffB[i] = (unsigned)(Rb * K + C) * 2u; }
    const size_t kstep = (size_t)(BK * 2);
    const size_t hstep = (size_t)HALF * K * 2;
    const size_t tstep = 2 * hstep;
    const unsigned ldsw = (unsigned)wid * 1024u;
    const int aoff = lds_byte(wr * 64 + fr, fq * 8), boff = lds_byte(wc * 32 + fr, fq * 8);
#define PG8_SA(b, h) (((b) * 2 + (h)) * HTB)
#define PG8_SB(b, h) ((4 + (b) * 2 + (h)) * HTB)
#define PG8_STAGE(bufoff, gbase, voff) do { _Pragma("unroll") for (int _i = 0; _i < 2; ++_i) \
        __builtin_amdgcn_global_load_lds((const unsigned*)((const char*)(gbase) + (voff)[_i]), (PG8_LAS unsigned*)(lds + (bufoff) + ldsw + _i * 8192), 16, 0, 0); } while (0)
#define PG8_LDA(dst, b, h) do { _Pragma("unroll") for (int m = 0; m < 4; ++m) _Pragma("unroll") for (int k = 0; k < 2; ++k) dst[m][k] = *(const PG8_LAS bf16x8*)(lds + PG8_SA(b, h) + aoff + m * 2048 + k * 1024); } while (0)
#define PG8_LDB(dst, b, h) do { _Pragma("unroll") for (int n = 0; n < 2; ++n) _Pragma("unroll") for (int k = 0; k < 2; ++k) dst[n][k] = *(const PG8_LAS bf16x8*)(lds + PG8_SB(b, h) + boff + n * 2048 + k * 1024); } while (0)
#define PG8_MMA(ai, bj, At, Bt) do { __builtin_amdgcn_s_setprio(1); _Pragma("unroll") for (int m = 0; m < 4; ++m) _Pragma("unroll") for (int n = 0; n < 2; ++n) _Pragma("unroll") for (int k = 0; k < 2; ++k) \
        acc[ai][bj][m][n] = __builtin_amdgcn_mfma_f32_16x16x32_bf16(Bt[n][k], At[m][k], acc[ai][bj][m][n], 0, 0, 0); __builtin_amdgcn_s_setprio(0); } while (0)
#define PG8_WAIT_V(n) asm volatile("s_waitcnt vmcnt(" #n ")" ::: "memory")
#define PG8_WAIT_L(n) asm volatile("s_waitcnt lgkmcnt(" #n ")" ::: "memory")
#define PG8_BAR __builtin_amdgcn_s_barrier()
#define PG8_SCHED __builtin_amdgcn_sched_barrier(0)
    Unit cur, nxt; int ui = 0;
    if (!S.next(0, cur)) return;
    f32x4 acc[2][2][4][2];
#pragma unroll
    for (int a = 0; a < 2; ++a)
#pragma unroll
        for (int b = 0; b < 2; ++b)
#pragma unroll
            for (int m = 0; m < 4; ++m)
#pragma unroll
                for (int n = 0; n < 2; ++n) acc[a][b][m][n] = (f32x4){0.f, 0.f, 0.f, 0.f};
    bf16x8 At[4][2], B0[2][2], B1[2][2];
    const char* cA = (const char*)g.A + (size_t)cur.pm * tstep; const char* cB = (const char*)g.Bt + (size_t)cur.pn * tstep;
    S.a_ready(cur);
    if constexpr (SP2) {
        PG8_STAGE(PG8_SB(0, 0), cB, voffB); PG8_STAGE(PG8_SB(0, 1), cB + hstep, voffB); PG8_STAGE(PG8_SA(0, 0), cA, voffA); PG8_STAGE(PG8_SA(0, 1), cA + hstep, voffA);
        if (wr == 1) PG8_BAR;
        PG8_WAIT_V(2); PG8_BAR;
        PG8_STAGE(PG8_SB(1, 0), cB + kstep, voffB); PG8_STAGE(PG8_SA(1, 0), cA + kstep, voffA); PG8_STAGE(PG8_SB(1, 1), cB + hstep + kstep, voffB);
        PG8_WAIT_V(6); PG8_BAR;
    } else {
        PG8_STAGE(PG8_SB(0, 0), cB, voffB); PG8_STAGE(PG8_SA(0, 0), cA, voffA); PG8_STAGE(PG8_SB(0, 1), cB + hstep, voffB); PG8_STAGE(PG8_SA(0, 1), cA + hstep, voffA);
        if (wr == 1) PG8_BAR;
        PG8_WAIT_V(4); PG8_BAR;
        PG8_STAGE(PG8_SB(1, 0), cB + kstep, voffB); PG8_STAGE(PG8_SA(1, 0), cA + kstep, voffA); PG8_STAGE(PG8_SB(1, 1), cB + hstep + kstep, voffB);
        PG8_WAIT_V(6); PG8_BAR;
    }
    for (;;) {
        const bool has_next = S.next(ui + 1, nxt);
        const char* nA = has_next ? (const char*)g.A + (size_t)nxt.pm * tstep : cA; const char* nB = has_next ? (const char*)g.Bt + (size_t)nxt.pn * tstep : cB;
        for (int t = 0; t < nt; t += 2) {
            const bool last = (t == nt - 2);
            const char* a1 = cA + (size_t)(t + 1) * kstep;
            const char* a2 = last ? nA : cA + (size_t)(t + 2) * kstep; const char* b2 = last ? nB : cB + (size_t)(t + 2) * kstep;
            const char* a3 = a2 + kstep; const char* b3 = b2 + kstep;
            if (last && has_next) S.a_ready(nxt);
            if constexpr (SP2) {
            PG8_LDB(B0, 0, 0); PG8_LDB(B1, 0, 1); PG8_SCHED; PG8_LDA(At, 0, 0); PG8_STAGE(PG8_SA(1, 1), a1 + hstep, voffA);
            PG8_WAIT_V(8); PG8_WAIT_L(0); PG8_BAR; PG8_MMA(0, 0, At, B0); PG8_MMA(0, 1, At, B1); PG8_BAR; PG8_SCHED;
            PG8_LDA(At, 0, 1); PG8_STAGE(PG8_SB(0, 0), b2, voffB); PG8_STAGE(PG8_SB(0, 1), b2 + hstep, voffB); PG8_STAGE(PG8_SA(0, 0), a2, voffA);
            PG8_WAIT_V(8); PG8_WAIT_L(0); PG8_BAR; PG8_MMA(1, 0, At, B0); PG8_MMA(1, 1, At, B1); PG8_BAR; PG8_SCHED;
            PG8_LDB(B0, 1, 0); PG8_LDB(B1, 1, 1); PG8_SCHED; PG8_LDA(At, 1, 0); PG8_STAGE(PG8_SA(0, 1), a2 + hstep, voffA);
            PG8_WAIT_V(8); PG8_WAIT_L(0); PG8_BAR; PG8_MMA(0, 0, At, B0); PG8_MMA(0, 1, At, B1); PG8_BAR; PG8_SCHED;
            PG8_LDA(At, 1, 1); PG8_STAGE(PG8_SB(1, 0), b3, voffB); PG8_STAGE(PG8_SB(1, 1), b3 + hstep, voffB); PG8_STAGE(PG8_SA(1, 0), a3, voffA);
            PG8_WAIT_V(8); PG8_WAIT_L(0); PG8_BAR; PG8_MMA(1, 0, At, B0); PG8_MMA(1, 1, At, B1); PG8_BAR; PG8_SCHED;
            } else {
            PG8_LDB(B0, 0, 0); PG8_SCHED; PG8_LDA(At, 0, 0); PG8_STAGE(PG8_SA(1, 1), a1 + hstep, voffA);
            PG8_WAIT_L(8); PG8_BAR; PG8_WAIT_L(0); PG8_MMA(0, 0, At, B0); PG8_BAR; PG8_SCHED;
            PG8_LDB(B1, 0, 1); PG8_STAGE(PG8_SB(0, 0), b2, voffB);
            PG8_BAR; PG8_WAIT_L(0); PG8_MMA(0, 1, At, B1); PG8_BAR;
            PG8_LDA(At, 0, 1); PG8_STAGE(PG8_SA(0, 0), a2, voffA);
            PG8_BAR; PG8_WAIT_L(0); PG8_MMA(1, 0, At, B0); PG8_BAR; PG8_SCHED;
            PG8_STAGE(PG8_SB(0, 1), b2 + hstep, voffB);
            PG8_WAIT_V(6); PG8_BAR; PG8_MMA(1, 1, At, B1); PG8_BAR;
            PG8_LDB(B0, 1, 0); PG8_SCHED; PG8_LDA(At, 1, 0); PG8_STAGE(PG8_SA(0, 1), a2 + hstep, voffA);
            PG8_WAIT_L(8); PG8_BAR; PG8_WAIT_L(0); PG8_MMA(0, 0, At, B0); PG8_BAR; PG8_SCHED;
            PG8_LDB(B1, 1, 1); PG8_STAGE(PG8_SB(1, 0), b3, voffB);
            PG8_BAR; PG8_WAIT_L(0); PG8_MMA(0, 1, At, B1); PG8_BAR;
            PG8_LDA(At, 1, 1); PG8_STAGE(PG8_SA(1, 0), a3, voffA);
            PG8_BAR; PG8_WAIT_L(0); PG8_MMA(1, 0, At, B0); PG8_BAR; PG8_SCHED;
            PG8_STAGE(PG8_SB(1, 1), b3 + hstep, voffB);
            PG8_WAIT_V(6); PG8_BAR; PG8_MMA(1, 1, At, B1); PG8_BAR;
            }
        }
        if constexpr (ALIGN_EPI) { if (wr == 0) PG8_BAR; }
        if constexpr (!Epi::AFTER_DRAIN) { E(acc, cur, wr, wc, fr, fq); S.done(cur); }
        if (!has_next) break;
#pragma unroll
        for (int a = 0; a < 2; ++a)
#pragma unroll
            for (int b = 0; b < 2; ++b)
#pragma unroll
                for (int m = 0; m < 4; ++m)
#pragma unroll
                    for (int n = 0; n < 2; ++n) acc[a][b][m][n] = (f32x4){0.f, 0.f, 0.f, 0.f};
        cur = nxt; cA = nA; cB = nB; ++ui;
        if constexpr (ALIGN_EPI) { if (wr == 1) PG8_BAR; }
    }
    PG8_WAIT_V(0);
    if constexpr (!ALIGN_EPI) { if (wr == 0) PG8_BAR; }
    PG8_BAR;
    if constexpr (Epi::AFTER_DRAIN) { E.fused(acc, cur, wr, wc, fr, fq, lds, wid, lane); S.done(cur); }
#undef PG8_SA
#undef PG8_SB
#undef PG8_STAGE
#undef PG8_LDA
#undef PG8_LDB
#undef PG8_MMA
#undef PG8_WAIT_V
#undef PG8_WAIT_L
#undef PG8_BAR
#undef PG8_SCHED
}
}
#define LAS __attribute__((address_space(3)))
typedef unsigned short bf16;
typedef unsigned v4u __attribute__((ext_vector_type(4)));
typedef unsigned v2u __attribute__((ext_vector_type(2)));
typedef float f32x4 __attribute__((ext_vector_type(4)));
typedef float f32x2 __attribute__((ext_vector_type(2)));

constexpr int D = 1024, NB = 8, SEQ = 4096, CTX = 256, DEPTH = 4, DFF = 2816;
constexpr int MLAT = NB * SEQ, MCTX = NB * CTX, MTOT = MLAT + MCTX;
constexpr int INC = 2944, INCP = 3072;
constexpr int RW = 384, LW = 384, RC = 1408;
constexpr int QLEN = CTX + SEQ;
constexpr int PC_BG = 0, PC_CG = 256, PC_XIN = 512, PC_RW = 768, PC_XR = 2176, PC_GR = 2560;
constexpr int PC_Y = 768;
constexpr int PC_G = 1536;
constexpr int LORA_N = 2048, LORA_K = 256;
constexpr int NWAVES = 8, NTHR = 512;
constexpr int LDS_BYTES = 147456;

constexpr size_t MiB = 1u << 20;
constexpr size_t WS_BAR = 1536 * 1024, WS_BAR_BYTES = 16384;
constexpr size_t WS_MODS = 0, WS_XRCTX = 2 * MiB, WS_WT = 10 * MiB, WS_H = 52 * MiB, WS_A = 120 * MiB, WS_B = 324 * MiB;
constexpr size_t SC_ELEMS = (size_t)NB * QLEN * RW;
constexpr size_t WS_END = WS_B + 9 * SC_ELEMS * 2 + (size_t)NB * QLEN * 128 * 2;
static_assert(WS_END <= 600 * MiB, "workspace map");
static_assert(WS_A + (size_t)MTOT * INCP * 2 <= WS_B, "P fits");
constexpr size_t WT_GU1 = 0, WT_DOWN1 = WT_GU1 + (size_t)2 * DFF * D, WT_IN = WT_DOWN1 + (size_t)D * DFF, WT_OUT = WT_IN + (size_t)INCP * D,
                 WT_GU2 = WT_OUT + (size_t)D * D, WT_DOWN2 = WT_GU2 + (size_t)2 * DFF * D, WT_TOTAL = WT_DOWN2 + (size_t)D * DFF;
constexpr size_t WT_LORA = WT_TOTAL;
static_assert(WS_WT + (WT_TOTAL + (size_t)LORA_N * LORA_K) * 2 <= WS_H, "weights fit");
constexpr size_t HB_AP = 0, HB_KT = (size_t)MTOT * LORA_K * 2;
static_assert(HB_KT + (size_t)MTOT * RW * 2 <= WS_A - WS_H, "H region overlay");

enum { I_X = 0, I_C, I_CTX, I_CCTX, I_WMOD, I_BMOD, I_GFFN1, I_WGU1, I_WDOWN1, I_GMIX, I_WIN, I_CONVA, I_MU, I_W0, I_W2, I_A0, I_A2, I_G2, I_KK, I_KA, I_RK,
       I_LNG, I_LNB, I_LCW, I_LCB, I_LWR, I_LBR, I_LWI, I_LBI, I_LAM, I_WOUT, I_GFFN2, I_WGU2, I_WDOWN2, I_GFINAL, N_IN };

struct Args { const float* in[N_IN]; float* out; unsigned char* ws; int ph_lo, ph_hi; };
typedef const __attribute__((address_space(4))) Args* CArgsP;

__device__ __forceinline__ float bf2f(unsigned h) { return __builtin_bit_cast(float, h << 16); }
__device__ __forceinline__ unsigned f2bf(float f) { unsigned u = __builtin_bit_cast(unsigned, f); return (u + 0x7fffu + ((u >> 16) & 1u)) >> 16; }
__device__ __forceinline__ unsigned pk2(float lo, float hi) { unsigned r; asm("v_cvt_pk_bf16_f32 %0, %1, %2" : "=v"(r) : "v"(lo), "v"(hi)); return r; }
__device__ __forceinline__ void unpack8(v4u p, float* o) {
    o[0] = __builtin_bit_cast(float, p.x << 16); o[1] = __builtin_bit_cast(float, p.x & 0xffff0000u);
    o[2] = __builtin_bit_cast(float, p.y << 16); o[3] = __builtin_bit_cast(float, p.y & 0xffff0000u);
    o[4] = __builtin_bit_cast(float, p.z << 16); o[5] = __builtin_bit_cast(float, p.z & 0xffff0000u);
    o[6] = __builtin_bit_cast(float, p.w << 16); o[7] = __builtin_bit_cast(float, p.w & 0xffff0000u);
}
__device__ __forceinline__ v4u pack8(const float* v) { v4u o; o.x = pk2(v[0], v[1]); o.y = pk2(v[2], v[3]); o.z = pk2(v[4], v[5]); o.w = pk2(v[6], v[7]); return o; }
template <int CTRL> __device__ __forceinline__ float dppf(float v) { return __builtin_bit_cast(float, __builtin_amdgcn_update_dpp(0, __builtin_bit_cast(int, v), CTRL, 0xF, 0xF, true)); }
__device__ __forceinline__ float wave_sum(float v) {
    v += dppf<0xB1>(v); v += dppf<0x4E>(v); v += dppf<0x141>(v); v += dppf<0x140>(v);
    const float a = __builtin_bit_cast(float, __builtin_amdgcn_readlane(__builtin_bit_cast(int, v), 0)), b = __builtin_bit_cast(float, __builtin_amdgcn_readlane(__builtin_bit_cast(int, v), 16));
    const float c = __builtin_bit_cast(float, __builtin_amdgcn_readlane(__builtin_bit_cast(int, v), 32)), d = __builtin_bit_cast(float, __builtin_amdgcn_readlane(__builtin_bit_cast(int, v), 48));
    return (a + b) + (c + d);
}
__device__ __forceinline__ float sigmoidf_(float x) { return 1.0f / (1.0f + __expf(-x)); }
__device__ __forceinline__ float siluf_(float x) { return x / (1.0f + __expf(-x)); }
__device__ __forceinline__ float softplusf_(float z) { return fmaxf(z, 0.f) + log1pf(__expf(-fabsf(z))); }
__device__ __forceinline__ float tanh_fast(float x) { const float e = __expf(2.0f * fminf(fmaxf(x, -15.f), 15.f)); return 1.0f - 2.0f * __builtin_amdgcn_rcpf(e + 1.0f); }
__device__ __forceinline__ float gelu_tanh(float x) { const float u = 0.7978845608028654f * (x + 0.044715f * x * x * x); return 0.5f * x * (1.0f + tanh_fast(u)); }
__device__ __forceinline__ float reduce16(float x) { x += dppf<0xB1>(x); x += dppf<0x4E>(x); x += dppf<0x141>(x); x += dppf<0x140>(x); return x; }
__device__ __forceinline__ float reduce8(float x) { x += dppf<0xB1>(x); x += dppf<0x4E>(x); x += dppf<0x141>(x); return x; }
__device__ __forceinline__ int row_of(int b, int q, int odd) {
    if (q < CTX) return MLAT + b * CTX + q;
    const int s = q - CTX; const int t = odd ? (((s & 63) << 6) | (s >> 6)) : s;
    return b * SEQ + t;
}

struct EpiSwiGLU {
    static constexpr bool PERM = true, AFTER_DRAIN = false;
    bf16* O;
    __device__ __forceinline__ void operator()(const pg8::f32x4 (&acc)[2][2][4][2], const pg8::Unit& u, int wr, int wc, int fr, int fq) const {
        const int row0 = u.pm * 256 + wr * 64 + fr, col0 = u.pn * 128 + wc * 32 + 8 * fq;
#pragma unroll
        for (int ai = 0; ai < 2; ++ai)
#pragma unroll
            for (int m = 0; m < 4; ++m) {
                float o[8];
#pragma unroll
                for (int n = 0; n < 2; ++n)
#pragma unroll
                    for (int j = 0; j < 4; ++j) { const float g = acc[ai][0][m][n][j], up = acc[ai][1][m][n][j]; o[n * 4 + j] = siluf_(g) * up; }
                *(v4u*)(O + (size_t)(row0 + ai * 128 + m * 16) * DFF + col0) = pack8(o);
            }
    }
};
struct EpiP {
    static constexpr bool PERM = true, AFTER_DRAIN = false;
    bf16* O; int ldc;
    __device__ __forceinline__ void operator()(const pg8::f32x4 (&acc)[2][2][4][2], const pg8::Unit& u, int wr, int wc, int fr, int fq) const {
        const int row0 = u.pm * 256 + wr * 64 + fr, col0 = u.pn * 256 + wc * 32 + 8 * fq;
#pragma unroll
        for (int ai = 0; ai < 2; ++ai)
#pragma unroll
            for (int m = 0; m < 4; ++m)
#pragma unroll
                for (int bj = 0; bj < 2; ++bj) {
                    float o[8];
#pragma unroll
                    for (int n = 0; n < 2; ++n)
#pragma unroll
                        for (int j = 0; j < 4; ++j) o[n * 4 + j] = acc[ai][bj][m][n][j];
                    *(v4u*)(O + (size_t)(row0 + ai * 128 + m * 16) * ldc + col0 + bj * 128) = pack8(o);
                }
    }
};
struct EpiResid {
    static constexpr bool PERM = true, AFTER_DRAIN = false;
    const float* res_lat; const float* res_ctx; float* dst_lat; float* dst_ctx; const float* gate; float coef;
    __device__ __forceinline__ void operator()(const pg8::f32x4 (&acc)[2][2][4][2], const pg8::Unit& u, int wr, int wc, int fr, int fq) const {
        const int rowbase = u.pm * 256; const bool isctx = rowbase >= MLAT;
        const int b = isctx ? 8 : (rowbase >> 12);
        const float* res = isctx ? res_ctx + (size_t)(rowbase - MLAT) * D : res_lat + (size_t)rowbase * D;
        float* dst = isctx ? dst_ctx + (size_t)(rowbase - MLAT) * D : dst_lat + (size_t)rowbase * D;
#pragma unroll
        for (int bj = 0; bj < 2; ++bj) {
            const int col = u.pn * 256 + bj * 128 + wc * 32 + 8 * fq;
            const f32x4 g0 = *(const f32x4*)(gate + (size_t)b * 9216 + col) * coef, g1 = *(const f32x4*)(gate + (size_t)b * 9216 + col + 4) * coef;
#pragma unroll
            for (int ai = 0; ai < 2; ++ai)
#pragma unroll
                for (int m = 0; m < 4; ++m) {
                    const size_t off = (size_t)(ai * 128 + wr * 64 + m * 16 + fr) * D + col;
                    const f32x4 r0 = *(const f32x4*)(res + off), r1 = *(const f32x4*)(res + off + 4);
                    *(f32x4*)(dst + off) = r0 + g0 * acc[ai][bj][m][0];
                    *(f32x4*)(dst + off + 4) = r1 + g1 * acc[ai][bj][m][1];
                }
        }
    }
};

struct EpiLora {
    static constexpr bool PERM = true, AFTER_DRAIN = false;
    const float* w0; const float* a0; const float* ka; const bf16* kt; const bf16* kk; bf16* scb; bf16* P; int odd;
    __device__ __forceinline__ void operator()(const pg8::f32x4 (&acc)[2][2][4][2], const pg8::Unit& u, int wr, int wc, int fr, int fq) const {
        asm volatile("" : "+v"(fr), "+v"(fq));
#pragma unroll
        for (int bj = 0; bj < 2; ++bj) {
            const int half = __builtin_amdgcn_readfirstlane(u.pn * 2 + bj), kind = half / 3, c = (half - kind * 3) * 128 + wc * 32 + 8 * fq;
            if (kind >= 5) continue;
#pragma unroll
            for (int ai = 0; ai < 2; ++ai)
#pragma unroll
                for (int m = 0; m < 4; ++m) {
                    const int pos = u.pm * 256 + ai * 128 + wr * 64 + m * 16 + fr;
                    float v[8];
#pragma unroll
                    for (int n = 0; n < 2; ++n)
#pragma unroll
                        for (int j = 0; j < 4; ++j) v[n * 4 + j] = acc[ai][bj][m][n][j];
                    if (kind < 2) {
                        const f32x4 q0 = *(const f32x4*)(w0 + kind * 384 + c), q1 = *(const f32x4*)(w0 + kind * 384 + c + 4);
                        const float p0[8] = {q0.x, q0.y, q0.z, q0.w, q1.x, q1.y, q1.z, q1.w};
#pragma unroll
                        for (int e = 0; e < 8; ++e) { const float wl = p0[e] + v[e]; const float sp = fmaxf(-wl, 0.f) + __logf(1.0f + __expf(-fabsf(wl)));
                            v[e] = 1.0f - __expf(-__expf(-sp - 0.5f)); }
                        *(v4u*)(scb + (size_t)(7 + kind) * SC_ELEMS + (size_t)pos * RW + c) = pack8(v);
                    } else if (kind < 4) {
                        const f32x4 q0 = *(const f32x4*)(a0 + (kind - 2) * 384 + c), q1 = *(const f32x4*)(a0 + (kind - 2) * 384 + c + 4);
                        const float p0[8] = {q0.x, q0.y, q0.z, q0.w, q1.x, q1.y, q1.z, q1.w};
#pragma unroll
                        for (int e = 0; e < 8; ++e) v[e] = sigmoidf_(p0[e] + v[e]);
                        {   float kkv[8]; unpack8(*(const v4u*)(kk + (size_t)pos * RW + c), kkv);
#pragma unroll
                            for (int e = 0; e < 8; ++e) kkv[e] *= v[e];
                            *(v4u*)(scb + (size_t)(5 + kind - 2) * SC_ELEMS + (size_t)pos * RW + c) = pack8(kkv); }
                        {   float kv[8]; unpack8(*(const v4u*)(kt + (size_t)pos * RW + c), kv);
                            const f32x4 r0 = *(const f32x4*)(ka + c), r1 = *(const f32x4*)(ka + c + 4);
                            const float p1[8] = {r0.x, r0.y, r0.z, r0.w, r1.x, r1.y, r1.z, r1.w};
#pragma unroll
                            for (int e = 0; e < 8; ++e) kv[e] *= (1.0f + (v[e] - 1.0f) * p1[e]);
                            *(v4u*)(scb + (size_t)(3 + kind - 2) * SC_ELEMS + (size_t)pos * RW + c) = pack8(kv); }
                    } else {
                        const int b = pos / QLEN, q = pos - b * QLEN;
                        *(v4u*)(P + (size_t)row_of(b, q, odd) * INCP + PC_G + c) = pack8(v);
                    }
                    asm volatile("" ::: "memory");
                }
        }
    }
};
struct WS {
    float* mods; float* xrctx; bf16* wt; bf16* H; bf16* P; bf16* ACT;
    bf16 *scb, *sc_r, *sc_v, *sc_kk, *dgs;
};
__device__ __forceinline__ WS make_ws(unsigned char* ws) {
    WS w; w.mods = (float*)(ws + WS_MODS); w.xrctx = (float*)(ws + WS_XRCTX); w.wt = (bf16*)(ws + WS_WT); w.H = (bf16*)(ws + WS_H); w.P = (bf16*)(ws + WS_A); w.ACT = (bf16*)(ws + WS_A);
    bf16* b = (bf16*)(ws + WS_B);
    w.scb = b; w.sc_r = b; w.sc_v = b + SC_ELEMS; w.sc_kk = b + 2 * SC_ELEMS; w.dgs = b + 9 * SC_ELEMS;
    return w;
}

__device__ __forceinline__ void mods_phase(const int bx, const int G, CArgsP A, const WS& W, LAS unsigned char* lds, int tid, int lane, int wave) {
    LAS float* sl = (LAS float*)lds;
    LAS float* part = sl + 9 * 1024;
    const float* c = A->in[I_C]; const float* cctx = A->in[I_CCTX];
    for (int i = tid; i < 9216; i += NTHR) { const int r = i >> 10, k = i & 1023; const float v = r < 8 ? c[r * 1024 + k] : cctx[k]; sl[i] = siluf_(v); }
    __syncthreads();
    for (int item = bx; item < 288; item += G) {
        const int l = item / 72, cgp = item % 72;
        const float* Wp = A->in[I_WMOD] + (size_t)l * 1024 * 9216 + cgp * 128 + lane * 2;
        float acc[9][2];
#pragma unroll
        for (int r = 0; r < 9; ++r) { acc[r][0] = 0.f; acc[r][1] = 0.f; }
#pragma unroll 8
        for (int kk = 0; kk < 128; ++kk) {
            const int k = wave * 128 + kk;
            const f32x2 w = *(const f32x2*)(Wp + (size_t)k * 9216);
#pragma unroll
            for (int r = 0; r < 9; ++r) { const float s = sl[r * 1024 + k]; acc[r][0] += s * w.x; acc[r][1] += s * w.y; }
        }
#pragma unroll
        for (int r = 0; r < 9; ++r) { part[(wave * 9 + r) * 128 + lane * 2] = acc[r][0]; part[(wave * 9 + r) * 128 + lane * 2 + 1] = acc[r][1]; }
        __syncthreads();
        for (int o = tid; o < 1152; o += NTHR) {
            const int r = o >> 7, cc = o & 127; float s = A->in[I_BMOD][l * 9216 + cgp * 128 + cc];
#pragma unroll
            for (int w8 = 0; w8 < 8; ++w8) s += part[(w8 * 9 + r) * 128 + cc];
            W.mods[(size_t)(l * 9 + r) * 9216 + cgp * 128 + cc] = s;
        }
        __syncthreads();
    }
}

__device__ __forceinline__ void transpose_item(const float* Wsrc, int K, int N, bf16* WT, int kb, int n0, int drow0, LAS float* scr, int lane) {
    const int k0 = 64 * kb;
#pragma unroll 8
    for (int i = 0; i < 32; ++i) { const int kk = 2 * i + (lane >> 5); scr[kk * 33 + (lane & 31)] = Wsrc[(size_t)(k0 + kk) * N + n0 + (lane & 31)]; }
    asm volatile("s_waitcnt lgkmcnt(0)" ::: "memory");
    const int c = lane & 7;
#pragma unroll
    for (int j = 0; j < 4; ++j) { const int n = (lane >> 3) + 8 * j; const LAS float* s = scr + (8 * c) * 33 + n;
        v4u o; o.x = pk2(s[0 * 33], s[1 * 33]); o.y = pk2(s[2 * 33], s[3 * 33]); o.z = pk2(s[4 * 33], s[5 * 33]); o.w = pk2(s[6 * 33], s[7 * 33]);
        *(v4u*)(WT + (size_t)(drow0 + n) * K + k0 + 8 * c) = o; }
    asm volatile("s_waitcnt lgkmcnt(0)" ::: "memory");
}
__device__ __forceinline__ int gu_drow(int n0) { return n0 < DFF ? 256 * (n0 >> 7) + (n0 & 127) : 256 * ((n0 - DFF) >> 7) + 128 + ((n0 - DFF) & 127); }
__device__ __forceinline__ void convert_phase(const int bx, const int G, CArgsP A, const WS& W, int l, LAS unsigned char* lds, int lane, int wave) {
    LAS float* scr = (LAS float*)(lds + wave * 16384);
    const int gw = bx * NWAVES + wave, NGW = G * NWAVES;
    constexpr int I_GU = (D / 64) * (2 * DFF / 32), I_DN = (DFF / 64) * (D / 32), I_IN = (D / 64) * (INC / 32), I_OUT = (D / 64) * (D / 32);
    constexpr int NITEMS = 2 * I_GU + 2 * I_DN + I_IN + I_OUT;
    for (int it = gw; it < NITEMS; it += NGW) {
        int r = it;
        if (r < I_GU) { const int nblk = 2 * DFF / 32, kb = r / nblk, n0 = (r % nblk) * 32; transpose_item(A->in[I_WGU1] + (size_t)l * D * 2 * DFF, D, 2 * DFF, W.wt + WT_GU1, kb, n0, gu_drow(n0), scr, lane); continue; } r -= I_GU;
        if (r < I_GU) { const int nblk = 2 * DFF / 32, kb = r / nblk, n0 = (r % nblk) * 32; transpose_item(A->in[I_WGU2] + (size_t)l * D * 2 * DFF, D, 2 * DFF, W.wt + WT_GU2, kb, n0, gu_drow(n0), scr, lane); continue; } r -= I_GU;
        if (r < I_DN) { const int nblk = D / 32, kb = r / nblk, n0 = (r % nblk) * 32; transpose_item(A->in[I_WDOWN1] + (size_t)l * DFF * D, DFF, D, W.wt + WT_DOWN1, kb, n0, n0, scr, lane); continue; } r -= I_DN;
        if (r < I_DN) { const int nblk = D / 32, kb = r / nblk, n0 = (r % nblk) * 32; transpose_item(A->in[I_WDOWN2] + (size_t)l * DFF * D, DFF, D, W.wt + WT_DOWN2, kb, n0, n0, scr, lane); continue; } r -= I_DN;
        if (r < I_IN) { const int nblk = INC / 32, kb = r / nblk, n0 = (r % nblk) * 32; transpose_item(A->in[I_WIN] + (size_t)l * D * INC, D, INC, W.wt + WT_IN, kb, n0, n0, scr, lane); continue; } r -= I_IN;
        { const int nblk = D / 32, kb = r / nblk, n0 = (r % nblk) * 32; transpose_item(A->in[I_WOUT] + (size_t)l * D * D, D, D, W.wt + WT_OUT, kb, n0, n0, scr, lane); }
    }
    for (int idx = (bx * NWAVES + wave) * 64 + lane; idx < LORA_N * LORA_K; idx += G * NTHR) {
        const int n = idx % LORA_N, k = idx / LORA_N, kind = n / 384, c = n - kind * 384;
        float v = 0.f;
        if (kind < 2) { if (k < 64) v = A->in[I_W2][((size_t)(l * 2 + kind) * 64 + k) * RW + c]; }
        else if (kind < 4) { if (k >= 64 && k < 128) v = A->in[I_A2][((size_t)(l * 2 + kind - 2) * 64 + (k - 64)) * RW + c]; }
        else if (kind == 4) { if (k >= 128) v = A->in[I_G2][((size_t)l * 128 + (k - 128)) * RW + c]; }
        W.wt[WT_LORA + (size_t)n * LORA_K + k] = (bf16)f2bf(v);
    }
}

__device__ __forceinline__ void norm_phase(const int bx, const int G, const float* lat, const float* ctxp, const float* g, const float* mods_l, int ishift, int iscale, bf16* H, int nrows, int lane, int wave) {
    const int gw = bx * NWAVES + wave, NGW = G * NWAVES;
    for (int r = gw; r < nrows; r += NGW) {
        const float* xr = r < MLAT ? lat + (size_t)r * D : ctxp + (size_t)(r - MLAT) * D;
        const int b = r < MLAT ? (r >> 12) : 8;
        const float* sh = mods_l + (size_t)b * 9216 + ishift * 1024; const float* sc = mods_l + (size_t)b * 9216 + iscale * 1024;
        f32x4 v[4]; float s = 0.f;
#pragma unroll
        for (int j = 0; j < 4; ++j) { v[j] = *(const f32x4*)(xr + (lane + 64 * j) * 4); s += (v[j].x * v[j].x + v[j].y * v[j].y) + (v[j].z * v[j].z + v[j].w * v[j].w); }
        s = wave_sum(s);
        const float rstd = rsqrtf(s * (1.0f / D) + 1e-6f);
#pragma unroll
        for (int j = 0; j < 4; ++j) {
            const int col = (lane + 64 * j) * 4;
            const f32x4 gg = *(const f32x4*)(g + col), s4 = *(const f32x4*)(sh + col), c4 = *(const f32x4*)(sc + col);
            const f32x4 h = (v[j] * rstd) * gg * (c4 + 1.0f) + s4;
            v2u o; o.x = pk2(h.x, h.y); o.y = pk2(h.z, h.w);
            *(v2u*)(H + (size_t)r * D + col) = o;
        }
    }
}
__device__ __forceinline__ void final_norm_phase(const int bx, const int G, float* xo, const float* g, int lane, int wave) {
    const int gw = bx * NWAVES + wave, NGW = G * NWAVES;
    for (int r = gw; r < MLAT; r += NGW) {
        float* xr = xo + (size_t)r * D;
        f32x4 v[4]; float s = 0.f;
#pragma unroll
        for (int j = 0; j < 4; ++j) { v[j] = *(const f32x4*)(xr + (lane + 64 * j) * 4); s += (v[j].x * v[j].x + v[j].y * v[j].y) + (v[j].z * v[j].z + v[j].w * v[j].w); }
        s = wave_sum(s);
        const float rstd = rsqrtf(s * (1.0f / D) + 1e-6f);
#pragma unroll
        for (int j = 0; j < 4; ++j) { const int col = (lane + 64 * j) * 4; const f32x4 gg = *(const f32x4*)(g + col); *(f32x4*)(xr + col) = (v[j] * rstd) * gg; }
    }
}

__device__ __forceinline__ void pre_item(int it, int& i, int& col) {
    if (it < 2304) { const int seg = it / 768, r = it - seg * 768; i = r / 48; col = seg * 384 + (r % 48) * 8; }
    else if (it < 2560) { const int r = it - 2304; i = (r & 127) >> 3; col = 1152 + (r >> 7) * 64 + (r & 7) * 8; }
    else { const int r = it - 2560; i = r >> 4; col = 1280 + (r & 15) * 8; }
}
__device__ __forceinline__ void pre_phase(const int bx, const int G, CArgsP A, const WS& W, int l, LAS unsigned char* lds, int tid, int lane, int wave) {
    LAS float* k_s = (LAS float*)lds;
    const int odd = l & 1;
    const float* mu0 = A->in[I_MU] + (size_t)l * 2 * RC; const float* mu1 = mu0 + RC;
    const float* kkp = A->in[I_KK] + l * RW;
    bf16* AP = (bf16*)((unsigned char*)W.H + HB_AP); bf16* KT = (bf16*)((unsigned char*)W.H + HB_KT);
    for (int tile = bx; tile < NB * (QLEN / 16); tile += G) {
        const int b = tile / (QLEN / 16), q0 = (tile % (QLEN / 16)) * 16;
        const int seq_lo = q0 < CTX ? 0 : CTX, seq_hi = q0 < CTX ? CTX : QLEN;
        for (int pass = 0; pass < 2; ++pass) {
            v4u rc[3], rp[3], rn[3];
#pragma unroll
            for (int u = 0; u < 3; ++u) { const int it0 = tid + NTHR * (pass * 3 + u), it = it0 < 16 * 176 ? it0 : 16 * 176 - 1;
                int i, col; pre_item(it, i, col); const int q = q0 + i;
                const int qp = q - 1 >= seq_lo ? q - 1 : q, qn = q + 1 < seq_hi ? q + 1 : q;
                rc[u] = *(const v4u*)(W.P + (size_t)row_of(b, q, odd) * INCP + PC_RW + col);
                rp[u] = *(const v4u*)(W.P + (size_t)row_of(b, qp, odd) * INCP + PC_RW + col);
                rn[u] = *(const v4u*)(W.P + (size_t)row_of(b, qn, odd) * INCP + PC_RW + col); }
#pragma unroll
            for (int u = 0; u < 3; ++u) { const int it0 = tid + NTHR * (pass * 3 + u);
                if (it0 < 16 * 176) {
                    int i, col; pre_item(it0, i, col); const int q = q0 + i;
                    const size_t pos = (size_t)b * QLEN + q;
                    float cur[8], prv[8], nxt[8], ps[8];
                    unpack8(rc[u], cur); unpack8(rp[u], prv); unpack8(rn[u], nxt);
                    const float mp = q - 1 >= seq_lo ? 1.f : 0.f, mn = q + 1 < seq_hi ? 1.f : 0.f;
#pragma unroll
                    for (int e = 0; e < 8; ++e) ps[e] = cur[e] + mu0[col + e] * (prv[e] * mp - cur[e]) + mu1[col + e] * (nxt[e] * mn - cur[e]);
                    if (col < 384) *(v4u*)(W.sc_r + pos * RW + col) = pack8(ps);
                    else if (col < 768) {
#pragma unroll
                        for (int e = 0; e < 8; ++e) k_s[i * 384 + col - 384 + e] = ps[e];
                        *(v4u*)(KT + pos * RW + (col - 384)) = pack8(ps); }
                    else if (col < 1152) *(v4u*)(W.sc_v + pos * RW + (col - 768)) = pack8(ps);
                    else if (col < 1216) {
#pragma unroll
                        for (int e = 0; e < 8; ++e) ps[e] = tanh_fast(ps[e]);
                        *(v4u*)(AP + pos * LORA_K + (col - 1152)) = pack8(ps); }
                    else if (col < 1280) *(v4u*)(AP + pos * LORA_K + 64 + (col - 1216)) = pack8(ps);
                    else {
#pragma unroll
                        for (int e = 0; e < 8; ++e) ps[e] = sigmoidf_(ps[e]);
                        *(v4u*)(AP + pos * LORA_K + 128 + (col - 1280)) = pack8(ps); }
                }
            }
        }
        __syncthreads();
        for (int it = wave; it < 96; it += NWAVES) {
            const int i = it / 6, h = it % 6, c = h * 64 + lane;
            const float val = k_s[i * 384 + c] * kkp[c];
            const float ss = wave_sum(val * val);
            W.sc_kk[((size_t)b * QLEN + q0 + i) * RW + c] = (bf16)f2bf(val * rsqrtf(ss + 1e-12f));
        }
        __syncthreads();
    }
}

__device__ __forceinline__ int q_of_step(int n, int d) { return d == 0 ? n : (n < CTX ? CTX - 1 - n : QLEN + CTX - 1 - n); }
constexpr int RCH = 32, RNCH = QLEN / RCH;
__device__ __forceinline__ void rwkv_scan_phase(const WS& W, int l, int blk, LAS unsigned char* lds, int tid, int lane, int wave) {
    const int item = blk >> 1, half = blk & 1;
    const int b = item / 12, rem = item % 12, h = rem >> 1, d = rem & 1, odd = l & 1;
    LAS float* buf = (LAS float*)lds;
    LAS float* ybuf = buf + 2 * RCH * 384;
    const bf16* s_omw = W.scb + (size_t)(7 + d) * SC_ELEMS; const bf16* s_b = W.scb + (size_t)(5 + d) * SC_ELEMS; const bf16* s_kd = W.scb + (size_t)(3 + d) * SC_ELEMS;
    const int rg = lane >> 4, j = lane & 15, rlA = (wave & 3) * 8 + rg, rlB = rlA + 4, rowA = half * 32 + rlA, rowB = half * 32 + rlB;
    v4u pre[3];
#define RW_LOAD(c) do { _Pragma("unroll") for (int jj = 0; jj < 3; ++jj) { const int p = tid + NTHR * jj, i = p / 48, r48 = p % 48, vec = r48 >> 3, part = r48 & 7; \
        const int q = q_of_step((c) * RCH + i, d); const size_t pos = (size_t)b * QLEN + q; \
        const bf16* base = vec == 0 ? s_omw : vec == 1 ? s_b : vec == 2 ? s_kd : vec == 3 ? W.sc_kk : vec == 4 ? W.sc_r : W.sc_v; \
        pre[jj] = *(const v4u*)(base + pos * RW + h * 64 + part * 8); } } while (0)
#define RW_STORE(c) do { _Pragma("unroll") for (int jj = 0; jj < 3; ++jj) { const int p = tid + NTHR * jj, i = p / 48, r48 = p % 48, vec = r48 >> 3, part = r48 & 7; \
        float f[8]; unpack8(pre[jj], f); if (vec == 0) { _Pragma("unroll") for (int e = 0; e < 8; ++e) f[e] = 1.0f - f[e]; } \
        LAS float* dst = buf + (((c) & 1) * RCH + i) * 384 + vec * 64 + part * 8; \
        *(LAS f32x4*)dst = (f32x4){f[0], f[1], f[2], f[3]}; *(LAS f32x4*)(dst + 4) = (f32x4){f[4], f[5], f[6], f[7]}; } } while (0)
    f32x2 SA0 = (f32x2){0.f, 0.f}, SA1 = SA0, SB0 = SA0, SB1 = SA0;
    RW_LOAD(0); RW_STORE(0);
    __syncthreads();
    for (int c = 0; c < RNCH; ++c) {
        if (c + 1 < RNCH) RW_LOAD(c + 1);
        const LAS float* cur = buf + (c & 1) * RCH * 384;
        if (wave < 4) {
        float ykA, ykB;
#define RW_LD(X, i_) do { const int ii_ = (i_) < RCH ? (i_) : RCH - 1; const LAS f32x4* bp_ = (const LAS f32x4*)(cur + ii_ * 384 + j * 4); \
        X##w = bp_[0]; X##b = bp_[16]; X##d = bp_[32]; X##k = bp_[48]; X##r = bp_[64]; X##va = cur[ii_ * 384 + 320 + rowA]; X##vb = cur[ii_ * 384 + 320 + rowB]; } while (0)
#define RW_CP(X, s_) do { \
        const f32x2 k0_ = (f32x2){X##k.x, X##k.y}, k1_ = (f32x2){X##k.z, X##k.w}; \
        const f32x2 ta_ = SA0 * k0_ + SA1 * k1_, tb_ = SB0 * k0_ + SB1 * k1_; \
        const float saA_ = -reduce16(ta_.x + ta_.y), saB_ = -reduce16(tb_.x + tb_.y); \
        const f32x2 w0_ = (f32x2){X##w.x, X##w.y}, w1_ = (f32x2){X##w.z, X##w.w}, b0_ = (f32x2){X##b.x, X##b.y}, b1_ = (f32x2){X##b.z, X##b.w}, d0_ = (f32x2){X##d.x, X##d.y}, d1_ = (f32x2){X##d.z, X##d.w}; \
        const f32x2 va2_ = (f32x2){X##va, X##va}, vb2_ = (f32x2){X##vb, X##vb}, sa2_ = (f32x2){saA_, saA_}, sb2_ = (f32x2){saB_, saB_}; \
        SA0 = SA0 * w0_ + va2_ * d0_ + sa2_ * b0_; SA1 = SA1 * w1_ + va2_ * d1_ + sa2_ * b1_; \
        SB0 = SB0 * w0_ + vb2_ * d0_ + sb2_ * b0_; SB1 = SB1 * w1_ + vb2_ * d1_ + sb2_ * b1_; \
        const f32x2 r0_ = (f32x2){X##r.x, X##r.y}, r1_ = (f32x2){X##r.z, X##r.w}; \
        const f32x2 ya_ = SA0 * r0_ + SA1 * r1_, yb_ = SB0 * r0_ + SB1 * r1_; \
        const float yA_ = reduce16(ya_.x + ya_.y), yB_ = reduce16(yb_.x + yb_.y); \
        ykA = ((s_) == j) ? yA_ : ykA; ykB = ((s_) == j) ? yB_ : ykB; } while (0)
        f32x4 Aw, Ab, Ad, Ak, Ar, Bw, Bb, Bd, Bk, Br; float Ava, Avb, Bva, Bvb;
        RW_LD(A, 0);
#pragma unroll 1
        for (int g = 0; g < 2; ++g) {
            ykA = 0.f; ykB = 0.f;
#pragma unroll
            for (int s2 = 0; s2 < 16; s2 += 2) {
                const int i = g * 16 + s2;
                RW_LD(B, i + 1);
                __builtin_amdgcn_sched_barrier(0);
                RW_CP(A, s2);
                __builtin_amdgcn_sched_barrier(0);
                RW_LD(A, i + 2);
                __builtin_amdgcn_sched_barrier(0);
                RW_CP(B, s2 + 1);
                __builtin_amdgcn_sched_barrier(0);
            }
            ybuf[(g * 16 + j) * 32 + rlA] = ykA; ybuf[(g * 16 + j) * 32 + rlB] = ykB;
        }
#undef RW_LD
#undef RW_CP
        }
        __syncthreads();
        if (tid < 256) {
            const int i = tid >> 3, r4 = (tid & 7) * 4;
            const int q = q_of_step(c * RCH + i, d);
            const f32x4 yv = *(const LAS f32x4*)(ybuf + i * 32 + r4);
            v2u o; o.x = pk2(yv.x, yv.y); o.y = pk2(yv.z, yv.w);
            *(v2u*)(W.P + (size_t)row_of(b, q, odd) * INCP + PC_Y + d * RW + h * 64 + half * 32 + r4) = o;
        }
        if (c + 1 < RNCH) RW_STORE(c + 1);
        __syncthreads();
    }
#undef RW_LOAD
#undef RW_STORE
}

__device__ __forceinline__ void lru_scan_phase(CArgsP A, const WS& W, int l, int idx, LAS unsigned char* lds, int tid, int lane, int wave) {
    const int b = idx / 6, n = idx % 6, odd = l & 1;
    LAS float* gs = (LAS float*)lds;
    LAS float* xs = gs;
    LAS float* us = gs + 4 * 4096;
    LAS bf16* ub = (LAS bf16*)(us + 2 * 4096);
    const int c = tid & 63;
    float cw[2][4], cb[2], sp[2];
#pragma unroll
    for (int dd = 0; dd < 2; ++dd) {
#pragma unroll
        for (int jj = 0; jj < 4; ++jj) cw[dd][jj] = A->in[I_LCW][((size_t)(l * 2 + dd) * 4 + jj) * LW + n * 64 + c];
        cb[dd] = A->in[I_LCB][(l * 2 + dd) * LW + n * 64 + c];
        sp[dd] = softplusf_(-A->in[I_LAM][(l * 2 + dd) * LW + n * 64 + c]);
    }
    const int g = wave >> 2, jcol = (wave & 3) * 16 + (lane & 15), quad = lane >> 4;
    pg8::bf16x8 bfrag[2][2]; float gbias[2];
#pragma unroll
    for (int dd = 0; dd < 2; ++dd) {
        const float* Wsrc = (g ? A->in[I_LWI] : A->in[I_LWR]) + ((size_t)((l * 2 + dd) * 6 + n) * 64) * 64 + jcol;
#pragma unroll
        for (int ks = 0; ks < 2; ++ks)
#pragma unroll
            for (int jj = 0; jj < 8; ++jj) bfrag[dd][ks][jj] = (short)f2bf(Wsrc[(size_t)(ks * 32 + quad * 8 + jj) * 64]);
        gbias[dd] = (g ? A->in[I_LBI] : A->in[I_LBR])[(l * 2 + dd) * LW + n * 64 + jcol];
    }
    float hstate = 0.f;
    v4u pre[2][2];
#define LRU_LOAD(ch) do { _Pragma("unroll") for (int dd = 0; dd < 2; ++dd) { const int n0 = (ch) * 64; const int qlo_ = dd == 0 ? n0 : q_of_step(n0, 1) - 63; const int qb_ = dd == 0 ? qlo_ - 3 : qlo_; \
        const int slo_ = qlo_ < CTX ? 0 : CTX, shi_ = qlo_ < CTX ? CTX : QLEN; \
        _Pragma("unroll") for (int jj = 0; jj < 2; ++jj) { const int p = tid + NTHR * jj; const int t = p >> 3, part = p & 7, q = qb_ + t; \
            pre[dd][jj] = (v4u){0u, 0u, 0u, 0u}; \
            if (t < 67 && q >= slo_ && q < shi_) pre[dd][jj] = *(const v4u*)(W.P + (size_t)row_of(b, q, odd) * INCP + PC_XR + n * 64 + part * 8); } } } while (0)
    LRU_LOAD(0);
    const int tid_o = tid, lane_o = lane;
    for (int ch = 0; ch < QLEN / 64; ++ch) {
        const int n0 = ch * 64;
        int tid = tid_o, lane = lane_o; asm volatile("" : "+v"(tid), "+v"(lane));
        const int c = tid & 63, jcol = (wave & 3) * 16 + (lane & 15), quad = lane >> 4;
#pragma unroll
        for (int dd = 0; dd < 2; ++dd)
#pragma unroll
            for (int jj = 0; jj < 2; ++jj) { const int p = tid + NTHR * jj; const int t = p >> 3, part = p & 7;
                if (t < 67) { float f[8]; unpack8(pre[dd][jj], f); LAS float* dst = xs + dd * 68 * 64 + t * 64 + part * 8;
                    *(LAS f32x4*)dst = (f32x4){f[0], f[1], f[2], f[3]}; *(LAS f32x4*)(dst + 4) = (f32x4){f[4], f[5], f[6], f[7]}; } }
        __syncthreads();
        if (ch + 1 < QLEN / 64) LRU_LOAD(ch + 1);
#pragma unroll
        for (int k = 0; k < 16; ++k) { const int dd = k >> 3, t = (tid >> 6) + 8 * (k & 7); const LAS float* x = xs + dd * 68 * 64;
            const float uv = cb[dd] + cw[dd][0] * x[t * 64 + c] + cw[dd][1] * x[(t + 1) * 64 + c] + cw[dd][2] * x[(t + 2) * 64 + c] + cw[dd][3] * x[(t + 3) * 64 + c];
            us[dd * 4096 + t * 64 + c] = uv; ub[dd * 64 * 72 + t * 72 + c] = (bf16)f2bf(uv); }
        __syncthreads();
#pragma unroll
        for (int dd = 0; dd < 2; ++dd)
#pragma unroll
            for (int rt = 0; rt < 4; ++rt) {
                pg8::f32x4 acc = {0.f, 0.f, 0.f, 0.f};
#pragma unroll
                for (int ks = 0; ks < 2; ++ks) {
                    const pg8::bf16x8 afrag = *(const LAS pg8::bf16x8*)(ub + dd * 64 * 72 + (rt * 16 + (lane & 15)) * 72 + ks * 32 + quad * 8);
                    acc = __builtin_amdgcn_mfma_f32_16x16x32_bf16(afrag, bfrag[dd][ks], acc, 0, 0, 0);
                }
#pragma unroll
                for (int jj = 0; jj < 4; ++jj) gs[((dd * 2 + g) * 64 + rt * 16 + quad * 4 + jj) * 64 + jcol] = sigmoidf_(acc[jj] + gbias[dd]);
            }
        __syncthreads();
#pragma unroll
        for (int k = 0; k < 16; ++k) { const int dd = k >> 3, t = (tid >> 6) + 8 * (k & 7);
            LAS float* ga = gs + (dd * 2) * 4096 + t * 64 + c; LAS float* gb = ga + 4096;
            const float rgv = *ga, igv = *gb, u = us[dd * 4096 + t * 64 + c];
            const float log_a = -8.0f * sp[dd] * rgv;
            const float a = __expf(log_a);
            const float bt = sqrtf(fmaxf(1.0f - a * a, 0.f)) * (igv * u);
            *ga = a; *gb = bt; }
        __syncthreads();
        if (wave < 2) {
            const int dd = wave; const int qlo = dd == 0 ? n0 : q_of_step(n0, 1) - 63;
            const LAS float* ga = gs + (dd * 2) * 4096 + lane;
#pragma unroll 8
            for (int s = 0; s < 64; ++s) { const int t = dd == 0 ? s : 63 - s;
                hstate = ga[t * 64] * hstate + ga[4096 + t * 64];
                W.H[(size_t)row_of(b, qlo + t, odd) * D + dd * LW + n * 64 + lane] = (bf16)f2bf(hstate); }
        }
        __syncthreads();
    }
#undef LRU_LOAD
}

__device__ __forceinline__ void post_phase(const int bx, const int G, CArgsP A, const WS& W, int l, LAS unsigned char* lds, int tid, int lane, int wave) {
    LAS float* hs = (LAS float*)lds;
    const int odd = l & 1;
    const float* cwa = A->in[I_CONVA] + (size_t)l * 3 * 256;
    const float* rk = A->in[I_RK] + l * RW; const float* lng = A->in[I_LNG] + l * RW; const float* lnb = A->in[I_LNB] + l * RW;
    bf16* Y = W.H;
    for (int tile = bx; tile < NB * (QLEN / 16); tile += G) {
        const int b = tile / (QLEN / 16), q0 = (tile % (QLEN / 16)) * 16;
        for (int it = tid; it < 16 * 48; it += NTHR) { const int i = it / 48, col = (it % 48) * 8; const size_t row = row_of(b, q0 + i, odd);
            float h0[8], h1[8]; unpack8(*(const v4u*)(W.H + row * D + col), h0); unpack8(*(const v4u*)(W.H + row * D + LW + col), h1);
#pragma unroll
            for (int e = 0; e < 8; ++e) hs[i * 384 + col + e] = h0[e] + h1[e]; }
        __syncthreads();
        for (int it = tid; it < 16 * 32; it += NTHR) { const int i = it >> 5, col = (it & 31) * 8, q = q0 + i;
            int lo, hi; if (q < CTX) { lo = 0; hi = CTX; } else { lo = CTX + ((q - CTX) & ~63); hi = lo + 64; }
            const size_t row = row_of(b, q, odd);
            float bg[8], cgv[8], xv[8], y[8];
            unpack8(*(const v4u*)(W.P + row * INCP + PC_BG + col), bg); unpack8(*(const v4u*)(W.P + row * INCP + PC_CG + col), cgv); unpack8(*(const v4u*)(W.P + row * INCP + PC_XIN + col), xv);
#pragma unroll
            for (int e = 0; e < 8; ++e) y[e] = cwa[256 + col + e] * (cgv[e] * xv[e]);
            if (q - 1 >= lo) { const size_t r2 = row_of(b, q - 1, odd); unpack8(*(const v4u*)(W.P + r2 * INCP + PC_CG + col), cgv); unpack8(*(const v4u*)(W.P + r2 * INCP + PC_XIN + col), xv);
#pragma unroll
                for (int e = 0; e < 8; ++e) y[e] += cwa[col + e] * (cgv[e] * xv[e]); }
            if (q + 1 < hi) { const size_t r2 = row_of(b, q + 1, odd); unpack8(*(const v4u*)(W.P + r2 * INCP + PC_CG + col), cgv); unpack8(*(const v4u*)(W.P + r2 * INCP + PC_XIN + col), xv);
#pragma unroll
                for (int e = 0; e < 8; ++e) y[e] += cwa[512 + col + e] * (cgv[e] * xv[e]); }
#pragma unroll
            for (int e = 0; e < 8; ++e) y[e] *= bg[e];
            *(v4u*)(Y + row * D + col) = pack8(y); }
        for (int k0 = 0; k0 < 12; k0 += 4) {
            float ys[4], rr[4], vv[4], kd[4], gg[4]; size_t rows[4];
#pragma unroll
            for (int u = 0; u < 4; ++u) { const int it = wave + 8 * (k0 + u), i = it / 6, h = it % 6, c = h * 64 + lane, q = q0 + i;
                const size_t row = row_of(b, q, odd), pos = (size_t)b * QLEN + q; rows[u] = row;
                ys[u] = bf2f(W.P[row * INCP + PC_Y + c]) + bf2f(W.P[row * INCP + PC_Y + RW + c]);
                rr[u] = bf2f(W.sc_r[pos * RW + c]); vv[u] = bf2f(W.sc_v[pos * RW + c]);
                kd[u] = bf2f((W.scb + (size_t)3 * SC_ELEMS)[pos * RW + c]) + bf2f((W.scb + (size_t)4 * SC_ELEMS)[pos * RW + c]);
                gg[u] = bf2f(W.P[row * INCP + PC_G + c]); }
#pragma unroll
            for (int u = 0; u < 4; ++u) { const int it = wave + 8 * (k0 + u), h = it % 6, c = h * 64 + lane;
                const float mean = wave_sum(ys[u]) * (1.0f / 64.0f); const float dv = ys[u] - mean;
                const float var = wave_sum(dv * dv) * (1.0f / 64.0f);
                const float gn = dv * rsqrtf(var + 64e-5f) * lng[c] + lnb[c];
                const float bon = wave_sum(rr[u] * kd[u] * rk[c]);
                Y[rows[u] * D + 256 + c] = (bf16)f2bf((gn + bon * vv[u]) * gg[u]); }
        }
        for (int it = tid; it < 16 * 48; it += NTHR) { const int i = it / 48, col = (it % 48) * 8; const size_t row = row_of(b, q0 + i, odd);
            float gr[8], o[8]; unpack8(*(const v4u*)(W.P + row * INCP + PC_GR + col), gr);
#pragma unroll
            for (int e = 0; e < 8; ++e) o[e] = gelu_tanh(gr[e]) * hs[i * 384 + col + e];
            *(v4u*)(Y + row * D + 640 + col) = pack8(o); }
        __syncthreads();
    }
}

#define XB_TMO      128
#define XB_XCNT(j)  (256  + 64 * (j))
#define XB_XSUB(j)  (1280 + 64 * (j))
#define XB_XGEN(j)  (2304 + 64 * (j))
#define XB_TOP      3328
#define XB_TOPGEN   3392
#define XCD_BAR_WORDS 3456
#define XB_SPIN_CAP (1u << 18)

__device__ __forceinline__ unsigned xb_ld(unsigned* p)              { return __hip_atomic_load(p, __ATOMIC_RELAXED, __HIP_MEMORY_SCOPE_AGENT); }
__device__ __forceinline__ unsigned xb_add(unsigned* p, unsigned v) { return __hip_atomic_fetch_add(p, v, __ATOMIC_RELAXED, __HIP_MEMORY_SCOPE_AGENT); }
__device__ __forceinline__ unsigned xb_xcc_id() { return (unsigned)__builtin_amdgcn_s_getreg((3 << 11) | 20) & 0xFu; }
#define XB_SPIN(cond, bar) do { unsigned _sp = 0; while (cond) { __builtin_amdgcn_s_sleep(1); \
    if ((++_sp & 255u) == 0u) { if (xb_ld(&(bar)[XB_TMO])) break; if (_sp > XB_SPIN_CAP) { atomicAdd(&(bar)[XB_TMO], 1u); break; } } } } while (0)

struct XcdBarrier {
    unsigned* bar; unsigned x;
    volatile LAS unsigned* st;
};

__device__ __forceinline__ XcdBarrier xcd_barrier_post(unsigned* bar, volatile LAS unsigned* st) {
    XcdBarrier b; b.bar = bar; b.x = xb_xcc_id(); b.st = st;
    if (threadIdx.x == 0) (void)xb_add(&bar[XB_XCNT(b.x)], 1u);
    return b;
}
__device__ __forceinline__ void xcd_barrier_complete(unsigned* bar, unsigned x, unsigned& nloc, unsigned& nx) {
    const unsigned G = gridDim.x * gridDim.y * gridDim.z;
    unsigned sum, cnt, mine, sp = 0u;
    for (;;) {
        sum = 0u; cnt = 0u; mine = 0u;
#pragma unroll
        for (unsigned j = 0; j < 16; ++j) { const unsigned c = xb_ld(&bar[XB_XCNT(j)]); sum += c; cnt += (c > 0u) ? 1u : 0u; mine = (j == x) ? c : mine; }
        if (sum == G) break;
        __builtin_amdgcn_s_sleep(1);
        if ((++sp & 255u) == 0u) { if (xb_ld(&bar[XB_TMO])) break; if (sp > XB_SPIN_CAP) { atomicAdd(&bar[XB_TMO], 1u); break; } }
    }
    nloc = mine > 0u ? mine : 1u; nx = cnt > 0u ? cnt : 1u;
}

__device__ __forceinline__ void xcd_barrier(const XcdBarrier& b) {
    asm volatile("s_waitcnt vmcnt(0)" ::: "memory");
    __syncthreads();
    if (threadIdx.x == 0) {
        unsigned* bar = b.bar;
        __builtin_amdgcn_s_waitcnt(0);
        unsigned nloc = b.st[0], nx = b.st[1];
        if (nloc == 0u) { xcd_barrier_complete(bar, b.x, nloc, nx); b.st[0] = nloc; b.st[1] = nx; }
        const unsigned old = xb_add(&bar[XB_XSUB(b.x)], 1u);
        const unsigned gen = old / nloc;
        if (old + 1u == (gen + 1u) * nloc) {
            __builtin_amdgcn_fence(__ATOMIC_RELEASE, "agent");
            asm volatile("s_waitcnt vmcnt(0)" ::: "memory");
            const unsigned og = xb_add(&bar[XB_TOP], 1u);
            const unsigned tg = og / nx;
            if (og + 1u == (tg + 1u) * nx) xb_add(&bar[XB_TOPGEN], 1u);
            else XB_SPIN(xb_ld(&bar[XB_TOPGEN]) == tg, bar);
            __builtin_amdgcn_fence(__ATOMIC_ACQUIRE, "agent");
            xb_add(&bar[XB_XGEN(b.x)], 1u);
            asm volatile("s_waitcnt vmcnt(0)" ::: "memory");
        } else {
            XB_SPIN(xb_ld(&bar[XB_XGEN(b.x)]) == gen, bar);
            __builtin_amdgcn_fence(__ATOMIC_ACQUIRE, "agent");
            asm volatile("s_waitcnt vmcnt(0)" ::: "memory");
        }
    }
    __syncthreads();
}

constexpr int PH_PER_LAYER = 13, N_PHASES = 1 + DEPTH * PH_PER_LAYER + 1;
__global__ void __launch_bounds__(NTHR, 2) fwd_megakernel(Args A0) {
    extern __shared__ __attribute__((aligned(16))) unsigned char lds_raw[];
    LAS unsigned char* lds = (LAS unsigned char*)lds_raw;
    cg::grid_group grid = cg::this_grid();
    const int ph_lo = A0.ph_lo, ph_hi = A0.ph_hi;
    volatile LAS unsigned* bst = (volatile LAS unsigned*)(lds + 131072);
    if (threadIdx.x < 2) bst[threadIdx.x] = 0u;
    __syncthreads();
    const XcdBarrier xbar = xcd_barrier_post((unsigned*)(A0.ws + WS_BAR), bst);
    const int wave0 = __builtin_amdgcn_readfirstlane((int)threadIdx.x >> 6);
    bool rep_done = false; (void)rep_done;
    for (int ph = ph_lo; ph < ph_hi; ++ph) {
        CArgsP A = (CArgsP)__builtin_amdgcn_kernarg_segment_ptr();
        asm volatile("" : "+s"(A) :: "memory");
        int G = gridDim.x, bx = blockIdx.x, wave = wave0;
        asm volatile("" : "+s"(G), "+s"(bx), "+s"(wave));
#define IDS() int lane; asm volatile("v_mbcnt_lo_u32_b32 %0, -1, 0\n\tv_mbcnt_hi_u32_b32 %0, -1, %0" : "=v"(lane)); const int tid = wave * 64 + lane; (void)tid
        const WS W = make_ws(A->ws);
        if (ph == 0) { IDS(); mods_phase(bx, G, A, W, lds, tid, lane, wave); convert_phase(bx, G, A, W, 0, lds, lane, wave); }
        else if (ph == N_PHASES - 1) { IDS(); final_norm_phase(bx, G, A->out, A->in[I_GFINAL], lane, wave); }
        else {
            const int l = (ph - 1) / PH_PER_LAYER, s = (ph - 1) % PH_PER_LAYER; const bool last = (l == DEPTH - 1);
            const float* mods_l = W.mods + (size_t)l * 9 * 9216;
            const float* xlat = A->out; const float* xctx = W.xrctx;
            if (s == 0) { IDS();
                if (l > 0) convert_phase(bx, G, A, W, l, lds, lane, wave);
                norm_phase(bx, G, l == 0 ? A->in[I_X] : xlat, l == 0 ? A->in[I_CTX] : xctx, A->in[I_GFFN1] + l * D, mods_l, 0, 1, W.H, MTOT, lane, wave);
            } else if (s == 1 || s == 11) { IDS();
                pg8::Gemm g{W.H, W.wt + (s == 1 ? WT_GU1 : WT_GU2), (s == 11 && last) ? MLAT : MTOT, 2 * DFF, D}; pg8::StaticOrder S; S.init(g.M, g.N, G, bx);
                EpiSwiGLU E{W.ACT};
                pg8::gemm_phase<EpiSwiGLU, pg8::StaticOrder, true, true>(lds, g, S, E, tid);
            } else if (s == 2 || s == 9 || s == 12) { IDS();
                pg8::Gemm g{s == 9 ? W.H : W.ACT, W.wt + (s == 2 ? WT_DOWN1 : s == 9 ? WT_OUT : WT_DOWN2), (s != 2 && last) ? MLAT : MTOT, D, s == 9 ? D : DFF};
                pg8::StaticOrder S; S.init(g.M, g.N, G, bx);
                const bool first = (l == 0 && s == 2);
                EpiResid E{first ? A->in[I_X] : xlat, first ? A->in[I_CTX] : xctx, A->out, W.xrctx, mods_l + (s == 2 ? 2 : s == 9 ? 5 : 8) * 1024, s == 9 ? 1.0f : 0.5f};
                pg8::gemm_phase<EpiResid, pg8::StaticOrder, true, true>(lds, g, S, E, tid);
            } else if (s == 3) { IDS();
                norm_phase(bx, G, xlat, xctx, A->in[I_GMIX] + l * D, mods_l, 3, 4, W.H, MTOT, lane, wave);
            } else if (s == 4) { IDS();
                pg8::Gemm g{W.H, W.wt + WT_IN, MTOT, INCP, D}; pg8::StaticOrder S; S.init(g.M, g.N, G, bx);
                EpiP E{W.P, INCP};
                pg8::gemm_phase<EpiP, pg8::StaticOrder, true, true>(lds, g, S, E, tid);
            } else if (s == 5) { IDS();
                pre_phase(bx, G, A, W, l, lds, tid, lane, wave);
            } else if (s == 6) { IDS();
                int Kl = LORA_K, Nl = LORA_N; asm volatile("" : "+s"(Kl), "+s"(Nl));
                pg8::Gemm g{(const bf16*)((const unsigned char*)W.H + HB_AP), W.wt + WT_LORA, MTOT, Nl, Kl}; pg8::StaticOrder S; S.init(g.M, g.N, G, bx);
                EpiLora E{A->in[I_W0] + l * 2 * RW, A->in[I_A0] + l * 2 * RW, A->in[I_KA] + l * RW, (const bf16*)((const unsigned char*)W.H + HB_KT), W.sc_kk, W.scb, W.P, l & 1};
                pg8::gemm_phase<EpiLora, pg8::StaticOrder, true, true>(lds, g, S, E, tid);
            } else if (s == 7) { IDS();
                for (int u = bx; u < 240; u += G) {
                    if (u < 192) rwkv_scan_phase(W, l, u, lds, tid, lane, wave); else lru_scan_phase(A, W, l, u - 192, lds, tid, lane, wave);
                    __syncthreads();
                }
            } else if (s == 8) { IDS();
                post_phase(bx, G, A, W, l, lds, tid, lane, wave);
            } else if (s == 10) { IDS();
                norm_phase(bx, G, xlat, xctx, A->in[I_GFFN2] + l * D, mods_l, 6, 7, W.H, last ? MLAT : MTOT, lane, wave);
            }
        }
#ifdef PROBE_REP_S
        if (ph > 0 && ph < N_PHASES - 1 && ((ph - 1) % PH_PER_LAYER) == PROBE_REP_S && !rep_done) { rep_done = true; grid.sync(); --ph; continue; }
        rep_done = false;
#endif
        if (ph + 1 < ph_hi) { if (ph == ph_lo) grid.sync(); else xcd_barrier(xbar); }
    }
}

#ifndef MK_MULTI
#define MK_MULTI 0
#endif
extern "C" void kernel_launch(void* const* d_in, const int* in_sizes, int n_in, void* d_out, int out_size, void* d_ws, size_t ws_size, hipStream_t stream) {
    static int grid = 0;
    if (grid == 0) {
        if (n_in != N_IN || out_size != MLAT * D || ws_size < WS_END) { fprintf(stderr, "kernel_launch: unexpected shapes (n_in %d out %d ws %zu)\n", n_in, out_size, ws_size); grid = -1; return; }
        int dev = 0, cus = 0, per_cu = 0;
        (void)hipGetDevice(&dev); (void)hipDeviceGetAttribute(&cus, hipDeviceAttributeMultiprocessorCount, dev);
        if (hipFuncSetAttribute((const void*)fwd_megakernel, hipFuncAttributeMaxDynamicSharedMemorySize, LDS_BYTES) != hipSuccess) { fprintf(stderr, "kernel_launch: hipFuncSetAttribute failed\n"); grid = -1; return; }
        if (hipOccupancyMaxActiveBlocksPerMultiprocessor(&per_cu, (const void*)fwd_megakernel, NTHR, LDS_BYTES) != hipSuccess || per_cu < 1) { fprintf(stderr, "kernel_launch: occupancy query says %d\n", per_cu); per_cu = 1; }
        (void)hipGetLastError();
        grid = cus * 1;
        if (grid <= 0) grid = 256;
    }
    if (grid < 0) return;
    if (hipMemsetAsync((unsigned char*)d_ws + WS_BAR, 0, WS_BAR_BYTES, stream) != hipSuccess) { fprintf(stderr, "kernel_launch: memset of the barrier words failed\n"); return; }
    Args a{};
    for (int i = 0; i < N_IN; ++i) a.in[i] = (const float*)d_in[i];
    a.out = (float*)d_out; a.ws = (unsigned char*)d_ws;
#if MK_MULTI
    for (int ph = 0; ph < N_PHASES; ++ph) { a.ph_lo = ph; a.ph_hi = ph + 1; hipLaunchKernelGGL(fwd_megakernel, dim3(grid), dim3(NTHR), LDS_BYTES, stream, a); }
#else
    a.ph_lo = 0; a.ph_hi = N_PHASES;
    void* args[] = {&a};
    hipError_t e = hipLaunchCooperativeKernel((const void*)fwd_megakernel, dim3(grid), dim3(NTHR), args, LDS_BYTES, stream);
    if (e != hipSuccess) fprintf(stderr, "kernel_launch: cooperative launch failed: %s (grid %d)\n", hipGetErrorString(e), grid);
#endif
}
```

```cpp
#include <hip/hip_runtime.h>
#include <hip/hip_cooperative_groups.h>
#include <cstdio>
#include <cstdint>
namespace cg = cooperative_groups;
namespace pg8 {
#define PG8_LAS __attribute__((address_space(3)))
typedef unsigned short bf16_t;
typedef short bf16x8 __attribute__((ext_vector_type(8)));
typedef float f32x4 __attribute__((ext_vector_type(4)));
typedef unsigned u32x4 __attribute__((ext_vector_type(4)));
constexpr int BM = 256, BK = 64, HALF = 128, HTB = HALF * BK * 2  , STAGE_BYTES = 8 * HTB, NXCD = 8, WGM = 8;

__host__ __device__ __forceinline__ int lds_byte(int r, int c) { const int st = (r >> 4) * 2 + (c >> 5), rr = r & 15, cc = c & 31, ob = rr * 64 + cc * 2; return st * 1024 + (ob ^ (((ob >> 9) & 1) << 5)); }
__host__ __device__ __forceinline__ void stage_rc(int b, int& R, int& C) { const int st = b / 1024, sb = b % 1024, swz = sb ^ (((sb >> 9) & 1) << 5); R = (st >> 1) * 16 + swz / 64; C = (st & 1) * 32 + (swz % 64) / 2; }
__host__ __device__ __forceinline__ int perm32(int rho) { const int n = rho >> 4, i = rho & 15; return 8 * (i >> 2) + 4 * n + (i & 3); }

struct Unit { int pm, pn; };
struct Gemm { const bf16_t* A; const bf16_t* Bt; int M, N, K; };

struct StaticOrder {
    int nM, nN, nwg, G, c;
    __host__ __device__ void init(int M, int N, int G_, int c_) { nM = M / BM; nN = N / BM; nwg = nM * nN; G = G_; c = c_; }
    __host__ __device__ bool next(int i, Unit& u) const {
        const long L = (long)i * G + c; if (L >= nwg) return false;
        int wgid = (int)L; { const int q = nwg / NXCD, r = nwg % NXCD, xcd = wgid % NXCD, off = wgid / NXCD; wgid = (xcd < r ? xcd * (q + 1) : r * (q + 1) + (xcd - r) * q) + off; }
        const int nig = WGM * nN, gid = wgid / nig, fm = gid * WGM, gsz = (nM - fm) < WGM ? (nM - fm) : WGM;
        u.pm = fm + ((wgid % nig) % gsz); u.pn = (wgid % nig) / gsz; return true;
    }
    __device__ __forceinline__ void a_ready(const Unit&) const {}
    __device__ __forceinline__ void done(const Unit&) const {}
};

template <class Epi, class Sched, bool ALIGN_EPI = false, bool SP2 = false>
__device__ __forceinline__ void gemm_phase(PG8_LAS unsigned char* lds, const Gemm g, const Sched& S, const Epi& E, const int tid) {
    const int wid = __builtin_amdgcn_readfirstlane(tid >> 6), lane = tid & 63, wr = wid >> 2, wc = wid & 3, fr = lane & 15, fq = lane >> 4;
    const int K = g.K, nt = K / BK;
    unsigned voffA[2], voffB[2];
#pragma unroll
    for (int i = 0; i < 2; ++i) { int R, C; stage_rc(tid * 16 + i * 8192, R, C); const int Rb = Epi::PERM ? ((R & ~31) + perm32(R & 31)) : R;
        voffA[i] = (unsigned)(R * K + C) * 2u; voffB[i] = (unsigned)(Rb * K + C) * 2u; }
    const size_t kstep = (size_t)(BK * 2);
    const size_t hstep = (size_t)HALF * K * 2;
    const size_t tstep = 2 * hstep;
    const unsigned ldsw = (unsigned)wid * 1024u;
    const int aoff = lds_byte(wr * 64 + fr, fq * 8), boff = lds_byte(wc * 32 + fr, fq * 8);
#define PG8_SA(b, h) (((b) * 2 + (h)) * HTB)
#define PG8_SB(b, h) ((4 + (b) * 2 + (h)) * HTB)
#define PG8_STAGE(bufoff, gbase, voff) do { _Pragma("unroll") for (int _i = 0; _i < 2; ++_i) \
        __builtin_amdgcn_global_load_lds((const unsigned*)((const char*)(gbase) + (voff)[_i]), (PG8_LAS unsigned*)(lds + (bufoff) + ldsw + _i * 8192), 16, 0, 0); } while (0)
#define PG8_LDA(dst, b, h) do { _Pragma("unroll") for (int m = 0; m < 4; ++m) _Pragma("unroll") for (int k = 0; k < 2; ++k) dst[m][k] = *(const PG8_LAS bf16x8*)(lds + PG8_SA(b, h) + aoff + m * 2048 + k * 1024); } while (0)
#define PG8_LDB(dst, b, h) do { _Pragma("unroll") for (int n = 0; n < 2; ++n) _Pragma("unroll") for (int k = 0; k < 2; ++k) dst[n][k] = *(const PG8_LAS bf16x8*)(lds + PG8_SB(b, h) + boff + n * 2048 + k * 1024); } while (0)
#define PG8_MMA(ai, bj, At, Bt) do { __builtin_amdgcn_s_setprio(1); _Pragma("unroll") for (int m = 0; m < 4; ++m) _Pragma("unroll") for (int n = 0; n < 2; ++n) _Pragma("unroll") for (int k = 0; k < 2; ++k) \
        acc[ai][bj][m][n] = __builtin_amdgcn_mfma_f32_16x16x32_bf16(Bt[n][k], At[m][k], acc[ai][bj][m][n], 0, 0, 0); __builtin_amdgcn_s_setprio(0); } while (0)
#define PG8_WAIT_V(n) asm volatile("s_waitcnt vmcnt(" #n ")" ::: "memory")
#define PG8_WAIT_L(n) asm volatile("s_waitcnt lgkmcnt(" #n ")" ::: "memory")
#define PG8_BAR __builtin_amdgcn_s_barrier()
#define PG8_SCHED __builtin_amdgcn_sched_barrier(0)
    Unit cur, nxt; int ui = 0;
    if (!S.next(0, cur)) return;
    f32x4 acc[2][2][4][2];
#pragma unroll
    for (int a = 0; a < 2; ++a)
#pragma unroll
        for (int b = 0; b < 2; ++b)
#pragma unroll
            for (int m = 0; m < 4; ++m)
#pragma unroll
                for (int n = 0; n < 2; ++n) acc[a][b][m][n] = (f32x4){0.f, 0.f, 0.f, 0.f};
    bf16x8 At[4][2], B0[2][2], B1[2][2];
    const char* cA = (const char*)g.A + (size_t)cur.pm * tstep; const char* cB = (const char*)g.Bt + (size_t)cur.pn * tstep;
    S.a_ready(cur);
    if constexpr (SP2) {
        PG8_STAGE(PG8_SB(0, 0), cB, voffB); PG8_STAGE(PG8_SB(0, 1), cB + hstep, voffB); PG8_STAGE(PG8_SA(0, 0), cA, voffA); PG8_STAGE(PG8_SA(0, 1), cA + hstep, voffA);
        if (wr == 1) PG8_BAR;
        PG8_WAIT_V(2); PG8_BAR;
        PG8_STAGE(PG8_SB(1, 0), cB + kstep, voffB); PG8_STAGE(PG8_SA(1, 0), cA + kstep, voffA); PG8_STAGE(PG8_SB(1, 1), cB + hstep + kstep, voffB);
        PG8_WAIT_V(6); PG8_BAR;
    } else {
        PG8_STAGE(PG8_SB(0, 0), cB, voffB); PG8_STAGE(PG8_SA(0, 0), cA, voffA); PG8_STAGE(PG8_SB(0, 1), cB + hstep, voffB); PG8_STAGE(PG8_SA(0, 1), cA + hstep, voffA);
        if (wr == 1) PG8_BAR;
        PG8_WAIT_V(4); PG8_BAR;
        PG8_STAGE(PG8_SB(1, 0), cB + kstep, voffB); PG8_STAGE(PG8_SA(1, 0), cA + kstep, voffA); PG8_STAGE(PG8_SB(1, 1), cB + hstep + kstep, voffB);
        PG8_WAIT_V(6); PG8_BAR;
    }
    for (;;) {
        const bool has_next = S.next(ui + 1, nxt);
        const char* nA = has_next ? (const char*)g.A + (size_t)nxt.pm * tstep : cA; const char* nB = has_next ? (const char*)g.Bt + (size_t)nxt.pn * tstep : cB;
        for (int t = 0; t < nt; t += 2) {
            const bool last = (t == nt - 2);
            const char* a1 = cA + (size_t)(t + 1) * kstep;
            const char* a2 = last ? nA : cA + (size_t)(t + 2) * kstep; const char* b2 = last ? nB : cB + (size_t)(t + 2) * kstep;
            const char* a3 = a2 + kstep; const char* b3 = b2 + kstep;
            if (last && has_next) S.a_ready(nxt);
            if constexpr (SP2) {
            PG8_LDB(B0, 0, 0); PG8_LDB(B1, 0, 1); PG8_SCHED; PG8_LDA(At, 0, 0); PG8_STAGE(PG8_SA(1, 1), a1 + hstep, voffA);
            PG8_WAIT_V(8); PG8_WAIT_L(0); PG8_BAR; PG8_MMA(0, 0, At, B0); PG8_MMA(0, 1, At, B1); PG8_BAR; PG8_SCHED;
            PG8_LDA(At, 0, 1); PG8_STAGE(PG8_SB(0, 0), b2, voffB); PG8_STAGE(PG8_SB(0, 1), b2 + hstep, voffB); PG8_STAGE(PG8_SA(0, 0), a2, voffA);
            PG8_WAIT_V(8); PG8_WAIT_L(0); PG8_BAR; PG8_MMA(1, 0, At, B0); PG8_MMA(1, 1, At, B1); PG8_BAR; PG8_SCHED;
            PG8_LDB(B0, 1, 0); PG8_LDB(B1, 1, 1); PG8_SCHED; PG8_LDA(At, 1, 0); PG8_STAGE(PG8_SA(0, 1), a2 + hstep, voffA);
            PG8_WAIT_V(8); PG8_WAIT_L(0); PG8_BAR; PG8_MMA(0, 0, At, B0); PG8_MMA(0, 1, At, B1); PG8_BAR; PG8_SCHED;
            PG8_LDA(At, 1, 1); PG8_STAGE(PG8_SB(1, 0), b3, voffB); PG8_STAGE(PG8_SB(1, 1), b3 + hstep, voffB); PG8_STAGE(PG8_SA(1, 0), a3, voffA);
            PG8_WAIT_V(8); PG8_WAIT_L(0); PG8_BAR; PG8_MMA(1, 0, At, B0); PG8_MMA(1, 1, At, B1); PG8_BAR; PG8_SCHED;
            } else {
            PG8_LDB(B0, 0, 0); PG8_SCHED; PG8_LDA(At, 0, 0); PG8_STAGE(PG8_SA(1, 1), a1 + hstep, voffA);
            PG8_WAIT_L(8); PG8_BAR; PG8_WAIT_L(0); PG8_MMA(0, 0, At, B0); PG8_BAR; PG8_SCHED;
            PG8_LDB(B1, 0, 1); PG8_STAGE(PG8_SB(0, 0), b2, voffB);
            PG8_BAR; PG8_WAIT_L(0); PG8_MMA(0, 1, At, B1); PG8_BAR;
            PG8_LDA(At, 0, 1); PG8_STAGE(PG8_SA(0, 0), a2, voffA);
            PG8_BAR; PG8_WAIT_L(0); PG8_MMA(1, 0, At, B0); PG8_BAR; PG8_SCHED;
            PG8_STAGE(PG8_SB(0, 1), b2 + hstep, voffB);
            PG8_WAIT_V(6); PG8_BAR; PG8_MMA(1, 1, At, B1); PG8_BAR;
            PG8_LDB(B0, 1, 0); PG8_SCHED; PG8_LDA(At, 1, 0); PG8_STAGE(PG8_SA(0, 1), a2 + hstep, voffA);
            PG8_WAIT_L(8); PG8_BAR; PG8_WAIT_L(0); PG8_MMA(0, 0, At, B0); PG8_BAR; PG8_SCHED;
            PG8_LDB(B1, 1, 1); PG8_STAGE(PG8_SB(1, 0), b3, voffB);
            PG8_BAR; PG8_WAIT_L(0); PG8_MMA(0, 1, At, B1); PG8_BAR;
            PG8_LDA(At, 1, 1); PG8_STAGE(PG8_SA(1, 0), a3, voffA);
            PG8_BAR; PG8_WAIT_L(0); PG8_MMA(1, 0, At, B0); PG8_BAR; PG8_SCHED;
            PG8_STAGE(PG8_SB(1, 1), b3 + hstep, voffB);
            PG8_WAIT_V(6); PG8_BAR; PG8_MMA(1, 1, At, B1); PG8_BAR;
            }
        }
        if constexpr (ALIGN_EPI) { if (wr == 0) PG8_BAR; }
        if constexpr (!Epi::AFTER_DRAIN) { E(acc, cur, wr, wc, fr, fq); S.done(cur); }
        if (!has_next) break;
#pragma unroll
        for (int a = 0; a < 2; ++a)
#pragma unroll
            for (int b = 0; b < 2; ++b)
#pragma unroll
                for (int m = 0; m < 4; ++m)
#pragma unroll
                    for (int n = 0; n < 2; ++n) acc[a][b][m][n] = (f32x4){0.f, 0.f, 0.f, 0.f};
        cur = nxt; cA = nA; cB = nB; ++ui;
        if constexpr (ALIGN_EPI) { if (wr == 1) PG8_BAR; }
    }
    PG8_WAIT_V(0);
    if constexpr (!ALIGN_EPI) { if (wr == 0) PG8_BAR; }
    PG8_BAR;
    if constexpr (Epi::AFTER_DRAIN) { E.fused(acc, cur, wr, wc, fr, fq, lds, wid, lane); S.done(cur); }
#undef PG8_SA
#undef PG8_SB
#undef PG8_STAGE
#undef PG8_LDA
#undef PG8_LDB
#undef PG8_MMA
#undef PG8_WAIT_V
#undef PG8_WAIT_L
#undef PG8_BAR
#undef PG8_SCHED
}
}
#define LAS __attribute__((address_space(3)))
typedef unsigned short bf16;
typedef unsigned v4u __attribute__((ext_vector_type(4)));
typedef unsigned v2u __attribute__((ext_vector_type(2)));
typedef float f32x4 __attribute__((ext_vector_type(4)));
typedef float f32x2 __attribute__((ext_vector_type(2)));

constexpr int D = 1024, NB = 8, SEQ = 4096, CTX = 256, DEPTH = 4, DFF = 2816;
constexpr int MLAT = NB * SEQ, MCTX = NB * CTX, MTOT = MLAT + MCTX;
constexpr int INC = 2944, INCP = 3072;
constexpr int RW = 384, LW = 384, RC = 1408;
constexpr int QLEN = CTX + SEQ;
constexpr int PC_BG = 0, PC_CG = 256, PC_XIN = 512, PC_RW = 768, PC_XR = 2176, PC_GR = 2560;
constexpr int PC_Y = 768;
constexpr int PC_G = 1536;
constexpr int LORA_N = 2048, LORA_K = 256;
constexpr int NWAVES = 8, NTHR = 512;
constexpr int LDS_BYTES = 147456;

constexpr size_t MiB = 1u << 20;
constexpr size_t WS_BAR = 1536 * 1024, WS_BAR_BYTES = 16384;
constexpr size_t WS_MODS = 0, WS_XRCTX = 2 * MiB, WS_WT = 10 * MiB, WS_H = 52 * MiB, WS_A = 120 * MiB, WS_B = 324 * MiB;
constexpr size_t SC_ELEMS = (size_t)NB * QLEN * RW;
constexpr size_t WS_END = WS_B + 9 * SC_ELEMS * 2 + (size_t)NB * QLEN * 128 * 2;
static_assert(WS_END <= 600 * MiB, "workspace map");
static_assert(WS_A + (size_t)MTOT * INCP * 2 <= WS_B, "P fits");
constexpr size_t WT_GU1 = 0, WT_DOWN1 = WT_GU1 + (size_t)2 * DFF * D, WT_IN = WT_DOWN1 + (size_t)D * DFF, WT_OUT = WT_IN + (size_t)INCP * D,
                 WT_GU2 = WT_OUT + (size_t)D * D, WT_DOWN2 = WT_GU2 + (size_t)2 * DFF * D, WT_TOTAL = WT_DOWN2 + (size_t)D * DFF;
constexpr size_t WT_LORA = WT_TOTAL;
static_assert(WS_WT + (WT_TOTAL + (size_t)LORA_N * LORA_K) * 2 <= WS_H, "weights fit");
constexpr size_t HB_AP = 0, HB_KT = (size_t)MTOT * LORA_K * 2;
static_assert(HB_KT + (size_t)MTOT * RW * 2 <= WS_A - WS_H, "H region overlay");

enum { I_X = 0, I_C, I_CTX, I_CCTX, I_WMOD, I_BMOD, I_GFFN1, I_WGU1, I_WDOWN1, I_GMIX, I_WIN, I_CONVA, I_MU, I_W0, I_W2, I_A0, I_A2, I_G2, I_KK, I_KA, I_RK,
       I_LNG, I_LNB, I_LCW, I_LCB, I_LWR, I_LBR, I_LWI, I_LBI, I_LAM, I_WOUT, I_GFFN2, I_WGU2, I_WDOWN2, I_GFINAL, N_IN };

struct Args { const float* in[N_IN]; float* out; unsigned char* ws; int ph_lo, ph_hi; };
typedef const __attribute__((address_space(4))) Args* CArgsP;

__device__ __forceinline__ float bf2f(unsigned h) { return __builtin_bit_cast(float, h << 16); }
__device__ __forceinline__ unsigned f2bf(float f) { unsigned u = __builtin_bit_cast(unsigned, f); return (u + 0x7fffu + ((u >> 16) & 1u)) >> 16; }
__device__ __forceinline__ unsigned pk2(float lo, float hi) { unsigned r; asm("v_cvt_pk_bf16_f32 %0, %1, %2" : "=v"(r) : "v"(lo), "v"(hi)); return r; }
__device__ __forceinline__ void unpack8(v4u p, float* o) {
    o[0] = __builtin_bit_cast(float, p.x << 16); o[1] = __builtin_bit_cast(float, p.x & 0xffff0000u);
    o[2] = __builtin_bit_cast(float, p.y << 16); o[3] = __builtin_bit_cast(float, p.y & 0xffff0000u);
    o[4] = __builtin_bit_cast(float, p.z << 16); o[5] = __builtin_bit_cast(float, p.z & 0xffff0000u);
    o[6] = __builtin_bit_cast(float, p.w << 16); o[7] = __builtin_bit_cast(float, p.w & 0xffff0000u);
}
__device__ __forceinline__ v4u pack8(const float* v) { v4u o; o.x = pk2(v[0], v[1]); o.y = pk2(v[2], v[3]); o.z = pk2(v[4], v[5]); o.w = pk2(v[6], v[7]); return o; }
template <int CTRL> __device__ __forceinline__ float dppf(float v) { return __builtin_bit_cast(float, __builtin_amdgcn_update_dpp(0, __builtin_bit_cast(int, v), CTRL, 0xF, 0xF, true)); }
__device__ __forceinline__ float wave_sum(float v) {
    v += dppf<0xB1>(v); v += dppf<0x4E>(v); v += dppf<0x141>(v); v += dppf<0x140>(v);
    const float a = __builtin_bit_cast(float, __builtin_amdgcn_readlane(__builtin_bit_cast(int, v), 0)), b = __builtin_bit_cast(float, __builtin_amdgcn_readlane(__builtin_bit_cast(int, v), 16));
    const float c = __builtin_bit_cast(float, __builtin_amdgcn_readlane(__builtin_bit_cast(int, v), 32)), d = __builtin_bit_cast(float, __builtin_amdgcn_readlane(__builtin_bit_cast(int, v), 48));
    return (a + b) + (c + d);
}
__device__ __forceinline__ float sigmoidf_(float x) { return __builtin_amdgcn_rcpf(1.0f + __expf(-x)); }
__device__ __forceinline__ float siluf_(float x) { return x * __builtin_amdgcn_rcpf(1.0f + __expf(-x)); }
__device__ __forceinline__ float softplusf_(float z) { return fmaxf(z, 0.f) + log1pf(__expf(-fabsf(z))); }
__device__ __forceinline__ float tanh_fast(float x) { const float e = __expf(2.0f * fminf(fmaxf(x, -15.f), 15.f)); return 1.0f - 2.0f * __builtin_amdgcn_rcpf(e + 1.0f); }
__device__ __forceinline__ float gelu_tanh(float x) { const float u = 0.7978845608028654f * (x + 0.044715f * x * x * x); return 0.5f * x * (1.0f + tanh_fast(u)); }
__device__ __forceinline__ float reduce16(float x) { x += dppf<0xB1>(x); x += dppf<0x4E>(x); x += dppf<0x141>(x); x += dppf<0x140>(x); return x; }
__device__ __forceinline__ float reduce8(float x) { x += dppf<0xB1>(x); x += dppf<0x4E>(x); x += dppf<0x141>(x); return x; }
__device__ __forceinline__ int row_of(int b, int q, int odd) {
    if (q < CTX) return MLAT + b * CTX + q;
    const int s = q - CTX; const int t = odd ? (((s & 63) << 6) | (s >> 6)) : s;
    return b * SEQ + t;
}

struct EpiSwiGLU {
    static constexpr bool PERM = true, AFTER_DRAIN = false;
    bf16* O;
    __device__ __forceinline__ void operator()(const pg8::f32x4 (&acc)[2][2][4][2], const pg8::Unit& u, int wr, int wc, int fr, int fq) const {
        const int row0 = u.pm * 256 + wr * 64 + fr, col0 = u.pn * 128 + wc * 32 + 8 * fq;
#pragma unroll
        for (int ai = 0; ai < 2; ++ai)
#pragma unroll
            for (int m = 0; m < 4; ++m) {
                float o[8];
#pragma unroll
                for (int n = 0; n < 2; ++n)
#pragma unroll
                    for (int j = 0; j < 4; ++j) { const float g = acc[ai][0][m][n][j], up = acc[ai][1][m][n][j]; o[n * 4 + j] = siluf_(g) * up; }
                *(v4u*)(O + (size_t)(row0 + ai * 128 + m * 16) * DFF + col0) = pack8(o);
            }
    }
};
struct EpiP {
    static constexpr bool PERM = true, AFTER_DRAIN = false;
    bf16* O; int ldc;
    __device__ __forceinline__ void operator()(const pg8::f32x4 (&acc)[2][2][4][2], const pg8::Unit& u, int wr, int wc, int fr, int fq) const {
        const int row0 = u.pm * 256 + wr * 64 + fr, col0 = u.pn * 256 + wc * 32 + 8 * fq;
#pragma unroll
        for (int ai = 0; ai < 2; ++ai)
#pragma unroll
            for (int m = 0; m < 4; ++m)
#pragma unroll
                for (int bj = 0; bj < 2; ++bj) {
                    float o[8];
#pragma unroll
                    for (int n = 0; n < 2; ++n)
#pragma unroll
                        for (int j = 0; j < 4; ++j) o[n * 4 + j] = acc[ai][bj][m][n][j];
                    *(v4u*)(O + (size_t)(row0 + ai * 128 + m * 16) * ldc + col0 + bj * 128) = pack8(o);
                }
    }
};
struct EpiResid {
    static constexpr bool PERM = true, AFTER_DRAIN = false;
    const float* res_lat; const float* res_ctx; float* dst_lat; float* dst_ctx; const float* gate; float coef;
    __device__ __forceinline__ void operator()(const pg8::f32x4 (&acc)[2][2][4][2], const pg8::Unit& u, int wr, int wc, int fr, int fq) const {
        const int rowbase = u.pm * 256; const bool isctx = rowbase >= MLAT;
        const int b = isctx ? 8 : (rowbase >> 12);
        const float* res = isctx ? res_ctx + (size_t)(rowbase - MLAT) * D : res_lat + (size_t)rowbase * D;
        float* dst = isctx ? dst_ctx + (size_t)(rowbase - MLAT) * D : dst_lat + (size_t)rowbase * D;
#pragma unroll
        for (int bj = 0; bj < 2; ++bj) {
            const int col = u.pn * 256 + bj * 128 + wc * 32 + 8 * fq;
            const f32x4 g0 = *(const f32x4*)(gate + (size_t)b * 9216 + col) * coef, g1 = *(const f32x4*)(gate + (size_t)b * 9216 + col + 4) * coef;
#pragma unroll
            for (int ai = 0; ai < 2; ++ai)
#pragma unroll
                for (int m = 0; m < 4; ++m) {
                    const size_t off = (size_t)(ai * 128 + wr * 64 + m * 16 + fr) * D + col;
                    const f32x4 r0 = *(const f32x4*)(res + off), r1 = *(const f32x4*)(res + off + 4);
                    *(f32x4*)(dst + off) = r0 + g0 * acc[ai][bj][m][0];
                    *(f32x4*)(dst + off + 4) = r1 + g1 * acc[ai][bj][m][1];
                }
        }
    }
};

struct EpiLora {
    static constexpr bool PERM = true, AFTER_DRAIN = false;
    const float* w0; const float* a0; const float* ka; const bf16* kt; const bf16* kk; bf16* scb; bf16* P; int odd;
    __device__ __forceinline__ void operator()(const pg8::f32x4 (&acc)[2][2][4][2], const pg8::Unit& u, int wr, int wc, int fr, int fq) const {
        asm volatile("" : "+v"(fr), "+v"(fq));
#pragma unroll
        for (int bj = 0; bj < 2; ++bj) {
            const int half = __builtin_amdgcn_readfirstlane(u.pn * 2 + bj), kind = half / 3, c = (half - kind * 3) * 128 + wc * 32 + 8 * fq;
            if (kind >= 5) continue;
#pragma unroll
            for (int ai = 0; ai < 2; ++ai)
#pragma unroll
                for (int m = 0; m < 4; ++m) {
                    const int pos = u.pm * 256 + ai * 128 + wr * 64 + m * 16 + fr;
                    float v[8];
#pragma unroll
                    for (int n = 0; n < 2; ++n)
#pragma unroll
                        for (int j = 0; j < 4; ++j) v[n * 4 + j] = acc[ai][bj][m][n][j];
                    if (kind < 2) {
                        const f32x4 q0 = *(const f32x4*)(w0 + kind * 384 + c), q1 = *(const f32x4*)(w0 + kind * 384 + c + 4);
                        const float p0[8] = {q0.x, q0.y, q0.z, q0.w, q1.x, q1.y, q1.z, q1.w};
#pragma unroll
                        for (int e = 0; e < 8; ++e) { const float wl = p0[e] + v[e];
                            v[e] = 1.0f - __expf(-0.6065306597126334f * sigmoidf_(wl)); }
                        *(v4u*)(scb + (size_t)(7 + kind) * SC_ELEMS + (size_t)pos * RW + c) = pack8(v);
                    } else if (kind < 4) {
                        const f32x4 q0 = *(const f32x4*)(a0 + (kind - 2) * 384 + c), q1 = *(const f32x4*)(a0 + (kind - 2) * 384 + c + 4);
                        const float p0[8] = {q0.x, q0.y, q0.z, q0.w, q1.x, q1.y, q1.z, q1.w};
#pragma unroll
                        for (int e = 0; e < 8; ++e) v[e] = sigmoidf_(p0[e] + v[e]);
                        {   float kkv[8]; unpack8(*(const v4u*)(kk + (size_t)pos * RW + c), kkv);
#pragma unroll
                            for (int e = 0; e < 8; ++e) kkv[e] *= v[e];
                            *(v4u*)(scb + (size_t)(5 + kind - 2) * SC_ELEMS + (size_t)pos * RW + c) = pack8(kkv); }
                        {   float kv[8]; unpack8(*(const v4u*)(kt + (size_t)pos * RW + c), kv);
                            const f32x4 r0 = *(const f32x4*)(ka + c), r1 = *(const f32x4*)(ka + c + 4);
                            const float p1[8] = {r0.x, r0.y, r0.z, r0.w, r1.x, r1.y, r1.z, r1.w};
#pragma unroll
                            for (int e = 0; e < 8; ++e) kv[e] *= (1.0f + (v[e] - 1.0f) * p1[e]);
                            *(v4u*)(scb + (size_t)(3 + kind - 2) * SC_ELEMS + (size_t)pos * RW + c) = pack8(kv); }
                    } else {
                        const int b = pos / QLEN, q = pos - b * QLEN;
                        *(v4u*)(P + (size_t)row_of(b, q, odd) * INCP + PC_G + c) = pack8(v);
                    }
                    asm volatile("" ::: "memory");
                }
        }
    }
};
struct WS {
    float* mods; float* xrctx; bf16* wt; bf16* H; bf16* P; bf16* ACT;
    bf16 *scb, *sc_r, *sc_v, *sc_kk, *dgs;
};
__device__ __forceinline__ WS make_ws(unsigned char* ws) {
    WS w; w.mods = (float*)(ws + WS_MODS); w.xrctx = (float*)(ws + WS_XRCTX); w.wt = (bf16*)(ws + WS_WT); w.H = (bf16*)(ws + WS_H); w.P = (bf16*)(ws + WS_A); w.ACT = (bf16*)(ws + WS_A);
    bf16* b = (bf16*)(ws + WS_B);
    w.scb = b; w.sc_r = b; w.sc_v = b + SC_ELEMS; w.sc_kk = b + 2 * SC_ELEMS; w.dgs = b + 9 * SC_ELEMS;
    return w;
}

__device__ __forceinline__ void mods_phase(const int bx, const int G, CArgsP A, const WS& W, LAS unsigned char* lds, int tid, int lane, int wave) {
    LAS float* sl = (LAS float*)lds;
    LAS float* part = sl + 9 * 1024;
    const float* c = A->in[I_C]; const float* cctx = A->in[I_CCTX];
    for (int i = tid; i < 9216; i += NTHR) { const int r = i >> 10, k = i & 1023; const float v = r < 8 ? c[r * 1024 + k] : cctx[k]; sl[i] = siluf_(v); }
    __syncthreads();
    for (int item = bx; item < 288; item += G) {
        const int l = item / 72, cgp = item % 72;
        const float* Wp = A->in[I_WMOD] + (size_t)l * 1024 * 9216 + cgp * 128 + lane * 2;
        float acc[9][2];
#pragma unroll
        for (int r = 0; r < 9; ++r) { acc[r][0] = 0.f; acc[r][1] = 0.f; }
#pragma unroll 8
        for (int kk = 0; kk < 128; ++kk) {
            const int k = wave * 128 + kk;
            const f32x2 w = *(const f32x2*)(Wp + (size_t)k * 9216);
#pragma unroll
            for (int r = 0; r < 9; ++r) { const float s = sl[r * 1024 + k]; acc[r][0] += s * w.x; acc[r][1] += s * w.y; }
        }
#pragma unroll
        for (int r = 0; r < 9; ++r) { part[(wave * 9 + r) * 128 + lane * 2] = acc[r][0]; part[(wave * 9 + r) * 128 + lane * 2 + 1] = acc[r][1]; }
        __syncthreads();
        for (int o = tid; o < 1152; o += NTHR) {
            const int r = o >> 7, cc = o & 127; float s = A->in[I_BMOD][l * 9216 + cgp * 128 + cc];
#pragma unroll
            for (int w8 = 0; w8 < 8; ++w8) s += part[(w8 * 9 + r) * 128 + cc];
            W.mods[(size_t)(l * 9 + r) * 9216 + cgp * 128 + cc] = s;
        }
        __syncthreads();
    }
}

__device__ __forceinline__ void transpose_item(const float* Wsrc, int K, int N, bf16* WT, int kb, int n0, int drow0, LAS float* scr, int lane) {
    const int k0 = 64 * kb;
    float tv[32];
#pragma unroll
    for (int i = 0; i < 32; ++i) tv[i] = Wsrc[(size_t)(k0 + 2 * i + (lane >> 5)) * N + n0 + (lane & 31)];
#pragma unroll
    for (int i = 0; i < 32; ++i) scr[(2 * i + (lane >> 5)) * 33 + (lane & 31)] = tv[i];
    asm volatile("s_waitcnt lgkmcnt(0)" ::: "memory");
    const int c = lane & 7;
#pragma unroll
    for (int j = 0; j < 4; ++j) { const int n = (lane >> 3) + 8 * j; const LAS float* s = scr + (8 * c) * 33 + n;
        v4u o; o.x = pk2(s[0 * 33], s[1 * 33]); o.y = pk2(s[2 * 33], s[3 * 33]); o.z = pk2(s[4 * 33], s[5 * 33]); o.w = pk2(s[6 * 33], s[7 * 33]);
        *(v4u*)(WT + (size_t)(drow0 + n) * K + k0 + 8 * c) = o; }
    asm volatile("s_waitcnt lgkmcnt(0)" ::: "memory");
}
__device__ __forceinline__ int gu_drow(int n0) { return n0 < DFF ? 256 * (n0 >> 7) + (n0 & 127) : 256 * ((n0 - DFF) >> 7) + 128 + ((n0 - DFF) & 127); }
__device__ __forceinline__ void convert_phase(const int bx, const int G, CArgsP A, const WS& W, int l, LAS unsigned char* lds, int lane, int wave) {
    LAS float* scr = (LAS float*)(lds + wave * 16384);
    const int gw = bx * NWAVES + wave, NGW = G * NWAVES;
    constexpr int I_GU = (D / 64) * (2 * DFF / 32), I_DN = (DFF / 64) * (D / 32), I_IN = (D / 64) * (INC / 32), I_OUT = (D / 64) * (D / 32);
    constexpr int NITEMS = 2 * I_GU + 2 * I_DN + I_IN + I_OUT;
    for (int it = gw; it < NITEMS; it += NGW) {
        int r = it;
        if (r < I_GU) { const int nblk = 2 * DFF / 32, kb = r / nblk, n0 = (r % nblk) * 32; transpose_item(A->in[I_WGU1] + (size_t)l * D * 2 * DFF, D, 2 * DFF, W.wt + WT_GU1, kb, n0, gu_drow(n0), scr, lane); continue; } r -= I_GU;
        if (r < I_GU) { const int nblk = 2 * DFF / 32, kb = r / nblk, n0 = (r % nblk) * 32; transpose_item(A->in[I_WGU2] + (size_t)l * D * 2 * DFF, D, 2 * DFF, W.wt + WT_GU2, kb, n0, gu_drow(n0), scr, lane); continue; } r -= I_GU;
        if (r < I_DN) { const int nblk = D / 32, kb = r / nblk, n0 = (r % nblk) * 32; transpose_item(A->in[I_WDOWN1] + (size_t)l * DFF * D, DFF, D, W.wt + WT_DOWN1, kb, n0, n0, scr, lane); continue; } r -= I_DN;
        if (r < I_DN) { const int nblk = D / 32, kb = r / nblk, n0 = (r % nblk) * 32; transpose_item(A->in[I_WDOWN2] + (size_t)l * DFF * D, DFF, D, W.wt + WT_DOWN2, kb, n0, n0, scr, lane); continue; } r -= I_DN;
        if (r < I_IN) { const int nblk = INC / 32, kb = r / nblk, n0 = (r % nblk) * 32; transpose_item(A->in[I_WIN] + (size_t)l * D * INC, D, INC, W.wt + WT_IN, kb, n0, n0, scr, lane); continue; } r -= I_IN;
        { const int nblk = D / 32, kb = r / nblk, n0 = (r % nblk) * 32; transpose_item(A->in[I_WOUT] + (size_t)l * D * D, D, D, W.wt + WT_OUT, kb, n0, n0, scr, lane); }
    }
    for (int idx = (bx * NWAVES + wave) * 64 + lane; idx < LORA_N * LORA_K; idx += G * NTHR) {
        const int n = idx % LORA_N, k = idx / LORA_N, kind = n / 384, c = n - kind * 384;
        float v = 0.f;
        if (kind < 2) { if (k < 64) v = A->in[I_W2][((size_t)(l * 2 + kind) * 64 + k) * RW + c]; }
        else if (kind < 4) { if (k >= 64 && k < 128) v = A->in[I_A2][((size_t)(l * 2 + kind - 2) * 64 + (k - 64)) * RW + c]; }
        else if (kind == 4) { if (k >= 128) v = A->in[I_G2][((size_t)l * 128 + (k - 128)) * RW + c]; }
        W.wt[WT_LORA + (size_t)n * LORA_K + k] = (bf16)f2bf(v);
    }
}

__device__ __forceinline__ void norm_phase(const int bx, const int G, const float* lat, const float* ctxp, const float* g, const float* mods_l, int ishift, int iscale, bf16* H, int nrows, int lane, int wave) {
    const int gw = bx * NWAVES + wave, NGW = G * NWAVES;
    for (int r0 = gw; r0 < nrows; r0 += 2 * NGW) {
        const int r1 = r0 + NGW < nrows ? r0 + NGW : r0;
        const float* xa = r0 < MLAT ? lat + (size_t)r0 * D : ctxp + (size_t)(r0 - MLAT) * D;
        const float* xb = r1 < MLAT ? lat + (size_t)r1 * D : ctxp + (size_t)(r1 - MLAT) * D;
        f32x4 va[4], vb[4]; float sa = 0.f, sb = 0.f;
#pragma unroll
        for (int j = 0; j < 4; ++j) { va[j] = *(const f32x4*)(xa + (lane + 64 * j) * 4); vb[j] = *(const f32x4*)(xb + (lane + 64 * j) * 4); }
#pragma unroll
        for (int j = 0; j < 4; ++j) { sa += (va[j].x * va[j].x + va[j].y * va[j].y) + (va[j].z * va[j].z + va[j].w * va[j].w); sb += (vb[j].x * vb[j].x + vb[j].y * vb[j].y) + (vb[j].z * vb[j].z + vb[j].w * vb[j].w); }
        sa = wave_sum(sa); sb = wave_sum(sb);
        const float rsa = rsqrtf(sa * (1.0f / D) + 1e-6f), rsb = rsqrtf(sb * (1.0f / D) + 1e-6f);
        const int ba = r0 < MLAT ? (r0 >> 12) : 8, bb = r1 < MLAT ? (r1 >> 12) : 8;
        const float* sha = mods_l + (size_t)ba * 9216 + ishift * 1024; const float* sca = mods_l + (size_t)ba * 9216 + iscale * 1024;
        const float* shb = mods_l + (size_t)bb * 9216 + ishift * 1024; const float* scb2 = mods_l + (size_t)bb * 9216 + iscale * 1024;
#pragma unroll
        for (int j = 0; j < 4; ++j) {
            const int col = (lane + 64 * j) * 4;
            const f32x4 gg = *(const f32x4*)(g + col);
            { const f32x4 s4 = *(const f32x4*)(sha + col), c4 = *(const f32x4*)(sca + col); const f32x4 h = (va[j] * rsa) * gg * (c4 + 1.0f) + s4;
              v2u o; o.x = pk2(h.x, h.y); o.y = pk2(h.z, h.w); *(v2u*)(H + (size_t)r0 * D + col) = o; }
            if (r1 != r0) { const f32x4 s4 = *(const f32x4*)(shb + col), c4 = *(const f32x4*)(scb2 + col); const f32x4 h = (vb[j] * rsb) * gg * (c4 + 1.0f) + s4;
              v2u o; o.x = pk2(h.x, h.y); o.y = pk2(h.z, h.w); *(v2u*)(H + (size_t)r1 * D + col) = o; }
        }
    }
}
__device__ __forceinline__ void final_norm_phase(const int bx, const int G, float* xo, const float* g, int lane, int wave) {
    const int gw = bx * NWAVES + wave, NGW = G * NWAVES;
    for (int r0 = gw; r0 < MLAT; r0 += 2 * NGW) {
        const int r1 = r0 + NGW < MLAT ? r0 + NGW : r0;
        float* xa = xo + (size_t)r0 * D; float* xb = xo + (size_t)r1 * D;
        f32x4 va[4], vb[4]; float sa = 0.f, sb = 0.f;
#pragma unroll
        for (int j = 0; j < 4; ++j) { va[j] = *(const f32x4*)(xa + (lane + 64 * j) * 4); vb[j] = *(const f32x4*)(xb + (lane + 64 * j) * 4); }
#pragma unroll
        for (int j = 0; j < 4; ++j) { sa += (va[j].x * va[j].x + va[j].y * va[j].y) + (va[j].z * va[j].z + va[j].w * va[j].w); sb += (vb[j].x * vb[j].x + vb[j].y * vb[j].y) + (vb[j].z * vb[j].z + vb[j].w * vb[j].w); }
        sa = wave_sum(sa); sb = wave_sum(sb);
        const float rsa = rsqrtf(sa * (1.0f / D) + 1e-6f), rsb = rsqrtf(sb * (1.0f / D) + 1e-6f);
#pragma unroll
        for (int j = 0; j < 4; ++j) { const int col = (lane + 64 * j) * 4; const f32x4 gg = *(const f32x4*)(g + col);
            *(f32x4*)(xa + col) = (va[j] * rsa) * gg; if (r1 != r0) *(f32x4*)(xb + col) = (vb[j] * rsb) * gg; }
    }
}

__device__ __forceinline__ void pre_item(int it, int& i, int& col) {
    if (it < 2304) { const int seg = it / 768, r = it - seg * 768; i = r / 48; col = seg * 384 + (r % 48) * 8; }
    else if (it < 2560) { const int r = it - 2304; i = (r & 127) >> 3; col = 1152 + (r >> 7) * 64 + (r & 7) * 8; }
    else { const int r = it - 2560; i = r >> 4; col = 1280 + (r & 15) * 8; }
}
__device__ __forceinline__ void pre_phase(const int bx, const int G, CArgsP A, const WS& W, int l, LAS unsigned char* lds, int tid, int lane, int wave) {
    LAS float* k_s = (LAS float*)lds;
    const int odd = l & 1;
    const float* mu0 = A->in[I_MU] + (size_t)l * 2 * RC; const float* mu1 = mu0 + RC;
    const float* kkp = A->in[I_KK] + l * RW;
    bf16* AP = (bf16*)((unsigned char*)W.H + HB_AP); bf16* KT = (bf16*)((unsigned char*)W.H + HB_KT);
    for (int tile = bx; tile < NB * (QLEN / 16); tile += G) {
        const int b = tile / (QLEN / 16), q0 = (tile % (QLEN / 16)) * 16;
        const int seq_lo = q0 < CTX ? 0 : CTX, seq_hi = q0 < CTX ? CTX : QLEN;
        for (int pass = 0; pass < 2; ++pass) {
            v4u rc[3], rp[3], rn[3];
#pragma unroll
            for (int u = 0; u < 3; ++u) { const int it0 = tid + NTHR * (pass * 3 + u), it = it0 < 16 * 176 ? it0 : 16 * 176 - 1;
                int i, col; pre_item(it, i, col); const int q = q0 + i;
                const int qp = q - 1 >= seq_lo ? q - 1 : q, qn = q + 1 < seq_hi ? q + 1 : q;
                rc[u] = *(const v4u*)(W.P + (size_t)row_of(b, q, odd) * INCP + PC_RW + col);
                rp[u] = *(const v4u*)(W.P + (size_t)row_of(b, qp, odd) * INCP + PC_RW + col);
                rn[u] = *(const v4u*)(W.P + (size_t)row_of(b, qn, odd) * INCP + PC_RW + col); }
#pragma unroll
            for (int u = 0; u < 3; ++u) { const int it0 = tid + NTHR * (pass * 3 + u);
                if (it0 < 16 * 176) {
                    int i, col; pre_item(it0, i, col); const int q = q0 + i;
                    const size_t pos = (size_t)b * QLEN + q;
                    float cur[8], prv[8], nxt[8], ps[8];
                    unpack8(rc[u], cur); unpack8(rp[u], prv); unpack8(rn[u], nxt);
                    const float mp = q - 1 >= seq_lo ? 1.f : 0.f, mn = q + 1 < seq_hi ? 1.f : 0.f;
#pragma unroll
                    for (int e = 0; e < 8; ++e) ps[e] = cur[e] + mu0[col + e] * (prv[e] * mp - cur[e]) + mu1[col + e] * (nxt[e] * mn - cur[e]);
                    if (col < 384) *(v4u*)(W.sc_r + pos * RW + col) = pack8(ps);
                    else if (col < 768) {
#pragma unroll
                        for (int e = 0; e < 8; ++e) k_s[i * 384 + col - 384 + e] = ps[e];
                        *(v4u*)(KT + pos * RW + (col - 384)) = pack8(ps); }
                    else if (col < 1152) *(v4u*)(W.sc_v + pos * RW + (col - 768)) = pack8(ps);
                    else if (col < 1216) {
#pragma unroll
                        for (int e = 0; e < 8; ++e) ps[e] = tanh_fast(ps[e]);
                        *(v4u*)(AP + pos * LORA_K + (col - 1152)) = pack8(ps); }
                    else if (col < 1280) *(v4u*)(AP + pos * LORA_K + 64 + (col - 1216)) = pack8(ps);
                    else {
#pragma unroll
                        for (int e = 0; e < 8; ++e) ps[e] = sigmoidf_(ps[e]);
                        *(v4u*)(AP + pos * LORA_K + 128 + (col - 1280)) = pack8(ps); }
                }
            }
        }
        __syncthreads();
        for (int it = wave * 8 + (lane >> 3); it < 96; it += 64) {
            const int i = it / 6, h = it % 6, c = h * 64 + (lane & 7) * 8;
            float kv[8]; float ss = 0.f;
#pragma unroll
            for (int e = 0; e < 8; ++e) { kv[e] = k_s[i * 384 + c + e] * kkp[c + e]; ss += kv[e] * kv[e]; }
            const float rn = rsqrtf(reduce8(ss) + 1e-12f);
#pragma unroll
            for (int e = 0; e < 8; ++e) kv[e] *= rn;
            *(v4u*)(W.sc_kk + ((size_t)b * QLEN + q0 + i) * RW + c) = pack8(kv);
        }
        __syncthreads();
    }
}

__device__ __forceinline__ int q_of_step(int n, int d) { return d == 0 ? n : (n < CTX ? CTX - 1 - n : QLEN + CTX - 1 - n); }
constexpr int RCH = 32, RNCH = QLEN / RCH;
__device__ __forceinline__ void rwkv_scan_phase(const WS& W, int l, int blk, LAS unsigned char* lds, int tid, int lane, int wave) {
    const int item = blk >> 1, half = blk & 1;
    const int b = item / 12, rem = item % 12, h = rem >> 1, d = rem & 1, odd = l & 1;
    LAS float* buf = (LAS float*)lds;
    LAS float* ybuf = buf + 2 * RCH * 384;
    const bf16* s_omw = W.scb + (size_t)(7 + d) * SC_ELEMS; const bf16* s_b = W.scb + (size_t)(5 + d) * SC_ELEMS; const bf16* s_kd = W.scb + (size_t)(3 + d) * SC_ELEMS;
    const int rg = lane >> 4, j = lane & 15, rlA = (wave & 3) * 8 + rg, rlB = rlA + 4, rowA = half * 32 + rlA, rowB = half * 32 + rlB;
    v4u pre[3];
#define RW_LOAD(c) do { _Pragma("unroll") for (int jj = 0; jj < 3; ++jj) { const int p = tid + NTHR * jj, i = p / 48, r48 = p % 48, vec = r48 >> 3, part = r48 & 7; \
        const int q = q_of_step((c) * RCH + i, d); const size_t pos = (size_t)b * QLEN + q; \
        const bf16* base = vec == 0 ? s_omw : vec == 1 ? s_b : vec == 2 ? s_kd : vec == 3 ? W.sc_kk : vec == 4 ? W.sc_r : W.sc_v; \
        pre[jj] = *(const v4u*)(base + pos * RW + h * 64 + part * 8); } } while (0)
#define RW_STORE(c) do { _Pragma("unroll") for (int jj = 0; jj < 3; ++jj) { const int p = tid + NTHR * jj, i = p / 48, r48 = p % 48, vec = r48 >> 3, part = r48 & 7; \
        float f[8]; unpack8(pre[jj], f); if (vec == 0) { _Pragma("unroll") for (int e = 0; e < 8; ++e) f[e] = 1.0f - f[e]; } \
        LAS float* dst = buf + (((c) & 1) * RCH + i) * 384 + vec * 64 + part * 8; \
        *(LAS f32x4*)dst = (f32x4){f[0], f[1], f[2], f[3]}; *(LAS f32x4*)(dst + 4) = (f32x4){f[4], f[5], f[6], f[7]}; } } while (0)
    f32x2 SA0 = (f32x2){0.f, 0.f}, SA1 = SA0, SB0 = SA0, SB1 = SA0;
    RW_LOAD(0); RW_STORE(0);
    __syncthreads();
    for (int c = 0; c < RNCH; ++c) {
        if (c + 1 < RNCH) RW_LOAD(c + 1);
        const LAS float* cur = buf + (c & 1) * RCH * 384;
        if (wave < 4) {
        float ykA, ykB;
#define RW_LD(X, i_) do { const int ii_ = (i_) < RCH ? (i_) : RCH - 1; const LAS f32x4* bp_ = (const LAS f32x4*)(cur + ii_ * 384 + j * 4); \
        X##w = bp_[0]; X##b = bp_[16]; X##d = bp_[32]; X##k = bp_[48]; X##r = bp_[64]; X##va = cur[ii_ * 384 + 320 + rowA]; X##vb = cur[ii_ * 384 + 320 + rowB]; } while (0)
#define RW_CP(X, s_) do { \
        const f32x2 k0_ = (f32x2){X##k.x, X##k.y}, k1_ = (f32x2){X##k.z, X##k.w}; \
        const f32x2 ta_ = SA0 * k0_ + SA1 * k1_, tb_ = SB0 * k0_ + SB1 * k1_; \
        const float saA_ = -reduce16(ta_.x + ta_.y), saB_ = -reduce16(tb_.x + tb_.y); \
        const f32x2 w0_ = (f32x2){X##w.x, X##w.y}, w1_ = (f32x2){X##w.z, X##w.w}, b0_ = (f32x2){X##b.x, X##b.y}, b1_ = (f32x2){X##b.z, X##b.w}, d0_ = (f32x2){X##d.x, X##d.y}, d1_ = (f32x2){X##d.z, X##d.w}; \
        const f32x2 va2_ = (f32x2){X##va, X##va}, vb2_ = (f32x2){X##vb, X##vb}, sa2_ = (f32x2){saA_, saA_}, sb2_ = (f32x2){saB_, saB_}; \
        SA0 = SA0 * w0_ + va2_ * d0_ + sa2_ * b0_; SA1 = SA1 * w1_ + va2_ * d1_ + sa2_ * b1_; \
        SB0 = SB0 * w0_ + vb2_ * d0_ + sb2_ * b0_; SB1 = SB1 * w1_ + vb2_ * d1_ + sb2_ * b1_; \
        const f32x2 r0_ = (f32x2){X##r.x, X##r.y}, r1_ = (f32x2){X##r.z, X##r.w}; \
        const f32x2 ya_ = SA0 * r0_ + SA1 * r1_, yb_ = SB0 * r0_ + SB1 * r1_; \
        const float yA_ = reduce16(ya_.x + ya_.y), yB_ = reduce16(yb_.x + yb_.y); \
        ykA = ((s_) == j) ? yA_ : ykA; ykB = ((s_) == j) ? yB_ : ykB; } while (0)
        f32x4 Aw, Ab, Ad, Ak, Ar, Bw, Bb, Bd, Bk, Br; float Ava, Avb, Bva, Bvb;
        RW_LD(A, 0);
#pragma unroll 1
        for (int g = 0; g < 2; ++g) {
            ykA = 0.f; ykB = 0.f;
#pragma unroll
            for (int s2 = 0; s2 < 16; s2 += 2) {
                const int i = g * 16 + s2;
                RW_LD(B, i + 1);
                __builtin_amdgcn_sched_barrier(0);
                RW_CP(A, s2);
                __builtin_amdgcn_sched_barrier(0);
                RW_LD(A, i + 2);
                __builtin_amdgcn_sched_barrier(0);
                RW_CP(B, s2 + 1);
                __builtin_amdgcn_sched_barrier(0);
            }
            ybuf[(g * 16 + j) * 32 + rlA] = ykA; ybuf[(g * 16 + j) * 32 + rlB] = ykB;
        }
#undef RW_LD
#undef RW_CP
        }
        __syncthreads();
        if (tid < 256) {
            const int i = tid >> 3, r4 = (tid & 7) * 4;
            const int q = q_of_step(c * RCH + i, d);
            const f32x4 yv = *(const LAS f32x4*)(ybuf + i * 32 + r4);
            v2u o; o.x = pk2(yv.x, yv.y); o.y = pk2(yv.z, yv.w);
            *(v2u*)(W.P + (size_t)row_of(b, q, odd) * INCP + PC_Y + d * RW + h * 64 + half * 32 + r4) = o;
        }
        if (c + 1 < RNCH) RW_STORE(c + 1);
        __syncthreads();
    }
#undef RW_LOAD
#undef RW_STORE
}

__device__ __forceinline__ void lru_scan_phase(CArgsP A, const WS& W, int l, int idx, LAS unsigned char* lds, int tid, int lane, int wave) {
    const int b = idx / 6, n = idx % 6, odd = l & 1;
    LAS float* gs = (LAS float*)lds;
    LAS float* xs = gs;
    LAS float* us = gs + 4 * 4096;
    LAS bf16* ub = (LAS bf16*)(us + 2 * 4096);
    const int c = tid & 63;
    float cw[2][4], cb[2], sp[2];
#pragma unroll
    for (int dd = 0; dd < 2; ++dd) {
#pragma unroll
        for (int jj = 0; jj < 4; ++jj) cw[dd][jj] = A->in[I_LCW][((size_t)(l * 2 + dd) * 4 + jj) * LW + n * 64 + c];
        cb[dd] = A->in[I_LCB][(l * 2 + dd) * LW + n * 64 + c];
        sp[dd] = softplusf_(-A->in[I_LAM][(l * 2 + dd) * LW + n * 64 + c]);
    }
    const int g = wave >> 2, jcol = (wave & 3) * 16 + (lane & 15), quad = lane >> 4;
    pg8::bf16x8 bfrag[2][2]; float gbias[2];
#pragma unroll
    for (int dd = 0; dd < 2; ++dd) {
        const float* Wsrc = (g ? A->in[I_LWI] : A->in[I_LWR]) + ((size_t)((l * 2 + dd) * 6 + n) * 64) * 64 + jcol;
#pragma unroll
        for (int ks = 0; ks < 2; ++ks)
#pragma unroll
            for (int jj = 0; jj < 8; ++jj) bfrag[dd][ks][jj] = (short)f2bf(Wsrc[(size_t)(ks * 32 + quad * 8 + jj) * 64]);
        gbias[dd] = (g ? A->in[I_LBI] : A->in[I_LBR])[(l * 2 + dd) * LW + n * 64 + jcol];
    }
    float hstate = 0.f;
    v4u pre[2][2];
#define LRU_LOAD(ch) do { _Pragma("unroll") for (int dd = 0; dd < 2; ++dd) { const int n0 = (ch) * 64; const int qlo_ = dd == 0 ? n0 : q_of_step(n0, 1) - 63; const int qb_ = dd == 0 ? qlo_ - 3 : qlo_; \
        const int slo_ = qlo_ < CTX ? 0 : CTX, shi_ = qlo_ < CTX ? CTX : QLEN; \
        _Pragma("unroll") for (int jj = 0; jj < 2; ++jj) { const int p = tid + NTHR * jj; const int t = p >> 3, part = p & 7, q = qb_ + t; \
            pre[dd][jj] = (v4u){0u, 0u, 0u, 0u}; \
            if (t < 67 && q >= slo_ && q < shi_) pre[dd][jj] = *(const v4u*)(W.P + (size_t)row_of(b, q, odd) * INCP + PC_XR + n * 64 + part * 8); } } } while (0)
    LRU_LOAD(0);
    const int tid_o = tid, lane_o = lane;
    for (int ch = 0; ch < QLEN / 64; ++ch) {
        const int n0 = ch * 64;
        int tid = tid_o, lane = lane_o; asm volatile("" : "+v"(tid), "+v"(lane));
        const int c = tid & 63, jcol = (wave & 3) * 16 + (lane & 15), quad = lane >> 4;
#pragma unroll
        for (int dd = 0; dd < 2; ++dd)
#pragma unroll
            for (int jj = 0; jj < 2; ++jj) { const int p = tid + NTHR * jj; const int t = p >> 3, part = p & 7;
                if (t < 67) { float f[8]; unpack8(pre[dd][jj], f); LAS float* dst = xs + dd * 68 * 64 + t * 64 + part * 8;
                    *(LAS f32x4*)dst = (f32x4){f[0], f[1], f[2], f[3]}; *(LAS f32x4*)(dst + 4) = (f32x4){f[4], f[5], f[6], f[7]}; } }
        __syncthreads();
        if (ch + 1 < QLEN / 64) LRU_LOAD(ch + 1);
#pragma unroll
        for (int k = 0; k < 16; ++k) { const int dd = k >> 3, t = (tid >> 6) + 8 * (k & 7); const LAS float* x = xs + dd * 68 * 64;
            const float uv = cb[dd] + cw[dd][0] * x[t * 64 + c] + cw[dd][1] * x[(t + 1) * 64 + c] + cw[dd][2] * x[(t + 2) * 64 + c] + cw[dd][3] * x[(t + 3) * 64 + c];
            us[dd * 4096 + t * 64 + c] = uv; ub[dd * 64 * 72 + t * 72 + c] = (bf16)f2bf(uv); }
        __syncthreads();
#pragma unroll
        for (int dd = 0; dd < 2; ++dd)
#pragma unroll
            for (int rt = 0; rt < 4; ++rt) {
                pg8::f32x4 acc = {0.f, 0.f, 0.f, 0.f};
#pragma unroll
                for (int ks = 0; ks < 2; ++ks) {
                    const pg8::bf16x8 afrag = *(const LAS pg8::bf16x8*)(ub + dd * 64 * 72 + (rt * 16 + (lane & 15)) * 72 + ks * 32 + quad * 8);
                    acc = __builtin_amdgcn_mfma_f32_16x16x32_bf16(afrag, bfrag[dd][ks], acc, 0, 0, 0);
                }
#pragma unroll
                for (int jj = 0; jj < 4; ++jj) gs[((dd * 2 + g) * 64 + rt * 16 + quad * 4 + jj) * 64 + jcol] = sigmoidf_(acc[jj] + gbias[dd]);
            }
        __syncthreads();
#pragma unroll
        for (int k = 0; k < 16; ++k) { const int dd = k >> 3, t = (tid >> 6) + 8 * (k & 7);
            LAS float* ga = gs + (dd * 2) * 4096 + t * 64 + c; LAS float* gb = ga + 4096;
            const float rgv = *ga, igv = *gb, u = us[dd * 4096 + t * 64 + c];
            const float log_a = -8.0f * sp[dd] * rgv;
            const float a = __expf(log_a);
            const float bt = __builtin_amdgcn_sqrtf(fmaxf(1.0f - a * a, 0.f)) * (igv * u);
            *ga = a; *gb = bt; }
        __syncthreads();
        if (wave < 2) {
            const int dd = wave; const int qlo = dd == 0 ? n0 : q_of_step(n0, 1) - 63;
            const LAS float* ga = gs + (dd * 2) * 4096 + lane;
#pragma unroll 8
            for (int s = 0; s < 64; ++s) { const int t = dd == 0 ? s : 63 - s;
                hstate = ga[t * 64] * hstate + ga[4096 + t * 64];
                W.H[(size_t)row_of(b, qlo + t, odd) * D + dd * LW + n * 64 + lane] = (bf16)f2bf(hstate); }
        }
        __syncthreads();
    }
#undef LRU_LOAD
}

__device__ __forceinline__ void post_phase(const int bx, const int G, CArgsP A, const WS& W, int l, LAS unsigned char* lds, int tid, int lane, int wave) {
    LAS float* hs = (LAS float*)lds;
    const int odd = l & 1;
    const float* cwa = A->in[I_CONVA] + (size_t)l * 3 * 256;
    const float* rk = A->in[I_RK] + l * RW; const float* lng = A->in[I_LNG] + l * RW; const float* lnb = A->in[I_LNB] + l * RW;
    bf16* Y = W.H;
    for (int tile = bx; tile < NB * (QLEN / 16); tile += G) {
        const int b = tile / (QLEN / 16), q0 = (tile % (QLEN / 16)) * 16;
        for (int it = tid; it < 16 * 48; it += NTHR) { const int i = it / 48, col = (it % 48) * 8; const size_t row = row_of(b, q0 + i, odd);
            float h0[8], h1[8]; unpack8(*(const v4u*)(W.H + row * D + col), h0); unpack8(*(const v4u*)(W.H + row * D + LW + col), h1);
#pragma unroll
            for (int e = 0; e < 8; ++e) hs[i * 384 + col + e] = h0[e] + h1[e]; }
        __syncthreads();
        v4u grv[2];
#pragma unroll
        for (int u = 0; u < 2; ++u) { const int it0 = tid + NTHR * u, it = it0 < 16 * 48 ? it0 : 16 * 48 - 1; const int i = it / 48, col = (it % 48) * 8;
            grv[u] = *(const v4u*)(W.P + (size_t)row_of(b, q0 + i, odd) * INCP + PC_GR + col); }
        {   const int it = tid, i = it >> 5, col = (it & 31) * 8, q = q0 + i;
            int lo, hi; if (q < CTX) { lo = 0; hi = CTX; } else { lo = CTX + ((q - CTX) & ~63); hi = lo + 64; }
            const size_t row = row_of(b, q, odd), rp = row_of(b, q - 1 >= lo ? q - 1 : q, odd), rn = row_of(b, q + 1 < hi ? q + 1 : q, odd);
            const float mp = q - 1 >= lo ? 1.f : 0.f, mn = q + 1 < hi ? 1.f : 0.f;
            const v4u l0 = *(const v4u*)(W.P + row * INCP + PC_BG + col), l1 = *(const v4u*)(W.P + row * INCP + PC_CG + col), l2 = *(const v4u*)(W.P + row * INCP + PC_XIN + col);
            const v4u l3 = *(const v4u*)(W.P + rp * INCP + PC_CG + col), l4 = *(const v4u*)(W.P + rp * INCP + PC_XIN + col);
            const v4u l5 = *(const v4u*)(W.P + rn * INCP + PC_CG + col), l6 = *(const v4u*)(W.P + rn * INCP + PC_XIN + col);
            float bg[8], c0[8], x0[8], c1[8], x1[8], c2[8], x2[8], y[8];
            unpack8(l0, bg); unpack8(l1, c0); unpack8(l2, x0); unpack8(l3, c1); unpack8(l4, x1); unpack8(l5, c2); unpack8(l6, x2);
#pragma unroll
            for (int e = 0; e < 8; ++e) y[e] = bg[e] * (cwa[256 + col + e] * (c0[e] * x0[e]) + mp * cwa[col + e] * (c1[e] * x1[e]) + mn * cwa[512 + col + e] * (c2[e] * x2[e]));
            *(v4u*)(Y + row * D + col) = pack8(y); }
        for (int it = wave * 8 + (lane >> 3); it < 96; it += 64) {
            const int i = it / 6, h = it % 6, c = h * 64 + (lane & 7) * 8, q = q0 + i;
            const size_t row = row_of(b, q, odd), pos = (size_t)b * QLEN + q;
            float y0[8], y1[8], rr[8], vv[8], k0[8], k1[8], gg[8];
            unpack8(*(const v4u*)(W.P + row * INCP + PC_Y + c), y0); unpack8(*(const v4u*)(W.P + row * INCP + PC_Y + RW + c), y1);
            unpack8(*(const v4u*)(W.sc_r + pos * RW + c), rr); unpack8(*(const v4u*)(W.sc_v + pos * RW + c), vv);
            unpack8(*(const v4u*)(W.scb + (size_t)3 * SC_ELEMS + pos * RW + c), k0); unpack8(*(const v4u*)(W.scb + (size_t)4 * SC_ELEMS + pos * RW + c), k1);
            unpack8(*(const v4u*)(W.P + row * INCP + PC_G + c), gg);
            float sum = 0.f, bon = 0.f;
#pragma unroll
            for (int e = 0; e < 8; ++e) { y0[e] += y1[e]; sum += y0[e]; bon += rr[e] * (k0[e] + k1[e]) * rk[c + e]; }
            const float mean = reduce8(sum) * (1.0f / 64.0f); bon = reduce8(bon);
            float sq = 0.f;
#pragma unroll
            for (int e = 0; e < 8; ++e) { y0[e] -= mean; sq += y0[e] * y0[e]; }
            const float rstd = rsqrtf(reduce8(sq) * (1.0f / 64.0f) + 64e-5f);
#pragma unroll
            for (int e = 0; e < 8; ++e) y0[e] = (y0[e] * rstd * lng[c + e] + lnb[c + e] + bon * vv[e]) * gg[e];
            *(v4u*)(Y + row * D + 256 + c) = pack8(y0);
        }
#pragma unroll
        for (int u = 0; u < 2; ++u) { const int it = tid + NTHR * u;
            if (it < 16 * 48) { const int i = it / 48, col = (it % 48) * 8; const size_t row = row_of(b, q0 + i, odd);
                float gr[8], o[8]; unpack8(grv[u], gr);
#pragma unroll
                for (int e = 0; e < 8; ++e) o[e] = gelu_tanh(gr[e]) * hs[i * 384 + col + e];
                *(v4u*)(Y + row * D + 640 + col) = pack8(o); } }
        __syncthreads();
    }
}

#define XB_TMO      128
#define XB_XCNT(j)  (256  + 64 * (j))
#define XB_XSUB(j)  (1280 + 64 * (j))
#define XB_XGEN(j)  (2304 + 64 * (j))
#define XB_TOP      3328
#define XB_TOPGEN   3392
#define XCD_BAR_WORDS 3456
#define XB_SPIN_CAP (1u << 18)

__device__ __forceinline__ unsigned xb_ld(unsigned* p)              { return __hip_atomic_load(p, __ATOMIC_RELAXED, __HIP_MEMORY_SCOPE_AGENT); }
__device__ __forceinline__ unsigned xb_add(unsigned* p, unsigned v) { return __hip_atomic_fetch_add(p, v, __ATOMIC_RELAXED, __HIP_MEMORY_SCOPE_AGENT); }
__device__ __forceinline__ unsigned xb_xcc_id() { return (unsigned)__builtin_amdgcn_s_getreg((3 << 11) | 20) & 0xFu; }
#define XB_SPIN(cond, bar) do { unsigned _sp = 0; while (cond) { __builtin_amdgcn_s_sleep(1); \
    if ((++_sp & 255u) == 0u) { if (xb_ld(&(bar)[XB_TMO])) break; if (_sp > XB_SPIN_CAP) { atomicAdd(&(bar)[XB_TMO], 1u); break; } } } } while (0)

struct XcdBarrier {
    unsigned* bar; unsigned x;
    volatile LAS unsigned* st;
};

__device__ __forceinline__ XcdBarrier xcd_barrier_post(unsigned* bar, volatile LAS unsigned* st) {
    XcdBarrier b; b.bar = bar; b.x = xb_xcc_id(); b.st = st;
    if (threadIdx.x == 0) (void)xb_add(&bar[XB_XCNT(b.x)], 1u);
    return b;
}
__device__ __forceinline__ void xcd_barrier_complete(unsigned* bar, unsigned x, unsigned& nloc, unsigned& nx) {
    const unsigned G = gridDim.x * gridDim.y * gridDim.z;
    unsigned sum, cnt, mine, sp = 0u;
    for (;;) {
        sum = 0u; cnt = 0u; mine = 0u;
#pragma unroll
        for (unsigned j = 0; j < 16; ++j) { const unsigned c = xb_ld(&bar[XB_XCNT(j)]); sum += c; cnt += (c > 0u) ? 1u : 0u; mine = (j == x) ? c : mine; }
        if (sum == G) break;
        __builtin_amdgcn_s_sleep(1);
        if ((++sp & 255u) == 0u) { if (xb_ld(&bar[XB_TMO])) break; if (sp > XB_SPIN_CAP) { atomicAdd(&bar[XB_TMO], 1u); break; } }
    }
    nloc = mine > 0u ? mine : 1u; nx = cnt > 0u ? cnt : 1u;
}

__device__ __forceinline__ void xcd_barrier(const XcdBarrier& b) {
    asm volatile("s_waitcnt vmcnt(0)" ::: "memory");
    __syncthreads();
    if (threadIdx.x == 0) {
        unsigned* bar = b.bar;
        __builtin_amdgcn_s_waitcnt(0);
        unsigned nloc = b.st[0], nx = b.st[1];
        if (nloc == 0u) { xcd_barrier_complete(bar, b.x, nloc, nx); b.st[0] = nloc; b.st[1] = nx; }
        const unsigned old = xb_add(&bar[XB_XSUB(b.x)], 1u);
        const unsigned gen = old / nloc;
        if (old + 1u == (gen + 1u) * nloc) {
            __builtin_amdgcn_fence(__ATOMIC_RELEASE, "agent");
            asm volatile("s_waitcnt vmcnt(0)" ::: "memory");
            const unsigned og = xb_add(&bar[XB_TOP], 1u);
            const unsigned tg = og / nx;
            if (og + 1u == (tg + 1u) * nx) xb_add(&bar[XB_TOPGEN], 1u);
            else XB_SPIN(xb_ld(&bar[XB_TOPGEN]) == tg, bar);
            __builtin_amdgcn_fence(__ATOMIC_ACQUIRE, "agent");
            xb_add(&bar[XB_XGEN(b.x)], 1u);
            asm volatile("s_waitcnt vmcnt(0)" ::: "memory");
        } else {
            XB_SPIN(xb_ld(&bar[XB_XGEN(b.x)]) == gen, bar);
            __builtin_amdgcn_fence(__ATOMIC_ACQUIRE, "agent");
            asm volatile("s_waitcnt vmcnt(0)" ::: "memory");
        }
    }
    __syncthreads();
}

constexpr int PH_PER_LAYER = 13, N_PHASES = 1 + DEPTH * PH_PER_LAYER + 1;
__global__ void __launch_bounds__(NTHR, 2) fwd_megakernel(Args A0) {
    extern __shared__ __attribute__((aligned(16))) unsigned char lds_raw[];
    LAS unsigned char* lds = (LAS unsigned char*)lds_raw;
    cg::grid_group grid = cg::this_grid();
    const int ph_lo = A0.ph_lo, ph_hi = A0.ph_hi;
    volatile LAS unsigned* bst = (volatile LAS unsigned*)(lds + 131072);
    if (threadIdx.x < 2) bst[threadIdx.x] = 0u;
    __syncthreads();
    const XcdBarrier xbar = xcd_barrier_post((unsigned*)(A0.ws + WS_BAR), bst);
    const int wave0 = __builtin_amdgcn_readfirstlane((int)threadIdx.x >> 6);
    bool rep_done = false; (void)rep_done;
    for (int ph = ph_lo; ph < ph_hi; ++ph) {
        CArgsP A = (CArgsP)__builtin_amdgcn_kernarg_segment_ptr();
        asm volatile("" : "+s"(A) :: "memory");
        int G = gridDim.x, bx = blockIdx.x, wave = wave0;
        asm volatile("" : "+s"(G), "+s"(bx), "+s"(wave));
#define IDS() int lane; asm volatile("v_mbcnt_lo_u32_b32 %0, -1, 0\n\tv_mbcnt_hi_u32_b32 %0, -1, %0" : "=v"(lane)); const int tid = wave * 64 + lane; (void)tid
        const WS W = make_ws(A->ws);
        if (ph == 0) { IDS(); mods_phase(bx, G, A, W, lds, tid, lane, wave); convert_phase(bx, G, A, W, 0, lds, lane, wave); }
        else if (ph == N_PHASES - 1) { IDS(); final_norm_phase(bx, G, A->out, A->in[I_GFINAL], lane, wave); }
        else {
            const int l = (ph - 1) / PH_PER_LAYER, s = (ph - 1) % PH_PER_LAYER; const bool last = (l == DEPTH - 1);
            const float* mods_l = W.mods + (size_t)l * 9 * 9216;
            const float* xlat = A->out; const float* xctx = W.xrctx;
            if (s == 0) { IDS();
                if (l > 0) convert_phase(bx, G, A, W, l, lds, lane, wave);
                norm_phase(bx, G, l == 0 ? A->in[I_X] : xlat, l == 0 ? A->in[I_CTX] : xctx, A->in[I_GFFN1] + l * D, mods_l, 0, 1, W.H, MTOT, lane, wave);
            } else if (s == 1 || s == 11) { IDS();
                pg8::Gemm g{W.H, W.wt + (s == 1 ? WT_GU1 : WT_GU2), (s == 11 && last) ? MLAT : MTOT, 2 * DFF, D}; pg8::StaticOrder S; S.init(g.M, g.N, G, bx);
                EpiSwiGLU E{W.ACT};
                pg8::gemm_phase<EpiSwiGLU, pg8::StaticOrder, true, true>(lds, g, S, E, tid);
            } else if (s == 2 || s == 9 || s == 12) { IDS();
                pg8::Gemm g{s == 9 ? W.H : W.ACT, W.wt + (s == 2 ? WT_DOWN1 : s == 9 ? WT_OUT : WT_DOWN2), (s != 2 && last) ? MLAT : MTOT, D, s == 9 ? D : DFF};
                pg8::StaticOrder S; S.init(g.M, g.N, G, bx);
                const bool first = (l == 0 && s == 2);
                EpiResid E{first ? A->in[I_X] : xlat, first ? A->in[I_CTX] : xctx, A->out, W.xrctx, mods_l + (s == 2 ? 2 : s == 9 ? 5 : 8) * 1024, s == 9 ? 1.0f : 0.5f};
                pg8::gemm_phase<EpiResid, pg8::StaticOrder, true, true>(lds, g, S, E, tid);
            } else if (s == 3) { IDS();
                norm_phase(bx, G, xlat, xctx, A->in[I_GMIX] + l * D, mods_l, 3, 4, W.H, MTOT, lane, wave);
            } else if (s == 4) { IDS();
                pg8::Gemm g{W.H, W.wt + WT_IN, MTOT, INCP, D}; pg8::StaticOrder S; S.init(g.M, g.N, G, bx);
                EpiP E{W.P, INCP};
                pg8::gemm_phase<EpiP, pg8::StaticOrder, true, true>(lds, g, S, E, tid);
            } else if (s == 5) { IDS();
                pre_phase(bx, G, A, W, l, lds, tid, lane, wave);
            } else if (s == 6) { IDS();
                int Kl = LORA_K, Nl = LORA_N; asm volatile("" : "+s"(Kl), "+s"(Nl));
                pg8::Gemm g{(const bf16*)((const unsigned char*)W.H + HB_AP), W.wt + WT_LORA, MTOT, Nl, Kl}; pg8::StaticOrder S; S.init(g.M, g.N, G, bx);
                EpiLora E{A->in[I_W0] + l * 2 * RW, A->in[I_A0] + l * 2 * RW, A->in[I_KA] + l * RW, (const bf16*)((const unsigned char*)W.H + HB_KT), W.sc_kk, W.scb, W.P, l & 1};
                pg8::gemm_phase<EpiLora, pg8::StaticOrder, true, true>(lds, g, S, E, tid);
            } else if (s == 7) { IDS();
                for (int u = bx; u < 240; u += G) {
                    if (u < 192) rwkv_scan_phase(W, l, u, lds, tid, lane, wave); else lru_scan_phase(A, W, l, u - 192, lds, tid, lane, wave);
                    __syncthreads();
                }
            } else if (s == 8) { IDS();
                post_phase(bx, G, A, W, l, lds, tid, lane, wave);
            } else if (s == 10) { IDS();
                norm_phase(bx, G, xlat, xctx, A->in[I_GFFN2] + l * D, mods_l, 6, 7, W.H, last ? MLAT : MTOT, lane, wave);
            }
        }
#ifdef PROBE_REP_S
        if (ph > 0 && ph < N_PHASES - 1 && ((ph - 1) % PH_PER_LAYER) == PROBE_REP_S && !rep_done) { rep_done = true; grid.sync(); --ph; continue; }
        rep_done = false;
#endif
        if (ph + 1 < ph_hi) { if (ph == ph_lo) grid.sync(); else xcd_barrier(xbar); }
    }
}

#ifndef MK_MULTI
#define MK_MULTI 0
#endif
extern "C" void kernel_launch(void* const* d_in, const int* in_sizes, int n_in, void* d_out, int out_size, void* d_ws, size_t ws_size, hipStream_t stream) {
    static int grid = 0;
    if (grid == 0) {
        if (n_in != N_IN || out_size != MLAT * D || ws_size < WS_END) { fprintf(stderr, "kernel_launch: unexpected shapes (n_in %d out %d ws %zu)\n", n_in, out_size, ws_size); grid = -1; return; }
        int dev = 0, cus = 0, per_cu = 0;
        (void)hipGetDevice(&dev); (void)hipDeviceGetAttribute(&cus, hipDeviceAttributeMultiprocessorCount, dev);
        if (hipFuncSetAttribute((const void*)fwd_megakernel, hipFuncAttributeMaxDynamicSharedMemorySize, LDS_BYTES) != hipSuccess) { fprintf(stderr, "kernel_launch: hipFuncSetAttribute failed\n"); grid = -1; return; }
        if (hipOccupancyMaxActiveBlocksPerMultiprocessor(&per_cu, (const void*)fwd_megakernel, NTHR, LDS_BYTES) != hipSuccess || per_cu < 1) { fprintf(stderr, "kernel_launch: occupancy query says %d\n", per_cu); per_cu = 1; }
        (void)hipGetLastError();
        grid = cus * 1;
        if (grid <= 0) grid = 256;
    }
    if (grid < 0) return;
    if (hipMemsetAsync((unsigned char*)d_ws + WS_BAR, 0, WS_BAR_BYTES, stream) != hipSuccess) { fprintf(stderr, "kernel_launch: memset of the barrier words failed\n"); return; }
    Args a{};
    for (int i = 0; i < N_IN; ++i) a.in[i] = (const float*)d_in[i];
    a.out = (float*)d_out; a.ws = (unsigned char*)d_ws;
#if MK_MULTI
    for (int ph = 0; ph < N_PHASES; ++ph) { a.ph_lo = ph; a.ph_hi = ph + 1; hipLaunchKernelGGL(fwd_megakernel, dim3(grid), dim3(NTHR), LDS_BYTES, stream, a); }
#else
    a.ph_lo = 0; a.ph_hi = N_PHASES;
    void* args[] = {&a};
    hipError_t e = hipLaunchCooperativeKernel((const void*)fwd_megakernel, dim3(grid), dim3(NTHR), args, LDS_BYTES, stream);
    if (e != hipSuccess) fprintf(stderr, "kernel_launch: cooperative launch failed: %s (grid %d)\n", hipGetErrorString(e), grid);
#endif
}
```

```cpp
#include <hip/hip_runtime.h>
#include <hip/hip_cooperative_groups.h>
#include <cstdio>
#include <cstdint>
namespace cg = cooperative_groups;
namespace pg8 {
#define PG8_LAS __attribute__((address_space(3)))
typedef unsigned short bf16_t;
typedef short bf16x8 __attribute__((ext_vector_type(8)));
typedef float f32x4 __attribute__((ext_vector_type(4)));
typedef unsigned u32x4 __attribute__((ext_vector_type(4)));
constexpr int BM = 256, BK = 64, HALF = 128, HTB = HALF * BK * 2  , STAGE_BYTES = 8 * HTB, NXCD = 8, WGM = 8;

__host__ __device__ __forceinline__ int lds_byte(int r, int c) { const int st = (r >> 4) * 2 + (c >> 5), rr = r & 15, cc = c & 31, ob = rr * 64 + cc * 2; return st * 1024 + (ob ^ (((ob >> 9) & 1) << 5)); }
__host__ __device__ __forceinline__ void stage_rc(int b, int& R, int& C) { const int st = b / 1024, sb = b % 1024, swz = sb ^ (((sb >> 9) & 1) << 5); R = (st >> 1) * 16 + swz / 64; C = (st & 1) * 32 + (swz % 64) / 2; }
__host__ __device__ __forceinline__ int perm32(int rho) { const int n = rho >> 4, i = rho & 15; return 8 * (i >> 2) + 4 * n + (i & 3); }

struct Unit { int pm, pn; };
struct Gemm { const bf16_t* A; const bf16_t* Bt; int M, N, K; };

struct StaticOrder {
    int nM, nN, nwg, G, c;
    __host__ __device__ void init(int M, int N, int G_, int c_) { nM = M / BM; nN = N / BM; nwg = nM * nN; G = G_; c = c_; }
    __host__ __device__ bool next(int i, Unit& u) const {
        const long L = (long)i * G + c; if (L >= nwg) return false;
        int wgid = (int)L; { const int q = nwg / NXCD, r = nwg % NXCD, xcd = wgid % NXCD, off = wgid / NXCD; wgid = (xcd < r ? xcd * (q + 1) : r * (q + 1) + (xcd - r) * q) + off; }
        const int nig = WGM * nN, gid = wgid / nig, fm = gid * WGM, gsz = (nM - fm) < WGM ? (nM - fm) : WGM;
        u.pm = fm + ((wgid % nig) % gsz); u.pn = (wgid % nig) / gsz; return true;
    }
    __device__ __forceinline__ void a_ready(const Unit&) const {}
    __device__ __forceinline__ void done(const Unit&) const {}
};

template <class Epi, class Sched, bool ALIGN_EPI = false, bool SP2 = false>
__device__ __forceinline__ void gemm_phase(PG8_LAS unsigned char* lds, const Gemm g, const Sched& S, const Epi& E, const int tid) {
    const int wid = __builtin_amdgcn_readfirstlane(tid >> 6), lane = tid & 63, wr = wid >> 2, wc = wid & 3, fr = lane & 15, fq = lane >> 4;
    const int K = g.K, nt = K / BK;
    unsigned voffA[2], voffB[2];
#pragma unroll
    for (int i = 0; i < 2; ++i) { int R, C; stage_rc(tid * 16 + i * 8192, R, C); const int Rb = Epi::PERM ? ((R & ~31) + perm32(R & 31)) : R;
        voffA[i] = (unsigned)(R * K + C) * 2u; voffB[i] = (unsigned)(Rb * K + C) * 2u; }
    const size_t kstep = (size_t)(BK * 2);
    const size_t hstep = (size_t)HALF * K * 2;
    const size_t tstep = 2 * hstep;
    const unsigned ldsw = (unsigned)wid * 1024u;
    const int aoff = lds_byte(wr * 64 + fr, fq * 8), boff = lds_byte(wc * 32 + fr, fq * 8);
#define PG8_SA(b, h) (((b) * 2 + (h)) * HTB)
#define PG8_SB(b, h) ((4 + (b) * 2 + (h)) * HTB)
#define PG8_STAGE(bufoff, gbase, voff) do { _Pragma("unroll") for (int _i = 0; _i < 2; ++_i) \
        __builtin_amdgcn_global_load_lds((const unsigned*)((const char*)(gbase) + (voff)[_i]), (PG8_LAS unsigned*)(lds + (bufoff) + ldsw + _i * 8192), 16, 0, 0); } while (0)
#define PG8_LDA(dst, b, h) do { _Pragma("unroll") for (int m = 0; m < 4; ++m) _Pragma("unroll") for (int k = 0; k < 2; ++k) dst[m][k] = *(const PG8_LAS bf16x8*)(lds + PG8_SA(b, h) + aoff + m * 2048 + k * 1024); } while (0)
#define PG8_LDB(dst, b, h) do { _Pragma("unroll") for (int n = 0; n < 2; ++n) _Pragma("unroll") for (int k = 0; k < 2; ++k) dst[n][k] = *(const PG8_LAS bf16x8*)(lds + PG8_SB(b, h) + boff + n * 2048 + k * 1024); } while (0)
#define PG8_MMA(ai, bj, At, Bt) do { __builtin_amdgcn_s_setprio(1); _Pragma("unroll") for (int m = 0; m < 4; ++m) _Pragma("unroll") for (int n = 0; n < 2; ++n) _Pragma("unroll") for (int k = 0; k < 2; ++k) \
        acc[ai][bj][m][n] = __builtin_amdgcn_mfma_f32_16x16x32_bf16(Bt[n][k], At[m][k], acc[ai][bj][m][n], 0, 0, 0); __builtin_amdgcn_s_setprio(0); } while (0)
#define PG8_WAIT_V(n) asm volatile("s_waitcnt vmcnt(" #n ")" ::: "memory")
#define PG8_WAIT_L(n) asm volatile("s_waitcnt lgkmcnt(" #n ")" ::: "memory")
#define PG8_BAR __builtin_amdgcn_s_barrier()
#define PG8_SCHED __builtin_amdgcn_sched_barrier(0)
    Unit cur, nxt; int ui = 0;
    if (!S.next(0, cur)) return;
    f32x4 acc[2][2][4][2];
#pragma unroll
    for (int a = 0; a < 2; ++a)
#pragma unroll
        for (int b = 0; b < 2; ++b)
#pragma unroll
            for (int m = 0; m < 4; ++m)
#pragma unroll
                for (int n = 0; n < 2; ++n) acc[a][b][m][n] = (f32x4){0.f, 0.f, 0.f, 0.f};
    bf16x8 At[4][2], B0[2][2], B1[2][2];
    const char* cA = (const char*)g.A + (size_t)cur.pm * tstep; const char* cB = (const char*)g.Bt + (size_t)cur.pn * tstep;
    S.a_ready(cur);
    if constexpr (SP2) {
        PG8_STAGE(PG8_SB(0, 0), cB, voffB); PG8_STAGE(PG8_SB(0, 1), cB + hstep, voffB); PG8_STAGE(PG8_SA(0, 0), cA, voffA); PG8_STAGE(PG8_SA(0, 1), cA + hstep, voffA);
        if (wr == 1) PG8_BAR;
        PG8_WAIT_V(2); PG8_BAR;
        PG8_STAGE(PG8_SB(1, 0), cB + kstep, voffB); PG8_STAGE(PG8_SA(1, 0), cA + kstep, voffA); PG8_STAGE(PG8_SB(1, 1), cB + hstep + kstep, voffB);
        PG8_WAIT_V(6); PG8_BAR;
    } else {
        PG8_STAGE(PG8_SB(0, 0), cB, voffB); PG8_STAGE(PG8_SA(0, 0), cA, voffA); PG8_STAGE(PG8_SB(0, 1), cB + hstep, voffB); PG8_STAGE(PG8_SA(0, 1), cA + hstep, voffA);
        if (wr == 1) PG8_BAR;
        PG8_WAIT_V(4); PG8_BAR;
        PG8_STAGE(PG8_SB(1, 0), cB + kstep, voffB); PG8_STAGE(PG8_SA(1, 0), cA + kstep, voffA); PG8_STAGE(PG8_SB(1, 1), cB + hstep + kstep, voffB);
        PG8_WAIT_V(6); PG8_BAR;
    }
    for (;;) {
        const bool has_next = S.next(ui + 1, nxt);
        const char* nA = has_next ? (const char*)g.A + (size_t)nxt.pm * tstep : cA; const char* nB = has_next ? (const char*)g.Bt + (size_t)nxt.pn * tstep : cB;
        for (int t = 0; t < nt; t += 2) {
            const bool last = (t == nt - 2);
            const char* a1 = cA + (size_t)(t + 1) * kstep;
            const char* a2 = last ? nA : cA + (size_t)(t + 2) * kstep; const char* b2 = last ? nB : cB + (size_t)(t + 2) * kstep;
            const char* a3 = a2 + kstep; const char* b3 = b2 + kstep;
            if (last && has_next) S.a_ready(nxt);
            if constexpr (SP2) {
            PG8_LDB(B0, 0, 0); PG8_LDB(B1, 0, 1); PG8_SCHED; PG8_LDA(At, 0, 0); PG8_STAGE(PG8_SA(1, 1), a1 + hstep, voffA);
            PG8_WAIT_V(8); PG8_WAIT_L(0); PG8_BAR; PG8_MMA(0, 0, At, B0); PG8_MMA(0, 1, At, B1); PG8_BAR; PG8_SCHED;
            PG8_LDA(At, 0, 1); PG8_STAGE(PG8_SB(0, 0), b2, voffB); PG8_STAGE(PG8_SB(0, 1), b2 + hstep, voffB); PG8_STAGE(PG8_SA(0, 0), a2, voffA);
            PG8_WAIT_V(8); PG8_WAIT_L(0); PG8_BAR; PG8_MMA(1, 0, At, B0); PG8_MMA(1, 1, At, B1); PG8_BAR; PG8_SCHED;
            PG8_LDB(B0, 1, 0); PG8_LDB(B1, 1, 1); PG8_SCHED; PG8_LDA(At, 1, 0); PG8_STAGE(PG8_SA(0, 1), a2 + hstep, voffA);
            PG8_WAIT_V(8); PG8_WAIT_L(0); PG8_BAR; PG8_MMA(0, 0, At, B0); PG8_MMA(0, 1, At, B1); PG8_BAR; PG8_SCHED;
            PG8_LDA(At, 1, 1); PG8_STAGE(PG8_SB(1, 0), b3, voffB); PG8_STAGE(PG8_SB(1, 1), b3 + hstep, voffB); PG8_STAGE(PG8_SA(1, 0), a3, voffA);
            PG8_WAIT_V(8); PG8_WAIT_L(0); PG8_BAR; PG8_MMA(1, 0, At, B0); PG8_MMA(1, 1, At, B1); PG8_BAR; PG8_SCHED;
            } else {
            PG8_LDB(B0, 0, 0); PG8_SCHED; PG8_LDA(At, 0, 0); PG8_STAGE(PG8_SA(1, 1), a1 + hstep, voffA);
            PG8_WAIT_L(8); PG8_BAR; PG8_WAIT_L(0); PG8_MMA(0, 0, At, B0); PG8_BAR; PG8_SCHED;
            PG8_LDB(B1, 0, 1); PG8_STAGE(PG8_SB(0, 0), b2, voffB);
            PG8_BAR; PG8_WAIT_L(0); PG8_MMA(0, 1, At, B1); PG8_BAR;
            PG8_LDA(At, 0, 1); PG8_STAGE(PG8_SA(0, 0), a2, voffA);
            PG8_BAR; PG8_WAIT_L(0); PG8_MMA(1, 0, At, B0); PG8_BAR; PG8_SCHED;
            PG8_STAGE(PG8_SB(0, 1), b2 + hstep, voffB);
            PG8_WAIT_V(6); PG8_BAR; PG8_MMA(1, 1, At, B1); PG8_BAR;
            PG8_LDB(B0, 1, 0); PG8_SCHED; PG8_LDA(At, 1, 0); PG8_STAGE(PG8_SA(0, 1), a2 + hstep, voffA);
            PG8_WAIT_L(8); PG8_BAR; PG8_WAIT_L(0); PG8_MMA(0, 0, At, B0); PG8_BAR; PG8_SCHED;
            PG8_LDB(B1, 1, 1); PG8_STAGE(PG8_SB(1, 0), b3, voffB);
            PG8_BAR; PG8_WAIT_L(0); PG8_MMA(0, 1, At, B1); PG8_BAR;
            PG8_LDA(At, 1, 1); PG8_STAGE(PG8_SA(1, 0), a3, voffA);
            PG8_BAR; PG8_WAIT_L(0); PG8_MMA(1, 0, At, B0); PG8_BAR; PG8_SCHED;
            PG8_STAGE(PG8_SB(1, 1), b3 + hstep, voffB);
            PG8_WAIT_V(6); PG8_BAR; PG8_MMA(1, 1, At, B1); PG8_BAR;
            }
        }
        if constexpr (ALIGN_EPI) { if (wr == 0) PG8_BAR; }
        if constexpr (!Epi::AFTER_DRAIN) { E(acc, cur, wr, wc, fr, fq); S.done(cur); }
        if (!has_next) break;
#pragma unroll
        for (int a = 0; a < 2; ++a)
#pragma unroll
            for (int b = 0; b < 2; ++b)
#pragma unroll
                for (int m = 0; m < 4; ++m)
#pragma unroll
                    for (int n = 0; n < 2; ++n) acc[a][b][m][n] = (f32x4){0.f, 0.f, 0.f, 0.f};
        cur = nxt; cA = nA; cB = nB; ++ui;
        if constexpr (ALIGN_EPI) { if (wr == 1) PG8_BAR; }
    }
    PG8_WAIT_V(0);
    if constexpr (!ALIGN_EPI) { if (wr == 0) PG8_BAR; }
    PG8_BAR;
    if constexpr (Epi::AFTER_DRAIN) { E.fused(acc, cur, wr, wc, fr, fq, lds, wid, lane); S.done(cur); }
#undef PG8_SA
#undef PG8_SB
#undef PG8_STAGE
#undef PG8_LDA
#undef PG8_LDB
#undef PG8_MMA
#undef PG8_WAIT_V
#undef PG8_WAIT_L
#undef PG8_BAR
#undef PG8_SCHED
}
}
#define LAS __attribute__((address_space(3)))
typedef unsigned short bf16;
typedef unsigned v4u __attribute__((ext_vector_type(4)));
typedef unsigned v2u __attribute__((ext_vector_type(2)));
typedef float f32x4 __attribute__((ext_vector_type(4)));
typedef float f32x2 __attribute__((ext_vector_type(2)));

constexpr int D = 1024, NB = 8, SEQ = 4096, CTX = 256, DEPTH = 4, DFF = 2816;
constexpr int MLAT = NB * SEQ, MCTX = NB * CTX, MTOT = MLAT + MCTX;
constexpr int INC = 2944, INCP = 3072;
constexpr int RW = 384, LW = 384, RC = 1408;
constexpr int QLEN = CTX + SEQ;
constexpr int PC_BG = 0, PC_CG = 256, PC_XIN = 512, PC_RW = 768, PC_XR = 2176, PC_GR = 2560;
constexpr int PC_Y = 768;
constexpr int PC_G = 1536;
constexpr int LORA_N = 2048, LORA_K = 256;
constexpr int NWAVES = 8, NTHR = 512;
constexpr int LDS_BYTES = 147456;

constexpr size_t MiB = 1u << 20;
constexpr size_t WS_BAR = 1536 * 1024, WS_BAR_BYTES = 16384;
constexpr size_t WS_MODS = 0, WS_XRCTX = 2 * MiB, WS_WT = 10 * MiB, WS_H = 52 * MiB, WS_A = 120 * MiB, WS_B = 324 * MiB;
constexpr size_t SC_ELEMS = (size_t)NB * QLEN * RW;
constexpr size_t WS_WT2 = WS_B + 9 * SC_ELEMS * 2;
constexpr size_t WS_END = WS_WT2 + 42 * MiB;
static_assert(WS_END <= 600 * MiB, "workspace map");
static_assert(WS_A + (size_t)MTOT * INCP * 2 <= WS_B, "P fits");
constexpr size_t WT_GU1 = 0, WT_DOWN1 = WT_GU1 + (size_t)2 * DFF * D, WT_IN = WT_DOWN1 + (size_t)D * DFF, WT_OUT = WT_IN + (size_t)INCP * D,
                 WT_GU2 = WT_OUT + (size_t)D * D, WT_DOWN2 = WT_GU2 + (size_t)2 * DFF * D, WT_TOTAL = WT_DOWN2 + (size_t)D * DFF;
constexpr size_t WT_LORA = WT_TOTAL;
static_assert(WS_WT + (WT_TOTAL + (size_t)LORA_N * LORA_K) * 2 <= WS_H, "weights fit");
constexpr size_t HB_AP = 0, HB_KT = (size_t)MTOT * LORA_K * 2;
static_assert(HB_KT + (size_t)MTOT * RW * 2 <= WS_A - WS_H, "H region overlay");

enum { I_X = 0, I_C, I_CTX, I_CCTX, I_WMOD, I_BMOD, I_GFFN1, I_WGU1, I_WDOWN1, I_GMIX, I_WIN, I_CONVA, I_MU, I_W0, I_W2, I_A0, I_A2, I_G2, I_KK, I_KA, I_RK,
       I_LNG, I_LNB, I_LCW, I_LCB, I_LWR, I_LBR, I_LWI, I_LBI, I_LAM, I_WOUT, I_GFFN2, I_WGU2, I_WDOWN2, I_GFINAL, N_IN };

struct Args { const float* in[N_IN]; float* out; unsigned char* ws; int ph_lo, ph_hi; };
typedef const __attribute__((address_space(4))) Args* CArgsP;

__device__ __forceinline__ float bf2f(unsigned h) { return __builtin_bit_cast(float, h << 16); }
__device__ __forceinline__ unsigned f2bf(float f) { unsigned u = __builtin_bit_cast(unsigned, f); return (u + 0x7fffu + ((u >> 16) & 1u)) >> 16; }
__device__ __forceinline__ unsigned pk2(float lo, float hi) { unsigned r; asm("v_cvt_pk_bf16_f32 %0, %1, %2" : "=v"(r) : "v"(lo), "v"(hi)); return r; }
__device__ __forceinline__ void unpack8(v4u p, float* o) {
    o[0] = __builtin_bit_cast(float, p.x << 16); o[1] = __builtin_bit_cast(float, p.x & 0xffff0000u);
    o[2] = __builtin_bit_cast(float, p.y << 16); o[3] = __builtin_bit_cast(float, p.y & 0xffff0000u);
    o[4] = __builtin_bit_cast(float, p.z << 16); o[5] = __builtin_bit_cast(float, p.z & 0xffff0000u);
    o[6] = __builtin_bit_cast(float, p.w << 16); o[7] = __builtin_bit_cast(float, p.w & 0xffff0000u);
}
__device__ __forceinline__ v4u pack8(const float* v) { v4u o; o.x = pk2(v[0], v[1]); o.y = pk2(v[2], v[3]); o.z = pk2(v[4], v[5]); o.w = pk2(v[6], v[7]); return o; }
template <int CTRL> __device__ __forceinline__ float dppf(float v) { return __builtin_bit_cast(float, __builtin_amdgcn_update_dpp(0, __builtin_bit_cast(int, v), CTRL, 0xF, 0xF, true)); }
__device__ __forceinline__ float wave_sum(float v) {
    v += dppf<0xB1>(v); v += dppf<0x4E>(v); v += dppf<0x141>(v); v += dppf<0x140>(v);
    const float a = __builtin_bit_cast(float, __builtin_amdgcn_readlane(__builtin_bit_cast(int, v), 0)), b = __builtin_bit_cast(float, __builtin_amdgcn_readlane(__builtin_bit_cast(int, v), 16));
    const float c = __builtin_bit_cast(float, __builtin_amdgcn_readlane(__builtin_bit_cast(int, v), 32)), d = __builtin_bit_cast(float, __builtin_amdgcn_readlane(__builtin_bit_cast(int, v), 48));
    return (a + b) + (c + d);
}
__device__ __forceinline__ float sigmoidf_(float x) { return __builtin_amdgcn_rcpf(1.0f + __expf(-x)); }
__device__ __forceinline__ float siluf_(float x) { return x * __builtin_amdgcn_rcpf(1.0f + __expf(-x)); }
__device__ __forceinline__ float softplusf_(float z) { return fmaxf(z, 0.f) + log1pf(__expf(-fabsf(z))); }
__device__ __forceinline__ float tanh_fast(float x) { const float e = __expf(2.0f * fminf(fmaxf(x, -15.f), 15.f)); return 1.0f - 2.0f * __builtin_amdgcn_rcpf(e + 1.0f); }
__device__ __forceinline__ float gelu_tanh(float x) { const float u = 0.7978845608028654f * (x + 0.044715f * x * x * x); return 0.5f * x * (1.0f + tanh_fast(u)); }
__device__ __forceinline__ float rscatter16(const float (&v)[16], int j) {
    const bool b1 = (j & 8) != 0, b2 = (j & 4) != 0, b3 = (j & 2) != 0, b4 = (j & 1) != 0;
    float a[8], c[4], d[2];
#pragma unroll
    for (int k = 0; k < 8; ++k) { const float keep = b1 ? v[k + 8] : v[k], send = b1 ? v[k] : v[k + 8]; a[k] = keep + dppf<0x140>(send); }
#pragma unroll
    for (int k = 0; k < 4; ++k) { const float keep = b2 ? a[k + 4] : a[k], send = b2 ? a[k] : a[k + 4]; c[k] = keep + dppf<0x141>(send); }
#pragma unroll
    for (int k = 0; k < 2; ++k) { const float keep = b3 ? c[k + 2] : c[k], send = b3 ? c[k] : c[k + 2]; d[k] = keep + dppf<0x4E>(send); }
    { const float keep = b4 ? d[1] : d[0], send = b4 ? d[0] : d[1]; return keep + dppf<0xB1>(send); }
}
__device__ __forceinline__ float reduce16(float x) { x += dppf<0xB1>(x); x += dppf<0x4E>(x); x += dppf<0x141>(x); x += dppf<0x140>(x); return x; }
__device__ __forceinline__ float reduce8(float x) { x += dppf<0xB1>(x); x += dppf<0x4E>(x); x += dppf<0x141>(x); return x; }
__device__ __forceinline__ int row_of(int b, int q, int odd) {
    if (q < CTX) return MLAT + b * CTX + q;
    const int s = q - CTX; const int t = odd ? (((s & 63) << 6) | (s >> 6)) : s;
    return b * SEQ + t;
}

struct EpiSwiGLU {
    static constexpr bool PERM = true, AFTER_DRAIN = false;
    bf16* O;
    __device__ __forceinline__ void operator()(const pg8::f32x4 (&acc)[2][2][4][2], const pg8::Unit& u, int wr, int wc, int fr, int fq) const {
        const int row0 = u.pm * 256 + wr * 64 + fr, col0 = u.pn * 128 + wc * 32 + 8 * fq;
#pragma unroll
        for (int ai = 0; ai < 2; ++ai)
#pragma unroll
            for (int m = 0; m < 4; ++m) {
                float o[8];
#pragma unroll
                for (int n = 0; n < 2; ++n)
#pragma unroll
                    for (int j = 0; j < 4; ++j) { const float g = acc[ai][0][m][n][j], up = acc[ai][1][m][n][j]; o[n * 4 + j] = siluf_(g) * up; }
                *(v4u*)(O + (size_t)(row0 + ai * 128 + m * 16) * DFF + col0) = pack8(o);
            }
    }
};
struct EpiP {
    static constexpr bool PERM = true, AFTER_DRAIN = false;
    bf16* O; int ldc;
    __device__ __forceinline__ void operator()(const pg8::f32x4 (&acc)[2][2][4][2], const pg8::Unit& u, int wr, int wc, int fr, int fq) const {
        const int row0 = u.pm * 256 + wr * 64 + fr, col0 = u.pn * 256 + wc * 32 + 8 * fq;
#pragma unroll
        for (int ai = 0; ai < 2; ++ai)
#pragma unroll
            for (int m = 0; m < 4; ++m)
#pragma unroll
                for (int bj = 0; bj < 2; ++bj) {
                    float o[8];
#pragma unroll
                    for (int n = 0; n < 2; ++n)
#pragma unroll
                        for (int j = 0; j < 4; ++j) o[n * 4 + j] = acc[ai][bj][m][n][j];
                    *(v4u*)(O + (size_t)(row0 + ai * 128 + m * 16) * ldc + col0 + bj * 128) = pack8(o);
                }
    }
};
struct EpiResid {
    static constexpr bool PERM = true, AFTER_DRAIN = false;
    const float* res_lat; const float* res_ctx; float* dst_lat; float* dst_ctx; const float* gate; float coef;
    __device__ __forceinline__ void operator()(const pg8::f32x4 (&acc)[2][2][4][2], const pg8::Unit& u, int wr, int wc, int fr, int fq) const {
        const int rowbase = u.pm * 256; const bool isctx = rowbase >= MLAT;
        const int b = isctx ? 8 : (rowbase >> 12);
        const float* res = isctx ? res_ctx + (size_t)(rowbase - MLAT) * D : res_lat + (size_t)rowbase * D;
        float* dst = isctx ? dst_ctx + (size_t)(rowbase - MLAT) * D : dst_lat + (size_t)rowbase * D;
#pragma unroll
        for (int bj = 0; bj < 2; ++bj) {
            const int col = u.pn * 256 + bj * 128 + wc * 32 + 8 * fq;
            const f32x4 g0 = *(const f32x4*)(gate + (size_t)b * 9216 + col) * coef, g1 = *(const f32x4*)(gate + (size_t)b * 9216 + col + 4) * coef;
#pragma unroll
            for (int ai = 0; ai < 2; ++ai)
#pragma unroll
                for (int m = 0; m < 4; ++m) {
                    const size_t off = (size_t)(ai * 128 + wr * 64 + m * 16 + fr) * D + col;
                    const f32x4 r0 = *(const f32x4*)(res + off), r1 = *(const f32x4*)(res + off + 4);
                    *(f32x4*)(dst + off) = r0 + g0 * acc[ai][bj][m][0];
                    *(f32x4*)(dst + off + 4) = r1 + g1 * acc[ai][bj][m][1];
                }
        }
    }
};

struct EpiLora {
    static constexpr bool PERM = true, AFTER_DRAIN = false;
    const float* w0; const float* a0; const float* ka; const bf16* kt; const bf16* kk; bf16* scb; bf16* P; int odd;
    __device__ __forceinline__ void operator()(const pg8::f32x4 (&acc)[2][2][4][2], const pg8::Unit& u, int wr, int wc, int fr, int fq) const {
        asm volatile("" : "+v"(fr), "+v"(fq));
#pragma unroll
        for (int bj = 0; bj < 2; ++bj) {
            const int half = __builtin_amdgcn_readfirstlane(u.pn * 2 + bj), kind = half / 3, c = (half - kind * 3) * 128 + wc * 32 + 8 * fq;
            if (kind >= 5) continue;
#pragma unroll
            for (int ai = 0; ai < 2; ++ai)
#pragma unroll
                for (int m = 0; m < 4; ++m) {
                    const int pos = u.pm * 256 + ai * 128 + wr * 64 + m * 16 + fr;
                    float v[8];
#pragma unroll
                    for (int n = 0; n < 2; ++n)
#pragma unroll
                        for (int j = 0; j < 4; ++j) v[n * 4 + j] = acc[ai][bj][m][n][j];
                    if (kind < 2) {
                        const f32x4 q0 = *(const f32x4*)(w0 + kind * 384 + c), q1 = *(const f32x4*)(w0 + kind * 384 + c + 4);
                        const float p0[8] = {q0.x, q0.y, q0.z, q0.w, q1.x, q1.y, q1.z, q1.w};
#pragma unroll
                        for (int e = 0; e < 8; ++e) { const float wl = p0[e] + v[e];
                            v[e] = 1.0f - __expf(-0.6065306597126334f * sigmoidf_(wl)); }
                        *(v4u*)(scb + (size_t)(7 + kind) * SC_ELEMS + (size_t)pos * RW + c) = pack8(v);
                    } else if (kind < 4) {
                        const f32x4 q0 = *(const f32x4*)(a0 + (kind - 2) * 384 + c), q1 = *(const f32x4*)(a0 + (kind - 2) * 384 + c + 4);
                        const float p0[8] = {q0.x, q0.y, q0.z, q0.w, q1.x, q1.y, q1.z, q1.w};
#pragma unroll
                        for (int e = 0; e < 8; ++e) v[e] = sigmoidf_(p0[e] + v[e]);
                        {   float kkv[8]; unpack8(*(const v4u*)(kk + (size_t)pos * RW + c), kkv);
#pragma unroll
                            for (int e = 0; e < 8; ++e) kkv[e] *= v[e];
                            *(v4u*)(scb + (size_t)(5 + kind - 2) * SC_ELEMS + (size_t)pos * RW + c) = pack8(kkv); }
                        {   float kv[8]; unpack8(*(const v4u*)(kt + (size_t)pos * RW + c), kv);
                            const f32x4 r0 = *(const f32x4*)(ka + c), r1 = *(const f32x4*)(ka + c + 4);
                            const float p1[8] = {r0.x, r0.y, r0.z, r0.w, r1.x, r1.y, r1.z, r1.w};
#pragma unroll
                            for (int e = 0; e < 8; ++e) kv[e] *= (1.0f + (v[e] - 1.0f) * p1[e]);
                            *(v4u*)(scb + (size_t)(3 + kind - 2) * SC_ELEMS + (size_t)pos * RW + c) = pack8(kv); }
                    } else {
                        const int b = pos / QLEN, q = pos - b * QLEN;
                        *(v4u*)(P + (size_t)row_of(b, q, odd) * INCP + PC_G + c) = pack8(v);
                    }
                    asm volatile("" ::: "memory");
                }
        }
    }
};
struct WS {
    float* mods; float* xrctx; bf16* wt; bf16* wt2; bf16* H; bf16* P; bf16* ACT;
    bf16 *scb, *sc_r, *sc_v, *sc_kk, *dgs;
};
__device__ __forceinline__ WS make_ws(unsigned char* ws) {
    WS w; w.mods = (float*)(ws + WS_MODS); w.xrctx = (float*)(ws + WS_XRCTX); w.wt = (bf16*)(ws + WS_WT); w.wt2 = (bf16*)(ws + WS_WT2); w.H = (bf16*)(ws + WS_H); w.P = (bf16*)(ws + WS_A); w.ACT = (bf16*)(ws + WS_A);
    bf16* b = (bf16*)(ws + WS_B);
    w.scb = b; w.sc_r = b; w.sc_v = b + SC_ELEMS; w.sc_kk = b + 2 * SC_ELEMS; w.dgs = b + 9 * SC_ELEMS;
    return w;
}

__device__ __forceinline__ void mods_phase(const int bx, const int G, CArgsP A, const WS& W, LAS unsigned char* lds, int tid, int lane, int wave) {
    LAS float* sl = (LAS float*)lds;
    LAS float* part = sl + 9 * 1024;
    const float* c = A->in[I_C]; const float* cctx = A->in[I_CCTX];
    for (int i = tid; i < 9216; i += NTHR) { const int r = i >> 10, k = i & 1023; const float v = r < 8 ? c[r * 1024 + k] : cctx[k]; sl[i] = siluf_(v); }
    __syncthreads();
    for (int item = bx; item < 288; item += G) {
        const int l = item / 72, cgp = item % 72;
        const float* Wp = A->in[I_WMOD] + (size_t)l * 1024 * 9216 + cgp * 128 + lane * 2;
        float acc[9][2];
#pragma unroll
        for (int r = 0; r < 9; ++r) { acc[r][0] = 0.f; acc[r][1] = 0.f; }
#pragma unroll 8
        for (int kk = 0; kk < 128; ++kk) {
            const int k = wave * 128 + kk;
            const f32x2 w = *(const f32x2*)(Wp + (size_t)k * 9216);
#pragma unroll
            for (int r = 0; r < 9; ++r) { const float s = sl[r * 1024 + k]; acc[r][0] += s * w.x; acc[r][1] += s * w.y; }
        }
#pragma unroll
        for (int r = 0; r < 9; ++r) { part[(wave * 9 + r) * 128 + lane * 2] = acc[r][0]; part[(wave * 9 + r) * 128 + lane * 2 + 1] = acc[r][1]; }
        __syncthreads();
        for (int o = tid; o < 1152; o += NTHR) {
            const int r = o >> 7, cc = o & 127; float s = A->in[I_BMOD][l * 9216 + cgp * 128 + cc];
#pragma unroll
            for (int w8 = 0; w8 < 8; ++w8) s += part[(w8 * 9 + r) * 128 + cc];
            W.mods[(size_t)(l * 9 + r) * 9216 + cgp * 128 + cc] = s;
        }
        __syncthreads();
    }
}

__device__ __forceinline__ void transpose_item(const float* Wsrc, int K, int N, bf16* WT, int kb, int n0, int drow0, LAS float* scr, int lane) {
    const int k0 = 64 * kb;
    float tv[32];
#pragma unroll
    for (int i = 0; i < 32; ++i) tv[i] = Wsrc[(size_t)(k0 + 2 * i + (lane >> 5)) * N + n0 + (lane & 31)];
#pragma unroll
    for (int i = 0; i < 32; ++i) scr[(2 * i + (lane >> 5)) * 33 + (lane & 31)] = tv[i];
    asm volatile("s_waitcnt lgkmcnt(0)" ::: "memory");
    const int c = lane & 7;
#pragma unroll
    for (int j = 0; j < 4; ++j) { const int n = (lane >> 3) + 8 * j; const LAS float* s = scr + (8 * c) * 33 + n;
        v4u o; o.x = pk2(s[0 * 33], s[1 * 33]); o.y = pk2(s[2 * 33], s[3 * 33]); o.z = pk2(s[4 * 33], s[5 * 33]); o.w = pk2(s[6 * 33], s[7 * 33]);
        *(v4u*)(WT + (size_t)(drow0 + n) * K + k0 + 8 * c) = o; }
    asm volatile("s_waitcnt lgkmcnt(0)" ::: "memory");
}
__device__ __forceinline__ int gu_drow(int n0) { return n0 < DFF ? 256 * (n0 >> 7) + (n0 & 127) : 256 * ((n0 - DFF) >> 7) + 128 + ((n0 - DFF) & 127); }
__device__ __forceinline__ void convert_phase(const int bx, const int G, CArgsP A, bf16* wtd, int l, LAS unsigned char* lds, int lane, int wave) {
    LAS float* scr = (LAS float*)(lds + wave * 16384);
    const int gw = bx * NWAVES + wave, NGW = G * NWAVES;
    constexpr int I_GU = (D / 64) * (2 * DFF / 32), I_DN = (DFF / 64) * (D / 32), I_IN = (D / 64) * (INC / 32), I_OUT = (D / 64) * (D / 32);
    constexpr int NITEMS = 2 * I_GU + 2 * I_DN + I_IN + I_OUT;
    for (int it = gw; it < NITEMS; it += NGW) {
        int r = it;
        if (r < I_GU) { const int nblk = 2 * DFF / 32, kb = r / nblk, n0 = (r % nblk) * 32; transpose_item(A->in[I_WGU1] + (size_t)l * D * 2 * DFF, D, 2 * DFF, wtd + WT_GU1, kb, n0, gu_drow(n0), scr, lane); continue; } r -= I_GU;
        if (r < I_GU) { const int nblk = 2 * DFF / 32, kb = r / nblk, n0 = (r % nblk) * 32; transpose_item(A->in[I_WGU2] + (size_t)l * D * 2 * DFF, D, 2 * DFF, wtd + WT_GU2, kb, n0, gu_drow(n0), scr, lane); continue; } r -= I_GU;
        if (r < I_DN) { const int nblk = D / 32, kb = r / nblk, n0 = (r % nblk) * 32; transpose_item(A->in[I_WDOWN1] + (size_t)l * DFF * D, DFF, D, wtd + WT_DOWN1, kb, n0, n0, scr, lane); continue; } r -= I_DN;
        if (r < I_DN) { const int nblk = D / 32, kb = r / nblk, n0 = (r % nblk) * 32; transpose_item(A->in[I_WDOWN2] + (size_t)l * DFF * D, DFF, D, wtd + WT_DOWN2, kb, n0, n0, scr, lane); continue; } r -= I_DN;
        if (r < I_IN) { const int nblk = INC / 32, kb = r / nblk, n0 = (r % nblk) * 32; transpose_item(A->in[I_WIN] + (size_t)l * D * INC, D, INC, wtd + WT_IN, kb, n0, n0, scr, lane); continue; } r -= I_IN;
        { const int nblk = D / 32, kb = r / nblk, n0 = (r % nblk) * 32; transpose_item(A->in[I_WOUT] + (size_t)l * D * D, D, D, wtd + WT_OUT, kb, n0, n0, scr, lane); }
    }
    for (int idx = (bx * NWAVES + wave) * 64 + lane; idx < LORA_N * LORA_K; idx += G * NTHR) {
        const int n = idx % LORA_N, k = idx / LORA_N, kind = n / 384, c = n - kind * 384;
        float v = 0.f;
        if (kind < 2) { if (k < 64) v = A->in[I_W2][((size_t)(l * 2 + kind) * 64 + k) * RW + c]; }
        else if (kind < 4) { if (k >= 64 && k < 128) v = A->in[I_A2][((size_t)(l * 2 + kind - 2) * 64 + (k - 64)) * RW + c]; }
        else if (kind == 4) { if (k >= 128) v = A->in[I_G2][((size_t)l * 128 + (k - 128)) * RW + c]; }
        wtd[WT_LORA + (size_t)n * LORA_K + k] = (bf16)f2bf(v);
    }
}

__device__ __forceinline__ void norm_phase(const int bx, const int G, const float* lat, const float* ctxp, const float* g, const float* mods_l, int ishift, int iscale, bf16* H, int nrows, int lane, int wave) {
    const int gw = bx * NWAVES + wave, NGW = G * NWAVES;
    for (int r0 = gw; r0 < nrows; r0 += 2 * NGW) {
        const int r1 = r0 + NGW < nrows ? r0 + NGW : r0;
        const float* xa = r0 < MLAT ? lat + (size_t)r0 * D : ctxp + (size_t)(r0 - MLAT) * D;
        const float* xb = r1 < MLAT ? lat + (size_t)r1 * D : ctxp + (size_t)(r1 - MLAT) * D;
        f32x4 va[4], vb[4]; float sa = 0.f, sb = 0.f;
#pragma unroll
        for (int j = 0; j < 4; ++j) { va[j] = *(const f32x4*)(xa + (lane + 64 * j) * 4); vb[j] = *(const f32x4*)(xb + (lane + 64 * j) * 4); }
#pragma unroll
        for (int j = 0; j < 4; ++j) { sa += (va[j].x * va[j].x + va[j].y * va[j].y) + (va[j].z * va[j].z + va[j].w * va[j].w); sb += (vb[j].x * vb[j].x + vb[j].y * vb[j].y) + (vb[j].z * vb[j].z + vb[j].w * vb[j].w); }
        sa = wave_sum(sa); sb = wave_sum(sb);
        const float rsa = rsqrtf(sa * (1.0f / D) + 1e-6f), rsb = rsqrtf(sb * (1.0f / D) + 1e-6f);
        const int ba = r0 < MLAT ? (r0 >> 12) : 8, bb = r1 < MLAT ? (r1 >> 12) : 8;
        const float* sha = mods_l + (size_t)ba * 9216 + ishift * 1024; const float* sca = mods_l + (size_t)ba * 9216 + iscale * 1024;
        const float* shb = mods_l + (size_t)bb * 9216 + ishift * 1024; const float* scb2 = mods_l + (size_t)bb * 9216 + iscale * 1024;
#pragma unroll
        for (int j = 0; j < 4; ++j) {
            const int col = (lane + 64 * j) * 4;
            const f32x4 gg = *(const f32x4*)(g + col);
            { const f32x4 s4 = *(const f32x4*)(sha + col), c4 = *(const f32x4*)(sca + col); const f32x4 h = (va[j] * rsa) * gg * (c4 + 1.0f) + s4;
              v2u o; o.x = pk2(h.x, h.y); o.y = pk2(h.z, h.w); *(v2u*)(H + (size_t)r0 * D + col) = o; }
            if (r1 != r0) { const f32x4 s4 = *(const f32x4*)(shb + col), c4 = *(const f32x4*)(scb2 + col); const f32x4 h = (vb[j] * rsb) * gg * (c4 + 1.0f) + s4;
              v2u o; o.x = pk2(h.x, h.y); o.y = pk2(h.z, h.w); *(v2u*)(H + (size_t)r1 * D + col) = o; }
        }
    }
}
__device__ __forceinline__ void final_norm_phase(const int bx, const int G, float* xo, const float* g, int lane, int wave) {
    const int gw = bx * NWAVES + wave, NGW = G * NWAVES;
    for (int r0 = gw; r0 < MLAT; r0 += 2 * NGW) {
        const int r1 = r0 + NGW < MLAT ? r0 + NGW : r0;
        float* xa = xo + (size_t)r0 * D; float* xb = xo + (size_t)r1 * D;
        f32x4 va[4], vb[4]; float sa = 0.f, sb = 0.f;
#pragma unroll
        for (int j = 0; j < 4; ++j) { va[j] = *(const f32x4*)(xa + (lane + 64 * j) * 4); vb[j] = *(const f32x4*)(xb + (lane + 64 * j) * 4); }
#pragma unroll
        for (int j = 0; j < 4; ++j) { sa += (va[j].x * va[j].x + va[j].y * va[j].y) + (va[j].z * va[j].z + va[j].w * va[j].w); sb += (vb[j].x * vb[j].x + vb[j].y * vb[j].y) + (vb[j].z * vb[j].z + vb[j].w * vb[j].w); }
        sa = wave_sum(sa); sb = wave_sum(sb);
        const float rsa = rsqrtf(sa * (1.0f / D) + 1e-6f), rsb = rsqrtf(sb * (1.0f / D) + 1e-6f);
#pragma unroll
        for (int j = 0; j < 4; ++j) { const int col = (lane + 64 * j) * 4; const f32x4 gg = *(const f32x4*)(g + col);
            *(f32x4*)(xa + col) = (va[j] * rsa) * gg; if (r1 != r0) *(f32x4*)(xb + col) = (vb[j] * rsb) * gg; }
    }
}

__device__ __forceinline__ void pre_item(int it, int& i, int& col) {
    if (it < 2304) { const int seg = it / 768, r = it - seg * 768; i = r / 48; col = seg * 384 + (r % 48) * 8; }
    else if (it < 2560) { const int r = it - 2304; i = (r & 127) >> 3; col = 1152 + (r >> 7) * 64 + (r & 7) * 8; }
    else { const int r = it - 2560; i = r >> 4; col = 1280 + (r & 15) * 8; }
}
__device__ __forceinline__ void pre_phase(const int bx, const int G, CArgsP A, const WS& W, int l, LAS unsigned char* lds, int tid, int lane, int wave) {
    LAS float* k_s = (LAS float*)lds;
    const int odd = l & 1;
    const float* mu0 = A->in[I_MU] + (size_t)l * 2 * RC; const float* mu1 = mu0 + RC;
    const float* kkp = A->in[I_KK] + l * RW;
    bf16* AP = (bf16*)((unsigned char*)W.H + HB_AP); bf16* KT = (bf16*)((unsigned char*)W.H + HB_KT);
    for (int tile = bx; tile < NB * (QLEN / 16); tile += G) {
        const int b = tile / (QLEN / 16), q0 = (tile % (QLEN / 16)) * 16;
        const int seq_lo = q0 < CTX ? 0 : CTX, seq_hi = q0 < CTX ? CTX : QLEN;
        for (int pass = 0; pass < 2; ++pass) {
            v4u rc[3], rp[3], rn[3];
#pragma unroll
            for (int u = 0; u < 3; ++u) { const int it0 = tid + NTHR * (pass * 3 + u), it = it0 < 16 * 176 ? it0 : 16 * 176 - 1;
                int i, col; pre_item(it, i, col); const int q = q0 + i;
                const int qp = q - 1 >= seq_lo ? q - 1 : q, qn = q + 1 < seq_hi ? q + 1 : q;
                rc[u] = *(const v4u*)(W.P + (size_t)row_of(b, q, odd) * INCP + PC_RW + col);
                rp[u] = *(const v4u*)(W.P + (size_t)row_of(b, qp, odd) * INCP + PC_RW + col);
                rn[u] = *(const v4u*)(W.P + (size_t)row_of(b, qn, odd) * INCP + PC_RW + col); }
#pragma unroll
            for (int u = 0; u < 3; ++u) { const int it0 = tid + NTHR * (pass * 3 + u);
                if (it0 < 16 * 176) {
                    int i, col; pre_item(it0, i, col); const int q = q0 + i;
                    const size_t pos = (size_t)b * QLEN + q;
                    float cur[8], prv[8], nxt[8], ps[8];
                    unpack8(rc[u], cur); unpack8(rp[u], prv); unpack8(rn[u], nxt);
                    const float mp = q - 1 >= seq_lo ? 1.f : 0.f, mn = q + 1 < seq_hi ? 1.f : 0.f;
#pragma unroll
                    for (int e = 0; e < 8; ++e) ps[e] = cur[e] + mu0[col + e] * (prv[e] * mp - cur[e]) + mu1[col + e] * (nxt[e] * mn - cur[e]);
                    if (col < 384) *(v4u*)(W.sc_r + pos * RW + col) = pack8(ps);
                    else if (col < 768) {
#pragma unroll
                        for (int e = 0; e < 8; ++e) k_s[i * 384 + col - 384 + e] = ps[e];
                        *(v4u*)(KT + pos * RW + (col - 384)) = pack8(ps); }
                    else if (col < 1152) *(v4u*)(W.sc_v + pos * RW + (col - 768)) = pack8(ps);
                    else if (col < 1216) {
#pragma unroll
                        for (int e = 0; e < 8; ++e) ps[e] = tanh_fast(ps[e]);
                        *(v4u*)(AP + pos * LORA_K + (col - 1152)) = pack8(ps); }
                    else if (col < 1280) *(v4u*)(AP + pos * LORA_K + 64 + (col - 1216)) = pack8(ps);
                    else {
#pragma unroll
                        for (int e = 0; e < 8; ++e) ps[e] = sigmoidf_(ps[e]);
                        *(v4u*)(AP + pos * LORA_K + 128 + (col - 1280)) = pack8(ps); }
                }
            }
        }
        __syncthreads();
        for (int it = wave * 8 + (lane >> 3); it < 96; it += 64) {
            const int i = it / 6, h = it % 6, c = h * 64 + (lane & 7) * 8;
            float kv[8]; float ss = 0.f;
#pragma unroll
            for (int e = 0; e < 8; ++e) { kv[e] = k_s[i * 384 + c + e] * kkp[c + e]; ss += kv[e] * kv[e]; }
            const float rn = rsqrtf(reduce8(ss) + 1e-12f);
#pragma unroll
            for (int e = 0; e < 8; ++e) kv[e] *= rn;
            *(v4u*)(W.sc_kk + ((size_t)b * QLEN + q0 + i) * RW + c) = pack8(kv);
        }
        __syncthreads();
    }
}

__device__ __forceinline__ int q_of_step(int n, int d) { return d == 0 ? n : (n < CTX ? CTX - 1 - n : QLEN + CTX - 1 - n); }
constexpr int RCH = 32, RNCH = QLEN / RCH;
__device__ __forceinline__ void rwkv_scan_phase(const WS& W, int l, int blk, LAS unsigned char* lds, int tid, int lane, int wave) {
    const int item = blk >> 1, half = blk & 1;
    const int b = item / 12, rem = item % 12, h = rem >> 1, d = rem & 1, odd = l & 1;
    LAS float* buf = (LAS float*)lds;
    LAS float* ybuf = buf + 2 * RCH * 384;
    const bf16* s_omw = W.scb + (size_t)(7 + d) * SC_ELEMS; const bf16* s_b = W.scb + (size_t)(5 + d) * SC_ELEMS; const bf16* s_kd = W.scb + (size_t)(3 + d) * SC_ELEMS;
    const int rg = lane >> 4, j = lane & 15, rlA = (wave & 3) * 8 + rg, rlB = rlA + 4, rowA = half * 32 + rlA, rowB = half * 32 + rlB;
    v4u pre[3];
#define RW_LOAD(c) do { _Pragma("unroll") for (int jj = 0; jj < 3; ++jj) { const int p = tid + NTHR * jj, i = p / 48, r48 = p % 48, vec = r48 >> 3, part = r48 & 7; \
        const int q = q_of_step((c) * RCH + i, d); const size_t pos = (size_t)b * QLEN + q; \
        const bf16* base = vec == 0 ? s_omw : vec == 1 ? s_b : vec == 2 ? s_kd : vec == 3 ? W.sc_kk : vec == 4 ? W.sc_r : W.sc_v; \
        pre[jj] = *(const v4u*)(base + pos * RW + h * 64 + part * 8); } } while (0)
#define RW_STORE(c) do { _Pragma("unroll") for (int jj = 0; jj < 3; ++jj) { const int p = tid + NTHR * jj, i = p / 48, r48 = p % 48, vec = r48 >> 3, part = r48 & 7; \
        float f[8]; unpack8(pre[jj], f); if (vec == 0) { _Pragma("unroll") for (int e = 0; e < 8; ++e) f[e] = 1.0f - f[e]; } \
        LAS float* dst = buf + (((c) & 1) * RCH + i) * 384 + vec * 64 + part * 8; \
        *(LAS f32x4*)dst = (f32x4){f[0], f[1], f[2], f[3]}; *(LAS f32x4*)(dst + 4) = (f32x4){f[4], f[5], f[6], f[7]}; } } while (0)
    f32x2 SA0 = (f32x2){0.f, 0.f}, SA1 = SA0, SB0 = SA0, SB1 = SA0;
    RW_LOAD(0); RW_STORE(0);
    __syncthreads();
    for (int c = 0; c < RNCH; ++c) {
        if (c + 1 < RNCH) RW_LOAD(c + 1);
        const LAS float* cur = buf + (c & 1) * RCH * 384;
        if (wave < 4) {
        float ykA, ykB, ypA[16], ypB[16];
#define RW_LD(X, i_) do { const int ii_ = (i_) < RCH ? (i_) : RCH - 1; const LAS f32x4* bp_ = (const LAS f32x4*)(cur + ii_ * 384 + j * 4); \
        X##w = bp_[0]; X##b = bp_[16]; X##d = bp_[32]; X##k = bp_[48]; X##r = bp_[64]; X##va = cur[ii_ * 384 + 320 + rowA]; X##vb = cur[ii_ * 384 + 320 + rowB]; } while (0)
#define RW_CP(X, s_) do { \
        const f32x2 k0_ = (f32x2){X##k.x, X##k.y}, k1_ = (f32x2){X##k.z, X##k.w}; \
        const f32x2 ta_ = SA0 * k0_ + SA1 * k1_, tb_ = SB0 * k0_ + SB1 * k1_; \
        const float saA_ = -reduce16(ta_.x + ta_.y), saB_ = -reduce16(tb_.x + tb_.y); \
        const f32x2 w0_ = (f32x2){X##w.x, X##w.y}, w1_ = (f32x2){X##w.z, X##w.w}, b0_ = (f32x2){X##b.x, X##b.y}, b1_ = (f32x2){X##b.z, X##b.w}, d0_ = (f32x2){X##d.x, X##d.y}, d1_ = (f32x2){X##d.z, X##d.w}; \
        const f32x2 va2_ = (f32x2){X##va, X##va}, vb2_ = (f32x2){X##vb, X##vb}, sa2_ = (f32x2){saA_, saA_}, sb2_ = (f32x2){saB_, saB_}; \
        SA0 = SA0 * w0_ + va2_ * d0_ + sa2_ * b0_; SA1 = SA1 * w1_ + va2_ * d1_ + sa2_ * b1_; \
        SB0 = SB0 * w0_ + vb2_ * d0_ + sb2_ * b0_; SB1 = SB1 * w1_ + vb2_ * d1_ + sb2_ * b1_; \
        const f32x2 r0_ = (f32x2){X##r.x, X##r.y}, r1_ = (f32x2){X##r.z, X##r.w}; \
        const f32x2 ya_ = SA0 * r0_ + SA1 * r1_, yb_ = SB0 * r0_ + SB1 * r1_; \
        ypA[s_] = ya_.x + ya_.y; ypB[s_] = yb_.x + yb_.y; } while (0)
        f32x4 Aw, Ab, Ad, Ak, Ar, Bw, Bb, Bd, Bk, Br; float Ava, Avb, Bva, Bvb;
        RW_LD(A, 0);
#pragma unroll 1
        for (int g = 0; g < 2; ++g) {
            ykA = 0.f; ykB = 0.f;
#pragma unroll
            for (int s2 = 0; s2 < 16; s2 += 2) {
                const int i = g * 16 + s2;
                RW_LD(B, i + 1);
                __builtin_amdgcn_sched_barrier(0);
                RW_CP(A, s2);
                __builtin_amdgcn_sched_barrier(0);
                RW_LD(A, i + 2);
                __builtin_amdgcn_sched_barrier(0);
                RW_CP(B, s2 + 1);
                __builtin_amdgcn_sched_barrier(0);
            }
            ykA = rscatter16(ypA, j); ykB = rscatter16(ypB, j);
            ybuf[(g * 16 + j) * 32 + rlA] = ykA; ybuf[(g * 16 + j) * 32 + rlB] = ykB;
        }
#undef RW_LD
#undef RW_CP
        }
        __syncthreads();
        if (tid < 256) {
            const int i = tid >> 3, r4 = (tid & 7) * 4;
            const int q = q_of_step(c * RCH + i, d);
            const f32x4 yv = *(const LAS f32x4*)(ybuf + i * 32 + r4);
            v2u o; o.x = pk2(yv.x, yv.y); o.y = pk2(yv.z, yv.w);
            *(v2u*)(W.P + (size_t)row_of(b, q, odd) * INCP + PC_Y + d * RW + h * 64 + half * 32 + r4) = o;
        }
        if (c + 1 < RNCH) RW_STORE(c + 1);
        __syncthreads();
    }
#undef RW_LOAD
#undef RW_STORE
}

__device__ __forceinline__ void lru_scan_phase(CArgsP A, const WS& W, int l, int idx, LAS unsigned char* lds, int tid, int lane, int wave) {
    const int b = idx / 6, n = idx % 6, odd = l & 1;
    LAS float* gs = (LAS float*)lds;
    LAS float* xs = gs;
    LAS float* us = gs + 4 * 4096;
    LAS bf16* ub = (LAS bf16*)(us + 2 * 4096);
    const int c = tid & 63;
    float cw[2][4], cb[2], sp[2];
#pragma unroll
    for (int dd = 0; dd < 2; ++dd) {
#pragma unroll
        for (int jj = 0; jj < 4; ++jj) cw[dd][jj] = A->in[I_LCW][((size_t)(l * 2 + dd) * 4 + jj) * LW + n * 64 + c];
        cb[dd] = A->in[I_LCB][(l * 2 + dd) * LW + n * 64 + c];
        sp[dd] = softplusf_(-A->in[I_LAM][(l * 2 + dd) * LW + n * 64 + c]);
    }
    const int g = wave >> 2, jcol = (wave & 3) * 16 + (lane & 15), quad = lane >> 4;
    pg8::bf16x8 bfrag[2][2]; float gbias[2];
#pragma unroll
    for (int dd = 0; dd < 2; ++dd) {
        const float* Wsrc = (g ? A->in[I_LWI] : A->in[I_LWR]) + ((size_t)((l * 2 + dd) * 6 + n) * 64) * 64 + jcol;
#pragma unroll
        for (int ks = 0; ks < 2; ++ks)
#pragma unroll
            for (int jj = 0; jj < 8; ++jj) bfrag[dd][ks][jj] = (short)f2bf(Wsrc[(size_t)(ks * 32 + quad * 8 + jj) * 64]);
        gbias[dd] = (g ? A->in[I_LBI] : A->in[I_LBR])[(l * 2 + dd) * LW + n * 64 + jcol];
    }
    float hstate = 0.f;
    v4u pre[2][2];
#define LRU_LOAD(ch) do { _Pragma("unroll") for (int dd = 0; dd < 2; ++dd) { const int n0 = (ch) * 64; const int qlo_ = dd == 0 ? n0 : q_of_step(n0, 1) - 63; const int qb_ = dd == 0 ? qlo_ - 3 : qlo_; \
        const int slo_ = qlo_ < CTX ? 0 : CTX, shi_ = qlo_ < CTX ? CTX : QLEN; \
        _Pragma("unroll") for (int jj = 0; jj < 2; ++jj) { const int p = tid + NTHR * jj; const int t = p >> 3, part = p & 7, q = qb_ + t; \
            pre[dd][jj] = (v4u){0u, 0u, 0u, 0u}; \
            if (t < 67 && q >= slo_ && q < shi_) pre[dd][jj] = *(const v4u*)(W.P + (size_t)row_of(b, q, odd) * INCP + PC_XR + n * 64 + part * 8); } } } while (0)
    LRU_LOAD(0);
    const int tid_o = tid, lane_o = lane;
    for (int ch = 0; ch < QLEN / 64; ++ch) {
        const int n0 = ch * 64;
        int tid = tid_o, lane = lane_o; asm volatile("" : "+v"(tid), "+v"(lane));
        const int c = tid & 63, jcol = (wave & 3) * 16 + (lane & 15), quad = lane >> 4;
#pragma unroll
        for (int dd = 0; dd < 2; ++dd)
#pragma unroll
            for (int jj = 0; jj < 2; ++jj) { const int p = tid + NTHR * jj; const int t = p >> 3, part = p & 7;
                if (t < 67) { float f[8]; unpack8(pre[dd][jj], f); LAS float* dst = xs + dd * 68 * 64 + t * 64 + part * 8;
                    *(LAS f32x4*)dst = (f32x4){f[0], f[1], f[2], f[3]}; *(LAS f32x4*)(dst + 4) = (f32x4){f[4], f[5], f[6], f[7]}; } }
        __syncthreads();
        if (ch + 1 < QLEN / 64) LRU_LOAD(ch + 1);
#pragma unroll
        for (int k = 0; k < 16; ++k) { const int dd = k >> 3, t = (tid >> 6) + 8 * (k & 7); const LAS float* x = xs + dd * 68 * 64;
            const float uv = cb[dd] + cw[dd][0] * x[t * 64 + c] + cw[dd][1] * x[(t + 1) * 64 + c] + cw[dd][2] * x[(t + 2) * 64 + c] + cw[dd][3] * x[(t + 3) * 64 + c];
            us[dd * 4096 + t * 64 + c] = uv; ub[dd * 64 * 72 + t * 72 + c] = (bf16)f2bf(uv); }
        __syncthreads();
#pragma unroll
        for (int dd = 0; dd < 2; ++dd)
#pragma unroll
            for (int rt = 0; rt < 4; ++rt) {
                pg8::f32x4 acc = {0.f, 0.f, 0.f, 0.f};
#pragma unroll
                for (int ks = 0; ks < 2; ++ks) {
                    const pg8::bf16x8 afrag = *(const LAS pg8::bf16x8*)(ub + dd * 64 * 72 + (rt * 16 + (lane & 15)) * 72 + ks * 32 + quad * 8);
                    acc = __builtin_amdgcn_mfma_f32_16x16x32_bf16(afrag, bfrag[dd][ks], acc, 0, 0, 0);
                }
#pragma unroll
                for (int jj = 0; jj < 4; ++jj) gs[((dd * 2 + g) * 64 + rt * 16 + quad * 4 + jj) * 64 + jcol] = sigmoidf_(acc[jj] + gbias[dd]);
            }
        __syncthreads();
#pragma unroll
        for (int k = 0; k < 16; ++k) { const int dd = k >> 3, t = (tid >> 6) + 8 * (k & 7);
            LAS float* ga = gs + (dd * 2) * 4096 + t * 64 + c; LAS float* gb = ga + 4096;
            const float rgv = *ga, igv = *gb, u = us[dd * 4096 + t * 64 + c];
            const float log_a = -8.0f * sp[dd] * rgv;
            const float a = __expf(log_a);
            const float bt = __builtin_amdgcn_sqrtf(fmaxf(1.0f - a * a, 0.f)) * (igv * u);
            *ga = a; *gb = bt; }
        __syncthreads();
        if (wave < 2) {
            const int dd = wave; const int qlo = dd == 0 ? n0 : q_of_step(n0, 1) - 63;
            const LAS float* ga = gs + (dd * 2) * 4096 + lane;
#pragma unroll 8
            for (int s = 0; s < 64; ++s) { const int t = dd == 0 ? s : 63 - s;
                hstate = ga[t * 64] * hstate + ga[4096 + t * 64];
                W.H[(size_t)row_of(b, qlo + t, odd) * D + dd * LW + n * 64 + lane] = (bf16)f2bf(hstate); }
        }
        __syncthreads();
    }
#undef LRU_LOAD
}

__device__ __forceinline__ void post_phase(const int bx, const int G, CArgsP A, const WS& W, int l, LAS unsigned char* lds, int tid, int lane, int wave) {
    LAS float* hs = (LAS float*)lds;
    const int odd = l & 1;
    const float* cwa = A->in[I_CONVA] + (size_t)l * 3 * 256;
    const float* rk = A->in[I_RK] + l * RW; const float* lng = A->in[I_LNG] + l * RW; const float* lnb = A->in[I_LNB] + l * RW;
    bf16* Y = W.H;
    for (int tile = bx; tile < NB * (QLEN / 16); tile += G) {
        const int b = tile / (QLEN / 16), q0 = (tile % (QLEN / 16)) * 16;
        for (int it = tid; it < 16 * 48; it += NTHR) { const int i = it / 48, col = (it % 48) * 8; const size_t row = row_of(b, q0 + i, odd);
            float h0[8], h1[8]; unpack8(*(const v4u*)(W.H + row * D + col), h0); unpack8(*(const v4u*)(W.H + row * D + LW + col), h1);
#pragma unroll
            for (int e = 0; e < 8; ++e) hs[i * 384 + col + e] = h0[e] + h1[e]; }
        __syncthreads();
        v4u grv[2];
#pragma unroll
        for (int u = 0; u < 2; ++u) { const int it0 = tid + NTHR * u, it = it0 < 16 * 48 ? it0 : 16 * 48 - 1; const int i = it / 48, col = (it % 48) * 8;
            grv[u] = *(const v4u*)(W.P + (size_t)row_of(b, q0 + i, odd) * INCP + PC_GR + col); }
        {   const int it = tid, i = it >> 5, col = (it & 31) * 8, q = q0 + i;
            int lo, hi; if (q < CTX) { lo = 0; hi = CTX; } else { lo = CTX + ((q - CTX) & ~63); hi = lo + 64; }
            const size_t row = row_of(b, q, odd), rp = row_of(b, q - 1 >= lo ? q - 1 : q, odd), rn = row_of(b, q + 1 < hi ? q + 1 : q, odd);
            const float mp = q - 1 >= lo ? 1.f : 0.f, mn = q + 1 < hi ? 1.f : 0.f;
            const v4u l0 = *(const v4u*)(W.P + row * INCP + PC_BG + col), l1 = *(const v4u*)(W.P + row * INCP + PC_CG + col), l2 = *(const v4u*)(W.P + row * INCP + PC_XIN + col);
            const v4u l3 = *(const v4u*)(W.P + rp * INCP + PC_CG + col), l4 = *(const v4u*)(W.P + rp * INCP + PC_XIN + col);
            const v4u l5 = *(const v4u*)(W.P + rn * INCP + PC_CG + col), l6 = *(const v4u*)(W.P + rn * INCP + PC_XIN + col);
            float bg[8], c0[8], x0[8], c1[8], x1[8], c2[8], x2[8], y[8];
            unpack8(l0, bg); unpack8(l1, c0); unpack8(l2, x0); unpack8(l3, c1); unpack8(l4, x1); unpack8(l5, c2); unpack8(l6, x2);
#pragma unroll
            for (int e = 0; e < 8; ++e) y[e] = bg[e] * (cwa[256 + col + e] * (c0[e] * x0[e]) + mp * cwa[col + e] * (c1[e] * x1[e]) + mn * cwa[512 + col + e] * (c2[e] * x2[e]));
            *(v4u*)(Y + row * D + col) = pack8(y); }
        for (int it = wave * 8 + (lane >> 3); it < 96; it += 64) {
            const int i = it / 6, h = it % 6, c = h * 64 + (lane & 7) * 8, q = q0 + i;
            const size_t row = row_of(b, q, odd), pos = (size_t)b * QLEN + q;
            float y0[8], y1[8], rr[8], vv[8], k0[8], k1[8], gg[8];
            unpack8(*(const v4u*)(W.P + row * INCP + PC_Y + c), y0); unpack8(*(const v4u*)(W.P + row * INCP + PC_Y + RW + c), y1);
            unpack8(*(const v4u*)(W.sc_r + pos * RW + c), rr); unpack8(*(const v4u*)(W.sc_v + pos * RW + c), vv);
            unpack8(*(const v4u*)(W.scb + (size_t)3 * SC_ELEMS + pos * RW + c), k0); unpack8(*(const v4u*)(W.scb + (size_t)4 * SC_ELEMS + pos * RW + c), k1);
            unpack8(*(const v4u*)(W.P + row * INCP + PC_G + c), gg);
            float sum = 0.f, bon = 0.f;
#pragma unroll
            for (int e = 0; e < 8; ++e) { y0[e] += y1[e]; sum += y0[e]; bon += rr[e] * (k0[e] + k1[e]) * rk[c + e]; }
            const float mean = reduce8(sum) * (1.0f / 64.0f); bon = reduce8(bon);
            float sq = 0.f;
#pragma unroll
            for (int e = 0; e < 8; ++e) { y0[e] -= mean; sq += y0[e] * y0[e]; }
            const float rstd = rsqrtf(reduce8(sq) * (1.0f / 64.0f) + 64e-5f);
#pragma unroll
            for (int e = 0; e < 8; ++e) y0[e] = (y0[e] * rstd * lng[c + e] + lnb[c + e] + bon * vv[e]) * gg[e];
            *(v4u*)(Y + row * D + 256 + c) = pack8(y0);
        }
#pragma unroll
        for (int u = 0; u < 2; ++u) { const int it = tid + NTHR * u;
            if (it < 16 * 48) { const int i = it / 48, col = (it % 48) * 8; const size_t row = row_of(b, q0 + i, odd);
                float gr[8], o[8]; unpack8(grv[u], gr);
#pragma unroll
                for (int e = 0; e < 8; ++e) o[e] = gelu_tanh(gr[e]) * hs[i * 384 + col + e];
                *(v4u*)(Y + row * D + 640 + col) = pack8(o); } }
        __syncthreads();
    }
}

#define XB_TMO      128
#define XB_XCNT(j)  (256  + 64 * (j))
#define XB_XSUB(j)  (1280 + 64 * (j))
#define XB_XGEN(j)  (2304 + 64 * (j))
#define XB_TOP      3328
#define XB_TOPGEN   3392
#define XCD_BAR_WORDS 3456
#define XB_SPIN_CAP (1u << 18)

__device__ __forceinline__ unsigned xb_ld(unsigned* p)              { return __hip_atomic_load(p, __ATOMIC_RELAXED, __HIP_MEMORY_SCOPE_AGENT); }
__device__ __forceinline__ unsigned xb_add(unsigned* p, unsigned v) { return __hip_atomic_fetch_add(p, v, __ATOMIC_RELAXED, __HIP_MEMORY_SCOPE_AGENT); }
__device__ __forceinline__ unsigned xb_xcc_id() { return (unsigned)__builtin_amdgcn_s_getreg((3 << 11) | 20) & 0xFu; }
#define XB_SPIN(cond, bar) do { unsigned _sp = 0; while (cond) { __builtin_amdgcn_s_sleep(1); \
    if ((++_sp & 255u) == 0u) { if (xb_ld(&(bar)[XB_TMO])) break; if (_sp > XB_SPIN_CAP) { atomicAdd(&(bar)[XB_TMO], 1u); break; } } } } while (0)

struct XcdBarrier {
    unsigned* bar; unsigned x;
    volatile LAS unsigned* st;
};

__device__ __forceinline__ XcdBarrier xcd_barrier_post(unsigned* bar, volatile LAS unsigned* st) {
    XcdBarrier b; b.bar = bar; b.x = xb_xcc_id(); b.st = st;
    if (threadIdx.x == 0) (void)xb_add(&bar[XB_XCNT(b.x)], 1u);
    return b;
}
__device__ __forceinline__ void xcd_barrier_complete(unsigned* bar, unsigned x, unsigned& nloc, unsigned& nx) {
    const unsigned G = gridDim.x * gridDim.y * gridDim.z;
    unsigned sum, cnt, mine, sp = 0u;
    for (;;) {
        sum = 0u; cnt = 0u; mine = 0u;
#pragma unroll
        for (unsigned j = 0; j < 16; ++j) { const unsigned c = xb_ld(&bar[XB_XCNT(j)]); sum += c; cnt += (c > 0u) ? 1u : 0u; mine = (j == x) ? c : mine; }
        if (sum == G) break;
        __builtin_amdgcn_s_sleep(1);
        if ((++sp & 255u) == 0u) { if (xb_ld(&bar[XB_TMO])) break; if (sp > XB_SPIN_CAP) { atomicAdd(&bar[XB_TMO], 1u); break; } }
    }
    nloc = mine > 0u ? mine : 1u; nx = cnt > 0u ? cnt : 1u;
}

__device__ __forceinline__ void xcd_barrier(const XcdBarrier& b) {
    asm volatile("s_waitcnt vmcnt(0)" ::: "memory");
    __syncthreads();
    if (threadIdx.x == 0) {
        unsigned* bar = b.bar;
        __builtin_amdgcn_s_waitcnt(0);
        unsigned nloc = b.st[0], nx = b.st[1];
        if (nloc == 0u) { xcd_barrier_complete(bar, b.x, nloc, nx); b.st[0] = nloc; b.st[1] = nx; }
        const unsigned old = xb_add(&bar[XB_XSUB(b.x)], 1u);
        const unsigned gen = old / nloc;
        if (old + 1u == (gen + 1u) * nloc) {
            __builtin_amdgcn_fence(__ATOMIC_RELEASE, "agent");
            asm volatile("s_waitcnt vmcnt(0)" ::: "memory");
            const unsigned og = xb_add(&bar[XB_TOP], 1u);
            const unsigned tg = og / nx;
            if (og + 1u == (tg + 1u) * nx) xb_add(&bar[XB_TOPGEN], 1u);
            else XB_SPIN(xb_ld(&bar[XB_TOPGEN]) == tg, bar);
            __builtin_amdgcn_fence(__ATOMIC_ACQUIRE, "agent");
            xb_add(&bar[XB_XGEN(b.x)], 1u);
            asm volatile("s_waitcnt vmcnt(0)" ::: "memory");
        } else {
            XB_SPIN(xb_ld(&bar[XB_XGEN(b.x)]) == gen, bar);
            __builtin_amdgcn_fence(__ATOMIC_ACQUIRE, "agent");
            asm volatile("s_waitcnt vmcnt(0)" ::: "memory");
        }
    }
    __syncthreads();
}

constexpr int PH_PER_LAYER = 13, N_PHASES = 1 + DEPTH * PH_PER_LAYER + 1;
__global__ void __launch_bounds__(NTHR, 2) fwd_megakernel(Args A0) {
    extern __shared__ __attribute__((aligned(16))) unsigned char lds_raw[];
    LAS unsigned char* lds = (LAS unsigned char*)lds_raw;
    cg::grid_group grid = cg::this_grid();
    const int ph_lo = A0.ph_lo, ph_hi = A0.ph_hi;
    volatile LAS unsigned* bst = (volatile LAS unsigned*)(lds + 131072);
    if (threadIdx.x < 2) bst[threadIdx.x] = 0u;
    __syncthreads();
    const XcdBarrier xbar = xcd_barrier_post((unsigned*)(A0.ws + WS_BAR), bst);
    const int wave0 = __builtin_amdgcn_readfirstlane((int)threadIdx.x >> 6);
    bool rep_done = false; (void)rep_done;
    for (int ph = ph_lo; ph < ph_hi; ++ph) {
        CArgsP A = (CArgsP)__builtin_amdgcn_kernarg_segment_ptr();
        asm volatile("" : "+s"(A) :: "memory");
        int G = gridDim.x, bx = blockIdx.x, wave = wave0;
        asm volatile("" : "+s"(G), "+s"(bx), "+s"(wave));
#define IDS() int lane; asm volatile("v_mbcnt_lo_u32_b32 %0, -1, 0\n\tv_mbcnt_hi_u32_b32 %0, -1, %0" : "=v"(lane)); const int tid = wave * 64 + lane; (void)tid
        const WS W = make_ws(A->ws);
        if (ph == 0) { IDS(); mods_phase(bx, G, A, W, lds, tid, lane, wave); convert_phase(bx, G, A, W.wt, 0, lds, lane, wave); }
        else if (ph == N_PHASES - 1) { IDS(); final_norm_phase(bx, G, A->out, A->in[I_GFINAL], lane, wave); }
        else {
            const int l = (ph - 1) / PH_PER_LAYER, s = (ph - 1) % PH_PER_LAYER; const bool last = (l == DEPTH - 1);
            const float* mods_l = W.mods + (size_t)l * 9 * 9216;
            const bf16* WTL = (l & 1) ? W.wt2 : W.wt;
            const float* xlat = A->out; const float* xctx = W.xrctx;
            if (s == 0) { IDS();
                norm_phase(bx, G, l == 0 ? A->in[I_X] : xlat, l == 0 ? A->in[I_CTX] : xctx, A->in[I_GFFN1] + l * D, mods_l, 0, 1, W.H, MTOT, lane, wave);
            } else if (s == 1 || s == 11) { IDS();
                pg8::Gemm g{W.H, WTL + (s == 1 ? WT_GU1 : WT_GU2), (s == 11 && last) ? MLAT : MTOT, 2 * DFF, D}; pg8::StaticOrder S; S.init(g.M, g.N, G, bx);
                EpiSwiGLU E{W.ACT};
                pg8::gemm_phase<EpiSwiGLU, pg8::StaticOrder, true, true>(lds, g, S, E, tid);
            } else if (s == 2 || s == 9 || s == 12) { IDS();
                pg8::Gemm g{s == 9 ? W.H : W.ACT, WTL + (s == 2 ? WT_DOWN1 : s == 9 ? WT_OUT : WT_DOWN2), (s != 2 && last) ? MLAT : MTOT, D, s == 9 ? D : DFF};
                pg8::StaticOrder S; S.init(g.M, g.N, G, bx);
                const bool first = (l == 0 && s == 2);
                EpiResid E{first ? A->in[I_X] : xlat, first ? A->in[I_CTX] : xctx, A->out, W.xrctx, mods_l + (s == 2 ? 2 : s == 9 ? 5 : 8) * 1024, s == 9 ? 1.0f : 0.5f};
                pg8::gemm_phase<EpiResid, pg8::StaticOrder, true, true>(lds, g, S, E, tid);
            } else if (s == 3) { IDS();
                norm_phase(bx, G, xlat, xctx, A->in[I_GMIX] + l * D, mods_l, 3, 4, W.H, MTOT, lane, wave);
            } else if (s == 4) { IDS();
                pg8::Gemm g{W.H, WTL + WT_IN, MTOT, INCP, D}; pg8::StaticOrder S; S.init(g.M, g.N, G, bx);
                EpiP E{W.P, INCP};
                pg8::gemm_phase<EpiP, pg8::StaticOrder, true, true>(lds, g, S, E, tid);
            } else if (s == 5) { IDS();
                pre_phase(bx, G, A, W, l, lds, tid, lane, wave);
            } else if (s == 6) { IDS();
                int Kl = LORA_K, Nl = LORA_N; asm volatile("" : "+s"(Kl), "+s"(Nl));
                pg8::Gemm g{(const bf16*)((const unsigned char*)W.H + HB_AP), WTL + WT_LORA, MTOT, Nl, Kl}; pg8::StaticOrder S; S.init(g.M, g.N, G, bx);
                EpiLora E{A->in[I_W0] + l * 2 * RW, A->in[I_A0] + l * 2 * RW, A->in[I_KA] + l * RW, (const bf16*)((const unsigned char*)W.H + HB_KT), W.sc_kk, W.scb, W.P, l & 1};
                pg8::gemm_phase<EpiLora, pg8::StaticOrder, true, true>(lds, g, S, E, tid);
            } else if (s == 7) { IDS();
                for (int u = bx; u < 240; u += G) {
                    if (u < 192) rwkv_scan_phase(W, l, u, lds, tid, lane, wave); else lru_scan_phase(A, W, l, u - 192, lds, tid, lane, wave);
                    __syncthreads();
                }
                if (!last) {
                    if (G > 240) { if (bx >= 240) convert_phase(bx - 240, G - 240, A, ((l + 1) & 1) ? W.wt2 : W.wt, l + 1, lds, lane, wave); }
                    else convert_phase(bx, G, A, ((l + 1) & 1) ? W.wt2 : W.wt, l + 1, lds, lane, wave);
                }
            } else if (s == 8) { IDS();
                post_phase(bx, G, A, W, l, lds, tid, lane, wave);
            } else if (s == 10) { IDS();
                norm_phase(bx, G, xlat, xctx, A->in[I_GFFN2] + l * D, mods_l, 6, 7, W.H, last ? MLAT : MTOT, lane, wave);
            }
        }
#ifdef PROBE_REP_S
        if (ph > 0 && ph < N_PHASES - 1 && ((ph - 1) % PH_PER_LAYER) == PROBE_REP_S && !rep_done) { rep_done = true; grid.sync(); --ph; continue; }
        rep_done = false;
#endif
        if (ph + 1 < ph_hi) { if (ph == ph_lo) grid.sync(); else xcd_barrier(xbar); }
    }
}

#ifndef MK_MULTI
#define MK_MULTI 0
#endif
extern "C" void kernel_launch(void* const* d_in, const int* in_sizes, int n_in, void* d_out, int out_size, void* d_ws, size_t ws_size, hipStream_t stream) {
    static int grid = 0;
    if (grid == 0) {
        if (n_in != N_IN || out_size != MLAT * D || ws_size < WS_END) { fprintf(stderr, "kernel_launch: unexpected shapes (n_in %d out %d ws %zu)\n", n_in, out_size, ws_size); grid = -1; return; }
        int dev = 0, cus = 0, per_cu = 0;
        (void)hipGetDevice(&dev); (void)hipDeviceGetAttribute(&cus, hipDeviceAttributeMultiprocessorCount, dev);
        if (hipFuncSetAttribute((const void*)fwd_megakernel, hipFuncAttributeMaxDynamicSharedMemorySize, LDS_BYTES) != hipSuccess) { fprintf(stderr, "kernel_launch: hipFuncSetAttribute failed\n"); grid = -1; return; }
        if (hipOccupancyMaxActiveBlocksPerMultiprocessor(&per_cu, (const void*)fwd_megakernel, NTHR, LDS_BYTES) != hipSuccess || per_cu < 1) { fprintf(stderr, "kernel_launch: occupancy query says %d\n", per_cu); per_cu = 1; }
        (void)hipGetLastError();
        grid = cus * 1;
        if (grid <= 0) grid = 256;
    }
    if (grid < 0) return;
    if (hipMemsetAsync((unsigned char*)d_ws + WS_BAR, 0, WS_BAR_BYTES, stream) != hipSuccess) { fprintf(stderr, "kernel_launch: memset of the barrier words failed\n"); return; }
    Args a{};
    for (int i = 0; i < N_IN; ++i) a.in[i] = (const float*)d_in[i];
    a.out = (float*)d_out; a.ws = (unsigned char*)d_ws;
#if MK_MULTI
    for (int ph = 0; ph < N_PHASES; ++ph) { a.ph_lo = ph; a.ph_hi = ph + 1; hipLaunchKernelGGL(fwd_megakernel, dim3(grid), dim3(NTHR), LDS_BYTES, stream, a); }
#else
    a.ph_lo = 0; a.ph_hi = N_PHASES;
    void* args[] = {&a};
    hipError_t e = hipLaunchCooperativeKernel((const void*)fwd_megakernel, dim3(grid), dim3(NTHR), args, LDS_BYTES, stream);
    if (e != hipSuccess) fprintf(stderr, "kernel_launch: cooperative launch failed: %s (grid %d)\n", hipGetErrorString(e), grid);
#endif
}
```

```cpp
#include <hip/hip_runtime.h>
#include <hip/hip_cooperative_groups.h>
#include <cstdio>
#include <cstdint>
namespace cg = cooperative_groups;
namespace pg8 {
#define PG8_LAS __attribute__((address_space(3)))
typedef unsigned short bf16_t;
typedef short bf16x8 __attribute__((ext_vector_type(8)));
typedef float f32x4 __attribute__((ext_vector_type(4)));
typedef unsigned u32x4 __attribute__((ext_vector_type(4)));
constexpr int BM = 256, BK = 64, HALF = 128, HTB = HALF * BK * 2  , STAGE_BYTES = 8 * HTB, NXCD = 8, WGM = 8;

__host__ __device__ __forceinline__ int lds_byte(int r, int c) { const int st = (r >> 4) * 2 + (c >> 5), rr = r & 15, cc = c & 31, ob = rr * 64 + cc * 2; return st * 1024 + (ob ^ (((ob >> 9) & 1) << 5)); }
__host__ __device__ __forceinline__ void stage_rc(int b, int& R, int& C) { const int st = b / 1024, sb = b % 1024, swz = sb ^ (((sb >> 9) & 1) << 5); R = (st >> 1) * 16 + swz / 64; C = (st & 1) * 32 + (swz % 64) / 2; }
__host__ __device__ __forceinline__ int perm32(int rho) { const int n = rho >> 4, i = rho & 15; return 8 * (i >> 2) + 4 * n + (i & 3); }

struct Unit { int pm, pn; };
struct Gemm { const bf16_t* A; const bf16_t* Bt; int M, N, K; };

struct StaticOrder {
    int nM, nN, nwg, G, c;
    __host__ __device__ void init(int M, int N, int G_, int c_) { nM = M / BM; nN = N / BM; nwg = nM * nN; G = G_; c = c_; }
    __host__ __device__ bool next(int i, Unit& u) const {
        const long L = (long)i * G + c; if (L >= nwg) return false;
        int wgid = (int)L; { const int q = nwg / NXCD, r = nwg % NXCD, xcd = wgid % NXCD, off = wgid / NXCD; wgid = (xcd < r ? xcd * (q + 1) : r * (q + 1) + (xcd - r) * q) + off; }
        const int nig = WGM * nN, gid = wgid / nig, fm = gid * WGM, gsz = (nM - fm) < WGM ? (nM - fm) : WGM;
        u.pm = fm + ((wgid % nig) % gsz); u.pn = (wgid % nig) / gsz; return true;
    }
    __device__ __forceinline__ void a_ready(const Unit&) const {}
    __device__ __forceinline__ void done(const Unit&) const {}
};

template <class Epi, class Sched, bool ALIGN_EPI = false, bool SP2 = false>
__device__ __forceinline__ void gemm_phase(PG8_LAS unsigned char* lds, const Gemm g, const Sched& S, const Epi& E, const int tid) {
    const int wid = __builtin_amdgcn_readfirstlane(tid >> 6), lane = tid & 63, wr = wid >> 2, wc = wid & 3, fr = lane & 15, fq = lane >> 4;
    const int K = g.K, nt = K / BK;
    unsigned voffA[2], voffB[2];
#pragma unroll
    for (int i = 0; i < 2; ++i) { int R, C; stage_rc(tid * 16 + i * 8192, R, C); const int Rb = Epi::PERM ? ((R & ~31) + perm32(R & 31)) : R;
        voffA[i] = (unsigned)(R * K + C) * 2u; voffB[i] = (unsigned)(Rb * K + C) * 2u; }
    const size_t kstep = (size_t)(BK * 2);
    const size_t hstep = (size_t)HALF * K * 2;
    const size_t tstep = 2 * hstep;
    const unsigned ldsw = (unsigned)wid * 1024u;
    const int aoff = lds_byte(wr * 64 + fr, fq * 8), boff = lds_byte(wc * 32 + fr, fq * 8);
#define PG8_SA(b, h) (((b) * 2 + (h)) * HTB)
#define PG8_SB(b, h) ((4 + (b) * 2 + (h)) * HTB)
#define PG8_STAGE(bufoff, gbase, voff) do { _Pragma("unroll") for (int _i = 0; _i < 2; ++_i) \
        __builtin_amdgcn_global_load_lds((const unsigned*)((const char*)(gbase) + (voff)[_i]), (PG8_LAS unsigned*)(lds + (bufoff) + ldsw + _i * 8192), 16, 0, 0); } while (0)
#define PG8_LDA(dst, b, h) do { _Pragma("unroll") for (int m = 0; m < 4; ++m) _Pragma("unroll") for (int k = 0; k < 2; ++k) dst[m][k] = *(const PG8_LAS bf16x8*)(lds + PG8_SA(b, h) + aoff + m * 2048 + k * 1024); } while (0)
#define PG8_LDB(dst, b, h) do { _Pragma("unroll") for (int n = 0; n < 2; ++n) _Pragma("unroll") for (int k = 0; k < 2; ++k) dst[n][k] = *(const PG8_LAS bf16x8*)(lds + PG8_SB(b, h) + boff + n * 2048 + k * 1024); } while (0)
#define PG8_MMA(ai, bj, At, Bt) do { __builtin_amdgcn_s_setprio(1); _Pragma("unroll") for (int m = 0; m < 4; ++m) _Pragma("unroll") for (int n = 0; n < 2; ++n) _Pragma("unroll") for (int k = 0; k < 2; ++k) \
        acc[ai][bj][m][n] = __builtin_amdgcn_mfma_f32_16x16x32_bf16(Bt[n][k], At[m][k], acc[ai][bj][m][n], 0, 0, 0); __builtin_amdgcn_s_setprio(0); } while (0)
#define PG8_WAIT_V(n) asm volatile("s_waitcnt vmcnt(" #n ")" ::: "memory")
#define PG8_WAIT_L(n) asm volatile("s_waitcnt lgkmcnt(" #n ")" ::: "memory")
#define PG8_BAR __builtin_amdgcn_s_barrier()
#define PG8_SCHED __builtin_amdgcn_sched_barrier(0)
    Unit cur, nxt; int ui = 0;
    if (!S.next(0, cur)) return;
    f32x4 acc[2][2][4][2];
#pragma unroll
    for (int a = 0; a < 2; ++a)
#pragma unroll
        for (int b = 0; b < 2; ++b)
#pragma unroll
            for (int m = 0; m < 4; ++m)
#pragma unroll
                for (int n = 0; n < 2; ++n) acc[a][b][m][n] = (f32x4){0.f, 0.f, 0.f, 0.f};
    bf16x8 At[4][2], B0[2][2], B1[2][2];
    const char* cA = (const char*)g.A + (size_t)cur.pm * tstep; const char* cB = (const char*)g.Bt + (size_t)cur.pn * tstep;
    S.a_ready(cur);
    if constexpr (SP2) {
        PG8_STAGE(PG8_SB(0, 0), cB, voffB); PG8_STAGE(PG8_SB(0, 1), cB + hstep, voffB); PG8_STAGE(PG8_SA(0, 0), cA, voffA); PG8_STAGE(PG8_SA(0, 1), cA + hstep, voffA);
        if (wr == 1) PG8_BAR;
        PG8_WAIT_V(2); PG8_BAR;
        PG8_STAGE(PG8_SB(1, 0), cB + kstep, voffB); PG8_STAGE(PG8_SA(1, 0), cA + kstep, voffA); PG8_STAGE(PG8_SB(1, 1), cB + hstep + kstep, voffB);
        PG8_WAIT_V(6); PG8_BAR;
    } else {
        PG8_STAGE(PG8_SB(0, 0), cB, voffB); PG8_STAGE(PG8_SA(0, 0), cA, voffA); PG8_STAGE(PG8_SB(0, 1), cB + hstep, voffB); PG8_STAGE(PG8_SA(0, 1), cA + hstep, voffA);
        if (wr == 1) PG8_BAR;
        PG8_WAIT_V(4); PG8_BAR;
        PG8_STAGE(PG8_SB(1, 0), cB + kstep, voffB); PG8_STAGE(PG8_SA(1, 0), cA + kstep, voffA); PG8_STAGE(PG8_SB(1, 1), cB + hstep + kstep, voffB);
        PG8_WAIT_V(6); PG8_BAR;
    }
    for (;;) {
        const bool has_next = S.next(ui + 1, nxt);
        const char* nA = has_next ? (const char*)g.A + (size_t)nxt.pm * tstep : cA; const char* nB = has_next ? (const char*)g.Bt + (size_t)nxt.pn * tstep : cB;
        for (int t = 0; t < nt; t += 2) {
            const bool last = (t == nt - 2);
            const char* a1 = cA + (size_t)(t + 1) * kstep;
            const char* a2 = last ? nA : cA + (size_t)(t + 2) * kstep; const char* b2 = last ? nB : cB + (size_t)(t + 2) * kstep;
            const char* a3 = a2 + kstep; const char* b3 = b2 + kstep;
            if (last && has_next) S.a_ready(nxt);
            if constexpr (SP2) {
            PG8_LDB(B0, 0, 0); PG8_LDB(B1, 0, 1); PG8_SCHED; PG8_LDA(At, 0, 0); PG8_STAGE(PG8_SA(1, 1), a1 + hstep, voffA);
            PG8_WAIT_V(8); PG8_WAIT_L(0); PG8_BAR; PG8_MMA(0, 0, At, B0); PG8_MMA(0, 1, At, B1); PG8_BAR; PG8_SCHED;
            PG8_LDA(At, 0, 1); PG8_STAGE(PG8_SB(0, 0), b2, voffB); PG8_STAGE(PG8_SB(0, 1), b2 + hstep, voffB); PG8_STAGE(PG8_SA(0, 0), a2, voffA);
            PG8_WAIT_V(8); PG8_WAIT_L(0); PG8_BAR; PG8_MMA(1, 0, At, B0); PG8_MMA(1, 1, At, B1); PG8_BAR; PG8_SCHED;
            PG8_LDB(B0, 1, 0); PG8_LDB(B1, 1, 1); PG8_SCHED; PG8_LDA(At, 1, 0); PG8_STAGE(PG8_SA(0, 1), a2 + hstep, voffA);
            PG8_WAIT_V(8); PG8_WAIT_L(0); PG8_BAR; PG8_MMA(0, 0, At, B0); PG8_MMA(0, 1, At, B1); PG8_BAR; PG8_SCHED;
            PG8_LDA(At, 1, 1); PG8_STAGE(PG8_SB(1, 0), b3, voffB); PG8_STAGE(PG8_SB(1, 1), b3 + hstep, voffB); PG8_STAGE(PG8_SA(1, 0), a3, voffA);
            PG8_WAIT_V(8); PG8_WAIT_L(0); PG8_BAR; PG8_MMA(1, 0, At, B0); PG8_MMA(1, 1, At, B1); PG8_BAR; PG8_SCHED;
            } else {
            PG8_LDB(B0, 0, 0); PG8_SCHED; PG8_LDA(At, 0, 0); PG8_STAGE(PG8_SA(1, 1), a1 + hstep, voffA);
            PG8_WAIT_L(8); PG8_BAR; PG8_WAIT_L(0); PG8_MMA(0, 0, At, B0); PG8_BAR; PG8_SCHED;
            PG8_LDB(B1, 0, 1); PG8_STAGE(PG8_SB(0, 0), b2, voffB);
            PG8_BAR; PG8_WAIT_L(0); PG8_MMA(0, 1, At, B1); PG8_BAR;
            PG8_LDA(At, 0, 1); PG8_STAGE(PG8_SA(0, 0), a2, voffA);
            PG8_BAR; PG8_WAIT_L(0); PG8_MMA(1, 0, At, B0); PG8_BAR; PG8_SCHED;
            PG8_STAGE(PG8_SB(0, 1), b2 + hstep, voffB);
            PG8_WAIT_V(6); PG8_BAR; PG8_MMA(1, 1, At, B1); PG8_BAR;
            PG8_LDB(B0, 1, 0); PG8_SCHED; PG8_LDA(At, 1, 0); PG8_STAGE(PG8_SA(0, 1), a2 + hstep, voffA);
            PG8_WAIT_L(8); PG8_BAR; PG8_WAIT_L(0); PG8_MMA(0, 0, At, B0); PG8_BAR; PG8_SCHED;
            PG8_LDB(B1, 1, 1); PG8_STAGE(PG8_SB(1, 0), b3, voffB);
            PG8_BAR; PG8_WAIT_L(0); PG8_MMA(0, 1, At, B1); PG8_BAR;
            PG8_LDA(At, 1, 1); PG8_STAGE(PG8_SA(1, 0), a3, voffA);
            PG8_BAR; PG8_WAIT_L(0); PG8_MMA(1, 0, At, B0); PG8_BAR; PG8_SCHED;
            PG8_STAGE(PG8_SB(1, 1), b3 + hstep, voffB);
            PG8_WAIT_V(6); PG8_BAR; PG8_MMA(1, 1, At, B1); PG8_BAR;
            }
        }
        if constexpr (ALIGN_EPI) { if (wr == 0) PG8_BAR; }
        if constexpr (!Epi::AFTER_DRAIN) { E(acc, cur, wr, wc, fr, fq); S.done(cur); }
        if (!has_next) break;
#pragma unroll
        for (int a = 0; a < 2; ++a)
#pragma unroll
            for (int b = 0; b < 2; ++b)
#pragma unroll
                for (int m = 0; m < 4; ++m)
#pragma unroll
                    for (int n = 0; n < 2; ++n) acc[a][b][m][n] = (f32x4){0.f, 0.f, 0.f, 0.f};
        cur = nxt; cA = nA; cB = nB; ++ui;
        if constexpr (ALIGN_EPI) { if (wr == 1) PG8_BAR; }
    }
    PG8_WAIT_V(0);
    if constexpr (!ALIGN_EPI) { if (wr == 0) PG8_BAR; }
    PG8_BAR;
    if constexpr (Epi::AFTER_DRAIN) { E.fused(acc, cur, wr, wc, fr, fq, lds, wid, lane); S.done(cur); }
#undef PG8_SA
#undef PG8_SB
#undef PG8_STAGE
#undef PG8_LDA
#undef PG8_LDB
#undef PG8_MMA
#undef PG8_WAIT_V
#undef PG8_WAIT_L
#undef PG8_BAR
#undef PG8_SCHED
}
}
#define LAS __attribute__((address_space(3)))
typedef unsigned short bf16;
typedef unsigned v4u __attribute__((ext_vector_type(4)));
typedef unsigned v2u __attribute__((ext_vector_type(2)));
typedef float f32x4 __attribute__((ext_vector_type(4)));
typedef float f32x2 __attribute__((ext_vector_type(2)));

constexpr int D = 1024, NB = 8, SEQ = 4096, CTX = 256, DEPTH = 4, DFF = 2816;
constexpr int MLAT = NB * SEQ, MCTX = NB * CTX, MTOT = MLAT + MCTX;
constexpr int INC = 2944, INCP = 3072;
constexpr int RW = 384, LW = 384, RC = 1408;
constexpr int QLEN = CTX + SEQ;
constexpr int PC_BG = 0, PC_CG = 256, PC_XIN = 512, PC_RW = 768, PC_XR = 2176, PC_GR = 2560;
constexpr int PC_Y = 768;
constexpr int PC_G = 1536;
constexpr int LORA_N = 2048, LORA_K = 256;
constexpr int NWAVES = 8, NTHR = 512;
constexpr int LDS_BYTES = 147456;

constexpr size_t MiB = 1u << 20;
constexpr size_t WS_BAR = 1536 * 1024, WS_BAR_BYTES = 16384;
constexpr size_t WS_MODS = 0, WS_XRCTX = 2 * MiB, WS_WT = 10 * MiB, WS_H = 52 * MiB, WS_A = 120 * MiB, WS_B = 324 * MiB;
constexpr size_t SC_ELEMS = (size_t)NB * QLEN * RW;
constexpr size_t WS_WT2 = WS_B + 9 * SC_ELEMS * 2;
constexpr size_t WS_END = WS_WT2 + 42 * MiB;
static_assert(WS_END <= 600 * MiB, "workspace map");
static_assert(WS_A + (size_t)MTOT * INCP * 2 <= WS_B, "P fits");
constexpr size_t WT_GU1 = 0, WT_DOWN1 = WT_GU1 + (size_t)2 * DFF * D, WT_IN = WT_DOWN1 + (size_t)D * DFF, WT_OUT = WT_IN + (size_t)INCP * D,
                 WT_GU2 = WT_OUT + (size_t)D * D, WT_DOWN2 = WT_GU2 + (size_t)2 * DFF * D, WT_TOTAL = WT_DOWN2 + (size_t)D * DFF;
constexpr size_t WT_LORA = WT_TOTAL;
static_assert(WS_WT + (WT_TOTAL + (size_t)LORA_N * LORA_K) * 2 <= WS_H, "weights fit");
constexpr size_t HB_AP = 0, HB_KT = (size_t)MTOT * LORA_K * 2;
static_assert(HB_KT + (size_t)MTOT * RW * 2 <= WS_A - WS_H, "H region overlay");

enum { I_X = 0, I_C, I_CTX, I_CCTX, I_WMOD, I_BMOD, I_GFFN1, I_WGU1, I_WDOWN1, I_GMIX, I_WIN, I_CONVA, I_MU, I_W0, I_W2, I_A0, I_A2, I_G2, I_KK, I_KA, I_RK,
       I_LNG, I_LNB, I_LCW, I_LCB, I_LWR, I_LBR, I_LWI, I_LBI, I_LAM, I_WOUT, I_GFFN2, I_WGU2, I_WDOWN2, I_GFINAL, N_IN };

struct Args { const float* in[N_IN]; float* out; unsigned char* ws; int ph_lo, ph_hi; };
typedef const __attribute__((address_space(4))) Args* CArgsP;

__device__ __forceinline__ float bf2f(unsigned h) { return __builtin_bit_cast(float, h << 16); }
__device__ __forceinline__ unsigned f2bf(float f) { unsigned u = __builtin_bit_cast(unsigned, f); return (u + 0x7fffu + ((u >> 16) & 1u)) >> 16; }
__device__ __forceinline__ unsigned pk2(float lo, float hi) { unsigned r; asm("v_cvt_pk_bf16_f32 %0, %1, %2" : "=v"(r) : "v"(lo), "v"(hi)); return r; }
__device__ __forceinline__ void unpack8(v4u p, float* o) {
    o[0] = __builtin_bit_cast(float, p.x << 16); o[1] = __builtin_bit_cast(float, p.x & 0xffff0000u);
    o[2] = __builtin_bit_cast(float, p.y << 16); o[3] = __builtin_bit_cast(float, p.y & 0xffff0000u);
    o[4] = __builtin_bit_cast(float, p.z << 16); o[5] = __builtin_bit_cast(float, p.z & 0xffff0000u);
    o[6] = __builtin_bit_cast(float, p.w << 16); o[7] = __builtin_bit_cast(float, p.w & 0xffff0000u);
}
__device__ __forceinline__ v4u pack8(const float* v) { v4u o; o.x = pk2(v[0], v[1]); o.y = pk2(v[2], v[3]); o.z = pk2(v[4], v[5]); o.w = pk2(v[6], v[7]); return o; }
template <int CTRL> __device__ __forceinline__ float dppf(float v) { return __builtin_bit_cast(float, __builtin_amdgcn_update_dpp(0, __builtin_bit_cast(int, v), CTRL, 0xF, 0xF, true)); }
__device__ __forceinline__ float wave_sum(float v) {
    v += dppf<0xB1>(v); v += dppf<0x4E>(v); v += dppf<0x141>(v); v += dppf<0x140>(v);
    const float a = __builtin_bit_cast(float, __builtin_amdgcn_readlane(__builtin_bit_cast(int, v), 0)), b = __builtin_bit_cast(float, __builtin_amdgcn_readlane(__builtin_bit_cast(int, v), 16));
    const float c = __builtin_bit_cast(float, __builtin_amdgcn_readlane(__builtin_bit_cast(int, v), 32)), d = __builtin_bit_cast(float, __builtin_amdgcn_readlane(__builtin_bit_cast(int, v), 48));
    return (a + b) + (c + d);
}
__device__ __forceinline__ float sigmoidf_(float x) { return __builtin_amdgcn_rcpf(1.0f + __expf(-x)); }
__device__ __forceinline__ float siluf_(float x) { return x * __builtin_amdgcn_rcpf(1.0f + __expf(-x)); }
__device__ __forceinline__ float softplusf_(float z) { return fmaxf(z, 0.f) + log1pf(__expf(-fabsf(z))); }
__device__ __forceinline__ float tanh_fast(float x) { const float e = __expf(2.0f * fminf(fmaxf(x, -15.f), 15.f)); return 1.0f - 2.0f * __builtin_amdgcn_rcpf(e + 1.0f); }
__device__ __forceinline__ float gelu_tanh(float x) { const float u = 0.7978845608028654f * (x + 0.044715f * x * x * x); return 0.5f * x * (1.0f + tanh_fast(u)); }
__device__ __forceinline__ float rscatter16(const float (&v)[16], int j) {
    const bool b1 = (j & 8) != 0, b2 = (j & 4) != 0, b3 = (j & 2) != 0, b4 = (j & 1) != 0;
    float a[8], c[4], d[2];
#pragma unroll
    for (int k = 0; k < 8; ++k) { const float keep = b1 ? v[k + 8] : v[k], send = b1 ? v[k] : v[k + 8]; a[k] = keep + dppf<0x140>(send); }
#pragma unroll
    for (int k = 0; k < 4; ++k) { const float keep = b2 ? a[k + 4] : a[k], send = b2 ? a[k] : a[k + 4]; c[k] = keep + dppf<0x141>(send); }
#pragma unroll
    for (int k = 0; k < 2; ++k) { const float keep = b3 ? c[k + 2] : c[k], send = b3 ? c[k] : c[k + 2]; d[k] = keep + dppf<0x4E>(send); }
    { const float keep = b4 ? d[1] : d[0], send = b4 ? d[0] : d[1]; return keep + dppf<0xB1>(send); }
}
__device__ __forceinline__ float reduce16(float x) { x += dppf<0xB1>(x); x += dppf<0x4E>(x); x += dppf<0x141>(x); x += dppf<0x140>(x); return x; }
__device__ __forceinline__ float reduce8(float x) { x += dppf<0xB1>(x); x += dppf<0x4E>(x); x += dppf<0x141>(x); return x; }
__device__ __forceinline__ int row_of(int b, int q, int odd) {
    if (q < CTX) return MLAT + b * CTX + q;
    const int s = q - CTX; const int t = odd ? (((s & 63) << 6) | (s >> 6)) : s;
    return b * SEQ + t;
}

struct EpiSwiGLU {
    static constexpr bool PERM = true, AFTER_DRAIN = false;
    bf16* O;
    __device__ __forceinline__ void operator()(const pg8::f32x4 (&acc)[2][2][4][2], const pg8::Unit& u, int wr, int wc, int fr, int fq) const {
        const int row0 = u.pm * 256 + wr * 64 + fr, col0 = u.pn * 128 + wc * 32 + 8 * fq;
#pragma unroll
        for (int ai = 0; ai < 2; ++ai)
#pragma unroll
            for (int m = 0; m < 4; ++m) {
                float o[8];
#pragma unroll
                for (int n = 0; n < 2; ++n)
#pragma unroll
                    for (int j = 0; j < 4; ++j) { const float g = acc[ai][0][m][n][j], up = acc[ai][1][m][n][j]; o[n * 4 + j] = siluf_(g) * up; }
                *(v4u*)(O + (size_t)(row0 + ai * 128 + m * 16) * DFF + col0) = pack8(o);
            }
    }
};
struct EpiP {
    static constexpr bool PERM = true, AFTER_DRAIN = false;
    bf16* O; int ldc;
    __device__ __forceinline__ void operator()(const pg8::f32x4 (&acc)[2][2][4][2], const pg8::Unit& u, int wr, int wc, int fr, int fq) const {
        const int row0 = u.pm * 256 + wr * 64 + fr, col0 = u.pn * 256 + wc * 32 + 8 * fq;
#pragma unroll
        for (int ai = 0; ai < 2; ++ai)
#pragma unroll
            for (int m = 0; m < 4; ++m)
#pragma unroll
                for (int bj = 0; bj < 2; ++bj) {
                    float o[8];
#pragma unroll
                    for (int n = 0; n < 2; ++n)
#pragma unroll
                        for (int j = 0; j < 4; ++j) o[n * 4 + j] = acc[ai][bj][m][n][j];
                    *(v4u*)(O + (size_t)(row0 + ai * 128 + m * 16) * ldc + col0 + bj * 128) = pack8(o);
                }
    }
};
struct EpiResid {
    static constexpr bool PERM = true, AFTER_DRAIN = false;
    const float* res_lat; const float* res_ctx; float* dst_lat; float* dst_ctx; const float* gate; float coef;
    __device__ __forceinline__ void operator()(const pg8::f32x4 (&acc)[2][2][4][2], const pg8::Unit& u, int wr, int wc, int fr, int fq) const {
        const int rowbase = u.pm * 256; const bool isctx = rowbase >= MLAT;
        const int b = isctx ? 8 : (rowbase >> 12);
        const float* res = isctx ? res_ctx + (size_t)(rowbase - MLAT) * D : res_lat + (size_t)rowbase * D;
        float* dst = isctx ? dst_ctx + (size_t)(rowbase - MLAT) * D : dst_lat + (size_t)rowbase * D;
#pragma unroll
        for (int bj = 0; bj < 2; ++bj) {
            const int col = u.pn * 256 + bj * 128 + wc * 32 + 8 * fq;
            const f32x4 g0 = *(const f32x4*)(gate + (size_t)b * 9216 + col) * coef, g1 = *(const f32x4*)(gate + (size_t)b * 9216 + col + 4) * coef;
#pragma unroll
            for (int ai = 0; ai < 2; ++ai)
#pragma unroll
                for (int m = 0; m < 4; ++m) {
                    const size_t off = (size_t)(ai * 128 + wr * 64 + m * 16 + fr) * D + col;
                    const f32x4 r0 = *(const f32x4*)(res + off), r1 = *(const f32x4*)(res + off + 4);
                    *(f32x4*)(dst + off) = r0 + g0 * acc[ai][bj][m][0];
                    *(f32x4*)(dst + off + 4) = r1 + g1 * acc[ai][bj][m][1];
                }
        }
    }
};

struct EpiLora {
    static constexpr bool PERM = true, AFTER_DRAIN = false;
    const float* w0; const float* a0; const float* ka; const bf16* kt; const bf16* kk; bf16* scb; bf16* P; int odd;
    __device__ __forceinline__ void operator()(const pg8::f32x4 (&acc)[2][2][4][2], const pg8::Unit& u, int wr, int wc, int fr, int fq) const {
        asm volatile("" : "+v"(fr), "+v"(fq));
#pragma unroll
        for (int bj = 0; bj < 2; ++bj) {
            const int half = __builtin_amdgcn_readfirstlane(u.pn * 2 + bj), kind = half / 3, c = (half - kind * 3) * 128 + wc * 32 + 8 * fq;
            if (kind >= 5) continue;
#pragma unroll
            for (int ai = 0; ai < 2; ++ai)
#pragma unroll
                for (int m = 0; m < 4; ++m) {
                    const int pos = u.pm * 256 + ai * 128 + wr * 64 + m * 16 + fr;
                    float v[8];
#pragma unroll
                    for (int n = 0; n < 2; ++n)
#pragma unroll
                        for (int j = 0; j < 4; ++j) v[n * 4 + j] = acc[ai][bj][m][n][j];
                    if (kind < 2) {
                        const f32x4 q0 = *(const f32x4*)(w0 + kind * 384 + c), q1 = *(const f32x4*)(w0 + kind * 384 + c + 4);
                        const float p0[8] = {q0.x, q0.y, q0.z, q0.w, q1.x, q1.y, q1.z, q1.w};
#pragma unroll
                        for (int e = 0; e < 8; ++e) { const float wl = p0[e] + v[e];
                            v[e] = 1.0f - __expf(-0.6065306597126334f * sigmoidf_(wl)); }
                        *(v4u*)(scb + (size_t)(7 + kind) * SC_ELEMS + (size_t)pos * RW + c) = pack8(v);
                    } else if (kind < 4) {
                        const f32x4 q0 = *(const f32x4*)(a0 + (kind - 2) * 384 + c), q1 = *(const f32x4*)(a0 + (kind - 2) * 384 + c + 4);
                        const float p0[8] = {q0.x, q0.y, q0.z, q0.w, q1.x, q1.y, q1.z, q1.w};
#pragma unroll
                        for (int e = 0; e < 8; ++e) v[e] = sigmoidf_(p0[e] + v[e]);
                        {   float kkv[8]; unpack8(*(const v4u*)(kk + (size_t)pos * RW + c), kkv);
#pragma unroll
                            for (int e = 0; e < 8; ++e) kkv[e] *= v[e];
                            *(v4u*)(scb + (size_t)(5 + kind - 2) * SC_ELEMS + (size_t)pos * RW + c) = pack8(kkv); }
                        {   float kv[8]; unpack8(*(const v4u*)(kt + (size_t)pos * RW + c), kv);
                            const f32x4 r0 = *(const f32x4*)(ka + c), r1 = *(const f32x4*)(ka + c + 4);
                            const float p1[8] = {r0.x, r0.y, r0.z, r0.w, r1.x, r1.y, r1.z, r1.w};
#pragma unroll
                            for (int e = 0; e < 8; ++e) kv[e] *= (1.0f + (v[e] - 1.0f) * p1[e]);
                            *(v4u*)(scb + (size_t)(3 + kind - 2) * SC_ELEMS + (size_t)pos * RW + c) = pack8(kv); }
                    } else {
                        const int b = pos / QLEN, q = pos - b * QLEN;
                        *(v4u*)(P + (size_t)row_of(b, q, odd) * INCP + PC_G + c) = pack8(v);
                    }
                    asm volatile("" ::: "memory");
                }
        }
    }
};
struct WS {
    float* mods; float* xrctx; bf16* wt; bf16* wt2; bf16* H; bf16* P; bf16* ACT;
    bf16 *scb, *sc_r, *sc_v, *sc_kk, *dgs;
};
__device__ __forceinline__ WS make_ws(unsigned char* ws) {
    WS w; w.mods = (float*)(ws + WS_MODS); w.xrctx = (float*)(ws + WS_XRCTX); w.wt = (bf16*)(ws + WS_WT); w.wt2 = (bf16*)(ws + WS_WT2); w.H = (bf16*)(ws + WS_H); w.P = (bf16*)(ws + WS_A); w.ACT = (bf16*)(ws + WS_A);
    bf16* b = (bf16*)(ws + WS_B);
    w.scb = b; w.sc_r = b; w.sc_v = b + SC_ELEMS; w.sc_kk = b + 2 * SC_ELEMS; w.dgs = b + 9 * SC_ELEMS;
    return w;
}

__device__ __forceinline__ void mods_phase(const int bx, const int G, CArgsP A, const WS& W, LAS unsigned char* lds, int tid, int lane, int wave) {
    LAS float* sl = (LAS float*)lds;
    LAS float* part = sl + 9 * 1024;
    const float* c = A->in[I_C]; const float* cctx = A->in[I_CCTX];
    for (int i = tid; i < 9216; i += NTHR) { const int r = i >> 10, k = i & 1023; const float v = r < 8 ? c[r * 1024 + k] : cctx[k]; sl[i] = siluf_(v); }
    __syncthreads();
    for (int item = bx; item < 288; item += G) {
        const int l = item / 72, cgp = item % 72;
        const float* Wp = A->in[I_WMOD] + (size_t)l * 1024 * 9216 + cgp * 128 + lane * 2;
        float acc[9][2];
#pragma unroll
        for (int r = 0; r < 9; ++r) { acc[r][0] = 0.f; acc[r][1] = 0.f; }
#pragma unroll 8
        for (int kk = 0; kk < 128; ++kk) {
            const int k = wave * 128 + kk;
            const f32x2 w = *(const f32x2*)(Wp + (size_t)k * 9216);
#pragma unroll
            for (int r = 0; r < 9; ++r) { const float s = sl[r * 1024 + k]; acc[r][0] += s * w.x; acc[r][1] += s * w.y; }
        }
#pragma unroll
        for (int r = 0; r < 9; ++r) { part[(wave * 9 + r) * 128 + lane * 2] = acc[r][0]; part[(wave * 9 + r) * 128 + lane * 2 + 1] = acc[r][1]; }
        __syncthreads();
        for (int o = tid; o < 1152; o += NTHR) {
            const int r = o >> 7, cc = o & 127; float s = A->in[I_BMOD][l * 9216 + cgp * 128 + cc];
#pragma unroll
            for (int w8 = 0; w8 < 8; ++w8) s += part[(w8 * 9 + r) * 128 + cc];
            W.mods[(size_t)(l * 9 + r) * 9216 + cgp * 128 + cc] = s;
        }
        __syncthreads();
    }
}

__device__ __forceinline__ void transpose_item(const float* Wsrc, int K, int N, bf16* WT, int kb, int n0, int drow0, LAS float* scr, int lane) {
    const int k0 = 64 * kb;
    float tv[32];
#pragma unroll
    for (int i = 0; i < 32; ++i) tv[i] = Wsrc[(size_t)(k0 + 2 * i + (lane >> 5)) * N + n0 + (lane & 31)];
#pragma unroll
    for (int i = 0; i < 32; ++i) scr[(2 * i + (lane >> 5)) * 33 + (lane & 31)] = tv[i];
    asm volatile("s_waitcnt lgkmcnt(0)" ::: "memory");
    const int c = lane & 7;
#pragma unroll
    for (int j = 0; j < 4; ++j) { const int n = (lane >> 3) + 8 * j; const LAS float* s = scr + (8 * c) * 33 + n;
        v4u o; o.x = pk2(s[0 * 33], s[1 * 33]); o.y = pk2(s[2 * 33], s[3 * 33]); o.z = pk2(s[4 * 33], s[5 * 33]); o.w = pk2(s[6 * 33], s[7 * 33]);
        *(v4u*)(WT + (size_t)(drow0 + n) * K + k0 + 8 * c) = o; }
    asm volatile("s_waitcnt lgkmcnt(0)" ::: "memory");
}
__device__ __forceinline__ int gu_drow(int n0) { return n0 < DFF ? 256 * (n0 >> 7) + (n0 & 127) : 256 * ((n0 - DFF) >> 7) + 128 + ((n0 - DFF) & 127); }
__device__ __forceinline__ void convert_phase(const int bx, const int G, CArgsP A, bf16* wtd, int l, LAS unsigned char* lds, int lane, int wave) {
    LAS float* scr = (LAS float*)(lds + wave * 16384);
    const int gw = bx * NWAVES + wave, NGW = G * NWAVES;
    constexpr int I_GU = (D / 64) * (2 * DFF / 32), I_DN = (DFF / 64) * (D / 32), I_IN = (D / 64) * (INC / 32), I_OUT = (D / 64) * (D / 32);
    constexpr int NITEMS = 2 * I_GU + 2 * I_DN + I_IN + I_OUT;
    for (int it = gw; it < NITEMS; it += NGW) {
        int r = it;
        if (r < I_GU) { const int nblk = 2 * DFF / 32, kb = r / nblk, n0 = (r % nblk) * 32; transpose_item(A->in[I_WGU1] + (size_t)l * D * 2 * DFF, D, 2 * DFF, wtd + WT_GU1, kb, n0, gu_drow(n0), scr, lane); continue; } r -= I_GU;
        if (r < I_GU) { const int nblk = 2 * DFF / 32, kb = r / nblk, n0 = (r % nblk) * 32; transpose_item(A->in[I_WGU2] + (size_t)l * D * 2 * DFF, D, 2 * DFF, wtd + WT_GU2, kb, n0, gu_drow(n0), scr, lane); continue; } r -= I_GU;
        if (r < I_DN) { const int nblk = D / 32, kb = r / nblk, n0 = (r % nblk) * 32; transpose_item(A->in[I_WDOWN1] + (size_t)l * DFF * D, DFF, D, wtd + WT_DOWN1, kb, n0, n0, scr, lane); continue; } r -= I_DN;
        if (r < I_DN) { const int nblk = D / 32, kb = r / nblk, n0 = (r % nblk) * 32; transpose_item(A->in[I_WDOWN2] + (size_t)l * DFF * D, DFF, D, wtd + WT_DOWN2, kb, n0, n0, scr, lane); continue; } r -= I_DN;
        if (r < I_IN) { const int nblk = INC / 32, kb = r / nblk, n0 = (r % nblk) * 32; transpose_item(A->in[I_WIN] + (size_t)l * D * INC, D, INC, wtd + WT_IN, kb, n0, n0, scr, lane); continue; } r -= I_IN;
        { const int nblk = D / 32, kb = r / nblk, n0 = (r % nblk) * 32; transpose_item(A->in[I_WOUT] + (size_t)l * D * D, D, D, wtd + WT_OUT, kb, n0, n0, scr, lane); }
    }
    for (int idx = (bx * NWAVES + wave) * 64 + lane; idx < LORA_N * LORA_K; idx += G * NTHR) {
        const int n = idx % LORA_N, k = idx / LORA_N, kind = n / 384, c = n - kind * 384;
        float v = 0.f;
        if (kind < 2) { if (k < 64) v = A->in[I_W2][((size_t)(l * 2 + kind) * 64 + k) * RW + c]; }
        else if (kind < 4) { if (k >= 64 && k < 128) v = A->in[I_A2][((size_t)(l * 2 + kind - 2) * 64 + (k - 64)) * RW + c]; }
        else if (kind == 4) { if (k >= 128) v = A->in[I_G2][((size_t)l * 128 + (k - 128)) * RW + c]; }
        wtd[WT_LORA + (size_t)n * LORA_K + k] = (bf16)f2bf(v);
    }
}

__device__ __forceinline__ void norm_phase(const int bx, const int G, const float* lat, const float* ctxp, const float* g, const float* mods_l, int ishift, int iscale, bf16* H, int nrows, int lane, int wave) {
    const int gw = bx * NWAVES + wave, NGW = G * NWAVES;
    for (int r0 = gw; r0 < nrows; r0 += 2 * NGW) {
        const int r1 = r0 + NGW < nrows ? r0 + NGW : r0;
        const float* xa = r0 < MLAT ? lat + (size_t)r0 * D : ctxp + (size_t)(r0 - MLAT) * D;
        const float* xb = r1 < MLAT ? lat + (size_t)r1 * D : ctxp + (size_t)(r1 - MLAT) * D;
        f32x4 va[4], vb[4]; float sa = 0.f, sb = 0.f;
#pragma unroll
        for (int j = 0; j < 4; ++j) { va[j] = *(const f32x4*)(xa + (lane + 64 * j) * 4); vb[j] = *(const f32x4*)(xb + (lane + 64 * j) * 4); }
#pragma unroll
        for (int j = 0; j < 4; ++j) { sa += (va[j].x * va[j].x + va[j].y * va[j].y) + (va[j].z * va[j].z + va[j].w * va[j].w); sb += (vb[j].x * vb[j].x + vb[j].y * vb[j].y) + (vb[j].z * vb[j].z + vb[j].w * vb[j].w); }
        sa = wave_sum(sa); sb = wave_sum(sb);
        const float rsa = rsqrtf(sa * (1.0f / D) + 1e-6f), rsb = rsqrtf(sb * (1.0f / D) + 1e-6f);
        const int ba = r0 < MLAT ? (r0 >> 12) : 8, bb = r1 < MLAT ? (r1 >> 12) : 8;
        const float* sha = mods_l + (size_t)ba * 9216 + ishift * 1024; const float* sca = mods_l + (size_t)ba * 9216 + iscale * 1024;
        const float* shb = mods_l + (size_t)bb * 9216 + ishift * 1024; const float* scb2 = mods_l + (size_t)bb * 9216 + iscale * 1024;
#pragma unroll
        for (int j = 0; j < 4; ++j) {
            const int col = (lane + 64 * j) * 4;
            const f32x4 gg = *(const f32x4*)(g + col);
            { const f32x4 s4 = *(const f32x4*)(sha + col), c4 = *(const f32x4*)(sca + col); const f32x4 h = (va[j] * rsa) * gg * (c4 + 1.0f) + s4;
              v2u o; o.x = pk2(h.x, h.y); o.y = pk2(h.z, h.w); *(v2u*)(H + (size_t)r0 * D + col) = o; }
            if (r1 != r0) { const f32x4 s4 = *(const f32x4*)(shb + col), c4 = *(const f32x4*)(scb2 + col); const f32x4 h = (vb[j] * rsb) * gg * (c4 + 1.0f) + s4;
              v2u o; o.x = pk2(h.x, h.y); o.y = pk2(h.z, h.w); *(v2u*)(H + (size_t)r1 * D + col) = o; }
        }
    }
}
__device__ __forceinline__ void final_norm_phase(const int bx, const int G, float* xo, const float* g, int lane, int wave) {
    const int gw = bx * NWAVES + wave, NGW = G * NWAVES;
    for (int r0 = gw; r0 < MLAT; r0 += 2 * NGW) {
        const int r1 = r0 + NGW < MLAT ? r0 + NGW : r0;
        float* xa = xo + (size_t)r0 * D; float* xb = xo + (size_t)r1 * D;
        f32x4 va[4], vb[4]; float sa = 0.f, sb = 0.f;
#pragma unroll
        for (int j = 0; j < 4; ++j) { va[j] = *(const f32x4*)(xa + (lane + 64 * j) * 4); vb[j] = *(const f32x4*)(xb + (lane + 64 * j) * 4); }
#pragma unroll
        for (int j = 0; j < 4; ++j) { sa += (va[j].x * va[j].x + va[j].y * va[j].y) + (va[j].z * va[j].z + va[j].w * va[j].w); sb += (vb[j].x * vb[j].x + vb[j].y * vb[j].y) + (vb[j].z * vb[j].z + vb[j].w * vb[j].w); }
        sa = wave_sum(sa); sb = wave_sum(sb);
        const float rsa = rsqrtf(sa * (1.0f / D) + 1e-6f), rsb = rsqrtf(sb * (1.0f / D) + 1e-6f);
#pragma unroll
        for (int j = 0; j < 4; ++j) { const int col = (lane + 64 * j) * 4; const f32x4 gg = *(const f32x4*)(g + col);
            *(f32x4*)(xa + col) = (va[j] * rsa) * gg; if (r1 != r0) *(f32x4*)(xb + col) = (vb[j] * rsb) * gg; }
    }
}

__device__ __forceinline__ void pre_item(int it, int& i, int& col) {
    if (it < 2304) { const int seg = it / 768, r = it - seg * 768; i = r / 48; col = seg * 384 + (r % 48) * 8; }
    else if (it < 2560) { const int r = it - 2304; i = (r & 127) >> 3; col = 1152 + (r >> 7) * 64 + (r & 7) * 8; }
    else { const int r = it - 2560; i = r >> 4; col = 1280 + (r & 15) * 8; }
}
__device__ __forceinline__ void pre_phase(const int bx, const int G, CArgsP A, const WS& W, int l, LAS unsigned char* lds, int tid, int lane, int wave) {
    LAS float* k_s = (LAS float*)lds;
    const int odd = l & 1;
    const float* mu0 = A->in[I_MU] + (size_t)l * 2 * RC; const float* mu1 = mu0 + RC;
    const float* kkp = A->in[I_KK] + l * RW;
    bf16* AP = (bf16*)((unsigned char*)W.H + HB_AP); bf16* KT = (bf16*)((unsigned char*)W.H + HB_KT);
    for (int tile = bx; tile < NB * (QLEN / 16); tile += G) {
        const int b = tile / (QLEN / 16), q0 = (tile % (QLEN / 16)) * 16;
        const int seq_lo = q0 < CTX ? 0 : CTX, seq_hi = q0 < CTX ? CTX : QLEN;
        for (int pass = 0; pass < 2; ++pass) {
            v4u rc[3], rp[3], rn[3];
#pragma unroll
            for (int u = 0; u < 3; ++u) { const int it0 = tid + NTHR * (pass * 3 + u), it = it0 < 16 * 176 ? it0 : 16 * 176 - 1;
                int i, col; pre_item(it, i, col); const int q = q0 + i;
                const int qp = q - 1 >= seq_lo ? q - 1 : q, qn = q + 1 < seq_hi ? q + 1 : q;
                rc[u] = *(const v4u*)(W.P + (size_t)row_of(b, q, odd) * INCP + PC_RW + col);
                rp[u] = *(const v4u*)(W.P + (size_t)row_of(b, qp, odd) * INCP + PC_RW + col);
                rn[u] = *(const v4u*)(W.P + (size_t)row_of(b, qn, odd) * INCP + PC_RW + col); }
#pragma unroll
            for (int u = 0; u < 3; ++u) { const int it0 = tid + NTHR * (pass * 3 + u);
                if (it0 < 16 * 176) {
                    int i, col; pre_item(it0, i, col); const int q = q0 + i;
                    const size_t pos = (size_t)b * QLEN + q;
                    float cur[8], prv[8], nxt[8], ps[8];
                    unpack8(rc[u], cur); unpack8(rp[u], prv); unpack8(rn[u], nxt);
                    const float mp = q - 1 >= seq_lo ? 1.f : 0.f, mn = q + 1 < seq_hi ? 1.f : 0.f;
#pragma unroll
                    for (int e = 0; e < 8; ++e) ps[e] = cur[e] + mu0[col + e] * (prv[e] * mp - cur[e]) + mu1[col + e] * (nxt[e] * mn - cur[e]);
                    if (col < 384) *(v4u*)(W.sc_r + pos * RW + col) = pack8(ps);
                    else if (col < 768) {
#pragma unroll
                        for (int e = 0; e < 8; ++e) k_s[i * 384 + col - 384 + e] = ps[e];
                        *(v4u*)(KT + pos * RW + (col - 384)) = pack8(ps); }
                    else if (col < 1152) *(v4u*)(W.sc_v + pos * RW + (col - 768)) = pack8(ps);
                    else if (col < 1216) {
#pragma unroll
                        for (int e = 0; e < 8; ++e) ps[e] = tanh_fast(ps[e]);
                        *(v4u*)(AP + pos * LORA_K + (col - 1152)) = pack8(ps); }
                    else if (col < 1280) *(v4u*)(AP + pos * LORA_K + 64 + (col - 1216)) = pack8(ps);
                    else {
#pragma unroll
                        for (int e = 0; e < 8; ++e) ps[e] = sigmoidf_(ps[e]);
                        *(v4u*)(AP + pos * LORA_K + 128 + (col - 1280)) = pack8(ps); }
                }
            }
        }
        __syncthreads();
        for (int it = wave * 8 + (lane >> 3); it < 96; it += 64) {
            const int i = it / 6, h = it % 6, c = h * 64 + (lane & 7) * 8;
            float kv[8]; float ss = 0.f;
#pragma unroll
            for (int e = 0; e < 8; ++e) { kv[e] = k_s[i * 384 + c + e] * kkp[c + e]; ss += kv[e] * kv[e]; }
            const float rn = rsqrtf(reduce8(ss) + 1e-12f);
#pragma unroll
            for (int e = 0; e < 8; ++e) kv[e] *= rn;
            *(v4u*)(W.sc_kk + ((size_t)b * QLEN + q0 + i) * RW + c) = pack8(kv);
        }
        __syncthreads();
    }
}

__device__ __forceinline__ int q_of_step(int n, int d) { return d == 0 ? n : (n < CTX ? CTX - 1 - n : QLEN + CTX - 1 - n); }
constexpr int RCH = 32, RNCH = QLEN / RCH;
__device__ __forceinline__ void rwkv_scan_phase(const WS& W, int l, int blk, LAS unsigned char* lds, int tid, int lane, int wave) {
    const int item = blk >> 1, half = blk & 1;
    const int b = item / 12, rem = item % 12, h = rem >> 1, d = rem & 1, odd = l & 1;
    LAS float* buf = (LAS float*)lds;
    LAS float* ybuf = buf + 2 * RCH * 384;
    const bf16* s_omw = W.scb + (size_t)(7 + d) * SC_ELEMS; const bf16* s_b = W.scb + (size_t)(5 + d) * SC_ELEMS; const bf16* s_kd = W.scb + (size_t)(3 + d) * SC_ELEMS;
    const int rg = lane >> 4, j = lane & 15, rlA = (wave & 3) * 8 + rg, rlB = rlA + 4, rowA = half * 32 + rlA, rowB = half * 32 + rlB;
    v4u pre[6];
    const int t4 = tid - 256;
#define RW_LOAD(c) do { _Pragma("unroll") for (int jj = 0; jj < 6; ++jj) { const int p = t4 + 256 * jj, i = p / 48, r48 = p % 48, vec = r48 >> 3, part = r48 & 7; \
        const int q = q_of_step((c) * RCH + i, d); const size_t pos = (size_t)b * QLEN + q; \
        const bf16* base = vec == 0 ? s_omw : vec == 1 ? s_b : vec == 2 ? s_kd : vec == 3 ? W.sc_kk : vec == 4 ? W.sc_r : W.sc_v; \
        pre[jj] = *(const v4u*)(base + pos * RW + h * 64 + part * 8); } } while (0)
#define RW_STORE(c) do { _Pragma("unroll") for (int jj = 0; jj < 6; ++jj) { const int p = t4 + 256 * jj, i = p / 48, r48 = p % 48, vec = r48 >> 3, part = r48 & 7; \
        float f[8]; unpack8(pre[jj], f); if (vec == 0) { _Pragma("unroll") for (int e = 0; e < 8; ++e) f[e] = 1.0f - f[e]; } \
        LAS float* dst = buf + (((c) & 1) * RCH + i) * 384 + vec * 64 + part * 8; \
        *(LAS f32x4*)dst = (f32x4){f[0], f[1], f[2], f[3]}; *(LAS f32x4*)(dst + 4) = (f32x4){f[4], f[5], f[6], f[7]}; } } while (0)
    f32x2 SA0 = (f32x2){0.f, 0.f}, SA1 = SA0, SB0 = SA0, SB1 = SA0;
#define RW_FLUSH(c) do { const int i = t4 >> 3, r4 = (t4 & 7) * 4; const int q = q_of_step((c) * RCH + i, d); \
        const f32x4 yv = *(const LAS f32x4*)(ybuf + ((c) & 1) * RCH * 32 + i * 32 + r4); \
        v2u o; o.x = pk2(yv.x, yv.y); o.y = pk2(yv.z, yv.w); \
        *(v2u*)(W.P + (size_t)row_of(b, q, odd) * INCP + PC_Y + d * RW + h * 64 + half * 32 + r4) = o; } while (0)
    if (wave >= 4) { RW_LOAD(0); RW_STORE(0); }
    __syncthreads();
    for (int c = 0; c < RNCH; ++c) {
        const LAS float* cur = buf + (c & 1) * RCH * 384;
        LAS float* yb = ybuf + (c & 1) * RCH * 32;
        if (wave >= 4) {
            if (c + 1 < RNCH) RW_LOAD(c + 1);
            if (c > 0) RW_FLUSH(c - 1);
            if (c + 1 < RNCH) RW_STORE(c + 1);
        } else {
        float ykA, ykB, ypA[16], ypB[16];
#define RW_LD(X, i_) do { const int ii_ = (i_) < RCH ? (i_) : RCH - 1; const LAS f32x4* bp_ = (const LAS f32x4*)(cur + ii_ * 384 + j * 4); \
        X##w = bp_[0]; X##b = bp_[16]; X##d = bp_[32]; X##k = bp_[48]; X##r = bp_[64]; X##va = cur[ii_ * 384 + 320 + rowA]; X##vb = cur[ii_ * 384 + 320 + rowB]; } while (0)
#define RW_CP(X, s_) do { \
        const f32x2 k0_ = (f32x2){X##k.x, X##k.y}, k1_ = (f32x2){X##k.z, X##k.w}; \
        const f32x2 ta_ = SA0 * k0_ + SA1 * k1_, tb_ = SB0 * k0_ + SB1 * k1_; \
        const float saA_ = -reduce16(ta_.x + ta_.y), saB_ = -reduce16(tb_.x + tb_.y); \
        const f32x2 w0_ = (f32x2){X##w.x, X##w.y}, w1_ = (f32x2){X##w.z, X##w.w}, b0_ = (f32x2){X##b.x, X##b.y}, b1_ = (f32x2){X##b.z, X##b.w}, d0_ = (f32x2){X##d.x, X##d.y}, d1_ = (f32x2){X##d.z, X##d.w}; \
        const f32x2 va2_ = (f32x2){X##va, X##va}, vb2_ = (f32x2){X##vb, X##vb}, sa2_ = (f32x2){saA_, saA_}, sb2_ = (f32x2){saB_, saB_}; \
        SA0 = SA0 * w0_ + va2_ * d0_ + sa2_ * b0_; SA1 = SA1 * w1_ + va2_ * d1_ + sa2_ * b1_; \
        SB0 = SB0 * w0_ + vb2_ * d0_ + sb2_ * b0_; SB1 = SB1 * w1_ + vb2_ * d1_ + sb2_ * b1_; \
        const f32x2 r0_ = (f32x2){X##r.x, X##r.y}, r1_ = (f32x2){X##r.z, X##r.w}; \
        const f32x2 ya_ = SA0 * r0_ + SA1 * r1_, yb_ = SB0 * r0_ + SB1 * r1_; \
        ypA[s_] = ya_.x + ya_.y; ypB[s_] = yb_.x + yb_.y; } while (0)
        f32x4 Aw, Ab, Ad, Ak, Ar, Bw, Bb, Bd, Bk, Br; float Ava, Avb, Bva, Bvb;
        RW_LD(A, 0);
#pragma unroll 1
        for (int g = 0; g < 2; ++g) {
            ykA = 0.f; ykB = 0.f;
#pragma unroll
            for (int s2 = 0; s2 < 16; s2 += 2) {
                const int i = g * 16 + s2;
                RW_LD(B, i + 1);
                __builtin_amdgcn_sched_barrier(0);
                RW_CP(A, s2);
                __builtin_amdgcn_sched_barrier(0);
                RW_LD(A, i + 2);
                __builtin_amdgcn_sched_barrier(0);
                RW_CP(B, s2 + 1);
                __builtin_amdgcn_sched_barrier(0);
            }
            ykA = rscatter16(ypA, j); ykB = rscatter16(ypB, j);
            yb[(g * 16 + j) * 32 + rlA] = ykA; yb[(g * 16 + j) * 32 + rlB] = ykB;
        }
#undef RW_LD
#undef RW_CP
        }
        __syncthreads();
    }
    if (wave >= 4) RW_FLUSH(RNCH - 1);
#undef RW_FLUSH
#undef RW_LOAD
#undef RW_STORE
}

__device__ __forceinline__ void lru_scan_phase(CArgsP A, const WS& W, int l, int idx, LAS unsigned char* lds, int tid, int lane, int wave) {
    const int b = idx / 6, n = idx % 6, odd = l & 1;
    LAS float* gs = (LAS float*)lds;
    LAS float* xs = gs;
    LAS float* us = gs + 4 * 4096;
    LAS bf16* ub = (LAS bf16*)(us + 2 * 4096);
    const int c = tid & 63;
    float cw[2][4], cb[2], sp[2];
#pragma unroll
    for (int dd = 0; dd < 2; ++dd) {
#pragma unroll
        for (int jj = 0; jj < 4; ++jj) cw[dd][jj] = A->in[I_LCW][((size_t)(l * 2 + dd) * 4 + jj) * LW + n * 64 + c];
        cb[dd] = A->in[I_LCB][(l * 2 + dd) * LW + n * 64 + c];
        sp[dd] = softplusf_(-A->in[I_LAM][(l * 2 + dd) * LW + n * 64 + c]);
    }
    const int g = wave >> 2, jcol = (wave & 3) * 16 + (lane & 15), quad = lane >> 4;
    pg8::bf16x8 bfrag[2][2]; float gbias[2];
#pragma unroll
    for (int dd = 0; dd < 2; ++dd) {
        const float* Wsrc = (g ? A->in[I_LWI] : A->in[I_LWR]) + ((size_t)((l * 2 + dd) * 6 + n) * 64) * 64 + jcol;
#pragma unroll
        for (int ks = 0; ks < 2; ++ks)
#pragma unroll
            for (int jj = 0; jj < 8; ++jj) bfrag[dd][ks][jj] = (short)f2bf(Wsrc[(size_t)(ks * 32 + quad * 8 + jj) * 64]);
        gbias[dd] = (g ? A->in[I_LBI] : A->in[I_LBR])[(l * 2 + dd) * LW + n * 64 + jcol];
    }
    float hstate = 0.f;
    v4u pre[2][2];
#define LRU_LOAD(ch) do { _Pragma("unroll") for (int dd = 0; dd < 2; ++dd) { const int n0 = (ch) * 64; const int qlo_ = dd == 0 ? n0 : q_of_step(n0, 1) - 63; const int qb_ = dd == 0 ? qlo_ - 3 : qlo_; \
        const int slo_ = qlo_ < CTX ? 0 : CTX, shi_ = qlo_ < CTX ? CTX : QLEN; \
        _Pragma("unroll") for (int jj = 0; jj < 2; ++jj) { const int p = tid + NTHR * jj; const int t = p >> 3, part = p & 7, q = qb_ + t; \
            pre[dd][jj] = (v4u){0u, 0u, 0u, 0u}; \
            if (t < 67 && q >= slo_ && q < shi_) pre[dd][jj] = *(const v4u*)(W.P + (size_t)row_of(b, q, odd) * INCP + PC_XR + n * 64 + part * 8); } } } while (0)
    LRU_LOAD(0);
    const int tid_o = tid, lane_o = lane;
    for (int ch = 0; ch < QLEN / 64; ++ch) {
        const int n0 = ch * 64;
        int tid = tid_o, lane = lane_o; asm volatile("" : "+v"(tid), "+v"(lane));
        const int c = tid & 63, jcol = (wave & 3) * 16 + (lane & 15), quad = lane >> 4;
#pragma unroll
        for (int dd = 0; dd < 2; ++dd)
#pragma unroll
            for (int jj = 0; jj < 2; ++jj) { const int p = tid + NTHR * jj; const int t = p >> 3, part = p & 7;
                if (t < 67) { float f[8]; unpack8(pre[dd][jj], f); LAS float* dst = xs + dd * 68 * 64 + t * 64 + part * 8;
                    *(LAS f32x4*)dst = (f32x4){f[0], f[1], f[2], f[3]}; *(LAS f32x4*)(dst + 4) = (f32x4){f[4], f[5], f[6], f[7]}; } }
        __syncthreads();
        if (ch + 1 < QLEN / 64) LRU_LOAD(ch + 1);
#pragma unroll
        for (int k = 0; k < 16; ++k) { const int dd = k >> 3, t = (tid >> 6) + 8 * (k & 7); const LAS float* x = xs + dd * 68 * 64;
            const float uv = cb[dd] + cw[dd][0] * x[t * 64 + c] + cw[dd][1] * x[(t + 1) * 64 + c] + cw[dd][2] * x[(t + 2) * 64 + c] + cw[dd][3] * x[(t + 3) * 64 + c];
            us[dd * 4096 + t * 64 + c] = uv; ub[dd * 64 * 72 + t * 72 + c] = (bf16)f2bf(uv); }
        __syncthreads();
#pragma unroll
        for (int dd = 0; dd < 2; ++dd)
#pragma unroll
            for (int rt = 0; rt < 4; ++rt) {
                pg8::f32x4 acc = {0.f, 0.f, 0.f, 0.f};
#pragma unroll
                for (int ks = 0; ks < 2; ++ks) {
                    const pg8::bf16x8 afrag = *(const LAS pg8::bf16x8*)(ub + dd * 64 * 72 + (rt * 16 + (lane & 15)) * 72 + ks * 32 + quad * 8);
                    acc = __builtin_amdgcn_mfma_f32_16x16x32_bf16(afrag, bfrag[dd][ks], acc, 0, 0, 0);
                }
#pragma unroll
                for (int jj = 0; jj < 4; ++jj) gs[((dd * 2 + g) * 64 + rt * 16 + quad * 4 + jj) * 64 + jcol] = sigmoidf_(acc[jj] + gbias[dd]);
            }
        __syncthreads();
#pragma unroll
        for (int k = 0; k < 16; ++k) { const int dd = k >> 3, t = (tid >> 6) + 8 * (k & 7);
            LAS float* ga = gs + (dd * 2) * 4096 + t * 64 + c; LAS float* gb = ga + 4096;
            const float rgv = *ga, igv = *gb, u = us[dd * 4096 + t * 64 + c];
            const float log_a = -8.0f * sp[dd] * rgv;
            const float a = __expf(log_a);
            const float bt = __builtin_amdgcn_sqrtf(fmaxf(1.0f - a * a, 0.f)) * (igv * u);
            *ga = a; *gb = bt; }
        __syncthreads();
        if (wave < 2) {
            const int dd = wave; const int qlo = dd == 0 ? n0 : q_of_step(n0, 1) - 63;
            const LAS float* ga = gs + (dd * 2) * 4096 + lane; LAS float* hb = us + dd * 4096 + lane;
            (void)qlo;
#pragma unroll 8
            for (int s = 0; s < 64; ++s) { const int t = dd == 0 ? s : 63 - s;
                hstate = ga[t * 64] * hstate + ga[4096 + t * 64];
                hb[t * 64] = hstate; }
        }
        __syncthreads();
#pragma unroll
        for (int k = 0; k < 2; ++k) { const int p = tid + NTHR * k, dd = p >> 9, t = (p >> 3) & 63, part = p & 7;
            const int qlo = dd == 0 ? n0 : q_of_step(n0, 1) - 63;
            const LAS f32x4* hp = (const LAS f32x4*)(us + dd * 4096 + t * 64 + part * 8);
            const f32x4 h0 = hp[0], h1 = hp[1]; const float hv[8] = {h0.x, h0.y, h0.z, h0.w, h1.x, h1.y, h1.z, h1.w};
            *(v4u*)(W.H + (size_t)row_of(b, qlo + t, odd) * D + dd * LW + n * 64 + part * 8) = pack8(hv); }
    }
#undef LRU_LOAD
}

__device__ __forceinline__ void post_phase(const int bx, const int G, CArgsP A, const WS& W, int l, LAS unsigned char* lds, int tid, int lane, int wave) {
    LAS float* hs = (LAS float*)lds;
    const int odd = l & 1;
    const float* cwa = A->in[I_CONVA] + (size_t)l * 3 * 256;
    const float* rk = A->in[I_RK] + l * RW; const float* lng = A->in[I_LNG] + l * RW; const float* lnb = A->in[I_LNB] + l * RW;
    bf16* Y = W.H;
    for (int tile = bx; tile < NB * (QLEN / 16); tile += G) {
        const int b = tile / (QLEN / 16), q0 = (tile % (QLEN / 16)) * 16;
        for (int it = tid; it < 16 * 48; it += NTHR) { const int i = it / 48, col = (it % 48) * 8; const size_t row = row_of(b, q0 + i, odd);
            float h0[8], h1[8]; unpack8(*(const v4u*)(W.H + row * D + col), h0); unpack8(*(const v4u*)(W.H + row * D + LW + col), h1);
#pragma unroll
            for (int e = 0; e < 8; ++e) hs[i * 384 + col + e] = h0[e] + h1[e]; }
        __syncthreads();
        v4u grv[2];
#pragma unroll
        for (int u = 0; u < 2; ++u) { const int it0 = tid + NTHR * u, it = it0 < 16 * 48 ? it0 : 16 * 48 - 1; const int i = it / 48, col = (it % 48) * 8;
            grv[u] = *(const v4u*)(W.P + (size_t)row_of(b, q0 + i, odd) * INCP + PC_GR + col); }
        {   const int it = tid, i = it >> 5, col = (it & 31) * 8, q = q0 + i;
            int lo, hi; if (q < CTX) { lo = 0; hi = CTX; } else { lo = CTX + ((q - CTX) & ~63); hi = lo + 64; }
            const size_t row = row_of(b, q, odd), rp = row_of(b, q - 1 >= lo ? q - 1 : q, odd), rn = row_of(b, q + 1 < hi ? q + 1 : q, odd);
            const float mp = q - 1 >= lo ? 1.f : 0.f, mn = q + 1 < hi ? 1.f : 0.f;
            const v4u l0 = *(const v4u*)(W.P + row * INCP + PC_BG + col), l1 = *(const v4u*)(W.P + row * INCP + PC_CG + col), l2 = *(const v4u*)(W.P + row * INCP + PC_XIN + col);
            const v4u l3 = *(const v4u*)(W.P + rp * INCP + PC_CG + col), l4 = *(const v4u*)(W.P + rp * INCP + PC_XIN + col);
            const v4u l5 = *(const v4u*)(W.P + rn * INCP + PC_CG + col), l6 = *(const v4u*)(W.P + rn * INCP + PC_XIN + col);
            float bg[8], c0[8], x0[8], c1[8], x1[8], c2[8], x2[8], y[8];
            unpack8(l0, bg); unpack8(l1, c0); unpack8(l2, x0); unpack8(l3, c1); unpack8(l4, x1); unpack8(l5, c2); unpack8(l6, x2);
#pragma unroll
            for (int e = 0; e < 8; ++e) y[e] = bg[e] * (cwa[256 + col + e] * (c0[e] * x0[e]) + mp * cwa[col + e] * (c1[e] * x1[e]) + mn * cwa[512 + col + e] * (c2[e] * x2[e]));
            *(v4u*)(Y + row * D + col) = pack8(y); }
        for (int it = wave * 8 + (lane >> 3); it < 96; it += 64) {
            const int i = it / 6, h = it % 6, c = h * 64 + (lane & 7) * 8, q = q0 + i;
            const size_t row = row_of(b, q, odd), pos = (size_t)b * QLEN + q;
            float y0[8], y1[8], rr[8], vv[8], k0[8], k1[8], gg[8];
            unpack8(*(const v4u*)(W.P + row * INCP + PC_Y + c), y0); unpack8(*(const v4u*)(W.P + row * INCP + PC_Y + RW + c), y1);
            unpack8(*(const v4u*)(W.sc_r + pos * RW + c), rr); unpack8(*(const v4u*)(W.sc_v + pos * RW + c), vv);
            unpack8(*(const v4u*)(W.scb + (size_t)3 * SC_ELEMS + pos * RW + c), k0); unpack8(*(const v4u*)(W.scb + (size_t)4 * SC_ELEMS + pos * RW + c), k1);
            unpack8(*(const v4u*)(W.P + row * INCP + PC_G + c), gg);
            float sum = 0.f, bon = 0.f;
#pragma unroll
            for (int e = 0; e < 8; ++e) { y0[e] += y1[e]; sum += y0[e]; bon += rr[e] * (k0[e] + k1[e]) * rk[c + e]; }
            const float mean = reduce8(sum) * (1.0f / 64.0f); bon = reduce8(bon);
            float sq = 0.f;
#pragma unroll
            for (int e = 0; e < 8; ++e) { y0[e] -= mean; sq += y0[e] * y0[e]; }
            const float rstd = rsqrtf(reduce8(sq) * (1.0f / 64.0f) + 64e-5f);
#pragma unroll
            for (int e = 0; e < 8; ++e) y0[e] = (y0[e] * rstd * lng[c + e] + lnb[c + e] + bon * vv[e]) * gg[e];
            *(v4u*)(Y + row * D + 256 + c) = pack8(y0);
        }
#pragma unroll
        for (int u = 0; u < 2; ++u) { const int it = tid + NTHR * u;
            if (it < 16 * 48) { const int i = it / 48, col = (it % 48) * 8; const size_t row = row_of(b, q0 + i, odd);
                float gr[8], o[8]; unpack8(grv[u], gr);
#pragma unroll
                for (int e = 0; e < 8; ++e) o[e] = gelu_tanh(gr[e]) * hs[i * 384 + col + e];
                *(v4u*)(Y + row * D + 640 + col) = pack8(o); } }
        __syncthreads();
    }
}

#define XB_TMO      128
#define XB_XCNT(j)  (256  + 64 * (j))
#define XB_XSUB(j)  (1280 + 64 * (j))
#define XB_XGEN(j)  (2304 + 64 * (j))
#define XB_TOP      3328
#define XB_TOPGEN   3392
#define XCD_BAR_WORDS 3456
#define XB_SPIN_CAP (1u << 18)

__device__ __forceinline__ unsigned xb_ld(unsigned* p)              { return __hip_atomic_load(p, __ATOMIC_RELAXED, __HIP_MEMORY_SCOPE_AGENT); }
__device__ __forceinline__ unsigned xb_add(unsigned* p, unsigned v) { return __hip_atomic_fetch_add(p, v, __ATOMIC_RELAXED, __HIP_MEMORY_SCOPE_AGENT); }
__device__ __forceinline__ unsigned xb_xcc_id() { return (unsigned)__builtin_amdgcn_s_getreg((3 << 11) | 20) & 0xFu; }
#define XB_SPIN(cond, bar) do { unsigned _sp = 0; while (cond) { __builtin_amdgcn_s_sleep(1); \
    if ((++_sp & 255u) == 0u) { if (xb_ld(&(bar)[XB_TMO])) break; if (_sp > XB_SPIN_CAP) { atomicAdd(&(bar)[XB_TMO], 1u); break; } } } } while (0)

struct XcdBarrier {
    unsigned* bar; unsigned x;
    volatile LAS unsigned* st;
};

__device__ __forceinline__ XcdBarrier xcd_barrier_post(unsigned* bar, volatile LAS unsigned* st) {
    XcdBarrier b; b.bar = bar; b.x = xb_xcc_id(); b.st = st;
    if (threadIdx.x == 0) (void)xb_add(&bar[XB_XCNT(b.x)], 1u);
    return b;
}
__device__ __forceinline__ void xcd_barrier_complete(unsigned* bar, unsigned x, unsigned& nloc, unsigned& nx) {
    const unsigned G = gridDim.x * gridDim.y * gridDim.z;
    unsigned sum, cnt, mine, sp = 0u;
    for (;;) {
        sum = 0u; cnt = 0u; mine = 0u;
#pragma unroll
        for (unsigned j = 0; j < 16; ++j) { const unsigned c = xb_ld(&bar[XB_XCNT(j)]); sum += c; cnt += (c > 0u) ? 1u : 0u; mine = (j == x) ? c : mine; }
        if (sum == G) break;
        __builtin_amdgcn_s_sleep(1);
        if ((++sp & 255u) == 0u) { if (xb_ld(&bar[XB_TMO])) break; if (sp > XB_SPIN_CAP) { atomicAdd(&bar[XB_TMO], 1u); break; } }
    }
    nloc = mine > 0u ? mine : 1u; nx = cnt > 0u ? cnt : 1u;
}

__device__ __forceinline__ void xcd_barrier(const XcdBarrier& b) {
    asm volatile("s_waitcnt vmcnt(0)" ::: "memory");
    __syncthreads();
    if (threadIdx.x == 0) {
        unsigned* bar = b.bar;
        __builtin_amdgcn_s_waitcnt(0);
        unsigned nloc = b.st[0], nx = b.st[1];
        if (nloc == 0u) { xcd_barrier_complete(bar, b.x, nloc, nx); b.st[0] = nloc; b.st[1] = nx; }
        const unsigned old = xb_add(&bar[XB_XSUB(b.x)], 1u);
        const unsigned gen = old / nloc;
        if (old + 1u == (gen + 1u) * nloc) {
            __builtin_amdgcn_fence(__ATOMIC_RELEASE, "agent");
            asm volatile("s_waitcnt vmcnt(0)" ::: "memory");
            const unsigned og = xb_add(&bar[XB_TOP], 1u);
            const unsigned tg = og / nx;
            if (og + 1u == (tg + 1u) * nx) xb_add(&bar[XB_TOPGEN], 1u);
            else XB_SPIN(xb_ld(&bar[XB_TOPGEN]) == tg, bar);
            __builtin_amdgcn_fence(__ATOMIC_ACQUIRE, "agent");
            xb_add(&bar[XB_XGEN(b.x)], 1u);
            asm volatile("s_waitcnt vmcnt(0)" ::: "memory");
        } else {
            XB_SPIN(xb_ld(&bar[XB_XGEN(b.x)]) == gen, bar);
            __builtin_amdgcn_fence(__ATOMIC_ACQUIRE, "agent");
            asm volatile("s_waitcnt vmcnt(0)" ::: "memory");
        }
    }
    __syncthreads();
}

constexpr int PH_PER_LAYER = 13, N_PHASES = 1 + DEPTH * PH_PER_LAYER + 1;
__global__ void __launch_bounds__(NTHR, 2) fwd_megakernel(Args A0) {
    extern __shared__ __attribute__((aligned(16))) unsigned char lds_raw[];
    LAS unsigned char* lds = (LAS unsigned char*)lds_raw;
    cg::grid_group grid = cg::this_grid();
    const int ph_lo = A0.ph_lo, ph_hi = A0.ph_hi;
    volatile LAS unsigned* bst = (volatile LAS unsigned*)(lds + 131072);
    if (threadIdx.x < 2) bst[threadIdx.x] = 0u;
    __syncthreads();
    const XcdBarrier xbar = xcd_barrier_post((unsigned*)(A0.ws + WS_BAR), bst);
    const int wave0 = __builtin_amdgcn_readfirstlane((int)threadIdx.x >> 6);
    bool rep_done = false; (void)rep_done;
    for (int ph = ph_lo; ph < ph_hi; ++ph) {
        CArgsP A = (CArgsP)__builtin_amdgcn_kernarg_segment_ptr();
        asm volatile("" : "+s"(A) :: "memory");
        int G = gridDim.x, bx = blockIdx.x, wave = wave0;
        asm volatile("" : "+s"(G), "+s"(bx), "+s"(wave));
#define IDS() int lane; asm volatile("v_mbcnt_lo_u32_b32 %0, -1, 0\n\tv_mbcnt_hi_u32_b32 %0, -1, %0" : "=v"(lane)); const int tid = wave * 64 + lane; (void)tid
        const WS W = make_ws(A->ws);
        if (ph == 0) { IDS(); mods_phase(bx, G, A, W, lds, tid, lane, wave); convert_phase(bx, G, A, W.wt, 0, lds, lane, wave); }
        else if (ph == N_PHASES - 1) { IDS(); final_norm_phase(bx, G, A->out, A->in[I_GFINAL], lane, wave); }
        else {
            const int l = (ph - 1) / PH_PER_LAYER, s = (ph - 1) % PH_PER_LAYER; const bool last = (l == DEPTH - 1);
            const float* mods_l = W.mods + (size_t)l * 9 * 9216;
            const bf16* WTL = (l & 1) ? W.wt2 : W.wt;
            const float* xlat = A->out; const float* xctx = W.xrctx;
            if (s == 0) { IDS();
                norm_phase(bx, G, l == 0 ? A->in[I_X] : xlat, l == 0 ? A->in[I_CTX] : xctx, A->in[I_GFFN1] + l * D, mods_l, 0, 1, W.H, MTOT, lane, wave);
            } else if (s == 1 || s == 11) { IDS();
                pg8::Gemm g{W.H, WTL + (s == 1 ? WT_GU1 : WT_GU2), (s == 11 && last) ? MLAT : MTOT, 2 * DFF, D}; pg8::StaticOrder S; S.init(g.M, g.N, G, bx);
                EpiSwiGLU E{W.ACT};
                pg8::gemm_phase<EpiSwiGLU, pg8::StaticOrder, true, true>(lds, g, S, E, tid);
            } else if (s == 2 || s == 9 || s == 12) { IDS();
                pg8::Gemm g{s == 9 ? W.H : W.ACT, WTL + (s == 2 ? WT_DOWN1 : s == 9 ? WT_OUT : WT_DOWN2), (s != 2 && last) ? MLAT : MTOT, D, s == 9 ? D : DFF};
                pg8::StaticOrder S; S.init(g.M, g.N, G, bx);
                const bool first = (l == 0 && s == 2);
                EpiResid E{first ? A->in[I_X] : xlat, first ? A->in[I_CTX] : xctx, A->out, W.xrctx, mods_l + (s == 2 ? 2 : s == 9 ? 5 : 8) * 1024, s == 9 ? 1.0f : 0.5f};
                pg8::gemm_phase<EpiResid, pg8::StaticOrder, true, true>(lds, g, S, E, tid);
            } else if (s == 3) { IDS();
                norm_phase(bx, G, xlat, xctx, A->in[I_GMIX] + l * D, mods_l, 3, 4, W.H, MTOT, lane, wave);
            } else if (s == 4) { IDS();
                pg8::Gemm g{W.H, WTL + WT_IN, MTOT, INCP, D}; pg8::StaticOrder S; S.init(g.M, g.N, G, bx);
                EpiP E{W.P, INCP};
                pg8::gemm_phase<EpiP, pg8::StaticOrder, true, true>(lds, g, S, E, tid);
            } else if (s == 5) { IDS();
                pre_phase(bx, G, A, W, l, lds, tid, lane, wave);
            } else if (s == 6) { IDS();
                int Kl = LORA_K, Nl = LORA_N; asm volatile("" : "+s"(Kl), "+s"(Nl));
                pg8::Gemm g{(const bf16*)((const unsigned char*)W.H + HB_AP), WTL + WT_LORA, MTOT, Nl, Kl}; pg8::StaticOrder S; S.init(g.M, g.N, G, bx);
                EpiLora E{A->in[I_W0] + l * 2 * RW, A->in[I_A0] + l * 2 * RW, A->in[I_KA] + l * RW, (const bf16*)((const unsigned char*)W.H + HB_KT), W.sc_kk, W.scb, W.P, l & 1};
                pg8::gemm_phase<EpiLora, pg8::StaticOrder, true, true>(lds, g, S, E, tid);
            } else if (s == 7) { IDS();
                for (int u = bx; u < 240; u += G) {
                    if (u < 192) rwkv_scan_phase(W, l, u, lds, tid, lane, wave); else lru_scan_phase(A, W, l, u - 192, lds, tid, lane, wave);
                    __syncthreads();
                }
                if (!last) {
                    if (G > 240) { if (bx >= 240) convert_phase(bx - 240, G - 240, A, ((l + 1) & 1) ? W.wt2 : W.wt, l + 1, lds, lane, wave); }
                    else convert_phase(bx, G, A, ((l + 1) & 1) ? W.wt2 : W.wt, l + 1, lds, lane, wave);
                }
            } else if (s == 8) { IDS();
                post_phase(bx, G, A, W, l, lds, tid, lane, wave);
            } else if (s == 10) { IDS();
                norm_phase(bx, G, xlat, xctx, A->in[I_GFFN2] + l * D, mods_l, 6, 7, W.H, last ? MLAT : MTOT, lane, wave);
            }
        }
#ifdef PROBE_REP_S
        if (ph > 0 && ph < N_PHASES - 1 && ((ph - 1) % PH_PER_LAYER) == PROBE_REP_S && !rep_done) { rep_done = true; grid.sync(); --ph; continue; }
        rep_done = false;
#endif
        if (ph + 1 < ph_hi) { if (ph == ph_lo) grid.sync(); else xcd_barrier(xbar); }
    }
}

#ifndef MK_MULTI
#define MK_MULTI 0
#endif
extern "C" void kernel_launch(void* const* d_in, const int* in_sizes, int n_in, void* d_out, int out_size, void* d_ws, size_t ws_size, hipStream_t stream) {
    static int grid = 0;
    if (grid == 0) {
        if (n_in != N_IN || out_size != MLAT * D || ws_size < WS_END) { fprintf(stderr, "kernel_launch: unexpected shapes (n_in %d out %d ws %zu)\n", n_in, out_size, ws_size); grid = -1; return; }
        int dev = 0, cus = 0, per_cu = 0;
        (void)hipGetDevice(&dev); (void)hipDeviceGetAttribute(&cus, hipDeviceAttributeMultiprocessorCount, dev);
        if (hipFuncSetAttribute((const void*)fwd_megakernel, hipFuncAttributeMaxDynamicSharedMemorySize, LDS_BYTES) != hipSuccess) { fprintf(stderr, "kernel_launch: hipFuncSetAttribute failed\n"); grid = -1; return; }
        if (hipOccupancyMaxActiveBlocksPerMultiprocessor(&per_cu, (const void*)fwd_megakernel, NTHR, LDS_BYTES) != hipSuccess || per_cu < 1) { fprintf(stderr, "kernel_launch: occupancy query says %d\n", per_cu); per_cu = 1; }
        (void)hipGetLastError();
        grid = cus * 1;
        if (grid <= 0) grid = 256;
    }
    if (grid < 0) return;
    if (hipMemsetAsync((unsigned char*)d_ws + WS_BAR, 0, WS_BAR_BYTES, stream) != hipSuccess) { fprintf(stderr, "kernel_launch: memset of the barrier words failed\n"); return; }
    Args a{};
    for (int i = 0; i < N_IN; ++i) a.in[i] = (const float*)d_in[i];
    a.out = (float*)d_out; a.ws = (unsigned char*)d_ws;
#if MK_MULTI
    for (int ph = 0; ph < N_PHASES; ++ph) { a.ph_lo = ph; a.ph_hi = ph + 1; hipLaunchKernelGGL(fwd_megakernel, dim3(grid), dim3(NTHR), LDS_BYTES, stream, a); }
#else
    a.ph_lo = 0; a.ph_hi = N_PHASES;
    void* args[] = {&a};
    hipError_t e = hipLaunchCooperativeKernel((const void*)fwd_megakernel, dim3(grid), dim3(NTHR), args, LDS_BYTES, stream);
    if (e != hipSuccess) fprintf(stderr, "kernel_launch: cooperative launch failed: %s (grid %d)\n", hipGetErrorString(e), grid);
#endif
}
```

```cpp
#include <hip/hip_runtime.h>
#include <hip/hip_cooperative_groups.h>
#include <cstdio>
#include <cstdint>
namespace cg = cooperative_groups;
namespace pg8 {
#define PG8_LAS __attribute__((address_space(3)))
typedef unsigned short bf16_t;
typedef short bf16x8 __attribute__((ext_vector_type(8)));
typedef float f32x4 __attribute__((ext_vector_type(4)));
typedef unsigned u32x4 __attribute__((ext_vector_type(4)));
constexpr int BM = 256, BK = 64, HALF = 128, HTB = HALF * BK * 2  , STAGE_BYTES = 8 * HTB, NXCD = 8, WGM = 8;

__host__ __device__ __forceinline__ int lds_byte(int r, int c) { const int st = (r >> 4) * 2 + (c >> 5), rr = r & 15, cc = c & 31, ob = rr * 64 + cc * 2; return st * 1024 + (ob ^ (((ob >> 9) & 1) << 5)); }
__host__ __device__ __forceinline__ void stage_rc(int b, int& R, int& C) { const int st = b / 1024, sb = b % 1024, swz = sb ^ (((sb >> 9) & 1) << 5); R = (st >> 1) * 16 + swz / 64; C = (st & 1) * 32 + (swz % 64) / 2; }
__host__ __device__ __forceinline__ int perm32(int rho) { const int n = rho >> 4, i = rho & 15; return 8 * (i >> 2) + 4 * n + (i & 3); }

struct Unit { int pm, pn; };
struct Gemm { const bf16_t* A; const bf16_t* Bt; int M, N, K; };

struct StaticOrder {
    int nM, nN, nwg, G, c, pm_off;
    __host__ __device__ void init(int M, int N, int G_, int c_, int off_ = 0) { nM = M / BM; nN = N / BM; nwg = nM * nN; G = G_; c = c_; pm_off = off_; }
    __host__ __device__ bool next(int i, Unit& u) const {
        const long L = (long)i * G + c; if (L >= nwg) return false;
        int wgid = (int)L; { const int q = nwg / NXCD, r = nwg % NXCD, xcd = wgid % NXCD, off = wgid / NXCD; wgid = (xcd < r ? xcd * (q + 1) : r * (q + 1) + (xcd - r) * q) + off; }
        const int nig = WGM * nN, gid = wgid / nig, fm = gid * WGM, gsz = (nM - fm) < WGM ? (nM - fm) : WGM;
        u.pm = fm + ((wgid % nig) % gsz) + pm_off; u.pn = (wgid % nig) / gsz; return true;
    }
    __device__ __forceinline__ void a_ready(const Unit&) const {}
    __device__ __forceinline__ void done(const Unit&) const {}
};

template <class Epi, class Sched, bool ALIGN_EPI = false, bool SP2 = false>
__device__ __forceinline__ void gemm_phase(PG8_LAS unsigned char* lds, const Gemm g, const Sched& S, const Epi& E, const int tid) {
    const int wid = __builtin_amdgcn_readfirstlane(tid >> 6), lane = tid & 63, wr = wid >> 2, wc = wid & 3, fr = lane & 15, fq = lane >> 4;
    const int K = g.K, nt = K / BK;
    unsigned voffA[2], voffB[2];
#pragma unroll
    for (int i = 0; i < 2; ++i) { int R, C; stage_rc(tid * 16 + i * 8192, R, C); const int Rb = Epi::PERM ? ((R & ~31) + perm32(R & 31)) : R;
        voffA[i] = (unsigned)(R * K + C) * 2u; voffB[i] = (unsigned)(Rb * K + C) * 2u; }
    const size_t kstep = (size_t)(BK * 2);
    const size_t hstep = (size_t)HALF * K * 2;
    const size_t tstep = 2 * hstep;
    const unsigned ldsw = (unsigned)wid * 1024u;
    const int aoff = lds_byte(wr * 64 + fr, fq * 8), boff = lds_byte(wc * 32 + fr, fq * 8);
#define PG8_SA(b, h) (((b) * 2 + (h)) * HTB)
#define PG8_SB(b, h) ((4 + (b) * 2 + (h)) * HTB)
#define PG8_STAGE(bufoff, gbase, voff) do { _Pragma("unroll") for (int _i = 0; _i < 2; ++_i) \
        __builtin_amdgcn_global_load_lds((const unsigned*)((const char*)(gbase) + (voff)[_i]), (PG8_LAS unsigned*)(lds + (bufoff) + ldsw + _i * 8192), 16, 0, 0); } while (0)
#define PG8_LDA(dst, b, h) do { _Pragma("unroll") for (int m = 0; m < 4; ++m) _Pragma("unroll") for (int k = 0; k < 2; ++k) dst[m][k] = *(const PG8_LAS bf16x8*)(lds + PG8_SA(b, h) + aoff + m * 2048 + k * 1024); } while (0)
#define PG8_LDB(dst, b, h) do { _Pragma("unroll") for (int n = 0; n < 2; ++n) _Pragma("unroll") for (int k = 0; k < 2; ++k) dst[n][k] = *(const PG8_LAS bf16x8*)(lds + PG8_SB(b, h) + boff + n * 2048 + k * 1024); } while (0)
#define PG8_MMA(ai, bj, At, Bt) do { __builtin_amdgcn_s_setprio(1); _Pragma("unroll") for (int m = 0; m < 4; ++m) _Pragma("unroll") for (int n = 0; n < 2; ++n) _Pragma("unroll") for (int k = 0; k < 2; ++k) \
        acc[ai][bj][m][n] = __builtin_amdgcn_mfma_f32_16x16x32_bf16(Bt[n][k], At[m][k], acc[ai][bj][m][n], 0, 0, 0); __builtin_amdgcn_s_setprio(0); } while (0)
#define PG8_WAIT_V(n) asm volatile("s_waitcnt vmcnt(" #n ")" ::: "memory")
#define PG8_WAIT_L(n) asm volatile("s_waitcnt lgkmcnt(" #n ")" ::: "memory")
#define PG8_BAR __builtin_amdgcn_s_barrier()
#define PG8_SCHED __builtin_amdgcn_sched_barrier(0)
    Unit cur, nxt; int ui = 0;
    if (!S.next(0, cur)) return;
    f32x4 acc[2][2][4][2];
#pragma unroll
    for (int a = 0; a < 2; ++a)
#pragma unroll
        for (int b = 0; b < 2; ++b)
#pragma unroll
            for (int m = 0; m < 4; ++m)
#pragma unroll
                for (int n = 0; n < 2; ++n) acc[a][b][m][n] = (f32x4){0.f, 0.f, 0.f, 0.f};
    bf16x8 At[4][2], B0[2][2], B1[2][2];
    const char* cA = (const char*)g.A + (size_t)cur.pm * tstep; const char* cB = (const char*)g.Bt + (size_t)cur.pn * tstep;
    S.a_ready(cur);
    if constexpr (SP2) {
        PG8_STAGE(PG8_SB(0, 0), cB, voffB); PG8_STAGE(PG8_SB(0, 1), cB + hstep, voffB); PG8_STAGE(PG8_SA(0, 0), cA, voffA); PG8_STAGE(PG8_SA(0, 1), cA + hstep, voffA);
        if (wr == 1) PG8_BAR;
        PG8_WAIT_V(2); PG8_BAR;
        PG8_STAGE(PG8_SB(1, 0), cB + kstep, voffB); PG8_STAGE(PG8_SA(1, 0), cA + kstep, voffA); PG8_STAGE(PG8_SB(1, 1), cB + hstep + kstep, voffB);
        PG8_WAIT_V(6); PG8_BAR;
    } else {
        PG8_STAGE(PG8_SB(0, 0), cB, voffB); PG8_STAGE(PG8_SA(0, 0), cA, voffA); PG8_STAGE(PG8_SB(0, 1), cB + hstep, voffB); PG8_STAGE(PG8_SA(0, 1), cA + hstep, voffA);
        if (wr == 1) PG8_BAR;
        PG8_WAIT_V(4); PG8_BAR;
        PG8_STAGE(PG8_SB(1, 0), cB + kstep, voffB); PG8_STAGE(PG8_SA(1, 0), cA + kstep, voffA); PG8_STAGE(PG8_SB(1, 1), cB + hstep + kstep, voffB);
        PG8_WAIT_V(6); PG8_BAR;
    }
    for (;;) {
        const bool has_next = S.next(ui + 1, nxt);
        const char* nA = has_next ? (const char*)g.A + (size_t)nxt.pm * tstep : cA; const char* nB = has_next ? (const char*)g.Bt + (size_t)nxt.pn * tstep : cB;
        for (int t = 0; t < nt; t += 2) {
            const bool last = (t == nt - 2);
            const char* a1 = cA + (size_t)(t + 1) * kstep;
            const char* a2 = last ? nA : cA + (size_t)(t + 2) * kstep; const char* b2 = last ? nB : cB + (size_t)(t + 2) * kstep;
            const char* a3 = a2 + kstep; const char* b3 = b2 + kstep;
            if (last && has_next) S.a_ready(nxt);
            if constexpr (SP2) {
            PG8_LDB(B0, 0, 0); PG8_LDB(B1, 0, 1); PG8_SCHED; PG8_LDA(At, 0, 0); PG8_STAGE(PG8_SA(1, 1), a1 + hstep, voffA);
            PG8_WAIT_V(8); PG8_WAIT_L(0); PG8_BAR; PG8_MMA(0, 0, At, B0); PG8_MMA(0, 1, At, B1); PG8_BAR; PG8_SCHED;
            PG8_LDA(At, 0, 1); PG8_STAGE(PG8_SB(0, 0), b2, voffB); PG8_STAGE(PG8_SB(0, 1), b2 + hstep, voffB); PG8_STAGE(PG8_SA(0, 0), a2, voffA);
            PG8_WAIT_V(8); PG8_WAIT_L(0); PG8_BAR; PG8_MMA(1, 0, At, B0); PG8_MMA(1, 1, At, B1); PG8_BAR; PG8_SCHED;
            PG8_LDB(B0, 1, 0); PG8_LDB(B1, 1, 1); PG8_SCHED; PG8_LDA(At, 1, 0); PG8_STAGE(PG8_SA(0, 1), a2 + hstep, voffA);
            PG8_WAIT_V(8); PG8_WAIT_L(0); PG8_BAR; PG8_MMA(0, 0, At, B0); PG8_MMA(0, 1, At, B1); PG8_BAR; PG8_SCHED;
            PG8_LDA(At, 1, 1); PG8_STAGE(PG8_SB(1, 0), b3, voffB); PG8_STAGE(PG8_SB(1, 1), b3 + hstep, voffB); PG8_STAGE(PG8_SA(1, 0), a3, voffA);
            PG8_WAIT_V(8); PG8_WAIT_L(0); PG8_BAR; PG8_MMA(1, 0, At, B0); PG8_MMA(1, 1, At, B1); PG8_BAR; PG8_SCHED;
            } else {
            PG8_LDB(B0, 0, 0); PG8_SCHED; PG8_LDA(At, 0, 0); PG8_STAGE(PG8_SA(1, 1), a1 + hstep, voffA);
            PG8_WAIT_L(8); PG8_BAR; PG8_WAIT_L(0); PG8_MMA(0, 0, At, B0); PG8_BAR; PG8_SCHED;
            PG8_LDB(B1, 0, 1); PG8_STAGE(PG8_SB(0, 0), b2, voffB);
            PG8_BAR; PG8_WAIT_L(0); PG8_MMA(0, 1, At, B1); PG8_BAR;
            PG8_LDA(At, 0, 1); PG8_STAGE(PG8_SA(0, 0), a2, voffA);
            PG8_BAR; PG8_WAIT_L(0); PG8_MMA(1, 0, At, B0); PG8_BAR; PG8_SCHED;
            PG8_STAGE(PG8_SB(0, 1), b2 + hstep, voffB);
            PG8_WAIT_V(6); PG8_BAR; PG8_MMA(1, 1, At, B1); PG8_BAR;
            PG8_LDB(B0, 1, 0); PG8_SCHED; PG8_LDA(At, 1, 0); PG8_STAGE(PG8_SA(0, 1), a2 + hstep, voffA);
            PG8_WAIT_L(8); PG8_BAR; PG8_WAIT_L(0); PG8_MMA(0, 0, At, B0); PG8_BAR; PG8_SCHED;
            PG8_LDB(B1, 1, 1); PG8_STAGE(PG8_SB(1, 0), b3, voffB);
            PG8_BAR; PG8_WAIT_L(0); PG8_MMA(0, 1, At, B1); PG8_BAR;
            PG8_LDA(At, 1, 1); PG8_STAGE(PG8_SA(1, 0), a3, voffA);
            PG8_BAR; PG8_WAIT_L(0); PG8_MMA(1, 0, At, B0); PG8_BAR; PG8_SCHED;
            PG8_STAGE(PG8_SB(1, 1), b3 + hstep, voffB);
            PG8_WAIT_V(6); PG8_BAR; PG8_MMA(1, 1, At, B1); PG8_BAR;
            }
        }
        if constexpr (ALIGN_EPI) { if (wr == 0) PG8_BAR; }
        if constexpr (!Epi::AFTER_DRAIN) { E(acc, cur, wr, wc, fr, fq); S.done(cur); }
        if (!has_next) break;
#pragma unroll
        for (int a = 0; a < 2; ++a)
#pragma unroll
            for (int b = 0; b < 2; ++b)
#pragma unroll
                for (int m = 0; m < 4; ++m)
#pragma unroll
                    for (int n = 0; n < 2; ++n) acc[a][b][m][n] = (f32x4){0.f, 0.f, 0.f, 0.f};
        cur = nxt; cA = nA; cB = nB; ++ui;
        if constexpr (ALIGN_EPI) { if (wr == 1) PG8_BAR; }
    }
    PG8_WAIT_V(0);
    if constexpr (!ALIGN_EPI) { if (wr == 0) PG8_BAR; }
    PG8_BAR;
    if constexpr (Epi::AFTER_DRAIN) { E.fused(acc, cur, wr, wc, fr, fq, lds, wid, lane); S.done(cur); }
#undef PG8_SA
#undef PG8_SB
#undef PG8_STAGE
#undef PG8_LDA
#undef PG8_LDB
#undef PG8_MMA
#undef PG8_WAIT_V
#undef PG8_WAIT_L
#undef PG8_BAR
#undef PG8_SCHED
}
}
#define LAS __attribute__((address_space(3)))
typedef unsigned short bf16;
typedef unsigned v4u __attribute__((ext_vector_type(4)));
typedef unsigned v2u __attribute__((ext_vector_type(2)));
typedef float f32x4 __attribute__((ext_vector_type(4)));
typedef float f32x2 __attribute__((ext_vector_type(2)));

constexpr int D = 1024, NB = 8, SEQ = 4096, CTX = 256, DEPTH = 4, DFF = 2816;
constexpr int MLAT = NB * SEQ, MCTX = NB * CTX, MTOT = MLAT + MCTX;
constexpr int INC = 2944, INCP = 3072;
constexpr int RW = 384, LW = 384, RC = 1408;
constexpr int QLEN = CTX + SEQ;
constexpr int PC_BG = 0, PC_CG = 256, PC_XIN = 512, PC_RW = 768, PC_XR = 2176, PC_GR = 2560;
constexpr int PC_Y = 768;
constexpr int PC_G = 1536;
constexpr int LORA_N = 2048, LORA_K = 256;
constexpr int NWAVES = 8, NTHR = 512;
constexpr int LDS_BYTES = 147456;

constexpr size_t MiB = 1u << 20;
constexpr size_t WS_BAR = 1536 * 1024, WS_BAR_BYTES = 16384;
constexpr size_t WS_MODS = 0, WS_XRCTX = 2 * MiB, WS_WT = 10 * MiB, WS_H = 52 * MiB, WS_A = 120 * MiB, WS_B = 324 * MiB;
constexpr size_t SC_ELEMS = (size_t)NB * QLEN * RW;
constexpr size_t WS_WT2 = WS_B + 9 * SC_ELEMS * 2;
constexpr size_t WS_END = WS_WT2 + 42 * MiB;
static_assert(WS_END <= 600 * MiB, "workspace map");
static_assert(WS_A + (size_t)MTOT * INCP * 2 <= WS_B, "P fits");
constexpr size_t WT_GU1 = 0, WT_DOWN1 = WT_GU1 + (size_t)2 * DFF * D, WT_IN = WT_DOWN1 + (size_t)D * DFF, WT_OUT = WT_IN + (size_t)INCP * D,
                 WT_GU2 = WT_OUT + (size_t)D * D, WT_DOWN2 = WT_GU2 + (size_t)2 * DFF * D, WT_TOTAL = WT_DOWN2 + (size_t)D * DFF;
constexpr size_t WT_LORA = WT_TOTAL;
static_assert(WS_WT + (WT_TOTAL + (size_t)LORA_N * LORA_K) * 2 <= WS_H, "weights fit");
constexpr size_t HB_AP = 0, HB_KT = (size_t)MTOT * LORA_K * 2;
static_assert(HB_KT + (size_t)MTOT * RW * 2 <= WS_A - WS_H, "H region overlay");

enum { I_X = 0, I_C, I_CTX, I_CCTX, I_WMOD, I_BMOD, I_GFFN1, I_WGU1, I_WDOWN1, I_GMIX, I_WIN, I_CONVA, I_MU, I_W0, I_W2, I_A0, I_A2, I_G2, I_KK, I_KA, I_RK,
       I_LNG, I_LNB, I_LCW, I_LCB, I_LWR, I_LBR, I_LWI, I_LBI, I_LAM, I_WOUT, I_GFFN2, I_WGU2, I_WDOWN2, I_GFINAL, N_IN };

struct Args { const float* in[N_IN]; float* out; unsigned char* ws; int ph_lo, ph_hi; };
typedef const __attribute__((address_space(4))) Args* CArgsP;

__device__ __forceinline__ float bf2f(unsigned h) { return __builtin_bit_cast(float, h << 16); }
__device__ __forceinline__ unsigned f2bf(float f) { unsigned u = __builtin_bit_cast(unsigned, f); return (u + 0x7fffu + ((u >> 16) & 1u)) >> 16; }
__device__ __forceinline__ unsigned pk2(float lo, float hi) { unsigned r; asm("v_cvt_pk_bf16_f32 %0, %1, %2" : "=v"(r) : "v"(lo), "v"(hi)); return r; }
__device__ __forceinline__ void unpack8(v4u p, float* o) {
    o[0] = __builtin_bit_cast(float, p.x << 16); o[1] = __builtin_bit_cast(float, p.x & 0xffff0000u);
    o[2] = __builtin_bit_cast(float, p.y << 16); o[3] = __builtin_bit_cast(float, p.y & 0xffff0000u);
    o[4] = __builtin_bit_cast(float, p.z << 16); o[5] = __builtin_bit_cast(float, p.z & 0xffff0000u);
    o[6] = __builtin_bit_cast(float, p.w << 16); o[7] = __builtin_bit_cast(float, p.w & 0xffff0000u);
}
__device__ __forceinline__ v4u pack8(const float* v) { v4u o; o.x = pk2(v[0], v[1]); o.y = pk2(v[2], v[3]); o.z = pk2(v[4], v[5]); o.w = pk2(v[6], v[7]); return o; }
template <int CTRL> __device__ __forceinline__ float dppf(float v) { return __builtin_bit_cast(float, __builtin_amdgcn_update_dpp(0, __builtin_bit_cast(int, v), CTRL, 0xF, 0xF, true)); }
__device__ __forceinline__ float wave_sum(float v) {
    v += dppf<0xB1>(v); v += dppf<0x4E>(v); v += dppf<0x141>(v); v += dppf<0x140>(v);
    const float a = __builtin_bit_cast(float, __builtin_amdgcn_readlane(__builtin_bit_cast(int, v), 0)), b = __builtin_bit_cast(float, __builtin_amdgcn_readlane(__builtin_bit_cast(int, v), 16));
    const float c = __builtin_bit_cast(float, __builtin_amdgcn_readlane(__builtin_bit_cast(int, v), 32)), d = __builtin_bit_cast(float, __builtin_amdgcn_readlane(__builtin_bit_cast(int, v), 48));
    return (a + b) + (c + d);
}
__device__ __forceinline__ float sigmoidf_(float x) { return __builtin_amdgcn_rcpf(1.0f + __expf(-x)); }
__device__ __forceinline__ float siluf_(float x) { return x * __builtin_amdgcn_rcpf(1.0f + __expf(-x)); }
__device__ __forceinline__ float softplusf_(float z) { return fmaxf(z, 0.f) + log1pf(__expf(-fabsf(z))); }
__device__ __forceinline__ float tanh_fast(float x) { const float e = __expf(2.0f * fminf(fmaxf(x, -15.f), 15.f)); return 1.0f - 2.0f * __builtin_amdgcn_rcpf(e + 1.0f); }
__device__ __forceinline__ float gelu_tanh(float x) { const float u = 0.7978845608028654f * (x + 0.044715f * x * x * x); return 0.5f * x * (1.0f + tanh_fast(u)); }
__device__ __forceinline__ float rscatter16(const float (&v)[16], int j) {
    const bool b1 = (j & 8) != 0, b2 = (j & 4) != 0, b3 = (j & 2) != 0, b4 = (j & 1) != 0;
    float a[8], c[4], d[2];
#pragma unroll
    for (int k = 0; k < 8; ++k) { const float keep = b1 ? v[k + 8] : v[k], send = b1 ? v[k] : v[k + 8]; a[k] = keep + dppf<0x140>(send); }
#pragma unroll
    for (int k = 0; k < 4; ++k) { const float keep = b2 ? a[k + 4] : a[k], send = b2 ? a[k] : a[k + 4]; c[k] = keep + dppf<0x141>(send); }
#pragma unroll
    for (int k = 0; k < 2; ++k) { const float keep = b3 ? c[k + 2] : c[k], send = b3 ? c[k] : c[k + 2]; d[k] = keep + dppf<0x4E>(send); }
    { const float keep = b4 ? d[1] : d[0], send = b4 ? d[0] : d[1]; return keep + dppf<0xB1>(send); }
}
__device__ __forceinline__ float reduce16(float x) { x += dppf<0xB1>(x); x += dppf<0x4E>(x); x += dppf<0x141>(x); x += dppf<0x140>(x); return x; }
__device__ __forceinline__ float reduce8(float x) { x += dppf<0xB1>(x); x += dppf<0x4E>(x); x += dppf<0x141>(x); return x; }
__device__ __forceinline__ int row_of(int b, int q, int odd) {
    if (q < CTX) return MLAT + b * CTX + q;
    const int s = q - CTX; const int t = odd ? (((s & 63) << 6) | (s >> 6)) : s;
    return b * SEQ + t;
}

struct EpiSwiGLU {
    static constexpr bool PERM = true, AFTER_DRAIN = false;
    bf16* O;
    __device__ __forceinline__ void operator()(const pg8::f32x4 (&acc)[2][2][4][2], const pg8::Unit& u, int wr, int wc, int fr, int fq) const {
        const int row0 = u.pm * 256 + wr * 64 + fr, col0 = u.pn * 128 + wc * 32 + 8 * fq;
#pragma unroll
        for (int ai = 0; ai < 2; ++ai)
#pragma unroll
            for (int m = 0; m < 4; ++m) {
                float o[8];
#pragma unroll
                for (int n = 0; n < 2; ++n)
#pragma unroll
                    for (int j = 0; j < 4; ++j) { const float g = acc[ai][0][m][n][j], up = acc[ai][1][m][n][j]; o[n * 4 + j] = siluf_(g) * up; }
                *(v4u*)(O + (size_t)(row0 + ai * 128 + m * 16) * DFF + col0) = pack8(o);
            }
    }
};
struct EpiP {
    static constexpr bool PERM = true, AFTER_DRAIN = false;
    bf16* O; int ldc;
    __device__ __forceinline__ void operator()(const pg8::f32x4 (&acc)[2][2][4][2], const pg8::Unit& u, int wr, int wc, int fr, int fq) const {
        const int row0 = u.pm * 256 + wr * 64 + fr, col0 = u.pn * 256 + wc * 32 + 8 * fq;
#pragma unroll
        for (int ai = 0; ai < 2; ++ai)
#pragma unroll
            for (int m = 0; m < 4; ++m)
#pragma unroll
                for (int bj = 0; bj < 2; ++bj) {
                    float o[8];
#pragma unroll
                    for (int n = 0; n < 2; ++n)
#pragma unroll
                        for (int j = 0; j < 4; ++j) o[n * 4 + j] = acc[ai][bj][m][n][j];
                    *(v4u*)(O + (size_t)(row0 + ai * 128 + m * 16) * ldc + col0 + bj * 128) = pack8(o);
                }
    }
};
struct EpiResid {
    static constexpr bool PERM = true, AFTER_DRAIN = false;
    const float* res_lat; const float* res_ctx; float* dst_lat; float* dst_ctx; const float* gate; float coef;
    __device__ __forceinline__ void operator()(const pg8::f32x4 (&acc)[2][2][4][2], const pg8::Unit& u, int wr, int wc, int fr, int fq) const {
        const int rowbase = u.pm * 256; const bool isctx = rowbase >= MLAT;
        const int b = isctx ? 8 : (rowbase >> 12);
        const float* res = isctx ? res_ctx + (size_t)(rowbase - MLAT) * D : res_lat + (size_t)rowbase * D;
        float* dst = isctx ? dst_ctx + (size_t)(rowbase - MLAT) * D : dst_lat + (size_t)rowbase * D;
#pragma unroll
        for (int bj = 0; bj < 2; ++bj) {
            const int col = u.pn * 256 + bj * 128 + wc * 32 + 8 * fq;
            const f32x4 g0 = *(const f32x4*)(gate + (size_t)b * 9216 + col) * coef, g1 = *(const f32x4*)(gate + (size_t)b * 9216 + col + 4) * coef;
#pragma unroll
            for (int ai = 0; ai < 2; ++ai)
#pragma unroll
                for (int m = 0; m < 4; ++m) {
                    const size_t off = (size_t)(ai * 128 + wr * 64 + m * 16 + fr) * D + col;
                    const f32x4 r0 = *(const f32x4*)(res + off), r1 = *(const f32x4*)(res + off + 4);
                    *(f32x4*)(dst + off) = r0 + g0 * acc[ai][bj][m][0];
                    *(f32x4*)(dst + off + 4) = r1 + g1 * acc[ai][bj][m][1];
                }
        }
    }
};

struct EpiLora {
    static constexpr bool PERM = true, AFTER_DRAIN = false;
    const float* w0; const float* a0; const float* ka; const bf16* kt; const bf16* kk; bf16* scb; bf16* P; int odd;
    __device__ __forceinline__ void operator()(const pg8::f32x4 (&acc)[2][2][4][2], const pg8::Unit& u, int wr, int wc, int fr, int fq) const {
        asm volatile("" : "+v"(fr), "+v"(fq));
#pragma unroll
        for (int bj = 0; bj < 2; ++bj) {
            const int half = __builtin_amdgcn_readfirstlane(u.pn * 2 + bj), kind = half / 3, c = (half - kind * 3) * 128 + wc * 32 + 8 * fq;
            if (kind >= 5) continue;
#pragma unroll
            for (int ai = 0; ai < 2; ++ai)
#pragma unroll
                for (int m = 0; m < 4; ++m) {
                    const int pos = u.pm * 256 + ai * 128 + wr * 64 + m * 16 + fr;
                    float v[8];
#pragma unroll
                    for (int n = 0; n < 2; ++n)
#pragma unroll
                        for (int j = 0; j < 4; ++j) v[n * 4 + j] = acc[ai][bj][m][n][j];
                    if (kind < 2) {
                        const f32x4 q0 = *(const f32x4*)(w0 + kind * 384 + c), q1 = *(const f32x4*)(w0 + kind * 384 + c + 4);
                        const float p0[8] = {q0.x, q0.y, q0.z, q0.w, q1.x, q1.y, q1.z, q1.w};
#pragma unroll
                        for (int e = 0; e < 8; ++e) { const float wl = p0[e] + v[e];
                            v[e] = 1.0f - __expf(-0.6065306597126334f * sigmoidf_(wl)); }
                        *(v4u*)(scb + (size_t)(7 + kind) * SC_ELEMS + (size_t)pos * RW + c) = pack8(v);
                    } else if (kind < 4) {
                        const f32x4 q0 = *(const f32x4*)(a0 + (kind - 2) * 384 + c), q1 = *(const f32x4*)(a0 + (kind - 2) * 384 + c + 4);
                        const float p0[8] = {q0.x, q0.y, q0.z, q0.w, q1.x, q1.y, q1.z, q1.w};
#pragma unroll
                        for (int e = 0; e < 8; ++e) v[e] = sigmoidf_(p0[e] + v[e]);
                        {   float kkv[8]; unpack8(*(const v4u*)(kk + (size_t)pos * RW + c), kkv);
#pragma unroll
                            for (int e = 0; e < 8; ++e) kkv[e] *= v[e];
                            *(v4u*)(scb + (size_t)(5 + kind - 2) * SC_ELEMS + (size_t)pos * RW + c) = pack8(kkv); }
                        {   float kv[8]; unpack8(*(const v4u*)(kt + (size_t)pos * RW + c), kv);
                            const f32x4 r0 = *(const f32x4*)(ka + c), r1 = *(const f32x4*)(ka + c + 4);
                            const float p1[8] = {r0.x, r0.y, r0.z, r0.w, r1.x, r1.y, r1.z, r1.w};
#pragma unroll
                            for (int e = 0; e < 8; ++e) kv[e] *= (1.0f + (v[e] - 1.0f) * p1[e]);
                            *(v4u*)(scb + (size_t)(3 + kind - 2) * SC_ELEMS + (size_t)pos * RW + c) = pack8(kv); }
                    } else {
                        const int b = pos / QLEN, q = pos - b * QLEN;
                        *(v4u*)(P + (size_t)row_of(b, q, odd) * INCP + PC_G + c) = pack8(v);
                    }
                    asm volatile("" ::: "memory");
                }
        }
    }
};
struct WS {
    float* mods; float* xrctx; bf16* wt; bf16* wt2; bf16* H; bf16* P; bf16* ACT;
    bf16 *scb, *sc_r, *sc_v, *sc_kk, *dgs;
};
__device__ __forceinline__ WS make_ws(unsigned char* ws) {
    WS w; w.mods = (float*)(ws + WS_MODS); w.xrctx = (float*)(ws + WS_XRCTX); w.wt = (bf16*)(ws + WS_WT); w.wt2 = (bf16*)(ws + WS_WT2); w.H = (bf16*)(ws + WS_H); w.P = (bf16*)(ws + WS_A); w.ACT = (bf16*)(ws + WS_A);
    bf16* b = (bf16*)(ws + WS_B);
    w.scb = b; w.sc_r = b; w.sc_v = b + SC_ELEMS; w.sc_kk = b + 2 * SC_ELEMS; w.dgs = b + 9 * SC_ELEMS;
    return w;
}

__device__ __forceinline__ void mods_phase(const int bx, const int G, CArgsP A, const WS& W, LAS unsigned char* lds, int tid, int lane, int wave) {
    LAS float* sl = (LAS float*)lds;
    LAS float* part = sl + 9 * 1024;
    const float* c = A->in[I_C]; const float* cctx = A->in[I_CCTX];
    for (int i = tid; i < 9216; i += NTHR) { const int r = i >> 10, k = i & 1023; const float v = r < 8 ? c[r * 1024 + k] : cctx[k]; sl[i] = siluf_(v); }
    __syncthreads();
    for (int item = bx; item < 288; item += G) {
        const int l = item / 72, cgp = item % 72;
        const float* Wp = A->in[I_WMOD] + (size_t)l * 1024 * 9216 + cgp * 128 + lane * 2;
        float acc[9][2];
#pragma unroll
        for (int r = 0; r < 9; ++r) { acc[r][0] = 0.f; acc[r][1] = 0.f; }
#pragma unroll 8
        for (int kk = 0; kk < 128; ++kk) {
            const int k = wave * 128 + kk;
            const f32x2 w = *(const f32x2*)(Wp + (size_t)k * 9216);
#pragma unroll
            for (int r = 0; r < 9; ++r) { const float s = sl[r * 1024 + k]; acc[r][0] += s * w.x; acc[r][1] += s * w.y; }
        }
#pragma unroll
        for (int r = 0; r < 9; ++r) { part[(wave * 9 + r) * 128 + lane * 2] = acc[r][0]; part[(wave * 9 + r) * 128 + lane * 2 + 1] = acc[r][1]; }
        __syncthreads();
        for (int o = tid; o < 1152; o += NTHR) {
            const int r = o >> 7, cc = o & 127; float s = A->in[I_BMOD][l * 9216 + cgp * 128 + cc];
#pragma unroll
            for (int w8 = 0; w8 < 8; ++w8) s += part[(w8 * 9 + r) * 128 + cc];
            W.mods[(size_t)(l * 9 + r) * 9216 + cgp * 128 + cc] = s;
        }
        __syncthreads();
    }
}

__device__ __forceinline__ void transpose_item(const float* Wsrc, int K, int N, bf16* WT, int kb, int n0, int drow0, LAS float* scr, int lane) {
    const int k0 = 64 * kb;
    float tv[32];
#pragma unroll
    for (int i = 0; i < 32; ++i) tv[i] = Wsrc[(size_t)(k0 + 2 * i + (lane >> 5)) * N + n0 + (lane & 31)];
#pragma unroll
    for (int i = 0; i < 32; ++i) scr[(2 * i + (lane >> 5)) * 33 + (lane & 31)] = tv[i];
    asm volatile("s_waitcnt lgkmcnt(0)" ::: "memory");
    const int c = lane & 7;
#pragma unroll
    for (int j = 0; j < 4; ++j) { const int n = (lane >> 3) + 8 * j; const LAS float* s = scr + (8 * c) * 33 + n;
        v4u o; o.x = pk2(s[0 * 33], s[1 * 33]); o.y = pk2(s[2 * 33], s[3 * 33]); o.z = pk2(s[4 * 33], s[5 * 33]); o.w = pk2(s[6 * 33], s[7 * 33]);
        *(v4u*)(WT + (size_t)(drow0 + n) * K + k0 + 8 * c) = o; }
    asm volatile("s_waitcnt lgkmcnt(0)" ::: "memory");
}
__device__ __forceinline__ int gu_drow(int n0) { return n0 < DFF ? 256 * (n0 >> 7) + (n0 & 127) : 256 * ((n0 - DFF) >> 7) + 128 + ((n0 - DFF) & 127); }
__device__ __forceinline__ void convert_phase(const int bx, const int G, CArgsP A, bf16* wtd, int l, LAS unsigned char* lds, int lane, int wave) {
    LAS float* scr = (LAS float*)(lds + wave * 16384);
    const int gw = bx * NWAVES + wave, NGW = G * NWAVES;
    constexpr int I_GU = (D / 64) * (2 * DFF / 32), I_DN = (DFF / 64) * (D / 32), I_IN = (D / 64) * (INC / 32), I_OUT = (D / 64) * (D / 32);
    constexpr int NITEMS = 2 * I_GU + 2 * I_DN + I_IN + I_OUT;
    for (int it = gw; it < NITEMS; it += NGW) {
        int r = it;
        if (r < I_GU) { const int nblk = 2 * DFF / 32, kb = r / nblk, n0 = (r % nblk) * 32; transpose_item(A->in[I_WGU1] + (size_t)l * D * 2 * DFF, D, 2 * DFF, wtd + WT_GU1, kb, n0, gu_drow(n0), scr, lane); continue; } r -= I_GU;
        if (r < I_GU) { const int nblk = 2 * DFF / 32, kb = r / nblk, n0 = (r % nblk) * 32; transpose_item(A->in[I_WGU2] + (size_t)l * D * 2 * DFF, D, 2 * DFF, wtd + WT_GU2, kb, n0, gu_drow(n0), scr, lane); continue; } r -= I_GU;
        if (r < I_DN) { const int nblk = D / 32, kb = r / nblk, n0 = (r % nblk) * 32; transpose_item(A->in[I_WDOWN1] + (size_t)l * DFF * D, DFF, D, wtd + WT_DOWN1, kb, n0, n0, scr, lane); continue; } r -= I_DN;
        if (r < I_DN) { const int nblk = D / 32, kb = r / nblk, n0 = (r % nblk) * 32; transpose_item(A->in[I_WDOWN2] + (size_t)l * DFF * D, DFF, D, wtd + WT_DOWN2, kb, n0, n0, scr, lane); continue; } r -= I_DN;
        if (r < I_IN) { const int nblk = INC / 32, kb = r / nblk, n0 = (r % nblk) * 32; transpose_item(A->in[I_WIN] + (size_t)l * D * INC, D, INC, wtd + WT_IN, kb, n0, n0, scr, lane); continue; } r -= I_IN;
        { const int nblk = D / 32, kb = r / nblk, n0 = (r % nblk) * 32; transpose_item(A->in[I_WOUT] + (size_t)l * D * D, D, D, wtd + WT_OUT, kb, n0, n0, scr, lane); }
    }
    for (int idx = (bx * NWAVES + wave) * 64 + lane; idx < LORA_N * LORA_K; idx += G * NTHR) {
        const int n = idx % LORA_N, k = idx / LORA_N, kind = n / 384, c = n - kind * 384;
        float v = 0.f;
        if (kind < 2) { if (k < 64) v = A->in[I_W2][((size_t)(l * 2 + kind) * 64 + k) * RW + c]; }
        else if (kind < 4) { if (k >= 64 && k < 128) v = A->in[I_A2][((size_t)(l * 2 + kind - 2) * 64 + (k - 64)) * RW + c]; }
        else if (kind == 4) { if (k >= 128) v = A->in[I_G2][((size_t)l * 128 + (k - 128)) * RW + c]; }
        wtd[WT_LORA + (size_t)n * LORA_K + k] = (bf16)f2bf(v);
    }
}

__device__ __forceinline__ void norm_phase(const int bx, const int G, const float* lat, const float* ctxp, const float* g, const float* mods_l, int ishift, int iscale, bf16* H, int row_lo, int nrows, int lane, int wave) {
    const int gw = bx * NWAVES + wave, NGW = G * NWAVES;
    for (int r0 = row_lo + gw; r0 < nrows; r0 += 2 * NGW) {
        const int r1 = r0 + NGW < nrows ? r0 + NGW : r0;
        const float* xa = r0 < MLAT ? lat + (size_t)r0 * D : ctxp + (size_t)(r0 - MLAT) * D;
        const float* xb = r1 < MLAT ? lat + (size_t)r1 * D : ctxp + (size_t)(r1 - MLAT) * D;
        f32x4 va[4], vb[4]; float sa = 0.f, sb = 0.f;
#pragma unroll
        for (int j = 0; j < 4; ++j) { va[j] = *(const f32x4*)(xa + (lane + 64 * j) * 4); vb[j] = *(const f32x4*)(xb + (lane + 64 * j) * 4); }
#pragma unroll
        for (int j = 0; j < 4; ++j) { sa += (va[j].x * va[j].x + va[j].y * va[j].y) + (va[j].z * va[j].z + va[j].w * va[j].w); sb += (vb[j].x * vb[j].x + vb[j].y * vb[j].y) + (vb[j].z * vb[j].z + vb[j].w * vb[j].w); }
        sa = wave_sum(sa); sb = wave_sum(sb);
        const float rsa = rsqrtf(sa * (1.0f / D) + 1e-6f), rsb = rsqrtf(sb * (1.0f / D) + 1e-6f);
        const int ba = r0 < MLAT ? (r0 >> 12) : 8, bb = r1 < MLAT ? (r1 >> 12) : 8;
        const float* sha = mods_l + (size_t)ba * 9216 + ishift * 1024; const float* sca = mods_l + (size_t)ba * 9216 + iscale * 1024;
        const float* shb = mods_l + (size_t)bb * 9216 + ishift * 1024; const float* scb2 = mods_l + (size_t)bb * 9216 + iscale * 1024;
#pragma unroll
        for (int j = 0; j < 4; ++j) {
            const int col = (lane + 64 * j) * 4;
            const f32x4 gg = *(const f32x4*)(g + col);
            { const f32x4 s4 = *(const f32x4*)(sha + col), c4 = *(const f32x4*)(sca + col); const f32x4 h = (va[j] * rsa) * gg * (c4 + 1.0f) + s4;
              v2u o; o.x = pk2(h.x, h.y); o.y = pk2(h.z, h.w); *(v2u*)(H + (size_t)r0 * D + col) = o; }
            if (r1 != r0) { const f32x4 s4 = *(const f32x4*)(shb + col), c4 = *(const f32x4*)(scb2 + col); const f32x4 h = (vb[j] * rsb) * gg * (c4 + 1.0f) + s4;
              v2u o; o.x = pk2(h.x, h.y); o.y = pk2(h.z, h.w); *(v2u*)(H + (size_t)r1 * D + col) = o; }
        }
    }
}
__device__ __forceinline__ void final_norm_phase(const int bx, const int G, float* xo, const float* g, int lane, int wave) {
    const int gw = bx * NWAVES + wave, NGW = G * NWAVES;
    for (int r0 = gw; r0 < MLAT; r0 += 2 * NGW) {
        const int r1 = r0 + NGW < MLAT ? r0 + NGW : r0;
        float* xa = xo + (size_t)r0 * D; float* xb = xo + (size_t)r1 * D;
        f32x4 va[4], vb[4]; float sa = 0.f, sb = 0.f;
#pragma unroll
        for (int j = 0; j < 4; ++j) { va[j] = *(const f32x4*)(xa + (lane + 64 * j) * 4); vb[j] = *(const f32x4*)(xb + (lane + 64 * j) * 4); }
#pragma unroll
        for (int j = 0; j < 4; ++j) { sa += (va[j].x * va[j].x + va[j].y * va[j].y) + (va[j].z * va[j].z + va[j].w * va[j].w); sb += (vb[j].x * vb[j].x + vb[j].y * vb[j].y) + (vb[j].z * vb[j].z + vb[j].w * vb[j].w); }
        sa = wave_sum(sa); sb = wave_sum(sb);
        const float rsa = rsqrtf(sa * (1.0f / D) + 1e-6f), rsb = rsqrtf(sb * (1.0f / D) + 1e-6f);
#pragma unroll
        for (int j = 0; j < 4; ++j) { const int col = (lane + 64 * j) * 4; const f32x4 gg = *(const f32x4*)(g + col);
            *(f32x4*)(xa + col) = (va[j] * rsa) * gg; if (r1 != r0) *(f32x4*)(xb + col) = (vb[j] * rsb) * gg; }
    }
}

__device__ __forceinline__ void pre_item(int it, int& i, int& col) {
    if (it < 2304) { const int seg = it / 768, r = it - seg * 768; i = r / 48; col = seg * 384 + (r % 48) * 8; }
    else if (it < 2560) { const int r = it - 2304; i = (r & 127) >> 3; col = 1152 + (r >> 7) * 64 + (r & 7) * 8; }
    else { const int r = it - 2560; i = r >> 4; col = 1280 + (r & 15) * 8; }
}
__device__ __forceinline__ void pre_phase(const int bx, const int G, CArgsP A, const WS& W, int l, LAS unsigned char* lds, int tid, int lane, int wave) {
    LAS float* k_s = (LAS float*)lds;
    const int odd = l & 1;
    const float* mu0 = A->in[I_MU] + (size_t)l * 2 * RC; const float* mu1 = mu0 + RC;
    const float* kkp = A->in[I_KK] + l * RW;
    bf16* AP = (bf16*)((unsigned char*)W.H + HB_AP); bf16* KT = (bf16*)((unsigned char*)W.H + HB_KT);
    for (int tile = bx; tile < NB * (QLEN / 16); tile += G) {
        const int b = tile / (QLEN / 16), q0 = (tile % (QLEN / 16)) * 16;
        const int seq_lo = q0 < CTX ? 0 : CTX, seq_hi = q0 < CTX ? CTX : QLEN;
        for (int pass = 0; pass < 2; ++pass) {
            v4u rc[3], rp[3], rn[3];
#pragma unroll
            for (int u = 0; u < 3; ++u) { const int it0 = tid + NTHR * (pass * 3 + u), it = it0 < 16 * 176 ? it0 : 16 * 176 - 1;
                int i, col; pre_item(it, i, col); const int q = q0 + i;
                const int qp = q - 1 >= seq_lo ? q - 1 : q, qn = q + 1 < seq_hi ? q + 1 : q;
                rc[u] = *(const v4u*)(W.P + (size_t)row_of(b, q, odd) * INCP + PC_RW + col);
                rp[u] = *(const v4u*)(W.P + (size_t)row_of(b, qp, odd) * INCP + PC_RW + col);
                rn[u] = *(const v4u*)(W.P + (size_t)row_of(b, qn, odd) * INCP + PC_RW + col); }
#pragma unroll
            for (int u = 0; u < 3; ++u) { const int it0 = tid + NTHR * (pass * 3 + u);
                if (it0 < 16 * 176) {
                    int i, col; pre_item(it0, i, col); const int q = q0 + i;
                    const size_t pos = (size_t)b * QLEN + q;
                    float cur[8], prv[8], nxt[8], ps[8];
                    unpack8(rc[u], cur); unpack8(rp[u], prv); unpack8(rn[u], nxt);
                    const float mp = q - 1 >= seq_lo ? 1.f : 0.f, mn = q + 1 < seq_hi ? 1.f : 0.f;
#pragma unroll
                    for (int e = 0; e < 8; ++e) ps[e] = cur[e] + mu0[col + e] * (prv[e] * mp - cur[e]) + mu1[col + e] * (nxt[e] * mn - cur[e]);
                    if (col < 384) *(v4u*)(W.sc_r + pos * RW + col) = pack8(ps);
                    else if (col < 768) {
#pragma unroll
                        for (int e = 0; e < 8; ++e) k_s[i * 384 + col - 384 + e] = ps[e];
                        *(v4u*)(KT + pos * RW + (col - 384)) = pack8(ps); }
                    else if (col < 1152) *(v4u*)(W.sc_v + pos * RW + (col - 768)) = pack8(ps);
                    else if (col < 1216) {
#pragma unroll
                        for (int e = 0; e < 8; ++e) ps[e] = tanh_fast(ps[e]);
                        *(v4u*)(AP + pos * LORA_K + (col - 1152)) = pack8(ps); }
                    else if (col < 1280) *(v4u*)(AP + pos * LORA_K + 64 + (col - 1216)) = pack8(ps);
                    else {
#pragma unroll
                        for (int e = 0; e < 8; ++e) ps[e] = sigmoidf_(ps[e]);
                        *(v4u*)(AP + pos * LORA_K + 128 + (col - 1280)) = pack8(ps); }
                }
            }
        }
        __syncthreads();
        for (int it = wave * 8 + (lane >> 3); it < 96; it += 64) {
            const int i = it / 6, h = it % 6, c = h * 64 + (lane & 7) * 8;
            float kv[8]; float ss = 0.f;
#pragma unroll
            for (int e = 0; e < 8; ++e) { kv[e] = k_s[i * 384 + c + e] * kkp[c + e]; ss += kv[e] * kv[e]; }
            const float rn = rsqrtf(reduce8(ss) + 1e-12f);
#pragma unroll
            for (int e = 0; e < 8; ++e) kv[e] *= rn;
            *(v4u*)(W.sc_kk + ((size_t)b * QLEN + q0 + i) * RW + c) = pack8(kv);
        }
        __syncthreads();
    }
}

__device__ __forceinline__ int q_of_step(int n, int d) { return d == 0 ? n : (n < CTX ? CTX - 1 - n : QLEN + CTX - 1 - n); }
constexpr int RCH = 32, RNCH = QLEN / RCH;
__device__ __forceinline__ void rwkv_scan_phase(const WS& W, int l, int blk, LAS unsigned char* lds, int tid, int lane, int wave) {
    const int item = blk >> 1, half = blk & 1;
    const int b = item / 12, rem = item % 12, h = rem >> 1, d = rem & 1, odd = l & 1;
    LAS float* buf = (LAS float*)lds;
    LAS float* ybuf = buf + 2 * RCH * 384;
    const bf16* s_omw = W.scb + (size_t)(7 + d) * SC_ELEMS; const bf16* s_b = W.scb + (size_t)(5 + d) * SC_ELEMS; const bf16* s_kd = W.scb + (size_t)(3 + d) * SC_ELEMS;
    const int rg = lane >> 4, j = lane & 15, rlA = (wave & 3) * 8 + rg, rlB = rlA + 4, rowA = half * 32 + rlA, rowB = half * 32 + rlB;
    v4u pre[6];
    const int t4 = tid - 256;
#define RW_LOAD(c) do { _Pragma("unroll") for (int jj = 0; jj < 6; ++jj) { const int p = t4 + 256 * jj, i = p / 48, r48 = p % 48, vec = r48 >> 3, part = r48 & 7; \
        const int q = q_of_step((c) * RCH + i, d); const size_t pos = (size_t)b * QLEN + q; \
        const bf16* base = vec == 0 ? s_omw : vec == 1 ? s_b : vec == 2 ? s_kd : vec == 3 ? W.sc_kk : vec == 4 ? W.sc_r : W.sc_v; \
        pre[jj] = *(const v4u*)(base + pos * RW + h * 64 + part * 8); } } while (0)
#define RW_STORE(c) do { _Pragma("unroll") for (int jj = 0; jj < 6; ++jj) { const int p = t4 + 256 * jj, i = p / 48, r48 = p % 48, vec = r48 >> 3, part = r48 & 7; \
        float f[8]; unpack8(pre[jj], f); if (vec == 0) { _Pragma("unroll") for (int e = 0; e < 8; ++e) f[e] = 1.0f - f[e]; } \
        LAS float* dst = buf + (((c) & 1) * RCH + i) * 384 + vec * 64 + part * 8; \
        *(LAS f32x4*)dst = (f32x4){f[0], f[1], f[2], f[3]}; *(LAS f32x4*)(dst + 4) = (f32x4){f[4], f[5], f[6], f[7]}; } } while (0)
    f32x2 SA0 = (f32x2){0.f, 0.f}, SA1 = SA0, SB0 = SA0, SB1 = SA0;
#define RW_FLUSH(c) do { const int i = t4 >> 3, r4 = (t4 & 7) * 4; const int q = q_of_step((c) * RCH + i, d); \
        const f32x4 yv = *(const LAS f32x4*)(ybuf + ((c) & 1) * RCH * 32 + i * 32 + r4); \
        v2u o; o.x = pk2(yv.x, yv.y); o.y = pk2(yv.z, yv.w); \
        *(v2u*)(W.P + (size_t)row_of(b, q, odd) * INCP + PC_Y + d * RW + h * 64 + half * 32 + r4) = o; } while (0)
    if (wave >= 4) { RW_LOAD(0); RW_STORE(0); }
    __syncthreads();
    for (int c = 0; c < RNCH; ++c) {
        const LAS float* cur = buf + (c & 1) * RCH * 384;
        LAS float* yb = ybuf + (c & 1) * RCH * 32;
        if (wave >= 4) {
            if (c + 1 < RNCH) RW_LOAD(c + 1);
            if (c > 0) RW_FLUSH(c - 1);
            if (c + 1 < RNCH) RW_STORE(c + 1);
        } else {
        float ykA, ykB, ypA[16], ypB[16];
#define RW_LD(X, i_) do { const int ii_ = (i_) < RCH ? (i_) : RCH - 1; const LAS f32x4* bp_ = (const LAS f32x4*)(cur + ii_ * 384 + j * 4); \
        X##w = bp_[0]; X##b = bp_[16]; X##d = bp_[32]; X##k = bp_[48]; X##r = bp_[64]; X##va = cur[ii_ * 384 + 320 + rowA]; X##vb = cur[ii_ * 384 + 320 + rowB]; } while (0)
#define RW_CP(X, s_) do { \
        const f32x2 k0_ = (f32x2){X##k.x, X##k.y}, k1_ = (f32x2){X##k.z, X##k.w}; \
        const f32x2 ta_ = SA0 * k0_ + SA1 * k1_, tb_ = SB0 * k0_ + SB1 * k1_; \
        const float saA_ = -reduce16(ta_.x + ta_.y), saB_ = -reduce16(tb_.x + tb_.y); \
        const f32x2 w0_ = (f32x2){X##w.x, X##w.y}, w1_ = (f32x2){X##w.z, X##w.w}, b0_ = (f32x2){X##b.x, X##b.y}, b1_ = (f32x2){X##b.z, X##b.w}, d0_ = (f32x2){X##d.x, X##d.y}, d1_ = (f32x2){X##d.z, X##d.w}; \
        const f32x2 va2_ = (f32x2){X##va, X##va}, vb2_ = (f32x2){X##vb, X##vb}, sa2_ = (f32x2){saA_, saA_}, sb2_ = (f32x2){saB_, saB_}; \
        SA0 = SA0 * w0_ + va2_ * d0_ + sa2_ * b0_; SA1 = SA1 * w1_ + va2_ * d1_ + sa2_ * b1_; \
        SB0 = SB0 * w0_ + vb2_ * d0_ + sb2_ * b0_; SB1 = SB1 * w1_ + vb2_ * d1_ + sb2_ * b1_; \
        const f32x2 r0_ = (f32x2){X##r.x, X##r.y}, r1_ = (f32x2){X##r.z, X##r.w}; \
        const f32x2 ya_ = SA0 * r0_ + SA1 * r1_, yb_ = SB0 * r0_ + SB1 * r1_; \
        ypA[s_] = ya_.x + ya_.y; ypB[s_] = yb_.x + yb_.y; } while (0)
        f32x4 Aw, Ab, Ad, Ak, Ar, Bw, Bb, Bd, Bk, Br; float Ava, Avb, Bva, Bvb;
        RW_LD(A, 0);
#pragma unroll 1
        for (int g = 0; g < 2; ++g) {
            ykA = 0.f; ykB = 0.f;
#pragma unroll
            for (int s2 = 0; s2 < 16; s2 += 2) {
                const int i = g * 16 + s2;
                RW_LD(B, i + 1);
                __builtin_amdgcn_sched_barrier(0);
                RW_CP(A, s2);
                __builtin_amdgcn_sched_barrier(0);
                RW_LD(A, i + 2);
                __builtin_amdgcn_sched_barrier(0);
                RW_CP(B, s2 + 1);
                __builtin_amdgcn_sched_barrier(0);
            }
            ykA = rscatter16(ypA, j); ykB = rscatter16(ypB, j);
            yb[(g * 16 + j) * 32 + rlA] = ykA; yb[(g * 16 + j) * 32 + rlB] = ykB;
        }
#undef RW_LD
#undef RW_CP
        }
        __syncthreads();
    }
    if (wave >= 4) RW_FLUSH(RNCH - 1);
#undef RW_FLUSH
#undef RW_LOAD
#undef RW_STORE
}

__device__ __forceinline__ void lru_scan_phase(CArgsP A, const WS& W, int l, int idx, LAS unsigned char* lds, int tid, int lane, int wave) {
    const int b = idx / 6, n = idx % 6, odd = l & 1;
    LAS float* gs = (LAS float*)lds;
    LAS float* xs = gs;
    LAS float* us = gs + 4 * 4096;
    LAS bf16* ub = (LAS bf16*)(us + 2 * 4096);
    const int c = tid & 63;
    float cw[2][4], cb[2], sp[2];
#pragma unroll
    for (int dd = 0; dd < 2; ++dd) {
#pragma unroll
        for (int jj = 0; jj < 4; ++jj) cw[dd][jj] = A->in[I_LCW][((size_t)(l * 2 + dd) * 4 + jj) * LW + n * 64 + c];
        cb[dd] = A->in[I_LCB][(l * 2 + dd) * LW + n * 64 + c];
        sp[dd] = softplusf_(-A->in[I_LAM][(l * 2 + dd) * LW + n * 64 + c]);
    }
    const int g = wave >> 2, jcol = (wave & 3) * 16 + (lane & 15), quad = lane >> 4;
    pg8::bf16x8 bfrag[2][2]; float gbias[2];
#pragma unroll
    for (int dd = 0; dd < 2; ++dd) {
        const float* Wsrc = (g ? A->in[I_LWI] : A->in[I_LWR]) + ((size_t)((l * 2 + dd) * 6 + n) * 64) * 64 + jcol;
#pragma unroll
        for (int ks = 0; ks < 2; ++ks)
#pragma unroll
            for (int jj = 0; jj < 8; ++jj) bfrag[dd][ks][jj] = (short)f2bf(Wsrc[(size_t)(ks * 32 + quad * 8 + jj) * 64]);
        gbias[dd] = (g ? A->in[I_LBI] : A->in[I_LBR])[(l * 2 + dd) * LW + n * 64 + jcol];
    }
    float hstate = 0.f;
    v4u pre[2][2];
#define LRU_LOAD(ch) do { _Pragma("unroll") for (int dd = 0; dd < 2; ++dd) { const int n0 = (ch) * 64; const int qlo_ = dd == 0 ? n0 : q_of_step(n0, 1) - 63; const int qb_ = dd == 0 ? qlo_ - 3 : qlo_; \
        const int slo_ = qlo_ < CTX ? 0 : CTX, shi_ = qlo_ < CTX ? CTX : QLEN; \
        _Pragma("unroll") for (int jj = 0; jj < 2; ++jj) { const int p = tid + NTHR * jj; const int t = p >> 3, part = p & 7, q = qb_ + t; \
            pre[dd][jj] = (v4u){0u, 0u, 0u, 0u}; \
            if (t < 67 && q >= slo_ && q < shi_) pre[dd][jj] = *(const v4u*)(W.P + (size_t)row_of(b, q, odd) * INCP + PC_XR + n * 64 + part * 8); } } } while (0)
    LRU_LOAD(0);
    const int tid_o = tid, lane_o = lane;
    for (int ch = 0; ch < QLEN / 64; ++ch) {
        const int n0 = ch * 64;
        int tid = tid_o, lane = lane_o; asm volatile("" : "+v"(tid), "+v"(lane));
        const int c = tid & 63, jcol = (wave & 3) * 16 + (lane & 15), quad = lane >> 4;
#pragma unroll
        for (int dd = 0; dd < 2; ++dd)
#pragma unroll
            for (int jj = 0; jj < 2; ++jj) { const int p = tid + NTHR * jj; const int t = p >> 3, part = p & 7;
                if (t < 67) { float f[8]; unpack8(pre[dd][jj], f); LAS float* dst = xs + dd * 68 * 64 + t * 64 + part * 8;
                    *(LAS f32x4*)dst = (f32x4){f[0], f[1], f[2], f[3]}; *(LAS f32x4*)(dst + 4) = (f32x4){f[4], f[5], f[6], f[7]}; } }
        __syncthreads();
        if (ch + 1 < QLEN / 64) LRU_LOAD(ch + 1);
#pragma unroll
        for (int k = 0; k < 16; ++k) { const int dd = k >> 3, t = (tid >> 6) + 8 * (k & 7); const LAS float* x = xs + dd * 68 * 64;
            const float uv = cb[dd] + cw[dd][0] * x[t * 64 + c] + cw[dd][1] * x[(t + 1) * 64 + c] + cw[dd][2] * x[(t + 2) * 64 + c] + cw[dd][3] * x[(t + 3) * 64 + c];
            us[dd * 4096 + t * 64 + c] = uv; ub[dd * 64 * 72 + t * 72 + c] = (bf16)f2bf(uv); }
        __syncthreads();
#pragma unroll
        for (int dd = 0; dd < 2; ++dd)
#pragma unroll
            for (int rt = 0; rt < 4; ++rt) {
                pg8::f32x4 acc = {0.f, 0.f, 0.f, 0.f};
#pragma unroll
                for (int ks = 0; ks < 2; ++ks) {
                    const pg8::bf16x8 afrag = *(const LAS pg8::bf16x8*)(ub + dd * 64 * 72 + (rt * 16 + (lane & 15)) * 72 + ks * 32 + quad * 8);
                    acc = __builtin_amdgcn_mfma_f32_16x16x32_bf16(afrag, bfrag[dd][ks], acc, 0, 0, 0);
                }
#pragma unroll
                for (int jj = 0; jj < 4; ++jj) gs[((dd * 2 + g) * 64 + rt * 16 + quad * 4 + jj) * 64 + jcol] = sigmoidf_(acc[jj] + gbias[dd]);
            }
        __syncthreads();
#pragma unroll
        for (int k = 0; k < 16; ++k) { const int dd = k >> 3, t = (tid >> 6) + 8 * (k & 7);
            LAS float* ga = gs + (dd * 2) * 4096 + t * 64 + c; LAS float* gb = ga + 4096;
            const float rgv = *ga, igv = *gb, u = us[dd * 4096 + t * 64 + c];
            const float log_a = -8.0f * sp[dd] * rgv;
            const float a = __expf(log_a);
            const float bt = __builtin_amdgcn_sqrtf(fmaxf(1.0f - a * a, 0.f)) * (igv * u);
            *ga = a; *gb = bt; }
        __syncthreads();
        if (wave < 2) {
            const int dd = wave; const int qlo = dd == 0 ? n0 : q_of_step(n0, 1) - 63;
            const LAS float* ga = gs + (dd * 2) * 4096 + lane; LAS float* hb = us + dd * 4096 + lane;
            (void)qlo;
#pragma unroll 8
            for (int s = 0; s < 64; ++s) { const int t = dd == 0 ? s : 63 - s;
                hstate = ga[t * 64] * hstate + ga[4096 + t * 64];
                hb[t * 64] = hstate; }
        }
        __syncthreads();
#pragma unroll
        for (int k = 0; k < 2; ++k) { const int p = tid + NTHR * k, dd = p >> 9, t = (p >> 3) & 63, part = p & 7;
            const int qlo = dd == 0 ? n0 : q_of_step(n0, 1) - 63;
            const LAS f32x4* hp = (const LAS f32x4*)(us + dd * 4096 + t * 64 + part * 8);
            const f32x4 h0 = hp[0], h1 = hp[1]; const float hv[8] = {h0.x, h0.y, h0.z, h0.w, h1.x, h1.y, h1.z, h1.w};
            *(v4u*)(W.H + (size_t)row_of(b, qlo + t, odd) * D + dd * LW + n * 64 + part * 8) = pack8(hv); }
    }
#undef LRU_LOAD
}

__device__ __forceinline__ void post_phase(const int bx, const int G, CArgsP A, const WS& W, int l, LAS unsigned char* lds, int tid, int lane, int wave) {
    LAS float* hs = (LAS float*)lds;
    const int odd = l & 1;
    const float* cwa = A->in[I_CONVA] + (size_t)l * 3 * 256;
    const float* rk = A->in[I_RK] + l * RW; const float* lng = A->in[I_LNG] + l * RW; const float* lnb = A->in[I_LNB] + l * RW;
    bf16* Y = W.H;
    for (int tile = bx; tile < NB * (QLEN / 16); tile += G) {
        const int b = tile / (QLEN / 16), q0 = (tile % (QLEN / 16)) * 16;
        for (int it = tid; it < 16 * 48; it += NTHR) { const int i = it / 48, col = (it % 48) * 8; const size_t row = row_of(b, q0 + i, odd);
            float h0[8], h1[8]; unpack8(*(const v4u*)(W.H + row * D + col), h0); unpack8(*(const v4u*)(W.H + row * D + LW + col), h1);
#pragma unroll
            for (int e = 0; e < 8; ++e) hs[i * 384 + col + e] = h0[e] + h1[e]; }
        __syncthreads();
        v4u grv[2];
#pragma unroll
        for (int u = 0; u < 2; ++u) { const int it0 = tid + NTHR * u, it = it0 < 16 * 48 ? it0 : 16 * 48 - 1; const int i = it / 48, col = (it % 48) * 8;
            grv[u] = *(const v4u*)(W.P + (size_t)row_of(b, q0 + i, odd) * INCP + PC_GR + col); }
        {   const int it = tid, i = it >> 5, col = (it & 31) * 8, q = q0 + i;
            int lo, hi; if (q < CTX) { lo = 0; hi = CTX; } else { lo = CTX + ((q - CTX) & ~63); hi = lo + 64; }
            const size_t row = row_of(b, q, odd), rp = row_of(b, q - 1 >= lo ? q - 1 : q, odd), rn = row_of(b, q + 1 < hi ? q + 1 : q, odd);
            const float mp = q - 1 >= lo ? 1.f : 0.f, mn = q + 1 < hi ? 1.f : 0.f;
            const v4u l0 = *(const v4u*)(W.P + row * INCP + PC_BG + col), l1 = *(const v4u*)(W.P + row * INCP + PC_CG + col), l2 = *(const v4u*)(W.P + row * INCP + PC_XIN + col);
            const v4u l3 = *(const v4u*)(W.P + rp * INCP + PC_CG + col), l4 = *(const v4u*)(W.P + rp * INCP + PC_XIN + col);
            const v4u l5 = *(const v4u*)(W.P + rn * INCP + PC_CG + col), l6 = *(const v4u*)(W.P + rn * INCP + PC_XIN + col);
            float bg[8], c0[8], x0[8], c1[8], x1[8], c2[8], x2[8], y[8];
            unpack8(l0, bg); unpack8(l1, c0); unpack8(l2, x0); unpack8(l3, c1); unpack8(l4, x1); unpack8(l5, c2); unpack8(l6, x2);
#pragma unroll
            for (int e = 0; e < 8; ++e) y[e] = bg[e] * (cwa[256 + col + e] * (c0[e] * x0[e]) + mp * cwa[col + e] * (c1[e] * x1[e]) + mn * cwa[512 + col + e] * (c2[e] * x2[e]));
            *(v4u*)(Y + row * D + col) = pack8(y); }
        for (int it = wave * 8 + (lane >> 3); it < 96; it += 64) {
            const int i = it / 6, h = it % 6, c = h * 64 + (lane & 7) * 8, q = q0 + i;
            const size_t row = row_of(b, q, odd), pos = (size_t)b * QLEN + q;
            float y0[8], y1[8], rr[8], vv[8], k0[8], k1[8], gg[8];
            unpack8(*(const v4u*)(W.P + row * INCP + PC_Y + c), y0); unpack8(*(const v4u*)(W.P + row * INCP + PC_Y + RW + c), y1);
            unpack8(*(const v4u*)(W.sc_r + pos * RW + c), rr); unpack8(*(const v4u*)(W.sc_v + pos * RW + c), vv);
            unpack8(*(const v4u*)(W.scb + (size_t)3 * SC_ELEMS + pos * RW + c), k0); unpack8(*(const v4u*)(W.scb + (size_t)4 * SC_ELEMS + pos * RW + c), k1);
            unpack8(*(const v4u*)(W.P + row * INCP + PC_G + c), gg);
            float sum = 0.f, bon = 0.f;
#pragma unroll
            for (int e = 0; e < 8; ++e) { y0[e] += y1[e]; sum += y0[e]; bon += rr[e] * (k0[e] + k1[e]) * rk[c + e]; }
            const float mean = reduce8(sum) * (1.0f / 64.0f); bon = reduce8(bon);
            float sq = 0.f;
#pragma unroll
            for (int e = 0; e < 8; ++e) { y0[e] -= mean; sq += y0[e] * y0[e]; }
            const float rstd = rsqrtf(reduce8(sq) * (1.0f / 64.0f) + 64e-5f);
#pragma unroll
            for (int e = 0; e < 8; ++e) y0[e] = (y0[e] * rstd * lng[c + e] + lnb[c + e] + bon * vv[e]) * gg[e];
            *(v4u*)(Y + row * D + 256 + c) = pack8(y0);
        }
#pragma unroll
        for (int u = 0; u < 2; ++u) { const int it = tid + NTHR * u;
            if (it < 16 * 48) { const int i = it / 48, col = (it % 48) * 8; const size_t row = row_of(b, q0 + i, odd);
                float gr[8], o[8]; unpack8(grv[u], gr);
#pragma unroll
                for (int e = 0; e < 8; ++e) o[e] = gelu_tanh(gr[e]) * hs[i * 384 + col + e];
                *(v4u*)(Y + row * D + 640 + col) = pack8(o); } }
        __syncthreads();
    }
}

#define XB_TMO      128
#define XB_XCNT(j)  (256  + 64 * (j))
#define XB_XSUB(j)  (1280 + 64 * (j))
#define XB_XGEN(j)  (2304 + 64 * (j))
#define XB_TOP      3328
#define XB_TOPGEN   3392
#define XCD_BAR_WORDS 3456
#define XB_SPIN_CAP (1u << 18)

__device__ __forceinline__ unsigned xb_ld(unsigned* p)              { return __hip_atomic_load(p, __ATOMIC_RELAXED, __HIP_MEMORY_SCOPE_AGENT); }
__device__ __forceinline__ unsigned xb_add(unsigned* p, unsigned v) { return __hip_atomic_fetch_add(p, v, __ATOMIC_RELAXED, __HIP_MEMORY_SCOPE_AGENT); }
__device__ __forceinline__ unsigned xb_xcc_id() { return (unsigned)__builtin_amdgcn_s_getreg((3 << 11) | 20) & 0xFu; }
#define XB_SPIN(cond, bar) do { unsigned _sp = 0; while (cond) { __builtin_amdgcn_s_sleep(1); \
    if ((++_sp & 255u) == 0u) { if (xb_ld(&(bar)[XB_TMO])) break; if (_sp > XB_SPIN_CAP) { atomicAdd(&(bar)[XB_TMO], 1u); break; } } } } while (0)

struct XcdBarrier {
    unsigned* bar; unsigned x;
    volatile LAS unsigned* st;
};

__device__ __forceinline__ XcdBarrier xcd_barrier_post(unsigned* bar, volatile LAS unsigned* st) {
    XcdBarrier b; b.bar = bar; b.x = xb_xcc_id(); b.st = st;
    if (threadIdx.x == 0) (void)xb_add(&bar[XB_XCNT(b.x)], 1u);
    return b;
}
__device__ __forceinline__ void xcd_barrier_complete(unsigned* bar, unsigned x, unsigned& nloc, unsigned& nx) {
    const unsigned G = gridDim.x * gridDim.y * gridDim.z;
    unsigned sum, cnt, mine, sp = 0u;
    for (;;) {
        sum = 0u; cnt = 0u; mine = 0u;
#pragma unroll
        for (unsigned j = 0; j < 16; ++j) { const unsigned c = xb_ld(&bar[XB_XCNT(j)]); sum += c; cnt += (c > 0u) ? 1u : 0u; mine = (j == x) ? c : mine; }
        if (sum == G) break;
        __builtin_amdgcn_s_sleep(1);
        if ((++sp & 255u) == 0u) { if (xb_ld(&bar[XB_TMO])) break; if (sp > XB_SPIN_CAP) { atomicAdd(&bar[XB_TMO], 1u); break; } }
    }
    nloc = mine > 0u ? mine : 1u; nx = cnt > 0u ? cnt : 1u;
}

__device__ __forceinline__ void xcd_barrier(const XcdBarrier& b) {
    asm volatile("s_waitcnt vmcnt(0)" ::: "memory");
    __syncthreads();
    if (threadIdx.x == 0) {
        unsigned* bar = b.bar;
        __builtin_amdgcn_s_waitcnt(0);
        unsigned nloc = b.st[0], nx = b.st[1];
        if (nloc == 0u) { xcd_barrier_complete(bar, b.x, nloc, nx); b.st[0] = nloc; b.st[1] = nx; }
        const unsigned old = xb_add(&bar[XB_XSUB(b.x)], 1u);
        const unsigned gen = old / nloc;
        if (old + 1u == (gen + 1u) * nloc) {
            __builtin_amdgcn_fence(__ATOMIC_RELEASE, "agent");
            asm volatile("s_waitcnt vmcnt(0)" ::: "memory");
            const unsigned og = xb_add(&bar[XB_TOP], 1u);
            const unsigned tg = og / nx;
            if (og + 1u == (tg + 1u) * nx) xb_add(&bar[XB_TOPGEN], 1u);
            else XB_SPIN(xb_ld(&bar[XB_TOPGEN]) == tg, bar);
            __builtin_amdgcn_fence(__ATOMIC_ACQUIRE, "agent");
            xb_add(&bar[XB_XGEN(b.x)], 1u);
            asm volatile("s_waitcnt vmcnt(0)" ::: "memory");
        } else {
            XB_SPIN(xb_ld(&bar[XB_XGEN(b.x)]) == gen, bar);
            __builtin_amdgcn_fence(__ATOMIC_ACQUIRE, "agent");
            asm volatile("s_waitcnt vmcnt(0)" ::: "memory");
        }
    }
    __syncthreads();
}

constexpr int NCTXB = 32;
constexpr int PH_PER_LAYER = 16, N_PHASES = 1 + DEPTH * PH_PER_LAYER + 1;
__global__ void __launch_bounds__(NTHR, 2) fwd_megakernel(Args A0) {
    extern __shared__ __attribute__((aligned(16))) unsigned char lds_raw[];
    LAS unsigned char* lds = (LAS unsigned char*)lds_raw;
    cg::grid_group grid = cg::this_grid();
    const int ph_lo = A0.ph_lo, ph_hi = A0.ph_hi;
    volatile LAS unsigned* bst = (volatile LAS unsigned*)(lds + 131072);
    if (threadIdx.x < 2) bst[threadIdx.x] = 0u;
    __syncthreads();
    const XcdBarrier xbar = xcd_barrier_post((unsigned*)(A0.ws + WS_BAR), bst);
    const int wave0 = __builtin_amdgcn_readfirstlane((int)threadIdx.x >> 6);
    bool rep_done = false; (void)rep_done;
    for (int ph = ph_lo; ph < ph_hi; ++ph) {
        CArgsP A = (CArgsP)__builtin_amdgcn_kernarg_segment_ptr();
        asm volatile("" : "+s"(A) :: "memory");
        int G = gridDim.x, bx = blockIdx.x, wave = wave0;
        asm volatile("" : "+s"(G), "+s"(bx), "+s"(wave));
#define IDS() int lane; asm volatile("v_mbcnt_lo_u32_b32 %0, -1, 0\n\tv_mbcnt_hi_u32_b32 %0, -1, %0" : "=v"(lane)); const int tid = wave * 64 + lane; (void)tid
        const WS W = make_ws(A->ws);
        if (ph == 0) { IDS(); mods_phase(bx, G, A, W, lds, tid, lane, wave); convert_phase(bx, G, A, W.wt, 0, lds, lane, wave); }
        else if (ph == N_PHASES - 1) { IDS(); final_norm_phase(bx, G, A->out, A->in[I_GFINAL], lane, wave); }
        else {
            const int l = (ph - 1) / PH_PER_LAYER, s = (ph - 1) % PH_PER_LAYER; const bool last = (l == DEPTH - 1);
            if ((s == 1 && l == 0) || (s == 13 && last)) continue;
            const float* mods_l = W.mods + (size_t)l * 9 * 9216;
            const bf16* WTL = (l & 1) ? W.wt2 : W.wt;
            const float* xlat = A->out; const float* xctx = W.xrctx;
            int gk = 0, gl = l; bool gctx = false;
            if (s == 3) gk = 1; else if (s == 4) { gk = 1; gctx = true; } else if (s == 11) gk = 2; else if (s == 12 && !last) { gk = 2; gctx = true; }
            else if (s == 15) gk = 3; else if (s == 0 && l > 0) { gk = 3; gctx = true; gl = l - 1; }
            const int nk = (s == 0 || s == 1) ? 1 : ((s == 4 || s == 5) ? 2 : ((s == 12 || s == 13) ? 3 : 0));
            const bool split = gk != 0 && gctx && G > 2 * NCTXB;
            if (gk != 0 && (!gctx || !split || bx < NCTXB)) { IDS();
                const float* mods_g = W.mods + (size_t)gl * 9 * 9216; const bf16* WTG = (gl & 1) ? W.wt2 : W.wt;
                pg8::Gemm g{gk == 2 ? W.H : W.ACT, WTG + (gk == 1 ? WT_DOWN1 : gk == 2 ? WT_OUT : WT_DOWN2), gctx ? MCTX : MLAT, D, gk == 2 ? D : DFF};
                pg8::StaticOrder S; S.init(g.M, g.N, (gctx && split) ? NCTXB : G, bx, gctx ? MLAT / 256 : 0);
                const bool first = (gl == 0 && gk == 1);
                EpiResid E{first ? A->in[I_X] : xlat, first ? A->in[I_CTX] : xctx, A->out, W.xrctx, mods_g + (gk == 1 ? 2 : gk == 2 ? 5 : 8) * 1024, gk == 2 ? 1.0f : 0.5f};
                pg8::gemm_phase<EpiResid, pg8::StaticOrder, true, true>(lds, g, S, E, tid);
            }
            if (nk != 0 && !(split && bx < NCTXB)) { IDS();
                const bool l0 = (l == 0 && s == 0);
                const bool ctxrows = (s == 1 || s == 5 || s == 13);
                const int row_lo = ctxrows ? MLAT : 0, row_hi = (ctxrows || l0) ? MTOT : MLAT;
                const float* gsrc = nk == 1 ? A->in[I_GFFN1] + l * D : (nk == 2 ? A->in[I_GMIX] + l * D : A->in[I_GFFN2] + l * D);
                norm_phase(split ? bx - NCTXB : bx, split ? G - NCTXB : G, l0 ? A->in[I_X] : xlat, l0 ? A->in[I_CTX] : xctx, gsrc, mods_l, (nk - 1) * 3, (nk - 1) * 3 + 1, W.H, row_lo, row_hi, lane, wave);
            }
            if (s == 2 || s == 14) { IDS();
                pg8::Gemm g{W.H, WTL + (s == 2 ? WT_GU1 : WT_GU2), (s == 14 && last) ? MLAT : MTOT, 2 * DFF, D}; pg8::StaticOrder S; S.init(g.M, g.N, G, bx);
                EpiSwiGLU E{W.ACT};
                pg8::gemm_phase<EpiSwiGLU, pg8::StaticOrder, true, true>(lds, g, S, E, tid);
            } else if (s == 6) { IDS();
                pg8::Gemm g{W.H, WTL + WT_IN, MTOT, INCP, D}; pg8::StaticOrder S; S.init(g.M, g.N, G, bx);
                EpiP E{W.P, INCP};
                pg8::gemm_phase<EpiP, pg8::StaticOrder, true, true>(lds, g, S, E, tid);
            } else if (s == 7) { IDS();
                pre_phase(bx, G, A, W, l, lds, tid, lane, wave);
            } else if (s == 8) { IDS();
                int Kl = LORA_K, Nl = LORA_N; asm volatile("" : "+s"(Kl), "+s"(Nl));
                pg8::Gemm g{(const bf16*)((const unsigned char*)W.H + HB_AP), WTL + WT_LORA, MTOT, Nl, Kl}; pg8::StaticOrder S; S.init(g.M, g.N, G, bx);
                EpiLora E{A->in[I_W0] + l * 2 * RW, A->in[I_A0] + l * 2 * RW, A->in[I_KA] + l * RW, (const bf16*)((const unsigned char*)W.H + HB_KT), W.sc_kk, W.scb, W.P, l & 1};
                pg8::gemm_phase<EpiLora, pg8::StaticOrder, true, true>(lds, g, S, E, tid);
            } else if (s == 9) { IDS();
                for (int u = bx; u < 240; u += G) {
                    if (u < 192) rwkv_scan_phase(W, l, u, lds, tid, lane, wave); else lru_scan_phase(A, W, l, u - 192, lds, tid, lane, wave);
                    __syncthreads();
                }
                if (!last) {
                    if (G > 240) { if (bx >= 240) convert_phase(bx - 240, G - 240, A, ((l + 1) & 1) ? W.wt2 : W.wt, l + 1, lds, lane, wave); }
                    else convert_phase(bx, G, A, ((l + 1) & 1) ? W.wt2 : W.wt, l + 1, lds, lane, wave);
                }
            } else if (s == 10) { IDS();
                post_phase(bx, G, A, W, l, lds, tid, lane, wave);
            }
        }
#ifdef PROBE_REP_S
        if (ph > 0 && ph < N_PHASES - 1 && ((ph - 1) % PH_PER_LAYER) == PROBE_REP_S && !rep_done) { rep_done = true; grid.sync(); --ph; continue; }
        rep_done = false;
#endif
        if (ph + 1 < ph_hi) { if (ph == ph_lo) grid.sync(); else xcd_barrier(xbar); }
    }
}

#ifndef MK_MULTI
#define MK_MULTI 0
#endif
extern "C" void kernel_launch(void* const* d_in, const int* in_sizes, int n_in, void* d_out, int out_size, void* d_ws, size_t ws_size, hipStream_t stream) {
    static int grid = 0;
    if (grid == 0) {
        if (n_in != N_IN || out_size != MLAT * D || ws_size < WS_END) { fprintf(stderr, "kernel_launch: unexpected shapes (n_in %d out %d ws %zu)\n", n_in, out_size, ws_size); grid = -1; return; }
        int dev = 0, cus = 0, per_cu = 0;
        (void)hipGetDevice(&dev); (void)hipDeviceGetAttribute(&cus, hipDeviceAttributeMultiprocessorCount, dev);
        if (hipFuncSetAttribute((const void*)fwd_megakernel, hipFuncAttributeMaxDynamicSharedMemorySize, LDS_BYTES) != hipSuccess) { fprintf(stderr, "kernel_launch: hipFuncSetAttribute failed\n"); grid = -1; return; }
        if (hipOccupancyMaxActiveBlocksPerMultiprocessor(&per_cu, (const void*)fwd_megakernel, NTHR, LDS_BYTES) != hipSuccess || per_cu < 1) { fprintf(stderr, "kernel_launch: occupancy query says %d\n", per_cu); per_cu = 1; }
        (void)hipGetLastError();
        grid = cus * 1;
        if (grid <= 0) grid = 256;
    }
    if (grid < 0) return;
    if (hipMemsetAsync((unsigned char*)d_ws + WS_BAR, 0, WS_BAR_BYTES, stream) != hipSuccess) { fprintf(stderr, "kernel_launch: memset of the barrier words failed\n"); return; }
    Args a{};
    for (int i = 0; i < N_IN; ++i) a.in[i] = (const float*)d_in[i];
    a.out = (float*)d_out; a.ws = (unsigned char*)d_ws;
#if MK_MULTI
    for (int ph = 0; ph < N_PHASES; ++ph) { a.ph_lo = ph; a.ph_hi = ph + 1; hipLaunchKernelGGL(fwd_megakernel, dim3(grid), dim3(NTHR), LDS_BYTES, stream, a); }
#else
    a.ph_lo = 0; a.ph_hi = N_PHASES;
    void* args[] = {&a};
    hipError_t e = hipLaunchCooperativeKernel((const void*)fwd_megakernel, dim3(grid), dim3(NTHR), args, LDS_BYTES, stream);
    if (e != hipSuccess) fprintf(stderr, "kernel_launch: cooperative launch failed: %s (grid %d)\n", hipGetErrorString(e), grid);
#endif
}
```

```cpp
#include <hip/hip_runtime.h>
#include <hip/hip_cooperative_groups.h>
#include <cstdio>
#include <cstdint>
namespace cg = cooperative_groups;
namespace pg8 {
#define PG8_LAS __attribute__((address_space(3)))
typedef unsigned short bf16_t;
typedef short bf16x8 __attribute__((ext_vector_type(8)));
typedef float f32x4 __attribute__((ext_vector_type(4)));
typedef unsigned u32x4 __attribute__((ext_vector_type(4)));
constexpr int BM = 256, BK = 64, HALF = 128, HTB = HALF * BK * 2  , STAGE_BYTES = 8 * HTB, NXCD = 8, WGM = 8;

__host__ __device__ __forceinline__ int lds_byte(int r, int c) { const int st = (r >> 4) * 2 + (c >> 5), rr = r & 15, cc = c & 31, ob = rr * 64 + cc * 2; return st * 1024 + (ob ^ (((ob >> 9) & 1) << 5)); }
__host__ __device__ __forceinline__ void stage_rc(int b, int& R, int& C) { const int st = b / 1024, sb = b % 1024, swz = sb ^ (((sb >> 9) & 1) << 5); R = (st >> 1) * 16 + swz / 64; C = (st & 1) * 32 + (swz % 64) / 2; }
__host__ __device__ __forceinline__ int perm32(int rho) { const int n = rho >> 4, i = rho & 15; return 8 * (i >> 2) + 4 * n + (i & 3); }

struct Unit { int pm, pn; };
struct Gemm { const bf16_t* A; const bf16_t* Bt; int M, N, K; };

struct StaticOrder {
    int nM, nN, nwg, G, c, pm_off;
    __host__ __device__ void init(int M, int N, int G_, int c_, int off_ = 0) { nM = M / BM; nN = N / BM; nwg = nM * nN; G = G_; c = c_; pm_off = off_; }
    __host__ __device__ bool next(int i, Unit& u) const {
        const long L = (long)i * G + c; if (L >= nwg) return false;
        int wgid = (int)L; { const int q = nwg / NXCD, r = nwg % NXCD, xcd = wgid % NXCD, off = wgid / NXCD; wgid = (xcd < r ? xcd * (q + 1) : r * (q + 1) + (xcd - r) * q) + off; }
        const int nig = WGM * nN, gid = wgid / nig, fm = gid * WGM, gsz = (nM - fm) < WGM ? (nM - fm) : WGM;
        u.pm = fm + ((wgid % nig) % gsz) + pm_off; u.pn = (wgid % nig) / gsz; return true;
    }
    __device__ __forceinline__ void a_ready(const Unit&) const {}
    __device__ __forceinline__ void done(const Unit&) const {}
};

template <class Epi, class Sched, bool ALIGN_EPI = false, bool SP2 = false>
__device__ __forceinline__ void gemm_phase(PG8_LAS unsigned char* lds, const Gemm g, const Sched& S, const Epi& E, const int tid) {
    const int wid = __builtin_amdgcn_readfirstlane(tid >> 6), lane = tid & 63, wr = wid >> 2, wc = wid & 3, fr = lane & 15, fq = lane >> 4;
    const int K = g.K, nt = K / BK;
    unsigned voffA[2], voffB[2];
#pragma unroll
    for (int i = 0; i < 2; ++i) { int R, C; stage_rc(tid * 16 + i * 8192, R, C); const int Rb = Epi::PERM ? ((R & ~31) + perm32(R & 31)) : R;
        voffA[i] = (unsigned)(R * K + C) * 2u; voffB[i] = (unsigned)(Rb * K + C) * 2u; }
    const size_t kstep = (size_t)(BK * 2);
    const size_t hstep = (size_t)HALF * K * 2;
    const size_t tstep = 2 * hstep;
    const unsigned ldsw = (unsigned)wid * 1024u;
    const int aoff = lds_byte(wr * 64 + fr, fq * 8), boff = lds_byte(wc * 32 + fr, fq * 8);
#define PG8_SA(b, h) (((b) * 2 + (h)) * HTB)
#define PG8_SB(b, h) ((4 + (b) * 2 + (h)) * HTB)
#define PG8_STAGE(bufoff, gbase, voff) do { _Pragma("unroll") for (int _i = 0; _i < 2; ++_i) \
        __builtin_amdgcn_global_load_lds((const unsigned*)((const char*)(gbase) + (voff)[_i]), (PG8_LAS unsigned*)(lds + (bufoff) + ldsw + _i * 8192), 16, 0, 0); } while (0)
#define PG8_LDA(dst, b, h) do { _Pragma("unroll") for (int m = 0; m < 4; ++m) _Pragma("unroll") for (int k = 0; k < 2; ++k) dst[m][k] = *(const PG8_LAS bf16x8*)(lds + PG8_SA(b, h) + aoff + m * 2048 + k * 1024); } while (0)
#define PG8_LDB(dst, b, h) do { _Pragma("unroll") for (int n = 0; n < 2; ++n) _Pragma("unroll") for (int k = 0; k < 2; ++k) dst[n][k] = *(const PG8_LAS bf16x8*)(lds + PG8_SB(b, h) + boff + n * 2048 + k * 1024); } while (0)
#define PG8_MMA(ai, bj, At, Bt) do { __builtin_amdgcn_s_setprio(1); _Pragma("unroll") for (int m = 0; m < 4; ++m) _Pragma("unroll") for (int n = 0; n < 2; ++n) _Pragma("unroll") for (int k = 0; k < 2; ++k) \
        acc[ai][bj][m][n] = __builtin_amdgcn_mfma_f32_16x16x32_bf16(Bt[n][k], At[m][k], acc[ai][bj][m][n], 0, 0, 0); __builtin_amdgcn_s_setprio(0); } while (0)
#define PG8_WAIT_V(n) asm volatile("s_waitcnt vmcnt(" #n ")" ::: "memory")
#define PG8_WAIT_L(n) asm volatile("s_waitcnt lgkmcnt(" #n ")" ::: "memory")
#define PG8_BAR __builtin_amdgcn_s_barrier()
#define PG8_SCHED __builtin_amdgcn_sched_barrier(0)
    Unit cur, nxt; int ui = 0;
    if (!S.next(0, cur)) return;
    f32x4 acc[2][2][4][2];
#pragma unroll
    for (int a = 0; a < 2; ++a)
#pragma unroll
        for (int b = 0; b < 2; ++b)
#pragma unroll
            for (int m = 0; m < 4; ++m)
#pragma unroll
                for (int n = 0; n < 2; ++n) acc[a][b][m][n] = (f32x4){0.f, 0.f, 0.f, 0.f};
    bf16x8 At[4][2], B0[2][2], B1[2][2];
    const char* cA = (const char*)g.A + (size_t)cur.pm * tstep; const char* cB = (const char*)g.Bt + (size_t)cur.pn * tstep;
    S.a_ready(cur);
    if constexpr (SP2) {
        PG8_STAGE(PG8_SB(0, 0), cB, voffB); PG8_STAGE(PG8_SB(0, 1), cB + hstep, voffB); PG8_STAGE(PG8_SA(0, 0), cA, voffA); PG8_STAGE(PG8_SA(0, 1), cA + hstep, voffA);
        if (wr == 1) PG8_BAR;
        PG8_WAIT_V(2); PG8_BAR;
        PG8_STAGE(PG8_SB(1, 0), cB + kstep, voffB); PG8_STAGE(PG8_SA(1, 0), cA + kstep, voffA); PG8_STAGE(PG8_SB(1, 1), cB + hstep + kstep, voffB);
        PG8_WAIT_V(6); PG8_BAR;
    } else {
        PG8_STAGE(PG8_SB(0, 0), cB, voffB); PG8_STAGE(PG8_SA(0, 0), cA, voffA); PG8_STAGE(PG8_SB(0, 1), cB + hstep, voffB); PG8_STAGE(PG8_SA(0, 1), cA + hstep, voffA);
        if (wr == 1) PG8_BAR;
        PG8_WAIT_V(4); PG8_BAR;
        PG8_STAGE(PG8_SB(1, 0), cB + kstep, voffB); PG8_STAGE(PG8_SA(1, 0), cA + kstep, voffA); PG8_STAGE(PG8_SB(1, 1), cB + hstep + kstep, voffB);
        PG8_WAIT_V(6); PG8_BAR;
    }
    for (;;) {
        const bool has_next = S.next(ui + 1, nxt);
        const char* nA = has_next ? (const char*)g.A + (size_t)nxt.pm * tstep : cA; const char* nB = has_next ? (const char*)g.Bt + (size_t)nxt.pn * tstep : cB;
        for (int t = 0; t < nt; t += 2) {
            const bool last = (t == nt - 2);
            const char* a1 = cA + (size_t)(t + 1) * kstep;
            const char* a2 = last ? nA : cA + (size_t)(t + 2) * kstep; const char* b2 = last ? nB : cB + (size_t)(t + 2) * kstep;
            const char* a3 = a2 + kstep; const char* b3 = b2 + kstep;
            if (last && has_next) S.a_ready(nxt);
            if constexpr (SP2) {
            PG8_LDB(B0, 0, 0); PG8_LDB(B1, 0, 1); PG8_SCHED; PG8_LDA(At, 0, 0); PG8_STAGE(PG8_SA(1, 1), a1 + hstep, voffA);
            PG8_WAIT_V(8); PG8_WAIT_L(0); PG8_BAR; PG8_MMA(0, 0, At, B0); PG8_MMA(0, 1, At, B1); PG8_BAR; PG8_SCHED;
            PG8_LDA(At, 0, 1); PG8_STAGE(PG8_SB(0, 0), b2, voffB); PG8_STAGE(PG8_SB(0, 1), b2 + hstep, voffB); PG8_STAGE(PG8_SA(0, 0), a2, voffA);
            PG8_WAIT_V(8); PG8_WAIT_L(0); PG8_BAR; PG8_MMA(1, 0, At, B0); PG8_MMA(1, 1, At, B1); PG8_BAR; PG8_SCHED;
            PG8_LDB(B0, 1, 0); PG8_LDB(B1, 1, 1); PG8_SCHED; PG8_LDA(At, 1, 0); PG8_STAGE(PG8_SA(0, 1), a2 + hstep, voffA);
            PG8_WAIT_V(8); PG8_WAIT_L(0); PG8_BAR; PG8_MMA(0, 0, At, B0); PG8_MMA(0, 1, At, B1); PG8_BAR; PG8_SCHED;
            PG8_LDA(At, 1, 1); PG8_STAGE(PG8_SB(1, 0), b3, voffB); PG8_STAGE(PG8_SB(1, 1), b3 + hstep, voffB); PG8_STAGE(PG8_SA(1, 0), a3, voffA);
            PG8_WAIT_V(8); PG8_WAIT_L(0); PG8_BAR; PG8_MMA(1, 0, At, B0); PG8_MMA(1, 1, At, B1); PG8_BAR; PG8_SCHED;
            } else {
            PG8_LDB(B0, 0, 0); PG8_SCHED; PG8_LDA(At, 0, 0); PG8_STAGE(PG8_SA(1, 1), a1 + hstep, voffA);
            PG8_WAIT_L(8); PG8_BAR; PG8_WAIT_L(0); PG8_MMA(0, 0, At, B0); PG8_BAR; PG8_SCHED;
            PG8_LDB(B1, 0, 1); PG8_STAGE(PG8_SB(0, 0), b2, voffB);
            PG8_BAR; PG8_WAIT_L(0); PG8_MMA(0, 1, At, B1); PG8_BAR;
            PG8_LDA(At, 0, 1); PG8_STAGE(PG8_SA(0, 0), a2, voffA);
            PG8_BAR; PG8_WAIT_L(0); PG8_MMA(1, 0, At, B0); PG8_BAR; PG8_SCHED;
            PG8_STAGE(PG8_SB(0, 1), b2 + hstep, voffB);
            PG8_WAIT_V(6); PG8_BAR; PG8_MMA(1, 1, At, B1); PG8_BAR;
            PG8_LDB(B0, 1, 0); PG8_SCHED; PG8_LDA(At, 1, 0); PG8_STAGE(PG8_SA(0, 1), a2 + hstep, voffA);
            PG8_WAIT_L(8); PG8_BAR; PG8_WAIT_L(0); PG8_MMA(0, 0, At, B0); PG8_BAR; PG8_SCHED;
            PG8_LDB(B1, 1, 1); PG8_STAGE(PG8_SB(1, 0), b3, voffB);
            PG8_BAR; PG8_WAIT_L(0); PG8_MMA(0, 1, At, B1); PG8_BAR;
            PG8_LDA(At, 1, 1); PG8_STAGE(PG8_SA(1, 0), a3, voffA);
            PG8_BAR; PG8_WAIT_L(0); PG8_MMA(1, 0, At, B0); PG8_BAR; PG8_SCHED;
            PG8_STAGE(PG8_SB(1, 1), b3 + hstep, voffB);
            PG8_WAIT_V(6); PG8_BAR; PG8_MMA(1, 1, At, B1); PG8_BAR;
            }
        }
        if constexpr (ALIGN_EPI) { if (wr == 0) PG8_BAR; }
        if constexpr (!Epi::AFTER_DRAIN) { E(acc, cur, wr, wc, fr, fq); S.done(cur); }
        if (!has_next) break;
#pragma unroll
        for (int a = 0; a < 2; ++a)
#pragma unroll
            for (int b = 0; b < 2; ++b)
#pragma unroll
                for (int m = 0; m < 4; ++m)
#pragma unroll
                    for (int n = 0; n < 2; ++n) acc[a][b][m][n] = (f32x4){0.f, 0.f, 0.f, 0.f};
        cur = nxt; cA = nA; cB = nB; ++ui;
        if constexpr (ALIGN_EPI) { if (wr == 1) PG8_BAR; }
    }
    PG8_WAIT_V(0);
    if constexpr (!ALIGN_EPI) { if (wr == 0) PG8_BAR; }
    PG8_BAR;
    if constexpr (Epi::AFTER_DRAIN) { E.fused(acc, cur, wr, wc, fr, fq, lds, wid, lane); S.done(cur); }
#undef PG8_SA
#undef PG8_SB
#undef PG8_STAGE
#undef PG8_LDA
#undef PG8_LDB
#undef PG8_MMA
#undef PG8_WAIT_V
#undef PG8_WAIT_L
#undef PG8_BAR
#undef PG8_SCHED
}
}
#define LAS __attribute__((address_space(3)))
typedef unsigned short bf16;
typedef unsigned v4u __attribute__((ext_vector_type(4)));
typedef unsigned v2u __attribute__((ext_vector_type(2)));
typedef float f32x4 __attribute__((ext_vector_type(4)));
typedef float f32x2 __attribute__((ext_vector_type(2)));

constexpr int D = 1024, NB = 8, SEQ = 4096, CTX = 256, DEPTH = 4, DFF = 2816;
constexpr int MLAT = NB * SEQ, MCTX = NB * CTX, MTOT = MLAT + MCTX;
constexpr int INC = 2944, INCP = 3072;
constexpr int RW = 384, LW = 384, RC = 1408;
constexpr int QLEN = CTX + SEQ;
constexpr int PC_BG = 0, PC_CG = 256, PC_XIN = 512, PC_RW = 768, PC_XR = 2176, PC_GR = 2560;
constexpr int PC_Y = 768;
constexpr int PC_G = 1536;
constexpr int LORA_N = 2048, LORA_K = 256;
constexpr int NWAVES = 8, NTHR = 512;
constexpr int LDS_BYTES = 147456;

constexpr size_t MiB = 1u << 20;
constexpr size_t WS_BAR = 1536 * 1024, WS_BAR_BYTES = 16384;
constexpr size_t WS_MODS = 0, WS_XRCTX = 2 * MiB, WS_WT = 10 * MiB, WS_H = 52 * MiB, WS_A = 120 * MiB, WS_B = 324 * MiB;
constexpr size_t SC_ELEMS = (size_t)NB * QLEN * RW;
constexpr size_t WS_WT2 = WS_B + 9 * SC_ELEMS * 2;
constexpr size_t WS_END = WS_WT2 + 42 * MiB;
static_assert(WS_END <= 600 * MiB, "workspace map");
static_assert(WS_A + (size_t)MTOT * INCP * 2 <= WS_B, "P fits");
constexpr size_t WT_GU1 = 0, WT_DOWN1 = WT_GU1 + (size_t)2 * DFF * D, WT_IN = WT_DOWN1 + (size_t)D * DFF, WT_OUT = WT_IN + (size_t)INCP * D,
                 WT_GU2 = WT_OUT + (size_t)D * D, WT_DOWN2 = WT_GU2 + (size_t)2 * DFF * D, WT_TOTAL = WT_DOWN2 + (size_t)D * DFF;
constexpr size_t WT_LORA = WT_TOTAL;
static_assert(WS_WT + (WT_TOTAL + (size_t)LORA_N * LORA_K) * 2 <= WS_H, "weights fit");
constexpr size_t HB_AP = 0, HB_KT = (size_t)MTOT * LORA_K * 2;
static_assert(HB_KT + (size_t)MTOT * RW * 2 <= WS_A - WS_H, "H region overlay");

enum { I_X = 0, I_C, I_CTX, I_CCTX, I_WMOD, I_BMOD, I_GFFN1, I_WGU1, I_WDOWN1, I_GMIX, I_WIN, I_CONVA, I_MU, I_W0, I_W2, I_A0, I_A2, I_G2, I_KK, I_KA, I_RK,
       I_LNG, I_LNB, I_LCW, I_LCB, I_LWR, I_LBR, I_LWI, I_LBI, I_LAM, I_WOUT, I_GFFN2, I_WGU2, I_WDOWN2, I_GFINAL, N_IN };

struct Args { const float* in[N_IN]; float* out; unsigned char* ws; int ph_lo, ph_hi; };
typedef const __attribute__((address_space(4))) Args* CArgsP;

__device__ __forceinline__ float bf2f(unsigned h) { return __builtin_bit_cast(float, h << 16); }
__device__ __forceinline__ unsigned f2bf(float f) { unsigned u = __builtin_bit_cast(unsigned, f); return (u + 0x7fffu + ((u >> 16) & 1u)) >> 16; }
__device__ __forceinline__ unsigned pk2(float lo, float hi) { unsigned r; asm("v_cvt_pk_bf16_f32 %0, %1, %2" : "=v"(r) : "v"(lo), "v"(hi)); return r; }
__device__ __forceinline__ void unpack8(v4u p, float* o) {
    o[0] = __builtin_bit_cast(float, p.x << 16); o[1] = __builtin_bit_cast(float, p.x & 0xffff0000u);
    o[2] = __builtin_bit_cast(float, p.y << 16); o[3] = __builtin_bit_cast(float, p.y & 0xffff0000u);
    o[4] = __builtin_bit_cast(float, p.z << 16); o[5] = __builtin_bit_cast(float, p.z & 0xffff0000u);
    o[6] = __builtin_bit_cast(float, p.w << 16); o[7] = __builtin_bit_cast(float, p.w & 0xffff0000u);
}
__device__ __forceinline__ v4u pack8(const float* v) { v4u o; o.x = pk2(v[0], v[1]); o.y = pk2(v[2], v[3]); o.z = pk2(v[4], v[5]); o.w = pk2(v[6], v[7]); return o; }
template <int CTRL> __device__ __forceinline__ float dppf(float v) { return __builtin_bit_cast(float, __builtin_amdgcn_update_dpp(0, __builtin_bit_cast(int, v), CTRL, 0xF, 0xF, true)); }
__device__ __forceinline__ float wave_sum(float v) {
    v += dppf<0xB1>(v); v += dppf<0x4E>(v); v += dppf<0x141>(v); v += dppf<0x140>(v);
    const float a = __builtin_bit_cast(float, __builtin_amdgcn_readlane(__builtin_bit_cast(int, v), 0)), b = __builtin_bit_cast(float, __builtin_amdgcn_readlane(__builtin_bit_cast(int, v), 16));
    const float c = __builtin_bit_cast(float, __builtin_amdgcn_readlane(__builtin_bit_cast(int, v), 32)), d = __builtin_bit_cast(float, __builtin_amdgcn_readlane(__builtin_bit_cast(int, v), 48));
    return (a + b) + (c + d);
}
__device__ __forceinline__ float sigmoidf_(float x) { return __builtin_amdgcn_rcpf(1.0f + __expf(-x)); }
__device__ __forceinline__ float siluf_(float x) { return x * __builtin_amdgcn_rcpf(1.0f + __expf(-x)); }
__device__ __forceinline__ float softplusf_(float z) { return fmaxf(z, 0.f) + log1pf(__expf(-fabsf(z))); }
__device__ __forceinline__ float tanh_fast(float x) { const float e = __expf(2.0f * fminf(fmaxf(x, -15.f), 15.f)); return 1.0f - 2.0f * __builtin_amdgcn_rcpf(e + 1.0f); }
__device__ __forceinline__ float gelu_tanh(float x) { const float u = 0.7978845608028654f * (x + 0.044715f * x * x * x); return 0.5f * x * (1.0f + tanh_fast(u)); }
__device__ __forceinline__ float rscatter16(const float (&v)[16], int j) {
    const bool b1 = (j & 8) != 0, b2 = (j & 4) != 0, b3 = (j & 2) != 0, b4 = (j & 1) != 0;
    float a[8], c[4], d[2];
#pragma unroll
    for (int k = 0; k < 8; ++k) { const float keep = b1 ? v[k + 8] : v[k], send = b1 ? v[k] : v[k + 8]; a[k] = keep + dppf<0x140>(send); }
#pragma unroll
    for (int k = 0; k < 4; ++k) { const float keep = b2 ? a[k + 4] : a[k], send = b2 ? a[k] : a[k + 4]; c[k] = keep + dppf<0x141>(send); }
#pragma unroll
    for (int k = 0; k < 2; ++k) { const float keep = b3 ? c[k + 2] : c[k], send = b3 ? c[k] : c[k + 2]; d[k] = keep + dppf<0x4E>(send); }
    { const float keep = b4 ? d[1] : d[0], send = b4 ? d[0] : d[1]; return keep + dppf<0xB1>(send); }
}
__device__ __forceinline__ float reduce16(float x) { x += dppf<0xB1>(x); x += dppf<0x4E>(x); x += dppf<0x141>(x); x += dppf<0x140>(x); return x; }
__device__ __forceinline__ float reduce8(float x) { x += dppf<0xB1>(x); x += dppf<0x4E>(x); x += dppf<0x141>(x); return x; }
__device__ __forceinline__ int row_of(int b, int q, int odd) {
    if (q < CTX) return MLAT + b * CTX + q;
    const int s = q - CTX; const int t = odd ? (((s & 63) << 6) | (s >> 6)) : s;
    return b * SEQ + t;
}

struct EpiSwiGLU {
    static constexpr bool PERM = true, AFTER_DRAIN = false;
    bf16* O;
    __device__ __forceinline__ void operator()(const pg8::f32x4 (&acc)[2][2][4][2], const pg8::Unit& u, int wr, int wc, int fr, int fq) const {
        const int row0 = u.pm * 256 + wr * 64 + fr, col0 = u.pn * 128 + wc * 32 + 8 * fq;
#pragma unroll
        for (int ai = 0; ai < 2; ++ai)
#pragma unroll
            for (int m = 0; m < 4; ++m) {
                float o[8];
#pragma unroll
                for (int n = 0; n < 2; ++n)
#pragma unroll
                    for (int j = 0; j < 4; ++j) { const float g = acc[ai][0][m][n][j], up = acc[ai][1][m][n][j]; o[n * 4 + j] = siluf_(g) * up; }
                *(v4u*)(O + (size_t)(row0 + ai * 128 + m * 16) * DFF + col0) = pack8(o);
            }
    }
};
struct EpiP {
    static constexpr bool PERM = true, AFTER_DRAIN = false;
    bf16* O; int ldc;
    __device__ __forceinline__ void operator()(const pg8::f32x4 (&acc)[2][2][4][2], const pg8::Unit& u, int wr, int wc, int fr, int fq) const {
        const int row0 = u.pm * 256 + wr * 64 + fr, col0 = u.pn * 256 + wc * 32 + 8 * fq;
#pragma unroll
        for (int ai = 0; ai < 2; ++ai)
#pragma unroll
            for (int m = 0; m < 4; ++m)
#pragma unroll
                for (int bj = 0; bj < 2; ++bj) {
                    float o[8];
#pragma unroll
                    for (int n = 0; n < 2; ++n)
#pragma unroll
                        for (int j = 0; j < 4; ++j) o[n * 4 + j] = acc[ai][bj][m][n][j];
                    *(v4u*)(O + (size_t)(row0 + ai * 128 + m * 16) * ldc + col0 + bj * 128) = pack8(o);
                }
    }
};
struct EpiResid {
    static constexpr bool PERM = true, AFTER_DRAIN = false;
    const float* res_lat; const float* res_ctx; float* dst_lat; float* dst_ctx; const float* gate; float coef;
    __device__ __forceinline__ void operator()(const pg8::f32x4 (&acc)[2][2][4][2], const pg8::Unit& u, int wr, int wc, int fr, int fq) const {
        const int rowbase = u.pm * 256; const bool isctx = rowbase >= MLAT;
        const int b = isctx ? 8 : (rowbase >> 12);
        const float* res = isctx ? res_ctx + (size_t)(rowbase - MLAT) * D : res_lat + (size_t)rowbase * D;
        float* dst = isctx ? dst_ctx + (size_t)(rowbase - MLAT) * D : dst_lat + (size_t)rowbase * D;
#pragma unroll
        for (int bj = 0; bj < 2; ++bj) {
            const int col = u.pn * 256 + bj * 128 + wc * 32 + 8 * fq;
            const f32x4 g0 = *(const f32x4*)(gate + (size_t)b * 9216 + col) * coef, g1 = *(const f32x4*)(gate + (size_t)b * 9216 + col + 4) * coef;
#pragma unroll
            for (int ai = 0; ai < 2; ++ai)
#pragma unroll
                for (int m = 0; m < 4; ++m) {
                    const size_t off = (size_t)(ai * 128 + wr * 64 + m * 16 + fr) * D + col;
                    const f32x4 r0 = *(const f32x4*)(res + off), r1 = *(const f32x4*)(res + off + 4);
                    *(f32x4*)(dst + off) = r0 + g0 * acc[ai][bj][m][0];
                    *(f32x4*)(dst + off + 4) = r1 + g1 * acc[ai][bj][m][1];
                }
        }
    }
};

struct EpiLora {
    static constexpr bool PERM = true, AFTER_DRAIN = false;
    const float* w0; const float* a0; const float* ka; const bf16* kt; const bf16* kk; bf16* scb; bf16* P; int odd;
    __device__ __forceinline__ void operator()(const pg8::f32x4 (&acc)[2][2][4][2], const pg8::Unit& u, int wr, int wc, int fr, int fq) const {
        asm volatile("" : "+v"(fr), "+v"(fq));
#pragma unroll
        for (int bj = 0; bj < 2; ++bj) {
            const int half = __builtin_amdgcn_readfirstlane(u.pn * 2 + bj), kind = half / 3, c = (half - kind * 3) * 128 + wc * 32 + 8 * fq;
            if (kind >= 5) continue;
            float p0[8], p1[8];
#pragma unroll
            for (int e = 0; e < 8; ++e) { p0[e] = 0.f; p1[e] = 0.f; }
            if (kind < 2) { const f32x4 q0 = *(const f32x4*)(w0 + kind * 384 + c), q1 = *(const f32x4*)(w0 + kind * 384 + c + 4);
                p0[0] = q0.x; p0[1] = q0.y; p0[2] = q0.z; p0[3] = q0.w; p0[4] = q1.x; p0[5] = q1.y; p0[6] = q1.z; p0[7] = q1.w; }
            else if (kind < 4) { const f32x4 q0 = *(const f32x4*)(a0 + (kind - 2) * 384 + c), q1 = *(const f32x4*)(a0 + (kind - 2) * 384 + c + 4), r0 = *(const f32x4*)(ka + c), r1 = *(const f32x4*)(ka + c + 4);
                p0[0] = q0.x; p0[1] = q0.y; p0[2] = q0.z; p0[3] = q0.w; p0[4] = q1.x; p0[5] = q1.y; p0[6] = q1.z; p0[7] = q1.w;
                p1[0] = r0.x; p1[1] = r0.y; p1[2] = r0.z; p1[3] = r0.w; p1[4] = r1.x; p1[5] = r1.y; p1[6] = r1.z; p1[7] = r1.w; }
#pragma unroll
            for (int ai = 0; ai < 2; ++ai) {
                v4u kkr[4], ktr[4];
                if (kind >= 2 && kind < 4) {
#pragma unroll
                    for (int m = 0; m < 4; ++m) { const int pos = u.pm * 256 + ai * 128 + wr * 64 + m * 16 + fr;
                        kkr[m] = *(const v4u*)(kk + (size_t)pos * RW + c); ktr[m] = *(const v4u*)(kt + (size_t)pos * RW + c); }
                }
#pragma unroll
                for (int m = 0; m < 4; ++m) {
                    const int pos = u.pm * 256 + ai * 128 + wr * 64 + m * 16 + fr;
                    float v[8];
#pragma unroll
                    for (int n = 0; n < 2; ++n)
#pragma unroll
                        for (int j = 0; j < 4; ++j) v[n * 4 + j] = acc[ai][bj][m][n][j];
                    if (kind < 2) {
#pragma unroll
                        for (int e = 0; e < 8; ++e) { const float wl = p0[e] + v[e];
                            v[e] = 1.0f - __expf(-0.6065306597126334f * sigmoidf_(wl)); }
                        *(v4u*)(scb + (size_t)(7 + kind) * SC_ELEMS + (size_t)pos * RW + c) = pack8(v);
                    } else if (kind < 4) {
#pragma unroll
                        for (int e = 0; e < 8; ++e) v[e] = sigmoidf_(p0[e] + v[e]);
                        {   float kkv[8]; unpack8(kkr[m], kkv);
#pragma unroll
                            for (int e = 0; e < 8; ++e) kkv[e] *= v[e];
                            *(v4u*)(scb + (size_t)(5 + kind - 2) * SC_ELEMS + (size_t)pos * RW + c) = pack8(kkv); }
                        {   float kv[8]; unpack8(ktr[m], kv);
#pragma unroll
                            for (int e = 0; e < 8; ++e) kv[e] *= (1.0f + (v[e] - 1.0f) * p1[e]);
                            *(v4u*)(scb + (size_t)(3 + kind - 2) * SC_ELEMS + (size_t)pos * RW + c) = pack8(kv); }
                    } else {
                        const int b = pos / QLEN, q = pos - b * QLEN;
                        *(v4u*)(P + (size_t)row_of(b, q, odd) * INCP + PC_G + c) = pack8(v);
                    }
                }
                asm volatile("" ::: "memory");
            }
        }
    }
};
struct WS {
    float* mods; float* xrctx; bf16* wt; bf16* wt2; bf16* H; bf16* P; bf16* ACT;
    bf16 *scb, *sc_r, *sc_v, *sc_kk, *dgs;
};
__device__ __forceinline__ WS make_ws(unsigned char* ws) {
    WS w; w.mods = (float*)(ws + WS_MODS); w.xrctx = (float*)(ws + WS_XRCTX); w.wt = (bf16*)(ws + WS_WT); w.wt2 = (bf16*)(ws + WS_WT2); w.H = (bf16*)(ws + WS_H); w.P = (bf16*)(ws + WS_A); w.ACT = (bf16*)(ws + WS_A);
    bf16* b = (bf16*)(ws + WS_B);
    w.scb = b; w.sc_r = b; w.sc_v = b + SC_ELEMS; w.sc_kk = b + 2 * SC_ELEMS; w.dgs = b + 9 * SC_ELEMS;
    return w;
}

__device__ __forceinline__ void mods_phase(const int bx, const int G, CArgsP A, const WS& W, LAS unsigned char* lds, int tid, int lane, int wave) {
    LAS float* sl = (LAS float*)lds;
    LAS float* part = sl + 9 * 1024;
    const float* c = A->in[I_C]; const float* cctx = A->in[I_CCTX];
    for (int i = tid; i < 9216; i += NTHR) { const int r = i >> 10, k = i & 1023; const float v = r < 8 ? c[r * 1024 + k] : cctx[k]; sl[i] = siluf_(v); }
    __syncthreads();
    for (int item = bx; item < 288; item += G) {
        const int l = item / 72, cgp = item % 72;
        const float* Wp = A->in[I_WMOD] + (size_t)l * 1024 * 9216 + cgp * 128 + lane * 2;
        float acc[9][2];
#pragma unroll
        for (int r = 0; r < 9; ++r) { acc[r][0] = 0.f; acc[r][1] = 0.f; }
#pragma unroll 8
        for (int kk = 0; kk < 128; ++kk) {
            const int k = wave * 128 + kk;
            const f32x2 w = *(const f32x2*)(Wp + (size_t)k * 9216);
#pragma unroll
            for (int r = 0; r < 9; ++r) { const float s = sl[r * 1024 + k]; acc[r][0] += s * w.x; acc[r][1] += s * w.y; }
        }
#pragma unroll
        for (int r = 0; r < 9; ++r) { part[(wave * 9 + r) * 128 + lane * 2] = acc[r][0]; part[(wave * 9 + r) * 128 + lane * 2 + 1] = acc[r][1]; }
        __syncthreads();
        for (int o = tid; o < 1152; o += NTHR) {
            const int r = o >> 7, cc = o & 127; float s = A->in[I_BMOD][l * 9216 + cgp * 128 + cc];
#pragma unroll
            for (int w8 = 0; w8 < 8; ++w8) s += part[(w8 * 9 + r) * 128 + cc];
            W.mods[(size_t)(l * 9 + r) * 9216 + cgp * 128 + cc] = s;
        }
        __syncthreads();
    }
}

__device__ __forceinline__ void transpose_item(const float* Wsrc, int K, int N, bf16* WT, int kb, int n0, int drow0, LAS float* scr, int lane) {
    const int k0 = 64 * kb;
    float tv[32];
#pragma unroll
    for (int i = 0; i < 32; ++i) tv[i] = Wsrc[(size_t)(k0 + 2 * i + (lane >> 5)) * N + n0 + (lane & 31)];
#pragma unroll
    for (int i = 0; i < 32; ++i) scr[(2 * i + (lane >> 5)) * 33 + (lane & 31)] = tv[i];
    asm volatile("s_waitcnt lgkmcnt(0)" ::: "memory");
    const int c = lane & 7;
#pragma unroll
    for (int j = 0; j < 4; ++j) { const int n = (lane >> 3) + 8 * j; const LAS float* s = scr + (8 * c) * 33 + n;
        v4u o; o.x = pk2(s[0 * 33], s[1 * 33]); o.y = pk2(s[2 * 33], s[3 * 33]); o.z = pk2(s[4 * 33], s[5 * 33]); o.w = pk2(s[6 * 33], s[7 * 33]);
        *(v4u*)(WT + (size_t)(drow0 + n) * K + k0 + 8 * c) = o; }
    asm volatile("s_waitcnt lgkmcnt(0)" ::: "memory");
}
__device__ __forceinline__ int gu_drow(int n0) { return n0 < DFF ? 256 * (n0 >> 7) + (n0 & 127) : 256 * ((n0 - DFF) >> 7) + 128 + ((n0 - DFF) & 127); }
__device__ __forceinline__ void convert_phase(const int bx, const int G, CArgsP A, bf16* wtd, int l, LAS unsigned char* lds, int lane, int wave) {
    LAS float* scr = (LAS float*)(lds + wave * 16384);
    const int gw = bx * NWAVES + wave, NGW = G * NWAVES;
    constexpr int I_GU = (D / 64) * (2 * DFF / 32), I_DN = (DFF / 64) * (D / 32), I_IN = (D / 64) * (INC / 32), I_OUT = (D / 64) * (D / 32);
    constexpr int NITEMS = 2 * I_GU + 2 * I_DN + I_IN + I_OUT;
    for (int it = gw; it < NITEMS; it += NGW) {
        int r = it;
        if (r < I_GU) { const int nblk = 2 * DFF / 32, kb = r / nblk, n0 = (r % nblk) * 32; transpose_item(A->in[I_WGU1] + (size_t)l * D * 2 * DFF, D, 2 * DFF, wtd + WT_GU1, kb, n0, gu_drow(n0), scr, lane); continue; } r -= I_GU;
        if (r < I_GU) { const int nblk = 2 * DFF / 32, kb = r / nblk, n0 = (r % nblk) * 32; transpose_item(A->in[I_WGU2] + (size_t)l * D * 2 * DFF, D, 2 * DFF, wtd + WT_GU2, kb, n0, gu_drow(n0), scr, lane); continue; } r -= I_GU;
        if (r < I_DN) { const int nblk = D / 32, kb = r / nblk, n0 = (r % nblk) * 32; transpose_item(A->in[I_WDOWN1] + (size_t)l * DFF * D, DFF, D, wtd + WT_DOWN1, kb, n0, n0, scr, lane); continue; } r -= I_DN;
        if (r < I_DN) { const int nblk = D / 32, kb = r / nblk, n0 = (r % nblk) * 32; transpose_item(A->in[I_WDOWN2] + (size_t)l * DFF * D, DFF, D, wtd + WT_DOWN2, kb, n0, n0, scr, lane); continue; } r -= I_DN;
        if (r < I_IN) { const int nblk = INC / 32, kb = r / nblk, n0 = (r % nblk) * 32; transpose_item(A->in[I_WIN] + (size_t)l * D * INC, D, INC, wtd + WT_IN, kb, n0, n0, scr, lane); continue; } r -= I_IN;
        { const int nblk = D / 32, kb = r / nblk, n0 = (r % nblk) * 32; transpose_item(A->in[I_WOUT] + (size_t)l * D * D, D, D, wtd + WT_OUT, kb, n0, n0, scr, lane); }
    }
    for (int idx = (bx * NWAVES + wave) * 64 + lane; idx < LORA_N * LORA_K; idx += G * NTHR) {
        const int n = idx % LORA_N, k = idx / LORA_N, kind = n / 384, c = n - kind * 384;
        float v = 0.f;
        if (kind < 2) { if (k < 64) v = A->in[I_W2][((size_t)(l * 2 + kind) * 64 + k) * RW + c]; }
        else if (kind < 4) { if (k >= 64 && k < 128) v = A->in[I_A2][((size_t)(l * 2 + kind - 2) * 64 + (k - 64)) * RW + c]; }
        else if (kind == 4) { if (k >= 128) v = A->in[I_G2][((size_t)l * 128 + (k - 128)) * RW + c]; }
        wtd[WT_LORA + (size_t)n * LORA_K + k] = (bf16)f2bf(v);
    }
}

__device__ __forceinline__ void norm_phase(const int bx, const int G, const float* lat, const float* ctxp, const float* g, const float* mods_l, int ishift, int iscale, bf16* H, int row_lo, int nrows, int lane, int wave) {
    const int gw = bx * NWAVES + wave, NGW = G * NWAVES;
    for (int r0 = row_lo + gw; r0 < nrows; r0 += 2 * NGW) {
        const int r1 = r0 + NGW < nrows ? r0 + NGW : r0;
        const float* xa = r0 < MLAT ? lat + (size_t)r0 * D : ctxp + (size_t)(r0 - MLAT) * D;
        const float* xb = r1 < MLAT ? lat + (size_t)r1 * D : ctxp + (size_t)(r1 - MLAT) * D;
        f32x4 va[4], vb[4]; float sa = 0.f, sb = 0.f;
#pragma unroll
        for (int j = 0; j < 4; ++j) { va[j] = *(const f32x4*)(xa + (lane + 64 * j) * 4); vb[j] = *(const f32x4*)(xb + (lane + 64 * j) * 4); }
#pragma unroll
        for (int j = 0; j < 4; ++j) { sa += (va[j].x * va[j].x + va[j].y * va[j].y) + (va[j].z * va[j].z + va[j].w * va[j].w); sb += (vb[j].x * vb[j].x + vb[j].y * vb[j].y) + (vb[j].z * vb[j].z + vb[j].w * vb[j].w); }
        sa = wave_sum(sa); sb = wave_sum(sb);
        const float rsa = rsqrtf(sa * (1.0f / D) + 1e-6f), rsb = rsqrtf(sb * (1.0f / D) + 1e-6f);
        const int ba = r0 < MLAT ? (r0 >> 12) : 8, bb = r1 < MLAT ? (r1 >> 12) : 8;
        const float* sha = mods_l + (size_t)ba * 9216 + ishift * 1024; const float* sca = mods_l + (size_t)ba * 9216 + iscale * 1024;
        const float* shb = mods_l + (size_t)bb * 9216 + ishift * 1024; const float* scb2 = mods_l + (size_t)bb * 9216 + iscale * 1024;
#pragma unroll
        for (int j = 0; j < 4; ++j) {
            const int col = (lane + 64 * j) * 4;
            const f32x4 gg = *(const f32x4*)(g + col);
            { const f32x4 s4 = *(const f32x4*)(sha + col), c4 = *(const f32x4*)(sca + col); const f32x4 h = (va[j] * rsa) * gg * (c4 + 1.0f) + s4;
              v2u o; o.x = pk2(h.x, h.y); o.y = pk2(h.z, h.w); *(v2u*)(H + (size_t)r0 * D + col) = o; }
            if (r1 != r0) { const f32x4 s4 = *(const f32x4*)(shb + col), c4 = *(const f32x4*)(scb2 + col); const f32x4 h = (vb[j] * rsb) * gg * (c4 + 1.0f) + s4;
              v2u o; o.x = pk2(h.x, h.y); o.y = pk2(h.z, h.w); *(v2u*)(H + (size_t)r1 * D + col) = o; }
        }
    }
}
__device__ __forceinline__ void final_norm_phase(const int bx, const int G, float* xo, const float* g, int lane, int wave) {
    const int gw = bx * NWAVES + wave, NGW = G * NWAVES;
    for (int r0 = gw; r0 < MLAT; r0 += 2 * NGW) {
        const int r1 = r0 + NGW < MLAT ? r0 + NGW : r0;
        float* xa = xo + (size_t)r0 * D; float* xb = xo + (size_t)r1 * D;
        f32x4 va[4], vb[4]; float sa = 0.f, sb = 0.f;
#pragma unroll
        for (int j = 0; j < 4; ++j) { va[j] = *(const f32x4*)(xa + (lane + 64 * j) * 4); vb[j] = *(const f32x4*)(xb + (lane + 64 * j) * 4); }
#pragma unroll
        for (int j = 0; j < 4; ++j) { sa += (va[j].x * va[j].x + va[j].y * va[j].y) + (va[j].z * va[j].z + va[j].w * va[j].w); sb += (vb[j].x * vb[j].x + vb[j].y * vb[j].y) + (vb[j].z * vb[j].z + vb[j].w * vb[j].w); }
        sa = wave_sum(sa); sb = wave_sum(sb);
        const float rsa = rsqrtf(sa * (1.0f / D) + 1e-6f), rsb = rsqrtf(sb * (1.0f / D) + 1e-6f);
#pragma unroll
        for (int j = 0; j < 4; ++j) { const int col = (lane + 64 * j) * 4; const f32x4 gg = *(const f32x4*)(g + col);
            *(f32x4*)(xa + col) = (va[j] * rsa) * gg; if (r1 != r0) *(f32x4*)(xb + col) = (vb[j] * rsb) * gg; }
    }
}

__device__ __forceinline__ void pre_item(int it, int& i, int& col) {
    if (it < 2304) { const int seg = it / 768, r = it - seg * 768; i = r / 48; col = seg * 384 + (r % 48) * 8; }
    else if (it < 2560) { const int r = it - 2304; i = (r & 127) >> 3; col = 1152 + (r >> 7) * 64 + (r & 7) * 8; }
    else { const int r = it - 2560; i = r >> 4; col = 1280 + (r & 15) * 8; }
}
__device__ __forceinline__ void pre_phase(const int bx, const int G, CArgsP A, const WS& W, int l, LAS unsigned char* lds, int tid, int lane, int wave) {
    LAS float* k_s = (LAS float*)lds;
    const int odd = l & 1;
    const float* mu0 = A->in[I_MU] + (size_t)l * 2 * RC; const float* mu1 = mu0 + RC;
    const float* kkp = A->in[I_KK] + l * RW;
    bf16* AP = (bf16*)((unsigned char*)W.H + HB_AP); bf16* KT = (bf16*)((unsigned char*)W.H + HB_KT);
    for (int tile = bx; tile < NB * (QLEN / 16); tile += G) {
        const int b = tile / (QLEN / 16), q0 = (tile % (QLEN / 16)) * 16;
        const int seq_lo = q0 < CTX ? 0 : CTX, seq_hi = q0 < CTX ? CTX : QLEN;
        for (int pass = 0; pass < 2; ++pass) {
            v4u rc[3], rp[3], rn[3];
#pragma unroll
            for (int u = 0; u < 3; ++u) { const int it0 = tid + NTHR * (pass * 3 + u), it = it0 < 16 * 176 ? it0 : 16 * 176 - 1;
                int i, col; pre_item(it, i, col); const int q = q0 + i;
                const int qp = q - 1 >= seq_lo ? q - 1 : q, qn = q + 1 < seq_hi ? q + 1 : q;
                rc[u] = *(const v4u*)(W.P + (size_t)row_of(b, q, odd) * INCP + PC_RW + col);
                rp[u] = *(const v4u*)(W.P + (size_t)row_of(b, qp, odd) * INCP + PC_RW + col);
                rn[u] = *(const v4u*)(W.P + (size_t)row_of(b, qn, odd) * INCP + PC_RW + col); }
#pragma unroll
            for (int u = 0; u < 3; ++u) { const int it0 = tid + NTHR * (pass * 3 + u);
                if (it0 < 16 * 176) {
                    int i, col; pre_item(it0, i, col); const int q = q0 + i;
                    const size_t pos = (size_t)b * QLEN + q;
                    float cur[8], prv[8], nxt[8], ps[8];
                    unpack8(rc[u], cur); unpack8(rp[u], prv); unpack8(rn[u], nxt);
                    const float mp = q - 1 >= seq_lo ? 1.f : 0.f, mn = q + 1 < seq_hi ? 1.f : 0.f;
#pragma unroll
                    for (int e = 0; e < 8; ++e) ps[e] = cur[e] + mu0[col + e] * (prv[e] * mp - cur[e]) + mu1[col + e] * (nxt[e] * mn - cur[e]);
                    if (col < 384) *(v4u*)(W.sc_r + pos * RW + col) = pack8(ps);
                    else if (col < 768) {
#pragma unroll
                        for (int e = 0; e < 8; ++e) k_s[i * 384 + col - 384 + e] = ps[e];
                        *(v4u*)(KT + pos * RW + (col - 384)) = pack8(ps); }
                    else if (col < 1152) *(v4u*)(W.sc_v + pos * RW + (col - 768)) = pack8(ps);
                    else if (col < 1216) {
#pragma unroll
                        for (int e = 0; e < 8; ++e) ps[e] = tanh_fast(ps[e]);
                        *(v4u*)(AP + pos * LORA_K + (col - 1152)) = pack8(ps); }
                    else if (col < 1280) *(v4u*)(AP + pos * LORA_K + 64 + (col - 1216)) = pack8(ps);
                    else {
#pragma unroll
                        for (int e = 0; e < 8; ++e) ps[e] = sigmoidf_(ps[e]);
                        *(v4u*)(AP + pos * LORA_K + 128 + (col - 1280)) = pack8(ps); }
                }
            }
        }
        __syncthreads();
        for (int it = wave * 8 + (lane >> 3); it < 96; it += 64) {
            const int i = it / 6, h = it % 6, c = h * 64 + (lane & 7) * 8;
            float kv[8]; float ss = 0.f;
#pragma unroll
            for (int e = 0; e < 8; ++e) { kv[e] = k_s[i * 384 + c + e] * kkp[c + e]; ss += kv[e] * kv[e]; }
            const float rn = rsqrtf(reduce8(ss) + 1e-12f);
#pragma unroll
            for (int e = 0; e < 8; ++e) kv[e] *= rn;
            *(v4u*)(W.sc_kk + ((size_t)b * QLEN + q0 + i) * RW + c) = pack8(kv);
        }
        __syncthreads();
    }
}

__device__ __forceinline__ int q_of_step(int n, int d) { return d == 0 ? n : (n < CTX ? CTX - 1 - n : QLEN + CTX - 1 - n); }
constexpr int RCH = 32, RNCH = QLEN / RCH;
__device__ __forceinline__ void rwkv_scan_phase(const WS& W, int l, int blk, LAS unsigned char* lds, int tid, int lane, int wave) {
    const int item = blk >> 1, half = blk & 1;
    const int b = item / 12, rem = item % 12, h = rem >> 1, d = rem & 1, odd = l & 1;
    LAS float* buf = (LAS float*)lds;
    LAS float* ybuf = buf + 2 * RCH * 384;
    const bf16* s_omw = W.scb + (size_t)(7 + d) * SC_ELEMS; const bf16* s_b = W.scb + (size_t)(5 + d) * SC_ELEMS; const bf16* s_kd = W.scb + (size_t)(3 + d) * SC_ELEMS;
    const int rg = lane >> 4, j = lane & 15, rlA = (wave & 3) * 8 + rg, rlB = rlA + 4, rowA = half * 32 + rlA, rowB = half * 32 + rlB;
    v4u pre[6];
    const int t4 = tid - 256;
#define RW_LOAD(c) do { _Pragma("unroll") for (int jj = 0; jj < 6; ++jj) { const int p = t4 + 256 * jj, i = p / 48, r48 = p % 48, vec = r48 >> 3, part = r48 & 7; \
        const int q = q_of_step((c) * RCH + i, d); const size_t pos = (size_t)b * QLEN + q; \
        const bf16* base = vec == 0 ? s_omw : vec == 1 ? s_b : vec == 2 ? s_kd : vec == 3 ? W.sc_kk : vec == 4 ? W.sc_r : W.sc_v; \
        pre[jj] = *(const v4u*)(base + pos * RW + h * 64 + part * 8); } } while (0)
#define RW_STORE(c) do { _Pragma("unroll") for (int jj = 0; jj < 6; ++jj) { const int p = t4 + 256 * jj, i = p / 48, r48 = p % 48, vec = r48 >> 3, part = r48 & 7; \
        float f[8]; unpack8(pre[jj], f); if (vec == 0) { _Pragma("unroll") for (int e = 0; e < 8; ++e) f[e] = 1.0f - f[e]; } \
        LAS float* dst = buf + (((c) & 1) * RCH + i) * 384 + vec * 64 + part * 8; \
        *(LAS f32x4*)dst = (f32x4){f[0], f[1], f[2], f[3]}; *(LAS f32x4*)(dst + 4) = (f32x4){f[4], f[5], f[6], f[7]}; } } while (0)
    f32x2 SA0 = (f32x2){0.f, 0.f}, SA1 = SA0, SB0 = SA0, SB1 = SA0;
#define RW_FLUSH(c) do { const int i = t4 >> 3, r4 = (t4 & 7) * 4; const int q = q_of_step((c) * RCH + i, d); \
        const f32x4 yv = *(const LAS f32x4*)(ybuf + ((c) & 1) * RCH * 32 + i * 32 + r4); \
        v2u o; o.x = pk2(yv.x, yv.y); o.y = pk2(yv.z, yv.w); \
        *(v2u*)(W.P + (size_t)row_of(b, q, odd) * INCP + PC_Y + d * RW + h * 64 + half * 32 + r4) = o; } while (0)
    if (wave >= 4) { RW_LOAD(0); RW_STORE(0); }
    __syncthreads();
    for (int c = 0; c < RNCH; ++c) {
        const LAS float* cur = buf + (c & 1) * RCH * 384;
        LAS float* yb = ybuf + (c & 1) * RCH * 32;
        if (wave >= 4) {
            if (c + 1 < RNCH) RW_LOAD(c + 1);
            if (c > 0) RW_FLUSH(c - 1);
            if (c + 1 < RNCH) RW_STORE(c + 1);
        } else {
        float ykA, ykB, ypA[16], ypB[16];
#define RW_LD(X, i_) do { const int ii_ = (i_) < RCH ? (i_) : RCH - 1; const LAS f32x4* bp_ = (const LAS f32x4*)(cur + ii_ * 384 + j * 4); \
        X##w = bp_[0]; X##b = bp_[16]; X##d = bp_[32]; X##k = bp_[48]; X##r = bp_[64]; X##va = cur[ii_ * 384 + 320 + rowA]; X##vb = cur[ii_ * 384 + 320 + rowB]; } while (0)
#define RW_CP(X, s_) do { \
        const f32x2 k0_ = (f32x2){X##k.x, X##k.y}, k1_ = (f32x2){X##k.z, X##k.w}; \
        const f32x2 ta_ = SA0 * k0_ + SA1 * k1_, tb_ = SB0 * k0_ + SB1 * k1_; \
        const float saA_ = -reduce16(ta_.x + ta_.y), saB_ = -reduce16(tb_.x + tb_.y); \
        const f32x2 w0_ = (f32x2){X##w.x, X##w.y}, w1_ = (f32x2){X##w.z, X##w.w}, b0_ = (f32x2){X##b.x, X##b.y}, b1_ = (f32x2){X##b.z, X##b.w}, d0_ = (f32x2){X##d.x, X##d.y}, d1_ = (f32x2){X##d.z, X##d.w}; \
        const f32x2 va2_ = (f32x2){X##va, X##va}, vb2_ = (f32x2){X##vb, X##vb}, sa2_ = (f32x2){saA_, saA_}, sb2_ = (f32x2){saB_, saB_}; \
        SA0 = SA0 * w0_ + va2_ * d0_ + sa2_ * b0_; SA1 = SA1 * w1_ + va2_ * d1_ + sa2_ * b1_; \
        SB0 = SB0 * w0_ + vb2_ * d0_ + sb2_ * b0_; SB1 = SB1 * w1_ + vb2_ * d1_ + sb2_ * b1_; \
        const f32x2 r0_ = (f32x2){X##r.x, X##r.y}, r1_ = (f32x2){X##r.z, X##r.w}; \
        const f32x2 ya_ = SA0 * r0_ + SA1 * r1_, yb_ = SB0 * r0_ + SB1 * r1_; \
        ypA[s_] = ya_.x + ya_.y; ypB[s_] = yb_.x + yb_.y; } while (0)
        f32x4 Aw, Ab, Ad, Ak, Ar, Bw, Bb, Bd, Bk, Br; float Ava, Avb, Bva, Bvb;
        RW_LD(A, 0);
#pragma unroll 1
        for (int g = 0; g < 2; ++g) {
            ykA = 0.f; ykB = 0.f;
#pragma unroll
            for (int s2 = 0; s2 < 16; s2 += 2) {
                const int i = g * 16 + s2;
                RW_LD(B, i + 1);
                __builtin_amdgcn_sched_barrier(0);
                RW_CP(A, s2);
                __builtin_amdgcn_sched_barrier(0);
                RW_LD(A, i + 2);
                __builtin_amdgcn_sched_barrier(0);
                RW_CP(B, s2 + 1);
                __builtin_amdgcn_sched_barrier(0);
            }
            ykA = rscatter16(ypA, j); ykB = rscatter16(ypB, j);
            yb[(g * 16 + j) * 32 + rlA] = ykA; yb[(g * 16 + j) * 32 + rlB] = ykB;
        }
#undef RW_LD
#undef RW_CP
        }
        __syncthreads();
    }
    if (wave >= 4) RW_FLUSH(RNCH - 1);
#undef RW_FLUSH
#undef RW_LOAD
#undef RW_STORE
}

__device__ __forceinline__ void lru_scan_phase(CArgsP A, const WS& W, int l, int idx, LAS unsigned char* lds, int tid, int lane, int wave) {
    const int b = idx / 6, n = idx % 6, odd = l & 1;
    LAS float* gs = (LAS float*)lds;
    LAS float* xs = gs;
    LAS float* us = gs + 4 * 4096;
    LAS bf16* ub = (LAS bf16*)(us + 2 * 4096);
    const int c = tid & 63;
    float cw[2][4], cb[2], sp[2];
#pragma unroll
    for (int dd = 0; dd < 2; ++dd) {
#pragma unroll
        for (int jj = 0; jj < 4; ++jj) cw[dd][jj] = A->in[I_LCW][((size_t)(l * 2 + dd) * 4 + jj) * LW + n * 64 + c];
        cb[dd] = A->in[I_LCB][(l * 2 + dd) * LW + n * 64 + c];
        sp[dd] = softplusf_(-A->in[I_LAM][(l * 2 + dd) * LW + n * 64 + c]);
    }
    const int g = wave >> 2, jcol = (wave & 3) * 16 + (lane & 15), quad = lane >> 4;
    pg8::bf16x8 bfrag[2][2]; float gbias[2];
#pragma unroll
    for (int dd = 0; dd < 2; ++dd) {
        const float* Wsrc = (g ? A->in[I_LWI] : A->in[I_LWR]) + ((size_t)((l * 2 + dd) * 6 + n) * 64) * 64 + jcol;
#pragma unroll
        for (int ks = 0; ks < 2; ++ks)
#pragma unroll
            for (int jj = 0; jj < 8; ++jj) bfrag[dd][ks][jj] = (short)f2bf(Wsrc[(size_t)(ks * 32 + quad * 8 + jj) * 64]);
        gbias[dd] = (g ? A->in[I_LBI] : A->in[I_LBR])[(l * 2 + dd) * LW + n * 64 + jcol];
    }
    float hstate = 0.f;
    v4u pre[2][2];
#define LRU_LOAD(ch) do { _Pragma("unroll") for (int dd = 0; dd < 2; ++dd) { const int n0 = (ch) * 64; const int qlo_ = dd == 0 ? n0 : q_of_step(n0, 1) - 63; const int qb_ = dd == 0 ? qlo_ - 3 : qlo_; \
        const int slo_ = qlo_ < CTX ? 0 : CTX, shi_ = qlo_ < CTX ? CTX : QLEN; \
        _Pragma("unroll") for (int jj = 0; jj < 2; ++jj) { const int p = tid + NTHR * jj; const int t = p >> 3, part = p & 7, q = qb_ + t; \
            pre[dd][jj] = (v4u){0u, 0u, 0u, 0u}; \
            if (t < 67 && q >= slo_ && q < shi_) pre[dd][jj] = *(const v4u*)(W.P + (size_t)row_of(b, q, odd) * INCP + PC_XR + n * 64 + part * 8); } } } while (0)
    LRU_LOAD(0);
    const int tid_o = tid, lane_o = lane;
    for (int ch = 0; ch < QLEN / 64; ++ch) {
        const int n0 = ch * 64;
        int tid = tid_o, lane = lane_o; asm volatile("" : "+v"(tid), "+v"(lane));
        const int c = tid & 63, jcol = (wave & 3) * 16 + (lane & 15), quad = lane >> 4;
#pragma unroll
        for (int dd = 0; dd < 2; ++dd)
#pragma unroll
            for (int jj = 0; jj < 2; ++jj) { const int p = tid + NTHR * jj; const int t = p >> 3, part = p & 7;
                if (t < 67) { float f[8]; unpack8(pre[dd][jj], f); LAS float* dst = xs + dd * 68 * 64 + t * 64 + part * 8;
                    *(LAS f32x4*)dst = (f32x4){f[0], f[1], f[2], f[3]}; *(LAS f32x4*)(dst + 4) = (f32x4){f[4], f[5], f[6], f[7]}; } }
        __syncthreads();
        if (ch + 1 < QLEN / 64) LRU_LOAD(ch + 1);
#pragma unroll
        for (int k = 0; k < 16; ++k) { const int dd = k >> 3, t = (tid >> 6) + 8 * (k & 7); const LAS float* x = xs + dd * 68 * 64;
            const float uv = cb[dd] + cw[dd][0] * x[t * 64 + c] + cw[dd][1] * x[(t + 1) * 64 + c] + cw[dd][2] * x[(t + 2) * 64 + c] + cw[dd][3] * x[(t + 3) * 64 + c];
            us[dd * 4096 + t * 64 + c] = uv; ub[dd * 64 * 72 + t * 72 + c] = (bf16)f2bf(uv); }
        __syncthreads();
#pragma unroll
        for (int dd = 0; dd < 2; ++dd)
#pragma unroll
            for (int rt = 0; rt < 4; ++rt) {
                pg8::f32x4 acc = {0.f, 0.f, 0.f, 0.f};
#pragma unroll
                for (int ks = 0; ks < 2; ++ks) {
                    const pg8::bf16x8 afrag = *(const LAS pg8::bf16x8*)(ub + dd * 64 * 72 + (rt * 16 + (lane & 15)) * 72 + ks * 32 + quad * 8);
                    acc = __builtin_amdgcn_mfma_f32_16x16x32_bf16(afrag, bfrag[dd][ks], acc, 0, 0, 0);
                }
#pragma unroll
                for (int jj = 0; jj < 4; ++jj) gs[((dd * 2 + g) * 64 + rt * 16 + quad * 4 + jj) * 64 + jcol] = sigmoidf_(acc[jj] + gbias[dd]);
            }
        __syncthreads();
#pragma unroll
        for (int k = 0; k < 16; ++k) { const int dd = k >> 3, t = (tid >> 6) + 8 * (k & 7);
            LAS float* ga = gs + (dd * 2) * 4096 + t * 64 + c; LAS float* gb = ga + 4096;
            const float rgv = *ga, igv = *gb, u = us[dd * 4096 + t * 64 + c];
            const float log_a = -8.0f * sp[dd] * rgv;
            const float a = __expf(log_a);
            const float bt = __builtin_amdgcn_sqrtf(fmaxf(1.0f - a * a, 0.f)) * (igv * u);
            *ga = a; *gb = bt; }
        __syncthreads();
        if (wave < 2) {
            const int dd = wave; const int qlo = dd == 0 ? n0 : q_of_step(n0, 1) - 63;
            const LAS float* ga = gs + (dd * 2) * 4096 + lane; LAS float* hb = us + dd * 4096 + lane;
            (void)qlo;
#pragma unroll 8
            for (int s = 0; s < 64; ++s) { const int t = dd == 0 ? s : 63 - s;
                hstate = ga[t * 64] * hstate + ga[4096 + t * 64];
                hb[t * 64] = hstate; }
        }
        __syncthreads();
#pragma unroll
        for (int k = 0; k < 2; ++k) { const int p = tid + NTHR * k, dd = p >> 9, t = (p >> 3) & 63, part = p & 7;
            const int qlo = dd == 0 ? n0 : q_of_step(n0, 1) - 63;
            const LAS f32x4* hp = (const LAS f32x4*)(us + dd * 4096 + t * 64 + part * 8);
            const f32x4 h0 = hp[0], h1 = hp[1]; const float hv[8] = {h0.x, h0.y, h0.z, h0.w, h1.x, h1.y, h1.z, h1.w};
            *(v4u*)(W.H + (size_t)row_of(b, qlo + t, odd) * D + dd * LW + n * 64 + part * 8) = pack8(hv); }
    }
#undef LRU_LOAD
}

__device__ __forceinline__ void post_phase(const int bx, const int G, CArgsP A, const WS& W, int l, LAS unsigned char* lds, int tid, int lane, int wave) {
    LAS float* hs = (LAS float*)lds;
    const int odd = l & 1;
    const float* cwa = A->in[I_CONVA] + (size_t)l * 3 * 256;
    const float* rk = A->in[I_RK] + l * RW; const float* lng = A->in[I_LNG] + l * RW; const float* lnb = A->in[I_LNB] + l * RW;
    bf16* Y = W.H;
    for (int tile = bx; tile < NB * (QLEN / 16); tile += G) {
        const int b = tile / (QLEN / 16), q0 = (tile % (QLEN / 16)) * 16;
        for (int it = tid; it < 16 * 48; it += NTHR) { const int i = it / 48, col = (it % 48) * 8; const size_t row = row_of(b, q0 + i, odd);
            float h0[8], h1[8]; unpack8(*(const v4u*)(W.H + row * D + col), h0); unpack8(*(const v4u*)(W.H + row * D + LW + col), h1);
#pragma unroll
            for (int e = 0; e < 8; ++e) hs[i * 384 + col + e] = h0[e] + h1[e]; }
        __syncthreads();
        v4u grv[2];
#pragma unroll
        for (int u = 0; u < 2; ++u) { const int it0 = tid + NTHR * u, it = it0 < 16 * 48 ? it0 : 16 * 48 - 1; const int i = it / 48, col = (it % 48) * 8;
            grv[u] = *(const v4u*)(W.P + (size_t)row_of(b, q0 + i, odd) * INCP + PC_GR + col); }
        {   const int it = tid, i = it >> 5, col = (it & 31) * 8, q = q0 + i;
            int lo, hi; if (q < CTX) { lo = 0; hi = CTX; } else { lo = CTX + ((q - CTX) & ~63); hi = lo + 64; }
            const size_t row = row_of(b, q, odd), rp = row_of(b, q - 1 >= lo ? q - 1 : q, odd), rn = row_of(b, q + 1 < hi ? q + 1 : q, odd);
            const float mp = q - 1 >= lo ? 1.f : 0.f, mn = q + 1 < hi ? 1.f : 0.f;
            const v4u l0 = *(const v4u*)(W.P + row * INCP + PC_BG + col), l1 = *(const v4u*)(W.P + row * INCP + PC_CG + col), l2 = *(const v4u*)(W.P + row * INCP + PC_XIN + col);
            const v4u l3 = *(const v4u*)(W.P + rp * INCP + PC_CG + col), l4 = *(const v4u*)(W.P + rp * INCP + PC_XIN + col);
            const v4u l5 = *(const v4u*)(W.P + rn * INCP + PC_CG + col), l6 = *(const v4u*)(W.P + rn * INCP + PC_XIN + col);
            float bg[8], c0[8], x0[8], c1[8], x1[8], c2[8], x2[8], y[8];
            unpack8(l0, bg); unpack8(l1, c0); unpack8(l2, x0); unpack8(l3, c1); unpack8(l4, x1); unpack8(l5, c2); unpack8(l6, x2);
#pragma unroll
            for (int e = 0; e < 8; ++e) y[e] = bg[e] * (cwa[256 + col + e] * (c0[e] * x0[e]) + mp * cwa[col + e] * (c1[e] * x1[e]) + mn * cwa[512 + col + e] * (c2[e] * x2[e]));
            *(v4u*)(Y + row * D + col) = pack8(y); }
        for (int it = wave * 8 + (lane >> 3); it < 96; it += 64) {
            const int i = it / 6, h = it % 6, c = h * 64 + (lane & 7) * 8, q = q0 + i;
            const size_t row = row_of(b, q, odd), pos = (size_t)b * QLEN + q;
            float y0[8], y1[8], rr[8], vv[8], k0[8], k1[8], gg[8];
            unpack8(*(const v4u*)(W.P + row * INCP + PC_Y + c), y0); unpack8(*(const v4u*)(W.P + row * INCP + PC_Y + RW + c), y1);
            unpack8(*(const v4u*)(W.sc_r + pos * RW + c), rr); unpack8(*(const v4u*)(W.sc_v + pos * RW + c), vv);
            unpack8(*(const v4u*)(W.scb + (size_t)3 * SC_ELEMS + pos * RW + c), k0); unpack8(*(const v4u*)(W.scb + (size_t)4 * SC_ELEMS + pos * RW + c), k1);
            unpack8(*(const v4u*)(W.P + row * INCP + PC_G + c), gg);
            float sum = 0.f, bon = 0.f;
#pragma unroll
            for (int e = 0; e < 8; ++e) { y0[e] += y1[e]; sum += y0[e]; bon += rr[e] * (k0[e] + k1[e]) * rk[c + e]; }
            const float mean = reduce8(sum) * (1.0f / 64.0f); bon = reduce8(bon);
            float sq = 0.f;
#pragma unroll
            for (int e = 0; e < 8; ++e) { y0[e] -= mean; sq += y0[e] * y0[e]; }
            const float rstd = rsqrtf(reduce8(sq) * (1.0f / 64.0f) + 64e-5f);
#pragma unroll
            for (int e = 0; e < 8; ++e) y0[e] = (y0[e] * rstd * lng[c + e] + lnb[c + e] + bon * vv[e]) * gg[e];
            *(v4u*)(Y + row * D + 256 + c) = pack8(y0);
        }
#pragma unroll
        for (int u = 0; u < 2; ++u) { const int it = tid + NTHR * u;
            if (it < 16 * 48) { const int i = it / 48, col = (it % 48) * 8; const size_t row = row_of(b, q0 + i, odd);
                float gr[8], o[8]; unpack8(grv[u], gr);
#pragma unroll
                for (int e = 0; e < 8; ++e) o[e] = gelu_tanh(gr[e]) * hs[i * 384 + col + e];
                *(v4u*)(Y + row * D + 640 + col) = pack8(o); } }
        __syncthreads();
    }
}

#define XB_TMO      128
#define XB_XCNT(j)  (256  + 64 * (j))
#define XB_XSUB(j)  (1280 + 64 * (j))
#define XB_XGEN(j)  (2304 + 64 * (j))
#define XB_TOP      3328
#define XB_TOPGEN   3392
#define XCD_BAR_WORDS 3456
#define XB_SPIN_CAP (1u << 18)

__device__ __forceinline__ unsigned xb_ld(unsigned* p)              { return __hip_atomic_load(p, __ATOMIC_RELAXED, __HIP_MEMORY_SCOPE_AGENT); }
__device__ __forceinline__ unsigned xb_add(unsigned* p, unsigned v) { return __hip_atomic_fetch_add(p, v, __ATOMIC_RELAXED, __HIP_MEMORY_SCOPE_AGENT); }
__device__ __forceinline__ unsigned xb_xcc_id() { return (unsigned)__builtin_amdgcn_s_getreg((3 << 11) | 20) & 0xFu; }
#define XB_SPIN(cond, bar) do { unsigned _sp = 0; while (cond) { __builtin_amdgcn_s_sleep(1); \
    if ((++_sp & 255u) == 0u) { if (xb_ld(&(bar)[XB_TMO])) break; if (_sp > XB_SPIN_CAP) { atomicAdd(&(bar)[XB_TMO], 1u); break; } } } } while (0)

struct XcdBarrier {
    unsigned* bar; unsigned x;
    volatile LAS unsigned* st;
};

__device__ __forceinline__ XcdBarrier xcd_barrier_post(unsigned* bar, volatile LAS unsigned* st) {
    XcdBarrier b; b.bar = bar; b.x = xb_xcc_id(); b.st = st;
    if (threadIdx.x == 0) (void)xb_add(&bar[XB_XCNT(b.x)], 1u);
    return b;
}
__device__ __forceinline__ void xcd_barrier_complete(unsigned* bar, unsigned x, unsigned& nloc, unsigned& nx) {
    const unsigned G = gridDim.x * gridDim.y * gridDim.z;
    unsigned sum, cnt, mine, sp = 0u;
    for (;;) {
        sum = 0u; cnt = 0u; mine = 0u;
#pragma unroll
        for (unsigned j = 0; j < 16; ++j) { const unsigned c = xb_ld(&bar[XB_XCNT(j)]); sum += c; cnt += (c > 0u) ? 1u : 0u; mine = (j == x) ? c : mine; }
        if (sum == G) break;
        __builtin_amdgcn_s_sleep(1);
        if ((++sp & 255u) == 0u) { if (xb_ld(&bar[XB_TMO])) break; if (sp > XB_SPIN_CAP) { atomicAdd(&bar[XB_TMO], 1u); break; } }
    }
    nloc = mine > 0u ? mine : 1u; nx = cnt > 0u ? cnt : 1u;
}

__device__ __forceinline__ void xcd_barrier(const XcdBarrier& b) {
    asm volatile("s_waitcnt vmcnt(0)" ::: "memory");
    __syncthreads();
    if (threadIdx.x == 0) {
        unsigned* bar = b.bar;
        __builtin_amdgcn_s_waitcnt(0);
        unsigned nloc = b.st[0], nx = b.st[1];
        if (nloc == 0u) { xcd_barrier_complete(bar, b.x, nloc, nx); b.st[0] = nloc; b.st[1] = nx; }
        const unsigned old = xb_add(&bar[XB_XSUB(b.x)], 1u);
        const unsigned gen = old / nloc;
        if (old + 1u == (gen + 1u) * nloc) {
            __builtin_amdgcn_fence(__ATOMIC_RELEASE, "agent");
            asm volatile("s_waitcnt vmcnt(0)" ::: "memory");
            const unsigned og = xb_add(&bar[XB_TOP], 1u);
            const unsigned tg = og / nx;
            if (og + 1u == (tg + 1u) * nx) xb_add(&bar[XB_TOPGEN], 1u);
            else XB_SPIN(xb_ld(&bar[XB_TOPGEN]) == tg, bar);
            __builtin_amdgcn_fence(__ATOMIC_ACQUIRE, "agent");
            xb_add(&bar[XB_XGEN(b.x)], 1u);
            asm volatile("s_waitcnt vmcnt(0)" ::: "memory");
        } else {
            XB_SPIN(xb_ld(&bar[XB_XGEN(b.x)]) == gen, bar);
            __builtin_amdgcn_fence(__ATOMIC_ACQUIRE, "agent");
            asm volatile("s_waitcnt vmcnt(0)" ::: "memory");
        }
    }
    __syncthreads();
}

constexpr int NCTXB = 32;
constexpr int PH_PER_LAYER = 16, N_PHASES = 1 + DEPTH * PH_PER_LAYER + 1;
__global__ void __launch_bounds__(NTHR, 2) fwd_megakernel(Args A0) {
    extern __shared__ __attribute__((aligned(16))) unsigned char lds_raw[];
    LAS unsigned char* lds = (LAS unsigned char*)lds_raw;
    cg::grid_group grid = cg::this_grid();
    const int ph_lo = A0.ph_lo, ph_hi = A0.ph_hi;
    volatile LAS unsigned* bst = (volatile LAS unsigned*)(lds + 131072);
    if (threadIdx.x < 2) bst[threadIdx.x] = 0u;
    __syncthreads();
    const XcdBarrier xbar = xcd_barrier_post((unsigned*)(A0.ws + WS_BAR), bst);
    const int wave0 = __builtin_amdgcn_readfirstlane((int)threadIdx.x >> 6);
    bool rep_done = false; (void)rep_done;
    for (int ph = ph_lo; ph < ph_hi; ++ph) {
        CArgsP A = (CArgsP)__builtin_amdgcn_kernarg_segment_ptr();
        asm volatile("" : "+s"(A) :: "memory");
        int G = gridDim.x, bx = blockIdx.x, wave = wave0;
        asm volatile("" : "+s"(G), "+s"(bx), "+s"(wave));
#define IDS() int lane; asm volatile("v_mbcnt_lo_u32_b32 %0, -1, 0\n\tv_mbcnt_hi_u32_b32 %0, -1, %0" : "=v"(lane)); const int tid = wave * 64 + lane; (void)tid
        const WS W = make_ws(A->ws);
        if (ph == 0) { IDS(); mods_phase(bx, G, A, W, lds, tid, lane, wave); convert_phase(bx, G, A, W.wt, 0, lds, lane, wave); }
        else if (ph == N_PHASES - 1) { IDS(); final_norm_phase(bx, G, A->out, A->in[I_GFINAL], lane, wave); }
        else {
            const int l = (ph - 1) / PH_PER_LAYER, s = (ph - 1) % PH_PER_LAYER; const bool last = (l == DEPTH - 1);
            if ((s == 1 && l == 0) || (s == 13 && last)) continue;
            const float* mods_l = W.mods + (size_t)l * 9 * 9216;
            const bf16* WTL = (l & 1) ? W.wt2 : W.wt;
            const float* xlat = A->out; const float* xctx = W.xrctx;
            int gk = 0, gl = l; bool gctx = false;
            if (s == 3) gk = 1; else if (s == 4) { gk = 1; gctx = true; } else if (s == 11) gk = 2; else if (s == 12 && !last) { gk = 2; gctx = true; }
            else if (s == 15) gk = 3; else if (s == 0 && l > 0) { gk = 3; gctx = true; gl = l - 1; }
            const int nk = (s == 0 || s == 1) ? 1 : ((s == 4 || s == 5) ? 2 : ((s == 12 || s == 13) ? 3 : 0));
            const bool split = gk != 0 && gctx && G > 2 * NCTXB;
            if (gk != 0 && (!gctx || !split || bx < NCTXB)) { IDS();
                const float* mods_g = W.mods + (size_t)gl * 9 * 9216; const bf16* WTG = (gl & 1) ? W.wt2 : W.wt;
                pg8::Gemm g{gk == 2 ? W.H : W.ACT, WTG + (gk == 1 ? WT_DOWN1 : gk == 2 ? WT_OUT : WT_DOWN2), gctx ? MCTX : MLAT, D, gk == 2 ? D : DFF};
                pg8::StaticOrder S; S.init(g.M, g.N, (gctx && split) ? NCTXB : G, bx, gctx ? MLAT / 256 : 0);
                const bool first = (gl == 0 && gk == 1);
                EpiResid E{first ? A->in[I_X] : xlat, first ? A->in[I_CTX] : xctx, A->out, W.xrctx, mods_g + (gk == 1 ? 2 : gk == 2 ? 5 : 8) * 1024, gk == 2 ? 1.0f : 0.5f};
                pg8::gemm_phase<EpiResid, pg8::StaticOrder, true, true>(lds, g, S, E, tid);
            }
            if (nk != 0 && !(split && bx < NCTXB)) { IDS();
                const bool l0 = (l == 0 && s == 0);
                const bool ctxrows = (s == 1 || s == 5 || s == 13);
                const int row_lo = ctxrows ? MLAT : 0, row_hi = (ctxrows || l0) ? MTOT : MLAT;
                const float* gsrc = nk == 1 ? A->in[I_GFFN1] + l * D : (nk == 2 ? A->in[I_GMIX] + l * D : A->in[I_GFFN2] + l * D);
                norm_phase(split ? bx - NCTXB : bx, split ? G - NCTXB : G, l0 ? A->in[I_X] : xlat, l0 ? A->in[I_CTX] : xctx, gsrc, mods_l, (nk - 1) * 3, (nk - 1) * 3 + 1, W.H, row_lo, row_hi, lane, wave);
            }
            if (s == 2 || s == 14) { IDS();
                pg8::Gemm g{W.H, WTL + (s == 2 ? WT_GU1 : WT_GU2), (s == 14 && last) ? MLAT : MTOT, 2 * DFF, D}; pg8::StaticOrder S; S.init(g.M, g.N, G, bx);
                EpiSwiGLU E{W.ACT};
                pg8::gemm_phase<EpiSwiGLU, pg8::StaticOrder, true, true>(lds, g, S, E, tid);
            } else if (s == 6) { IDS();
                pg8::Gemm g{W.H, WTL + WT_IN, MTOT, INCP, D}; pg8::StaticOrder S; S.init(g.M, g.N, G, bx);
                EpiP E{W.P, INCP};
                pg8::gemm_phase<EpiP, pg8::StaticOrder, true, true>(lds, g, S, E, tid);
            } else if (s == 7) { IDS();
                pre_phase(bx, G, A, W, l, lds, tid, lane, wave);
            } else if (s == 8) { IDS();
                int Kl = LORA_K, Nl = LORA_N; asm volatile("" : "+s"(Kl), "+s"(Nl));
                pg8::Gemm g{(const bf16*)((const unsigned char*)W.H + HB_AP), WTL + WT_LORA, MTOT, Nl, Kl}; pg8::StaticOrder S; S.init(g.M, g.N, G, bx);
                EpiLora E{A->in[I_W0] + l * 2 * RW, A->in[I_A0] + l * 2 * RW, A->in[I_KA] + l * RW, (const bf16*)((const unsigned char*)W.H + HB_KT), W.sc_kk, W.scb, W.P, l & 1};
                pg8::gemm_phase<EpiLora, pg8::StaticOrder, true, true>(lds, g, S, E, tid);
            } else if (s == 9) { IDS();
                for (int u = bx; u < 240; u += G) {
                    if (u < 192) rwkv_scan_phase(W, l, u, lds, tid, lane, wave); else lru_scan_phase(A, W, l, u - 192, lds, tid, lane, wave);
                    __syncthreads();
                }
                if (!last) {
                    if (G > 240) { if (bx >= 240) convert_phase(bx - 240, G - 240, A, ((l + 1) & 1) ? W.wt2 : W.wt, l + 1, lds, lane, wave); }
                    else convert_phase(bx, G, A, ((l + 1) & 1) ? W.wt2 : W.wt, l + 1, lds, lane, wave);
                }
            } else if (s == 10) { IDS();
                post_phase(bx, G, A, W, l, lds, tid, lane, wave);
            }
        }
#ifdef PROBE_REP_S
        if (ph > 0 && ph < N_PHASES - 1 && ((ph - 1) % PH_PER_LAYER) == PROBE_REP_S && !rep_done) { rep_done = true; grid.sync(); --ph; continue; }
        rep_done = false;
#endif
        if (ph + 1 < ph_hi) { if (ph == ph_lo) grid.sync(); else xcd_barrier(xbar); }
    }
}

#ifndef MK_MULTI
#define MK_MULTI 0
#endif
extern "C" void kernel_launch(void* const* d_in, const int* in_sizes, int n_in, void* d_out, int out_size, void* d_ws, size_t ws_size, hipStream_t stream) {
    static int grid = 0;
    if (grid == 0) {
        if (n_in != N_IN || out_size != MLAT * D || ws_size < WS_END) { fprintf(stderr, "kernel_launch: unexpected shapes (n_in %d out %d ws %zu)\n", n_in, out_size, ws_size); grid = -1; return; }
        int dev = 0, cus = 0, per_cu = 0;
        (void)hipGetDevice(&dev); (void)hipDeviceGetAttribute(&cus, hipDeviceAttributeMultiprocessorCount, dev);
        if (hipFuncSetAttribute((const void*)fwd_megakernel, hipFuncAttributeMaxDynamicSharedMemorySize, LDS_BYTES) != hipSuccess) { fprintf(stderr, "kernel_launch: hipFuncSetAttribute failed\n"); grid = -1; return; }
        if (hipOccupancyMaxActiveBlocksPerMultiprocessor(&per_cu, (const void*)fwd_megakernel, NTHR, LDS_BYTES) != hipSuccess || per_cu < 1) { fprintf(stderr, "kernel_launch: occupancy query says %d\n", per_cu); per_cu = 1; }
        (void)hipGetLastError();
        grid = cus * 1;
        if (grid <= 0) grid = 256;
    }
    if (grid < 0) return;
    if (hipMemsetAsync((unsigned char*)d_ws + WS_BAR, 0, WS_BAR_BYTES, stream) != hipSuccess) { fprintf(stderr, "kernel_launch: memset of the barrier words failed\n"); return; }
    Args a{};
    for (int i = 0; i < N_IN; ++i) a.in[i] = (const float*)d_in[i];
    a.out = (float*)d_out; a.ws = (unsigned char*)d_ws;
#if MK_MULTI
    for (int ph = 0; ph < N_PHASES; ++ph) { a.ph_lo = ph; a.ph_hi = ph + 1; hipLaunchKernelGGL(fwd_megakernel, dim3(grid), dim3(NTHR), LDS_BYTES, stream, a); }
#else
    a.ph_lo = 0; a.ph_hi = N_PHASES;
    void* args[] = {&a};
    hipError_t e = hipLaunchCooperativeKernel((const void*)fwd_megakernel, dim3(grid), dim3(NTHR), args, LDS_BYTES, stream);
    if (e != hipSuccess) fprintf(stderr, "kernel_launch: cooperative launch failed: %s (grid %d)\n", hipGetErrorString(e), grid);
#endif
}
```

```cpp
#include <hip/hip_runtime.h>
#include <hip/hip_cooperative_groups.h>
#include <cstdio>
#include <cstdint>
namespace cg = cooperative_groups;
namespace pg8 {
#define PG8_LAS __attribute__((address_space(3)))
typedef unsigned short bf16_t;
typedef short bf16x8 __attribute__((ext_vector_type(8)));
typedef float f32x4 __attribute__((ext_vector_type(4)));
typedef unsigned u32x4 __attribute__((ext_vector_type(4)));
constexpr int BM = 256, BK = 64, HALF = 128, HTB = HALF * BK * 2  , STAGE_BYTES = 8 * HTB, NXCD = 8, WGM = 8;

__host__ __device__ __forceinline__ int lds_byte(int r, int c) { const int st = (r >> 4) * 2 + (c >> 5), rr = r & 15, cc = c & 31, ob = rr * 64 + cc * 2; return st * 1024 + (ob ^ (((ob >> 9) & 1) << 5)); }
__host__ __device__ __forceinline__ void stage_rc(int b, int& R, int& C) { const int st = b / 1024, sb = b % 1024, swz = sb ^ (((sb >> 9) & 1) << 5); R = (st >> 1) * 16 + swz / 64; C = (st & 1) * 32 + (swz % 64) / 2; }
__host__ __device__ __forceinline__ int perm32(int rho) { const int n = rho >> 4, i = rho & 15; return 8 * (i >> 2) + 4 * n + (i & 3); }

struct Unit { int pm, pn; };
struct Gemm { const bf16_t* A; const bf16_t* Bt; int M, N, K; };

struct StaticOrder {
    int nM, nN, nwg, G, c, pm_off;
    __host__ __device__ void init(int M, int N, int G_, int c_, int off_ = 0) { nM = M / BM; nN = N / BM; nwg = nM * nN; G = G_; c = c_; pm_off = off_; }
    __host__ __device__ bool next(int i, Unit& u) const {
        const long L = (long)i * G + c; if (L >= nwg) return false;
        int wgid = (int)L; { const int q = nwg / NXCD, r = nwg % NXCD, xcd = wgid % NXCD, off = wgid / NXCD; wgid = (xcd < r ? xcd * (q + 1) : r * (q + 1) + (xcd - r) * q) + off; }
        const int nig = WGM * nN, gid = wgid / nig, fm = gid * WGM, gsz = (nM - fm) < WGM ? (nM - fm) : WGM;
        u.pm = fm + ((wgid % nig) % gsz) + pm_off; u.pn = (wgid % nig) / gsz; return true;
    }
    __device__ __forceinline__ void a_ready(const Unit&) const {}
    __device__ __forceinline__ void done(const Unit&) const {}
};

template <class Epi, class Sched, bool ALIGN_EPI = false, bool SP2 = false>
__device__ __forceinline__ void gemm_phase(PG8_LAS unsigned char* lds, const Gemm g, const Sched& S, const Epi& E, const int tid) {
    const int wid = __builtin_amdgcn_readfirstlane(tid >> 6), lane = tid & 63, wr = wid >> 2, wc = wid & 3, fr = lane & 15, fq = lane >> 4;
    const int K = g.K, nt = K / BK;
    unsigned voffA[2], voffB[2];
#pragma unroll
    for (int i = 0; i < 2; ++i) { int R, C; stage_rc(tid * 16 + i * 8192, R, C); const int Rb = Epi::PERM ? ((R & ~31) + perm32(R & 31)) : R;
        voffA[i] = (unsigned)(R * K + C) * 2u; voffB[i] = (unsigned)(Rb * K + C) * 2u; }
    const size_t kstep = (size_t)(BK * 2);
    const size_t hstep = (size_t)HALF * K * 2;
    const size_t tstep = 2 * hstep;
    const unsigned ldsw = (unsigned)wid * 1024u;
    const int aoff = lds_byte(wr * 64 + fr, fq * 8), boff = lds_byte(wc * 32 + fr, fq * 8);
#define PG8_SA(b, h) (((b) * 2 + (h)) * HTB)
#define PG8_SB(b, h) ((4 + (b) * 2 + (h)) * HTB)
#define PG8_STAGE(bufoff, gbase, voff) do { _Pragma("unroll") for (int _i = 0; _i < 2; ++_i) \
        __builtin_amdgcn_global_load_lds((const unsigned*)((const char*)(gbase) + (voff)[_i]), (PG8_LAS unsigned*)(lds + (bufoff) + ldsw + _i * 8192), 16, 0, 0); } while (0)
#define PG8_LDA(dst, b, h) do { _Pragma("unroll") for (int m = 0; m < 4; ++m) _Pragma("unroll") for (int k = 0; k < 2; ++k) dst[m][k] = *(const PG8_LAS bf16x8*)(lds + PG8_SA(b, h) + aoff + m * 2048 + k * 1024); } while (0)
#define PG8_LDB(dst, b, h) do { _Pragma("unroll") for (int n = 0; n < 2; ++n) _Pragma("unroll") for (int k = 0; k < 2; ++k) dst[n][k] = *(const PG8_LAS bf16x8*)(lds + PG8_SB(b, h) + boff + n * 2048 + k * 1024); } while (0)
#define PG8_MMA(ai, bj, At, Bt) do { __builtin_amdgcn_s_setprio(1); _Pragma("unroll") for (int m = 0; m < 4; ++m) _Pragma("unroll") for (int n = 0; n < 2; ++n) _Pragma("unroll") for (int k = 0; k < 2; ++k) \
        acc[ai][bj][m][n] = __builtin_amdgcn_mfma_f32_16x16x32_bf16(Bt[n][k], At[m][k], acc[ai][bj][m][n], 0, 0, 0); __builtin_amdgcn_s_setprio(0); } while (0)
#define PG8_WAIT_V(n) asm volatile("s_waitcnt vmcnt(" #n ")" ::: "memory")
#define PG8_WAIT_L(n) asm volatile("s_waitcnt lgkmcnt(" #n ")" ::: "memory")
#define PG8_BAR __builtin_amdgcn_s_barrier()
#define PG8_SCHED __builtin_amdgcn_sched_barrier(0)
    Unit cur, nxt; int ui = 0;
    if (!S.next(0, cur)) return;
    f32x4 acc[2][2][4][2];
#pragma unroll
    for (int a = 0; a < 2; ++a)
#pragma unroll
        for (int b = 0; b < 2; ++b)
#pragma unroll
            for (int m = 0; m < 4; ++m)
#pragma unroll
                for (int n = 0; n < 2; ++n) acc[a][b][m][n] = (f32x4){0.f, 0.f, 0.f, 0.f};
    bf16x8 At[4][2], B0[2][2], B1[2][2];
    const char* cA = (const char*)g.A + (size_t)cur.pm * tstep; const char* cB = (const char*)g.Bt + (size_t)cur.pn * tstep;
    S.a_ready(cur);
    if constexpr (SP2) {
        PG8_STAGE(PG8_SB(0, 0), cB, voffB); PG8_STAGE(PG8_SB(0, 1), cB + hstep, voffB); PG8_STAGE(PG8_SA(0, 0), cA, voffA); PG8_STAGE(PG8_SA(0, 1), cA + hstep, voffA);
        if (wr == 1) PG8_BAR;
        PG8_WAIT_V(2); PG8_BAR;
        PG8_STAGE(PG8_SB(1, 0), cB + kstep, voffB); PG8_STAGE(PG8_SA(1, 0), cA + kstep, voffA); PG8_STAGE(PG8_SB(1, 1), cB + hstep + kstep, voffB);
        PG8_WAIT_V(6); PG8_BAR;
    } else {
        PG8_STAGE(PG8_SB(0, 0), cB, voffB); PG8_STAGE(PG8_SA(0, 0), cA, voffA); PG8_STAGE(PG8_SB(0, 1), cB + hstep, voffB); PG8_STAGE(PG8_SA(0, 1), cA + hstep, voffA);
        if (wr == 1) PG8_BAR;
        PG8_WAIT_V(4); PG8_BAR;
        PG8_STAGE(PG8_SB(1, 0), cB + kstep, voffB); PG8_STAGE(PG8_SA(1, 0), cA + kstep, voffA); PG8_STAGE(PG8_SB(1, 1), cB + hstep + kstep, voffB);
        PG8_WAIT_V(6); PG8_BAR;
    }
    for (;;) {
        const bool has_next = S.next(ui + 1, nxt);
        const char* nA = has_next ? (const char*)g.A + (size_t)nxt.pm * tstep : cA; const char* nB = has_next ? (const char*)g.Bt + (size_t)nxt.pn * tstep : cB;
        for (int t = 0; t < nt; t += 2) {
            const bool last = (t == nt - 2);
            const char* a1 = cA + (size_t)(t + 1) * kstep;
            const char* a2 = last ? nA : cA + (size_t)(t + 2) * kstep; const char* b2 = last ? nB : cB + (size_t)(t + 2) * kstep;
            const char* a3 = a2 + kstep; const char* b3 = b2 + kstep;
            if (last && has_next) S.a_ready(nxt);
            if constexpr (SP2) {
            PG8_LDB(B0, 0, 0); PG8_LDB(B1, 0, 1); PG8_SCHED; PG8_LDA(At, 0, 0); PG8_STAGE(PG8_SA(1, 1), a1 + hstep, voffA);
            PG8_WAIT_V(8); PG8_WAIT_L(0); PG8_BAR; PG8_MMA(0, 0, At, B0); PG8_MMA(0, 1, At, B1); PG8_BAR; PG8_SCHED;
            PG8_LDA(At, 0, 1); PG8_STAGE(PG8_SB(0, 0), b2, voffB); PG8_STAGE(PG8_SB(0, 1), b2 + hstep, voffB); PG8_STAGE(PG8_SA(0, 0), a2, voffA);
            PG8_WAIT_V(8); PG8_WAIT_L(0); PG8_BAR; PG8_MMA(1, 0, At, B0); PG8_MMA(1, 1, At, B1); PG8_BAR; PG8_SCHED;
            PG8_LDB(B0, 1, 0); PG8_LDB(B1, 1, 1); PG8_SCHED; PG8_LDA(At, 1, 0); PG8_STAGE(PG8_SA(0, 1), a2 + hstep, voffA);
            PG8_WAIT_V(8); PG8_WAIT_L(0); PG8_BAR; PG8_MMA(0, 0, At, B0); PG8_MMA(0, 1, At, B1); PG8_BAR; PG8_SCHED;
            PG8_LDA(At, 1, 1); PG8_STAGE(PG8_SB(1, 0), b3, voffB); PG8_STAGE(PG8_SB(1, 1), b3 + hstep, voffB); PG8_STAGE(PG8_SA(1, 0), a3, voffA);
            PG8_WAIT_V(8); PG8_WAIT_L(0); PG8_BAR; PG8_MMA(1, 0, At, B0); PG8_MMA(1, 1, At, B1); PG8_BAR; PG8_SCHED;
            } else {
            PG8_LDB(B0, 0, 0); PG8_SCHED; PG8_LDA(At, 0, 0); PG8_STAGE(PG8_SA(1, 1), a1 + hstep, voffA);
            PG8_WAIT_L(8); PG8_BAR; PG8_WAIT_L(0); PG8_MMA(0, 0, At, B0); PG8_BAR; PG8_SCHED;
            PG8_LDB(B1, 0, 1); PG8_STAGE(PG8_SB(0, 0), b2, voffB);
            PG8_BAR; PG8_WAIT_L(0); PG8_MMA(0, 1, At, B1); PG8_BAR;
            PG8_LDA(At, 0, 1); PG8_STAGE(PG8_SA(0, 0), a2, voffA);
            PG8_BAR; PG8_WAIT_L(0); PG8_MMA(1, 0, At, B0); PG8_BAR; PG8_SCHED;
            PG8_STAGE(PG8_SB(0, 1), b2 + hstep, voffB);
            PG8_WAIT_V(6); PG8_BAR; PG8_MMA(1, 1, At, B1); PG8_BAR;
            PG8_LDB(B0, 1, 0); PG8_SCHED; PG8_LDA(At, 1, 0); PG8_STAGE(PG8_SA(0, 1), a2 + hstep, voffA);
            PG8_WAIT_L(8); PG8_BAR; PG8_WAIT_L(0); PG8_MMA(0, 0, At, B0); PG8_BAR; PG8_SCHED;
            PG8_LDB(B1, 1, 1); PG8_STAGE(PG8_SB(1, 0), b3, voffB);
            PG8_BAR; PG8_WAIT_L(0); PG8_MMA(0, 1, At, B1); PG8_BAR;
            PG8_LDA(At, 1, 1); PG8_STAGE(PG8_SA(1, 0), a3, voffA);
            PG8_BAR; PG8_WAIT_L(0); PG8_MMA(1, 0, At, B0); PG8_BAR; PG8_SCHED;
            PG8_STAGE(PG8_SB(1, 1), b3 + hstep, voffB);
            PG8_WAIT_V(6); PG8_BAR; PG8_MMA(1, 1, At, B1); PG8_BAR;
            }
        }
        if constexpr (ALIGN_EPI) { if (wr == 0) PG8_BAR; }
        if constexpr (!Epi::AFTER_DRAIN) { E(acc, cur, wr, wc, fr, fq); S.done(cur); }
        if (!has_next) break;
#pragma unroll
        for (int a = 0; a < 2; ++a)
#pragma unroll
            for (int b = 0; b < 2; ++b)
#pragma unroll
                for (int m = 0; m < 4; ++m)
#pragma unroll
                    for (int n = 0; n < 2; ++n) acc[a][b][m][n] = (f32x4){0.f, 0.f, 0.f, 0.f};
        cur = nxt; cA = nA; cB = nB; ++ui;
        if constexpr (ALIGN_EPI) { if (wr == 1) PG8_BAR; }
    }
    PG8_WAIT_V(0);
    if constexpr (!ALIGN_EPI) { if (wr == 0) PG8_BAR; }
    PG8_BAR;
    if constexpr (Epi::AFTER_DRAIN) { E.fused(acc, cur, wr, wc, fr, fq, lds, wid, lane); S.done(cur); }
#undef PG8_SA
#undef PG8_SB
#undef PG8_STAGE
#undef PG8_LDA
#undef PG8_LDB
#undef PG8_MMA
#undef PG8_WAIT_V
#undef PG8_WAIT_L
#undef PG8_BAR
#undef PG8_SCHED
}
}
#define LAS __attribute__((address_space(3)))
typedef unsigned short bf16;
typedef unsigned v4u __attribute__((ext_vector_type(4)));
typedef unsigned v2u __attribute__((ext_vector_type(2)));
typedef float f32x4 __attribute__((ext_vector_type(4)));
typedef float f32x2 __attribute__((ext_vector_type(2)));

constexpr int D = 1024, NB = 8, SEQ = 4096, CTX = 256, DEPTH = 4, DFF = 2816;
constexpr int MLAT = NB * SEQ, MCTX = NB * CTX, MTOT = MLAT + MCTX;
constexpr int INC = 2944, INCP = 3072;
constexpr int RW = 384, LW = 384, RC = 1408;
constexpr int QLEN = CTX + SEQ;
constexpr int PC_BG = 0, PC_CG = 256, PC_XIN = 512, PC_RW = 768, PC_XR = 2176, PC_GR = 2560;
constexpr int PC_Y = 768;
constexpr int PC_G = 1536;
constexpr int LORA_N = 2048, LORA_K = 256;
constexpr int NWAVES = 8, NTHR = 512;
constexpr int LDS_BYTES = 147456;

constexpr size_t MiB = 1u << 20;
constexpr size_t WS_BAR = 1536 * 1024, WS_BAR_BYTES = 16384;
constexpr size_t WS_MODS = 0, WS_XRCTX = 2 * MiB, WS_WT = 10 * MiB, WS_H = 52 * MiB, WS_A = 120 * MiB, WS_B = 324 * MiB;
constexpr size_t SC_ELEMS = (size_t)NB * QLEN * RW;
constexpr size_t WS_WT2 = WS_B + 9 * SC_ELEMS * 2;
constexpr size_t WS_END = WS_WT2 + 42 * MiB;
static_assert(WS_END <= 600 * MiB, "workspace map");
static_assert(WS_A + (size_t)MTOT * INCP * 2 <= WS_B, "P fits");
constexpr size_t WT_GU1 = 0, WT_DOWN1 = WT_GU1 + (size_t)2 * DFF * D, WT_IN = WT_DOWN1 + (size_t)D * DFF, WT_OUT = WT_IN + (size_t)INCP * D,
                 WT_GU2 = WT_OUT + (size_t)D * D, WT_DOWN2 = WT_GU2 + (size_t)2 * DFF * D, WT_TOTAL = WT_DOWN2 + (size_t)D * DFF;
constexpr size_t WT_LORA = WT_TOTAL;
static_assert(WS_WT + (WT_TOTAL + (size_t)LORA_N * LORA_K) * 2 <= WS_H, "weights fit");
constexpr size_t HB_AP = 0, HB_KT = (size_t)MTOT * LORA_K * 2;
static_assert(HB_KT + (size_t)MTOT * RW * 2 <= WS_A - WS_H, "H region overlay");

enum { I_X = 0, I_C, I_CTX, I_CCTX, I_WMOD, I_BMOD, I_GFFN1, I_WGU1, I_WDOWN1, I_GMIX, I_WIN, I_CONVA, I_MU, I_W0, I_W2, I_A0, I_A2, I_G2, I_KK, I_KA, I_RK,
       I_LNG, I_LNB, I_LCW, I_LCB, I_LWR, I_LBR, I_LWI, I_LBI, I_LAM, I_WOUT, I_GFFN2, I_WGU2, I_WDOWN2, I_GFINAL, N_IN };

struct Args { const float* in[N_IN]; float* out; unsigned char* ws; int ph_lo, ph_hi; };
typedef const __attribute__((address_space(4))) Args* CArgsP;

__device__ __forceinline__ float bf2f(unsigned h) { return __builtin_bit_cast(float, h << 16); }
__device__ __forceinline__ unsigned f2bf(float f) { unsigned u = __builtin_bit_cast(unsigned, f); return (u + 0x7fffu + ((u >> 16) & 1u)) >> 16; }
__device__ __forceinline__ unsigned pk2(float lo, float hi) { unsigned r; asm("v_cvt_pk_bf16_f32 %0, %1, %2" : "=v"(r) : "v"(lo), "v"(hi)); return r; }
__device__ __forceinline__ void unpack8(v4u p, float* o) {
    o[0] = __builtin_bit_cast(float, p.x << 16); o[1] = __builtin_bit_cast(float, p.x & 0xffff0000u);
    o[2] = __builtin_bit_cast(float, p.y << 16); o[3] = __builtin_bit_cast(float, p.y & 0xffff0000u);
    o[4] = __builtin_bit_cast(float, p.z << 16); o[5] = __builtin_bit_cast(float, p.z & 0xffff0000u);
    o[6] = __builtin_bit_cast(float, p.w << 16); o[7] = __builtin_bit_cast(float, p.w & 0xffff0000u);
}
__device__ __forceinline__ v4u pack8(const float* v) { v4u o; o.x = pk2(v[0], v[1]); o.y = pk2(v[2], v[3]); o.z = pk2(v[4], v[5]); o.w = pk2(v[6], v[7]); return o; }
template <int CTRL> __device__ __forceinline__ float dppf(float v) { return __builtin_bit_cast(float, __builtin_amdgcn_update_dpp(0, __builtin_bit_cast(int, v), CTRL, 0xF, 0xF, true)); }
__device__ __forceinline__ float wave_sum(float v) {
    v += dppf<0xB1>(v); v += dppf<0x4E>(v); v += dppf<0x141>(v); v += dppf<0x140>(v);
    const float a = __builtin_bit_cast(float, __builtin_amdgcn_readlane(__builtin_bit_cast(int, v), 0)), b = __builtin_bit_cast(float, __builtin_amdgcn_readlane(__builtin_bit_cast(int, v), 16));
    const float c = __builtin_bit_cast(float, __builtin_amdgcn_readlane(__builtin_bit_cast(int, v), 32)), d = __builtin_bit_cast(float, __builtin_amdgcn_readlane(__builtin_bit_cast(int, v), 48));
    return (a + b) + (c + d);
}
__device__ __forceinline__ float sigmoidf_(float x) { return __builtin_amdgcn_rcpf(1.0f + __expf(-x)); }
__device__ __forceinline__ float siluf_(float x) { return x * __builtin_amdgcn_rcpf(1.0f + __expf(-x)); }
__device__ __forceinline__ float softplusf_(float z) { return fmaxf(z, 0.f) + log1pf(__expf(-fabsf(z))); }
__device__ __forceinline__ float tanh_fast(float x) { const float e = __expf(2.0f * fminf(fmaxf(x, -15.f), 15.f)); return 1.0f - 2.0f * __builtin_amdgcn_rcpf(e + 1.0f); }
__device__ __forceinline__ float gelu_tanh(float x) { const float u = 0.7978845608028654f * (x + 0.044715f * x * x * x); return 0.5f * x * (1.0f + tanh_fast(u)); }
__device__ __forceinline__ float rscatter16(const float (&v)[16], int j) {
    const bool b1 = (j & 8) != 0, b2 = (j & 4) != 0, b3 = (j & 2) != 0, b4 = (j & 1) != 0;
    float a[8], c[4], d[2];
#pragma unroll
    for (int k = 0; k < 8; ++k) { const float keep = b1 ? v[k + 8] : v[k], send = b1 ? v[k] : v[k + 8]; a[k] = keep + dppf<0x140>(send); }
#pragma unroll
    for (int k = 0; k < 4; ++k) { const float keep = b2 ? a[k + 4] : a[k], send = b2 ? a[k] : a[k + 4]; c[k] = keep + dppf<0x141>(send); }
#pragma unroll
    for (int k = 0; k < 2; ++k) { const float keep = b3 ? c[k + 2] : c[k], send = b3 ? c[k] : c[k + 2]; d[k] = keep + dppf<0x4E>(send); }
    { const float keep = b4 ? d[1] : d[0], send = b4 ? d[0] : d[1]; return keep + dppf<0xB1>(send); }
}
__device__ __forceinline__ float reduce16(float x) { x += dppf<0xB1>(x); x += dppf<0x4E>(x); x += dppf<0x141>(x); x += dppf<0x140>(x); return x; }
__device__ __forceinline__ float reduce8(float x) { x += dppf<0xB1>(x); x += dppf<0x4E>(x); x += dppf<0x141>(x); return x; }
__device__ __forceinline__ int row_of(int b, int q, int odd) {
    if (q < CTX) return MLAT + b * CTX + q;
    const int s = q - CTX; const int t = odd ? (((s & 63) << 6) | (s >> 6)) : s;
    return b * SEQ + t;
}

struct EpiSwiGLU {
    static constexpr bool PERM = true, AFTER_DRAIN = false;
    bf16* O;
    __device__ __forceinline__ void operator()(const pg8::f32x4 (&acc)[2][2][4][2], const pg8::Unit& u, int wr, int wc, int fr, int fq) const {
        const int row0 = u.pm * 256 + wr * 64 + fr, col0 = u.pn * 128 + wc * 32 + 8 * fq;
#pragma unroll
        for (int ai = 0; ai < 2; ++ai)
#pragma unroll
            for (int m = 0; m < 4; ++m) {
                float o[8];
#pragma unroll
                for (int n = 0; n < 2; ++n)
#pragma unroll
                    for (int j = 0; j < 4; ++j) { const float g = acc[ai][0][m][n][j], up = acc[ai][1][m][n][j]; o[n * 4 + j] = siluf_(g) * up; }
                *(v4u*)(O + (size_t)(row0 + ai * 128 + m * 16) * DFF + col0) = pack8(o);
            }
    }
};
struct EpiP {
    static constexpr bool PERM = true, AFTER_DRAIN = false;
    bf16* O; int ldc;
    __device__ __forceinline__ void operator()(const pg8::f32x4 (&acc)[2][2][4][2], const pg8::Unit& u, int wr, int wc, int fr, int fq) const {
        const int row0 = u.pm * 256 + wr * 64 + fr, col0 = u.pn * 256 + wc * 32 + 8 * fq;
#pragma unroll
        for (int ai = 0; ai < 2; ++ai)
#pragma unroll
            for (int m = 0; m < 4; ++m)
#pragma unroll
                for (int bj = 0; bj < 2; ++bj) {
                    float o[8];
#pragma unroll
                    for (int n = 0; n < 2; ++n)
#pragma unroll
                        for (int j = 0; j < 4; ++j) o[n * 4 + j] = acc[ai][bj][m][n][j];
                    *(v4u*)(O + (size_t)(row0 + ai * 128 + m * 16) * ldc + col0 + bj * 128) = pack8(o);
                }
    }
};
struct EpiResid {
    static constexpr bool PERM = true, AFTER_DRAIN = false;
    const float* res_lat; const float* res_ctx; float* dst_lat; float* dst_ctx; const float* gate; float coef;
    __device__ __forceinline__ void operator()(const pg8::f32x4 (&acc)[2][2][4][2], const pg8::Unit& u, int wr, int wc, int fr, int fq) const {
        const int rowbase = u.pm * 256; const bool isctx = rowbase >= MLAT;
        const int b = isctx ? 8 : (rowbase >> 12);
        const float* res = isctx ? res_ctx + (size_t)(rowbase - MLAT) * D : res_lat + (size_t)rowbase * D;
        float* dst = isctx ? dst_ctx + (size_t)(rowbase - MLAT) * D : dst_lat + (size_t)rowbase * D;
#pragma unroll
        for (int bj = 0; bj < 2; ++bj) {
            const int col = u.pn * 256 + bj * 128 + wc * 32 + 8 * fq;
            const f32x4 g0 = *(const f32x4*)(gate + (size_t)b * 9216 + col) * coef, g1 = *(const f32x4*)(gate + (size_t)b * 9216 + col + 4) * coef;
#pragma unroll
            for (int ai = 0; ai < 2; ++ai)
#pragma unroll
                for (int m = 0; m < 4; ++m) {
                    const size_t off = (size_t)(ai * 128 + wr * 64 + m * 16 + fr) * D + col;
                    const f32x4 r0 = *(const f32x4*)(res + off), r1 = *(const f32x4*)(res + off + 4);
                    *(f32x4*)(dst + off) = r0 + g0 * acc[ai][bj][m][0];
                    *(f32x4*)(dst + off + 4) = r1 + g1 * acc[ai][bj][m][1];
                }
        }
    }
};

struct EpiLora {
    static constexpr bool PERM = true, AFTER_DRAIN = false;
    const float* w0; const float* a0; const float* ka; const bf16* kt; const bf16* kk; bf16* scb; bf16* P; int odd;
    __device__ __forceinline__ void operator()(const pg8::f32x4 (&acc)[2][2][4][2], const pg8::Unit& u, int wr, int wc, int fr, int fq) const {
        asm volatile("" : "+v"(fr), "+v"(fq));
#pragma unroll
        for (int bj = 0; bj < 2; ++bj) {
            const int half = __builtin_amdgcn_readfirstlane(u.pn * 2 + bj), kind = half / 3, c = (half - kind * 3) * 128 + wc * 32 + 8 * fq;
            if (kind >= 5) continue;
            float p0[8], p1[8];
#pragma unroll
            for (int e = 0; e < 8; ++e) { p0[e] = 0.f; p1[e] = 0.f; }
            if (kind < 2) { const f32x4 q0 = *(const f32x4*)(w0 + kind * 384 + c), q1 = *(const f32x4*)(w0 + kind * 384 + c + 4);
                p0[0] = q0.x; p0[1] = q0.y; p0[2] = q0.z; p0[3] = q0.w; p0[4] = q1.x; p0[5] = q1.y; p0[6] = q1.z; p0[7] = q1.w; }
            else if (kind < 4) { const f32x4 q0 = *(const f32x4*)(a0 + (kind - 2) * 384 + c), q1 = *(const f32x4*)(a0 + (kind - 2) * 384 + c + 4), r0 = *(const f32x4*)(ka + c), r1 = *(const f32x4*)(ka + c + 4);
                p0[0] = q0.x; p0[1] = q0.y; p0[2] = q0.z; p0[3] = q0.w; p0[4] = q1.x; p0[5] = q1.y; p0[6] = q1.z; p0[7] = q1.w;
                p1[0] = r0.x; p1[1] = r0.y; p1[2] = r0.z; p1[3] = r0.w; p1[4] = r1.x; p1[5] = r1.y; p1[6] = r1.z; p1[7] = r1.w; }
#pragma unroll
            for (int ai = 0; ai < 2; ++ai) {
                v4u kkr[4], ktr[4];
                if (kind >= 2 && kind < 4) {
#pragma unroll
                    for (int m = 0; m < 4; ++m) { const int pos = u.pm * 256 + ai * 128 + wr * 64 + m * 16 + fr;
                        kkr[m] = *(const v4u*)(kk + (size_t)pos * RW + c); ktr[m] = *(const v4u*)(kt + (size_t)pos * RW + c); }
                }
#pragma unroll
                for (int m = 0; m < 4; ++m) {
                    const int pos = u.pm * 256 + ai * 128 + wr * 64 + m * 16 + fr;
                    float v[8];
#pragma unroll
                    for (int n = 0; n < 2; ++n)
#pragma unroll
                        for (int j = 0; j < 4; ++j) v[n * 4 + j] = acc[ai][bj][m][n][j];
                    if (kind < 2) {
#pragma unroll
                        for (int e = 0; e < 8; ++e) { const float wl = p0[e] + v[e];
                            v[e] = 1.0f - __expf(-0.6065306597126334f * sigmoidf_(wl)); }
                        *(v4u*)(scb + (size_t)(7 + kind) * SC_ELEMS + (size_t)pos * RW + c) = pack8(v);
                    } else if (kind < 4) {
#pragma unroll
                        for (int e = 0; e < 8; ++e) v[e] = sigmoidf_(p0[e] + v[e]);
                        {   float kkv[8]; unpack8(kkr[m], kkv);
#pragma unroll
                            for (int e = 0; e < 8; ++e) kkv[e] *= v[e];
                            *(v4u*)(scb + (size_t)(5 + kind - 2) * SC_ELEMS + (size_t)pos * RW + c) = pack8(kkv); }
                        {   float kv[8]; unpack8(ktr[m], kv);
#pragma unroll
                            for (int e = 0; e < 8; ++e) kv[e] *= (1.0f + (v[e] - 1.0f) * p1[e]);
                            *(v4u*)(scb + (size_t)(3 + kind - 2) * SC_ELEMS + (size_t)pos * RW + c) = pack8(kv); }
                    } else {
                        const int b = pos / QLEN, q = pos - b * QLEN;
                        *(v4u*)(P + (size_t)row_of(b, q, odd) * INCP + PC_G + c) = pack8(v);
                    }
                }
                asm volatile("" ::: "memory");
            }
        }
    }
};
struct WS {
    float* mods; float* xrctx; bf16* wt; bf16* wt2; bf16* H; bf16* P; bf16* ACT;
    bf16 *scb, *sc_r, *sc_v, *sc_kk, *dgs;
};
__device__ __forceinline__ WS make_ws(unsigned char* ws) {
    WS w; w.mods = (float*)(ws + WS_MODS); w.xrctx = (float*)(ws + WS_XRCTX); w.wt = (bf16*)(ws + WS_WT); w.wt2 = (bf16*)(ws + WS_WT2); w.H = (bf16*)(ws + WS_H); w.P = (bf16*)(ws + WS_A); w.ACT = (bf16*)(ws + WS_A);
    bf16* b = (bf16*)(ws + WS_B);
    w.scb = b; w.sc_r = b; w.sc_v = b + SC_ELEMS; w.sc_kk = b + 2 * SC_ELEMS; w.dgs = b + 9 * SC_ELEMS;
    return w;
}

__device__ __forceinline__ void mods_phase(const int bx, const int G, CArgsP A, const WS& W, LAS unsigned char* lds, int tid, int lane, int wave) {
    LAS float* sl = (LAS float*)lds;
    LAS float* part = sl + 9 * 1024;
    const float* c = A->in[I_C]; const float* cctx = A->in[I_CCTX];
    for (int i = tid; i < 9216; i += NTHR) { const int r = i >> 10, k = i & 1023; const float v = r < 8 ? c[r * 1024 + k] : cctx[k]; sl[i] = siluf_(v); }
    __syncthreads();
    for (int item = bx; item < 288; item += G) {
        const int l = item / 72, cgp = item % 72;
        const float* Wp = A->in[I_WMOD] + (size_t)l * 1024 * 9216 + cgp * 128 + lane * 2;
        float acc[9][2];
#pragma unroll
        for (int r = 0; r < 9; ++r) { acc[r][0] = 0.f; acc[r][1] = 0.f; }
#pragma unroll 8
        for (int kk = 0; kk < 128; ++kk) {
            const int k = wave * 128 + kk;
            const f32x2 w = *(const f32x2*)(Wp + (size_t)k * 9216);
#pragma unroll
            for (int r = 0; r < 9; ++r) { const float s = sl[r * 1024 + k]; acc[r][0] += s * w.x; acc[r][1] += s * w.y; }
        }
#pragma unroll
        for (int r = 0; r < 9; ++r) { part[(wave * 9 + r) * 128 + lane * 2] = acc[r][0]; part[(wave * 9 + r) * 128 + lane * 2 + 1] = acc[r][1]; }
        __syncthreads();
        for (int o = tid; o < 1152; o += NTHR) {
            const int r = o >> 7, cc = o & 127; float s = A->in[I_BMOD][l * 9216 + cgp * 128 + cc];
#pragma unroll
            for (int w8 = 0; w8 < 8; ++w8) s += part[(w8 * 9 + r) * 128 + cc];
            W.mods[(size_t)(l * 9 + r) * 9216 + cgp * 128 + cc] = s;
        }
        __syncthreads();
    }
}

__device__ __forceinline__ void transpose_item(const float* Wsrc, int K, int N, bf16* WT, int kb, int n0, int drow0, LAS float* scr, int lane) {
    const int k0 = 64 * kb;
    float tv[32];
#pragma unroll
    for (int i = 0; i < 32; ++i) tv[i] = Wsrc[(size_t)(k0 + 2 * i + (lane >> 5)) * N + n0 + (lane & 31)];
#pragma unroll
    for (int i = 0; i < 32; ++i) scr[(2 * i + (lane >> 5)) * 33 + (lane & 31)] = tv[i];
    asm volatile("s_waitcnt lgkmcnt(0)" ::: "memory");
    const int c = lane & 7;
#pragma unroll
    for (int j = 0; j < 4; ++j) { const int n = (lane >> 3) + 8 * j; const LAS float* s = scr + (8 * c) * 33 + n;
        v4u o; o.x = pk2(s[0 * 33], s[1 * 33]); o.y = pk2(s[2 * 33], s[3 * 33]); o.z = pk2(s[4 * 33], s[5 * 33]); o.w = pk2(s[6 * 33], s[7 * 33]);
        *(v4u*)(WT + (size_t)(drow0 + n) * K + k0 + 8 * c) = o; }
    asm volatile("s_waitcnt lgkmcnt(0)" ::: "memory");
}
__device__ __forceinline__ int gu_drow(int n0) { return n0 < DFF ? 256 * (n0 >> 7) + (n0 & 127) : 256 * ((n0 - DFF) >> 7) + 128 + ((n0 - DFF) & 127); }
__device__ __forceinline__ void convert_phase(const int bx, const int G, CArgsP A, bf16* wtd, int l, LAS unsigned char* lds, int lane, int wave) {
    LAS float* scr = (LAS float*)(lds + wave * 16384);
    const int gw = bx * NWAVES + wave, NGW = G * NWAVES;
    constexpr int I_GU = (D / 64) * (2 * DFF / 32), I_DN = (DFF / 64) * (D / 32), I_IN = (D / 64) * (INC / 32), I_OUT = (D / 64) * (D / 32);
    constexpr int NITEMS = 2 * I_GU + 2 * I_DN + I_IN + I_OUT;
    for (int it = gw; it < NITEMS; it += NGW) {
        int r = it;
        if (r < I_GU) { const int nblk = 2 * DFF / 32, kb = r / nblk, n0 = (r % nblk) * 32; transpose_item(A->in[I_WGU1] + (size_t)l * D * 2 * DFF, D, 2 * DFF, wtd + WT_GU1, kb, n0, gu_drow(n0), scr, lane); continue; } r -= I_GU;
        if (r < I_GU) { const int nblk = 2 * DFF / 32, kb = r / nblk, n0 = (r % nblk) * 32; transpose_item(A->in[I_WGU2] + (size_t)l * D * 2 * DFF, D, 2 * DFF, wtd + WT_GU2, kb, n0, gu_drow(n0), scr, lane); continue; } r -= I_GU;
        if (r < I_DN) { const int nblk = D / 32, kb = r / nblk, n0 = (r % nblk) * 32; transpose_item(A->in[I_WDOWN1] + (size_t)l * DFF * D, DFF, D, wtd + WT_DOWN1, kb, n0, n0, scr, lane); continue; } r -= I_DN;
        if (r < I_DN) { const int nblk = D / 32, kb = r / nblk, n0 = (r % nblk) * 32; transpose_item(A->in[I_WDOWN2] + (size_t)l * DFF * D, DFF, D, wtd + WT_DOWN2, kb, n0, n0, scr, lane); continue; } r -= I_DN;
        if (r < I_IN) { const int nblk = INC / 32, kb = r / nblk, n0 = (r % nblk) * 32; transpose_item(A->in[I_WIN] + (size_t)l * D * INC, D, INC, wtd + WT_IN, kb, n0, n0, scr, lane); continue; } r -= I_IN;
        { const int nblk = D / 32, kb = r / nblk, n0 = (r % nblk) * 32; transpose_item(A->in[I_WOUT] + (size_t)l * D * D, D, D, wtd + WT_OUT, kb, n0, n0, scr, lane); }
    }
    for (int idx = (bx * NWAVES + wave) * 64 + lane; idx < LORA_N * LORA_K; idx += G * NTHR) {
        const int n = idx % LORA_N, k = idx / LORA_N, kind = n / 384, c = n - kind * 384;
        float v = 0.f;
        if (kind < 2) { if (k < 64) v = A->in[I_W2][((size_t)(l * 2 + kind) * 64 + k) * RW + c]; }
        else if (kind < 4) { if (k >= 64 && k < 128) v = A->in[I_A2][((size_t)(l * 2 + kind - 2) * 64 + (k - 64)) * RW + c]; }
        else if (kind == 4) { if (k >= 128) v = A->in[I_G2][((size_t)l * 128 + (k - 128)) * RW + c]; }
        wtd[WT_LORA + (size_t)n * LORA_K + k] = (bf16)f2bf(v);
    }
}

__device__ __forceinline__ void norm_phase(const int bx, const int G, const float* lat, const float* ctxp, const float* g, const float* mods_l, int ishift, int iscale, bf16* H, int row_lo, int nrows, int lane, int wave) {
    const int gw = bx * NWAVES + wave, NGW = G * NWAVES;
    for (int r0 = row_lo + gw; r0 < nrows; r0 += 2 * NGW) {
        const int r1 = r0 + NGW < nrows ? r0 + NGW : r0;
        const float* xa = r0 < MLAT ? lat + (size_t)r0 * D : ctxp + (size_t)(r0 - MLAT) * D;
        const float* xb = r1 < MLAT ? lat + (size_t)r1 * D : ctxp + (size_t)(r1 - MLAT) * D;
        f32x4 va[4], vb[4]; float sa = 0.f, sb = 0.f;
#pragma unroll
        for (int j = 0; j < 4; ++j) { va[j] = *(const f32x4*)(xa + (lane + 64 * j) * 4); vb[j] = *(const f32x4*)(xb + (lane + 64 * j) * 4); }
#pragma unroll
        for (int j = 0; j < 4; ++j) { sa += (va[j].x * va[j].x + va[j].y * va[j].y) + (va[j].z * va[j].z + va[j].w * va[j].w); sb += (vb[j].x * vb[j].x + vb[j].y * vb[j].y) + (vb[j].z * vb[j].z + vb[j].w * vb[j].w); }
        sa = wave_sum(sa); sb = wave_sum(sb);
        const float rsa = rsqrtf(sa * (1.0f / D) + 1e-6f), rsb = rsqrtf(sb * (1.0f / D) + 1e-6f);
        const int ba = r0 < MLAT ? (r0 >> 12) : 8, bb = r1 < MLAT ? (r1 >> 12) : 8;
        const float* sha = mods_l + (size_t)ba * 9216 + ishift * 1024; const float* sca = mods_l + (size_t)ba * 9216 + iscale * 1024;
        const float* shb = mods_l + (size_t)bb * 9216 + ishift * 1024; const float* scb2 = mods_l + (size_t)bb * 9216 + iscale * 1024;
#pragma unroll
        for (int j = 0; j < 4; ++j) {
            const int col = (lane + 64 * j) * 4;
            const f32x4 gg = *(const f32x4*)(g + col);
            { const f32x4 s4 = *(const f32x4*)(sha + col), c4 = *(const f32x4*)(sca + col); const f32x4 h = (va[j] * rsa) * gg * (c4 + 1.0f) + s4;
              v2u o; o.x = pk2(h.x, h.y); o.y = pk2(h.z, h.w); *(v2u*)(H + (size_t)r0 * D + col) = o; }
            if (r1 != r0) { const f32x4 s4 = *(const f32x4*)(shb + col), c4 = *(const f32x4*)(scb2 + col); const f32x4 h = (vb[j] * rsb) * gg * (c4 + 1.0f) + s4;
              v2u o; o.x = pk2(h.x, h.y); o.y = pk2(h.z, h.w); *(v2u*)(H + (size_t)r1 * D + col) = o; }
        }
    }
}
__device__ __forceinline__ void final_norm_phase(const int bx, const int G, float* xo, const float* g, int lane, int wave) {
    const int gw = bx * NWAVES + wave, NGW = G * NWAVES;
    for (int r0 = gw; r0 < MLAT; r0 += 2 * NGW) {
        const int r1 = r0 + NGW < MLAT ? r0 + NGW : r0;
        float* xa = xo + (size_t)r0 * D; float* xb = xo + (size_t)r1 * D;
        f32x4 va[4], vb[4]; float sa = 0.f, sb = 0.f;
#pragma unroll
        for (int j = 0; j < 4; ++j) { va[j] = *(const f32x4*)(xa + (lane + 64 * j) * 4); vb[j] = *(const f32x4*)(xb + (lane + 64 * j) * 4); }
#pragma unroll
        for (int j = 0; j < 4; ++j) { sa += (va[j].x * va[j].x + va[j].y * va[j].y) + (va[j].z * va[j].z + va[j].w * va[j].w); sb += (vb[j].x * vb[j].x + vb[j].y * vb[j].y) + (vb[j].z * vb[j].z + vb[j].w * vb[j].w); }
        sa = wave_sum(sa); sb = wave_sum(sb);
        const float rsa = rsqrtf(sa * (1.0f / D) + 1e-6f), rsb = rsqrtf(sb * (1.0f / D) + 1e-6f);
#pragma unroll
        for (int j = 0; j < 4; ++j) { const int col = (lane + 64 * j) * 4; const f32x4 gg = *(const f32x4*)(g + col);
            *(f32x4*)(xa + col) = (va[j] * rsa) * gg; if (r1 != r0) *(f32x4*)(xb + col) = (vb[j] * rsb) * gg; }
    }
}

__device__ __forceinline__ void pre_item(int it, int& i, int& col) {
    if (it < 2304) { const int seg = it / 768, r = it - seg * 768; i = r / 48; col = seg * 384 + (r % 48) * 8; }
    else if (it < 2560) { const int r = it - 2304; i = (r & 127) >> 3; col = 1152 + (r >> 7) * 64 + (r & 7) * 8; }
    else { const int r = it - 2560; i = r >> 4; col = 1280 + (r & 15) * 8; }
}
__device__ __forceinline__ void pre_phase(const int bx, const int G, CArgsP A, const WS& W, int l, LAS unsigned char* lds, int tid, int lane, int wave) {
    LAS float* k_s = (LAS float*)lds;
    const int odd = l & 1;
    const float* mu0 = A->in[I_MU] + (size_t)l * 2 * RC; const float* mu1 = mu0 + RC;
    const float* kkp = A->in[I_KK] + l * RW;
    bf16* AP = (bf16*)((unsigned char*)W.H + HB_AP); bf16* KT = (bf16*)((unsigned char*)W.H + HB_KT);
    for (int tile = bx; tile < NB * (QLEN / 16); tile += G) {
        const int b = tile / (QLEN / 16), q0 = (tile % (QLEN / 16)) * 16;
        const int seq_lo = q0 < CTX ? 0 : CTX, seq_hi = q0 < CTX ? CTX : QLEN;
        for (int pass = 0; pass < 2; ++pass) {
            v4u rc[3], rp[3], rn[3];
#pragma unroll
            for (int u = 0; u < 3; ++u) { const int it0 = tid + NTHR * (pass * 3 + u), it = it0 < 16 * 176 ? it0 : 16 * 176 - 1;
                int i, col; pre_item(it, i, col); const int q = q0 + i;
                const int qp = q - 1 >= seq_lo ? q - 1 : q, qn = q + 1 < seq_hi ? q + 1 : q;
                rc[u] = *(const v4u*)(W.P + (size_t)row_of(b, q, odd) * INCP + PC_RW + col);
                rp[u] = *(const v4u*)(W.P + (size_t)row_of(b, qp, odd) * INCP + PC_RW + col);
                rn[u] = *(const v4u*)(W.P + (size_t)row_of(b, qn, odd) * INCP + PC_RW + col); }
#pragma unroll
            for (int u = 0; u < 3; ++u) { const int it0 = tid + NTHR * (pass * 3 + u);
                if (it0 < 16 * 176) {
                    int i, col; pre_item(it0, i, col); const int q = q0 + i;
                    const size_t pos = (size_t)b * QLEN + q;
                    float cur[8], prv[8], nxt[8], ps[8];
                    unpack8(rc[u], cur); unpack8(rp[u], prv); unpack8(rn[u], nxt);
                    const float mp = q - 1 >= seq_lo ? 1.f : 0.f, mn = q + 1 < seq_hi ? 1.f : 0.f;
#pragma unroll
                    for (int e = 0; e < 8; ++e) ps[e] = cur[e] + mu0[col + e] * (prv[e] * mp - cur[e]) + mu1[col + e] * (nxt[e] * mn - cur[e]);
                    if (col < 384) *(v4u*)(W.sc_r + pos * RW + col) = pack8(ps);
                    else if (col < 768) {
#pragma unroll
                        for (int e = 0; e < 8; ++e) k_s[i * 384 + col - 384 + e] = ps[e];
                        *(v4u*)(KT + pos * RW + (col - 384)) = pack8(ps); }
                    else if (col < 1152) *(v4u*)(W.sc_v + pos * RW + (col - 768)) = pack8(ps);
                    else if (col < 1216) {
#pragma unroll
                        for (int e = 0; e < 8; ++e) ps[e] = tanh_fast(ps[e]);
                        *(v4u*)(AP + pos * LORA_K + (col - 1152)) = pack8(ps); }
                    else if (col < 1280) *(v4u*)(AP + pos * LORA_K + 64 + (col - 1216)) = pack8(ps);
                    else {
#pragma unroll
                        for (int e = 0; e < 8; ++e) ps[e] = sigmoidf_(ps[e]);
                        *(v4u*)(AP + pos * LORA_K + 128 + (col - 1280)) = pack8(ps); }
                }
            }
        }
        __syncthreads();
        for (int it = wave * 8 + (lane >> 3); it < 96; it += 64) {
            const int i = it / 6, h = it % 6, c = h * 64 + (lane & 7) * 8;
            float kv[8]; float ss = 0.f;
#pragma unroll
            for (int e = 0; e < 8; ++e) { kv[e] = k_s[i * 384 + c + e] * kkp[c + e]; ss += kv[e] * kv[e]; }
            const float rn = rsqrtf(reduce8(ss) + 1e-12f);
#pragma unroll
            for (int e = 0; e < 8; ++e) kv[e] *= rn;
            *(v4u*)(W.sc_kk + ((size_t)b * QLEN + q0 + i) * RW + c) = pack8(kv);
        }
        __syncthreads();
    }
}

__device__ __forceinline__ int q_of_step(int n, int d) { return d == 0 ? n : (n < CTX ? CTX - 1 - n : QLEN + CTX - 1 - n); }
constexpr int RCH = 32, RNCH = QLEN / RCH;
__device__ __forceinline__ void rwkv_scan_phase(const WS& W, int l, int blk, LAS unsigned char* lds, int tid, int lane, int wave) {
    const int item = blk >> 1, half = blk & 1;
    const int b = item / 12, rem = item % 12, h = rem >> 1, d = rem & 1, odd = l & 1;
    LAS float* buf = (LAS float*)lds;
    LAS float* ybuf = buf + 2 * RCH * 384;
    const bf16* s_omw = W.scb + (size_t)(7 + d) * SC_ELEMS; const bf16* s_b = W.scb + (size_t)(5 + d) * SC_ELEMS; const bf16* s_kd = W.scb + (size_t)(3 + d) * SC_ELEMS;
    const int rg = lane >> 4, j = lane & 15, rlA = (wave & 3) * 8 + rg, rlB = rlA + 4, rowA = half * 32 + rlA, rowB = half * 32 + rlB;
    v4u pre[6];
    const int t4 = tid - 256;
#define RW_LOAD(c) do { _Pragma("unroll") for (int jj = 0; jj < 6; ++jj) { const int p = t4 + 256 * jj, i = p / 48, r48 = p % 48, vec = r48 >> 3, part = r48 & 7; \
        const int q = q_of_step((c) * RCH + i, d); const size_t pos = (size_t)b * QLEN + q; \
        const int aidx = vec == 0 ? 7 + d : vec == 1 ? 5 + d : vec == 2 ? 3 + d : vec == 3 ? 2 : vec == 4 ? 0 : 1;     \
        pre[jj] = *(const v4u*)(W.scb + (size_t)aidx * SC_ELEMS + pos * RW + h * 64 + part * 8); } } while (0)
#define RW_STORE(c) do { _Pragma("unroll") for (int jj = 0; jj < 6; ++jj) { const int p = t4 + 256 * jj, i = p / 48, r48 = p % 48, vec = r48 >> 3, part = r48 & 7; \
        float f[8]; unpack8(pre[jj], f); if (vec == 0) { _Pragma("unroll") for (int e = 0; e < 8; ++e) f[e] = 1.0f - f[e]; } \
        LAS float* dst = buf + (((c) & 1) * RCH + i) * 384 + vec * 64 + part * 8; \
        *(LAS f32x4*)dst = (f32x4){f[0], f[1], f[2], f[3]}; *(LAS f32x4*)(dst + 4) = (f32x4){f[4], f[5], f[6], f[7]}; } } while (0)
    f32x2 SA0 = (f32x2){0.f, 0.f}, SA1 = SA0, SB0 = SA0, SB1 = SA0;
#define RW_FLUSH(c) do { const int i = t4 >> 3, r4 = (t4 & 7) * 4; const int q = q_of_step((c) * RCH + i, d); \
        const f32x4 yv = *(const LAS f32x4*)(ybuf + ((c) & 1) * RCH * 32 + i * 32 + r4); \
        v2u o; o.x = pk2(yv.x, yv.y); o.y = pk2(yv.z, yv.w); \
        *(v2u*)(W.P + (size_t)row_of(b, q, odd) * INCP + PC_Y + d * RW + h * 64 + half * 32 + r4) = o; } while (0)
    if (wave >= 4) { RW_LOAD(0); RW_STORE(0); }
    __syncthreads();
    for (int c = 0; c < RNCH; ++c) {
        const LAS float* cur = buf + (c & 1) * RCH * 384;
        LAS float* yb = ybuf + (c & 1) * RCH * 32;
        if (wave >= 4) {
            if (c + 1 < RNCH) RW_LOAD(c + 1);
            if (c > 0) RW_FLUSH(c - 1);
            if (c + 1 < RNCH) RW_STORE(c + 1);
        } else {
        float ykA, ykB, ypA[16], ypB[16];
#define RW_LD(X, i_) do { const int ii_ = (i_) < RCH ? (i_) : RCH - 1; const LAS f32x4* bp_ = (const LAS f32x4*)(cur + ii_ * 384 + j * 4); \
        X##w = bp_[0]; X##b = bp_[16]; X##d = bp_[32]; X##k = bp_[48]; X##r = bp_[64]; X##va = cur[ii_ * 384 + 320 + rowA]; X##vb = cur[ii_ * 384 + 320 + rowB]; } while (0)
#define RW_CP(X, s_) do { \
        const f32x2 k0_ = (f32x2){X##k.x, X##k.y}, k1_ = (f32x2){X##k.z, X##k.w}; \
        const f32x2 ta_ = SA0 * k0_ + SA1 * k1_, tb_ = SB0 * k0_ + SB1 * k1_; \
        const float saA_ = -reduce16(ta_.x + ta_.y), saB_ = -reduce16(tb_.x + tb_.y); \
        const f32x2 w0_ = (f32x2){X##w.x, X##w.y}, w1_ = (f32x2){X##w.z, X##w.w}, b0_ = (f32x2){X##b.x, X##b.y}, b1_ = (f32x2){X##b.z, X##b.w}, d0_ = (f32x2){X##d.x, X##d.y}, d1_ = (f32x2){X##d.z, X##d.w}; \
        const f32x2 va2_ = (f32x2){X##va, X##va}, vb2_ = (f32x2){X##vb, X##vb}, sa2_ = (f32x2){saA_, saA_}, sb2_ = (f32x2){saB_, saB_}; \
        SA0 = SA0 * w0_ + va2_ * d0_ + sa2_ * b0_; SA1 = SA1 * w1_ + va2_ * d1_ + sa2_ * b1_; \
        SB0 = SB0 * w0_ + vb2_ * d0_ + sb2_ * b0_; SB1 = SB1 * w1_ + vb2_ * d1_ + sb2_ * b1_; \
        const f32x2 r0_ = (f32x2){X##r.x, X##r.y}, r1_ = (f32x2){X##r.z, X##r.w}; \
        const f32x2 ya_ = SA0 * r0_ + SA1 * r1_, yb_ = SB0 * r0_ + SB1 * r1_; \
        ypA[s_] = ya_.x + ya_.y; ypB[s_] = yb_.x + yb_.y; } while (0)
        f32x4 Aw, Ab, Ad, Ak, Ar, Bw, Bb, Bd, Bk, Br; float Ava, Avb, Bva, Bvb;
        RW_LD(A, 0);
#pragma unroll 1
        for (int g = 0; g < 2; ++g) {
            ykA = 0.f; ykB = 0.f;
#pragma unroll
            for (int s2 = 0; s2 < 16; s2 += 2) {
                const int i = g * 16 + s2;
                RW_LD(B, i + 1);
                __builtin_amdgcn_sched_barrier(0);
                RW_CP(A, s2);
                __builtin_amdgcn_sched_barrier(0);
                RW_LD(A, i + 2);
                __builtin_amdgcn_sched_barrier(0);
                RW_CP(B, s2 + 1);
                __builtin_amdgcn_sched_barrier(0);
            }
            ykA = rscatter16(ypA, j); ykB = rscatter16(ypB, j);
            yb[(g * 16 + j) * 32 + rlA] = ykA; yb[(g * 16 + j) * 32 + rlB] = ykB;
        }
#undef RW_LD
#undef RW_CP
        }
        __syncthreads();
    }
    if (wave >= 4) RW_FLUSH(RNCH - 1);
#undef RW_FLUSH
#undef RW_LOAD
#undef RW_STORE
}

__device__ __forceinline__ void lru_scan_phase(CArgsP A, const WS& W, int l, int idx, LAS unsigned char* lds, int tid, int lane, int wave) {
    const int b = idx / 6, n = idx % 6, odd = l & 1;
    LAS float* gs = (LAS float*)lds;
    LAS float* xs = gs;
    LAS float* us = gs + 4 * 4096;
    LAS bf16* ub = (LAS bf16*)(us + 2 * 4096);
    const int c = tid & 63;
    float cw[2][4], cb[2], sp[2];
#pragma unroll
    for (int dd = 0; dd < 2; ++dd) {
#pragma unroll
        for (int jj = 0; jj < 4; ++jj) cw[dd][jj] = A->in[I_LCW][((size_t)(l * 2 + dd) * 4 + jj) * LW + n * 64 + c];
        cb[dd] = A->in[I_LCB][(l * 2 + dd) * LW + n * 64 + c];
        sp[dd] = softplusf_(-A->in[I_LAM][(l * 2 + dd) * LW + n * 64 + c]);
    }
    const int g = wave >> 2, jcol = (wave & 3) * 16 + (lane & 15), quad = lane >> 4;
    pg8::bf16x8 bfrag[2][2]; float gbias[2];
#pragma unroll
    for (int dd = 0; dd < 2; ++dd) {
        const float* Wsrc = (g ? A->in[I_LWI] : A->in[I_LWR]) + ((size_t)((l * 2 + dd) * 6 + n) * 64) * 64 + jcol;
#pragma unroll
        for (int ks = 0; ks < 2; ++ks)
#pragma unroll
            for (int jj = 0; jj < 8; ++jj) bfrag[dd][ks][jj] = (short)f2bf(Wsrc[(size_t)(ks * 32 + quad * 8 + jj) * 64]);
        gbias[dd] = (g ? A->in[I_LBI] : A->in[I_LBR])[(l * 2 + dd) * LW + n * 64 + jcol];
    }
    float hstate = 0.f;
    v4u pre[2][2];
#define LRU_LOAD(ch) do { _Pragma("unroll") for (int dd = 0; dd < 2; ++dd) { const int n0 = (ch) * 64; const int qlo_ = dd == 0 ? n0 : q_of_step(n0, 1) - 63; const int qb_ = dd == 0 ? qlo_ - 3 : qlo_; \
        const int slo_ = qlo_ < CTX ? 0 : CTX, shi_ = qlo_ < CTX ? CTX : QLEN; \
        _Pragma("unroll") for (int jj = 0; jj < 2; ++jj) { const int p = tid + NTHR * jj; const int t = p >> 3, part = p & 7, q = qb_ + t; \
            pre[dd][jj] = (v4u){0u, 0u, 0u, 0u}; \
            if (t < 67 && q >= slo_ && q < shi_) pre[dd][jj] = *(const v4u*)(W.P + (size_t)row_of(b, q, odd) * INCP + PC_XR + n * 64 + part * 8); } } } while (0)
    LRU_LOAD(0);
    const int tid_o = tid, lane_o = lane;
    for (int ch = 0; ch < QLEN / 64; ++ch) {
        const int n0 = ch * 64;
        int tid = tid_o, lane = lane_o; asm volatile("" : "+v"(tid), "+v"(lane));
        const int c = tid & 63, jcol = (wave & 3) * 16 + (lane & 15), quad = lane >> 4;
#pragma unroll
        for (int dd = 0; dd < 2; ++dd)
#pragma unroll
            for (int jj = 0; jj < 2; ++jj) { const int p = tid + NTHR * jj; const int t = p >> 3, part = p & 7;
                if (t < 67) { float f[8]; unpack8(pre[dd][jj], f); LAS float* dst = xs + dd * 68 * 64 + t * 64 + part * 8;
                    *(LAS f32x4*)dst = (f32x4){f[0], f[1], f[2], f[3]}; *(LAS f32x4*)(dst + 4) = (f32x4){f[4], f[5], f[6], f[7]}; } }
        __syncthreads();
        if (ch + 1 < QLEN / 64) LRU_LOAD(ch + 1);
#pragma unroll
        for (int k = 0; k < 16; ++k) { const int dd = k >> 3, t = (tid >> 6) + 8 * (k & 7); const LAS float* x = xs + dd * 68 * 64;
            const float uv = cb[dd] + cw[dd][0] * x[t * 64 + c] + cw[dd][1] * x[(t + 1) * 64 + c] + cw[dd][2] * x[(t + 2) * 64 + c] + cw[dd][3] * x[(t + 3) * 64 + c];
            us[dd * 4096 + t * 64 + c] = uv; ub[dd * 64 * 72 + t * 72 + c] = (bf16)f2bf(uv); }
        __syncthreads();
#pragma unroll
        for (int dd = 0; dd < 2; ++dd)
#pragma unroll
            for (int rt = 0; rt < 4; ++rt) {
                pg8::f32x4 acc = {0.f, 0.f, 0.f, 0.f};
#pragma unroll
                for (int ks = 0; ks < 2; ++ks) {
                    const pg8::bf16x8 afrag = *(const LAS pg8::bf16x8*)(ub + dd * 64 * 72 + (rt * 16 + (lane & 15)) * 72 + ks * 32 + quad * 8);
                    acc = __builtin_amdgcn_mfma_f32_16x16x32_bf16(afrag, bfrag[dd][ks], acc, 0, 0, 0);
                }
#pragma unroll
                for (int jj = 0; jj < 4; ++jj) gs[((dd * 2 + g) * 64 + rt * 16 + quad * 4 + jj) * 64 + jcol] = sigmoidf_(acc[jj] + gbias[dd]);
            }
        __syncthreads();
#pragma unroll
        for (int k = 0; k < 16; ++k) { const int dd = k >> 3, t = (tid >> 6) + 8 * (k & 7);
            LAS float* ga = gs + (dd * 2) * 4096 + t * 64 + c; LAS float* gb = ga + 4096;
            const float rgv = *ga, igv = *gb, u = us[dd * 4096 + t * 64 + c];
            const float log_a = -8.0f * sp[dd] * rgv;
            const float a = __expf(log_a);
            const float bt = __builtin_amdgcn_sqrtf(fmaxf(1.0f - a * a, 0.f)) * (igv * u);
            *ga = a; *gb = bt; }
        __syncthreads();
        if (wave < 2) {
            const int dd = wave; const int qlo = dd == 0 ? n0 : q_of_step(n0, 1) - 63;
            const LAS float* ga = gs + (dd * 2) * 4096 + lane; LAS float* hb = us + dd * 4096 + lane;
            (void)qlo;
#pragma unroll 8
            for (int s = 0; s < 64; ++s) { const int t = dd == 0 ? s : 63 - s;
                hstate = ga[t * 64] * hstate + ga[4096 + t * 64];
                hb[t * 64] = hstate; }
        }
        __syncthreads();
#pragma unroll
        for (int k = 0; k < 2; ++k) { const int p = tid + NTHR * k, dd = p >> 9, t = (p >> 3) & 63, part = p & 7;
            const int qlo = dd == 0 ? n0 : q_of_step(n0, 1) - 63;
            const LAS f32x4* hp = (const LAS f32x4*)(us + dd * 4096 + t * 64 + part * 8);
            const f32x4 h0 = hp[0], h1 = hp[1]; const float hv[8] = {h0.x, h0.y, h0.z, h0.w, h1.x, h1.y, h1.z, h1.w};
            *(v4u*)(W.H + (size_t)row_of(b, qlo + t, odd) * D + dd * LW + n * 64 + part * 8) = pack8(hv); }
    }
#undef LRU_LOAD
}

__device__ __forceinline__ void post_phase(const int bx, const int G, CArgsP A, const WS& W, int l, LAS unsigned char* lds, int tid, int lane, int wave) {
    LAS float* hs = (LAS float*)lds;
    const int odd = l & 1;
    const float* cwa = A->in[I_CONVA] + (size_t)l * 3 * 256;
    const float* rk = A->in[I_RK] + l * RW; const float* lng = A->in[I_LNG] + l * RW; const float* lnb = A->in[I_LNB] + l * RW;
    bf16* Y = W.H;
    for (int tile = bx; tile < NB * (QLEN / 16); tile += G) {
        const int b = tile / (QLEN / 16), q0 = (tile % (QLEN / 16)) * 16;
        for (int it = tid; it < 16 * 48; it += NTHR) { const int i = it / 48, col = (it % 48) * 8; const size_t row = row_of(b, q0 + i, odd);
            float h0[8], h1[8]; unpack8(*(const v4u*)(W.H + row * D + col), h0); unpack8(*(const v4u*)(W.H + row * D + LW + col), h1);
#pragma unroll
            for (int e = 0; e < 8; ++e) hs[i * 384 + col + e] = h0[e] + h1[e]; }
        __syncthreads();
        v4u grv[2];
#pragma unroll
        for (int u = 0; u < 2; ++u) { const int it0 = tid + NTHR * u, it = it0 < 16 * 48 ? it0 : 16 * 48 - 1; const int i = it / 48, col = (it % 48) * 8;
            grv[u] = *(const v4u*)(W.P + (size_t)row_of(b, q0 + i, odd) * INCP + PC_GR + col); }
        {   const int it = tid, i = it >> 5, col = (it & 31) * 8, q = q0 + i;
            int lo, hi; if (q < CTX) { lo = 0; hi = CTX; } else { lo = CTX + ((q - CTX) & ~63); hi = lo + 64; }
            const size_t row = row_of(b, q, odd), rp = row_of(b, q - 1 >= lo ? q - 1 : q, odd), rn = row_of(b, q + 1 < hi ? q + 1 : q, odd);
            const float mp = q - 1 >= lo ? 1.f : 0.f, mn = q + 1 < hi ? 1.f : 0.f;
            const v4u l0 = *(const v4u*)(W.P + row * INCP + PC_BG + col), l1 = *(const v4u*)(W.P + row * INCP + PC_CG + col), l2 = *(const v4u*)(W.P + row * INCP + PC_XIN + col);
            const v4u l3 = *(const v4u*)(W.P + rp * INCP + PC_CG + col), l4 = *(const v4u*)(W.P + rp * INCP + PC_XIN + col);
            const v4u l5 = *(const v4u*)(W.P + rn * INCP + PC_CG + col), l6 = *(const v4u*)(W.P + rn * INCP + PC_XIN + col);
            float bg[8], c0[8], x0[8], c1[8], x1[8], c2[8], x2[8], y[8];
            unpack8(l0, bg); unpack8(l1, c0); unpack8(l2, x0); unpack8(l3, c1); unpack8(l4, x1); unpack8(l5, c2); unpack8(l6, x2);
#pragma unroll
            for (int e = 0; e < 8; ++e) y[e] = bg[e] * (cwa[256 + col + e] * (c0[e] * x0[e]) + mp * cwa[col + e] * (c1[e] * x1[e]) + mn * cwa[512 + col + e] * (c2[e] * x2[e]));
            *(v4u*)(Y + row * D + col) = pack8(y); }
        for (int it = wave * 8 + (lane >> 3); it < 96; it += 64) {
            const int i = it / 6, h = it % 6, c = h * 64 + (lane & 7) * 8, q = q0 + i;
            const size_t row = row_of(b, q, odd), pos = (size_t)b * QLEN + q;
            float y0[8], y1[8], rr[8], vv[8], k0[8], k1[8], gg[8];
            unpack8(*(const v4u*)(W.P + row * INCP + PC_Y + c), y0); unpack8(*(const v4u*)(W.P + row * INCP + PC_Y + RW + c), y1);
            unpack8(*(const v4u*)(W.sc_r + pos * RW + c), rr); unpack8(*(const v4u*)(W.sc_v + pos * RW + c), vv);
            unpack8(*(const v4u*)(W.scb + (size_t)3 * SC_ELEMS + pos * RW + c), k0); unpack8(*(const v4u*)(W.scb + (size_t)4 * SC_ELEMS + pos * RW + c), k1);
            unpack8(*(const v4u*)(W.P + row * INCP + PC_G + c), gg);
            float sum = 0.f, bon = 0.f;
#pragma unroll
            for (int e = 0; e < 8; ++e) { y0[e] += y1[e]; sum += y0[e]; bon += rr[e] * (k0[e] + k1[e]) * rk[c + e]; }
            const float mean = reduce8(sum) * (1.0f / 64.0f); bon = reduce8(bon);
            float sq = 0.f;
#pragma unroll
            for (int e = 0; e < 8; ++e) { y0[e] -= mean; sq += y0[e] * y0[e]; }
            const float rstd = rsqrtf(reduce8(sq) * (1.0f / 64.0f) + 64e-5f);
#pragma unroll
            for (int e = 0; e < 8; ++e) y0[e] = (y0[e] * rstd * lng[c + e] + lnb[c + e] + bon * vv[e]) * gg[e];
            *(v4u*)(Y + row * D + 256 + c) = pack8(y0);
        }
#pragma unroll
        for (int u = 0; u < 2; ++u) { const int it = tid + NTHR * u;
            if (it < 16 * 48) { const int i = it / 48, col = (it % 48) * 8; const size_t row = row_of(b, q0 + i, odd);
                float gr[8], o[8]; unpack8(grv[u], gr);
#pragma unroll
                for (int e = 0; e < 8; ++e) o[e] = gelu_tanh(gr[e]) * hs[i * 384 + col + e];
                *(v4u*)(Y + row * D + 640 + col) = pack8(o); } }
        __syncthreads();
    }
}

#define XB_TMO      128
#define XB_XCNT(j)  (256  + 64 * (j))
#define XB_XSUB(j)  (1280 + 64 * (j))
#define XB_XGEN(j)  (2304 + 64 * (j))
#define XB_TOP      3328
#define XB_TOPGEN   3392
#define XCD_BAR_WORDS 3456
#define XB_SPIN_CAP (1u << 18)

__device__ __forceinline__ unsigned xb_ld(unsigned* p)              { return __hip_atomic_load(p, __ATOMIC_RELAXED, __HIP_MEMORY_SCOPE_AGENT); }
__device__ __forceinline__ unsigned xb_add(unsigned* p, unsigned v) { return __hip_atomic_fetch_add(p, v, __ATOMIC_RELAXED, __HIP_MEMORY_SCOPE_AGENT); }
__device__ __forceinline__ unsigned xb_xcc_id() { return (unsigned)__builtin_amdgcn_s_getreg((3 << 11) | 20) & 0xFu; }
#define XB_SPIN(cond, bar) do { unsigned _sp = 0; while (cond) { __builtin_amdgcn_s_sleep(1); \
    if ((++_sp & 255u) == 0u) { if (xb_ld(&(bar)[XB_TMO])) break; if (_sp > XB_SPIN_CAP) { atomicAdd(&(bar)[XB_TMO], 1u); break; } } } } while (0)

struct XcdBarrier {
    unsigned* bar; unsigned x;
    volatile LAS unsigned* st;
};

__device__ __forceinline__ XcdBarrier xcd_barrier_post(unsigned* bar, volatile LAS unsigned* st) {
    XcdBarrier b; b.bar = bar; b.x = xb_xcc_id(); b.st = st;
    if (threadIdx.x == 0) (void)xb_add(&bar[XB_XCNT(b.x)], 1u);
    return b;
}
__device__ __forceinline__ void xcd_barrier_complete(unsigned* bar, unsigned x, unsigned& nloc, unsigned& nx) {
    const unsigned G = gridDim.x * gridDim.y * gridDim.z;
    unsigned sum, cnt, mine, sp = 0u;
    for (;;) {
        sum = 0u; cnt = 0u; mine = 0u;
#pragma unroll
        for (unsigned j = 0; j < 16; ++j) { const unsigned c = xb_ld(&bar[XB_XCNT(j)]); sum += c; cnt += (c > 0u) ? 1u : 0u; mine = (j == x) ? c : mine; }
        if (sum == G) break;
        __builtin_amdgcn_s_sleep(1);
        if ((++sp & 255u) == 0u) { if (xb_ld(&bar[XB_TMO])) break; if (sp > XB_SPIN_CAP) { atomicAdd(&bar[XB_TMO], 1u); break; } }
    }
    nloc = mine > 0u ? mine : 1u; nx = cnt > 0u ? cnt : 1u;
}

__device__ __forceinline__ void xcd_barrier(const XcdBarrier& b) {
    asm volatile("s_waitcnt vmcnt(0)" ::: "memory");
    __syncthreads();
    if (threadIdx.x == 0) {
        unsigned* bar = b.bar;
        __builtin_amdgcn_s_waitcnt(0);
        unsigned nloc = b.st[0], nx = b.st[1];
        if (nloc == 0u) { xcd_barrier_complete(bar, b.x, nloc, nx); b.st[0] = nloc; b.st[1] = nx; }
        const unsigned old = xb_add(&bar[XB_XSUB(b.x)], 1u);
        const unsigned gen = old / nloc;
        if (old + 1u == (gen + 1u) * nloc) {
            __builtin_amdgcn_fence(__ATOMIC_RELEASE, "agent");
            asm volatile("s_waitcnt vmcnt(0)" ::: "memory");
            const unsigned og = xb_add(&bar[XB_TOP], 1u);
            const unsigned tg = og / nx;
            if (og + 1u == (tg + 1u) * nx) xb_add(&bar[XB_TOPGEN], 1u);
            else XB_SPIN(xb_ld(&bar[XB_TOPGEN]) == tg, bar);
            __builtin_amdgcn_fence(__ATOMIC_ACQUIRE, "agent");
            xb_add(&bar[XB_XGEN(b.x)], 1u);
            asm volatile("s_waitcnt vmcnt(0)" ::: "memory");
        } else {
            XB_SPIN(xb_ld(&bar[XB_XGEN(b.x)]) == gen, bar);
            __builtin_amdgcn_fence(__ATOMIC_ACQUIRE, "agent");
            asm volatile("s_waitcnt vmcnt(0)" ::: "memory");
        }
    }
    __syncthreads();
}

constexpr int NCTXB = 32;
constexpr int PH_PER_LAYER = 16, N_PHASES = 1 + DEPTH * PH_PER_LAYER + 1;
__global__ void __launch_bounds__(NTHR, 2) fwd_megakernel(Args A0) {
    extern __shared__ __attribute__((aligned(16))) unsigned char lds_raw[];
    LAS unsigned char* lds = (LAS unsigned char*)lds_raw;
    cg::grid_group grid = cg::this_grid();
    const int ph_lo = A0.ph_lo, ph_hi = A0.ph_hi;
    volatile LAS unsigned* bst = (volatile LAS unsigned*)(lds + 131072);
    if (threadIdx.x < 2) bst[threadIdx.x] = 0u;
    __syncthreads();
    const XcdBarrier xbar = xcd_barrier_post((unsigned*)(A0.ws + WS_BAR), bst);
    const int wave0 = __builtin_amdgcn_readfirstlane((int)threadIdx.x >> 6);
    bool rep_done = false; (void)rep_done;
    for (int ph = ph_lo; ph < ph_hi; ++ph) {
        CArgsP A = (CArgsP)__builtin_amdgcn_kernarg_segment_ptr();
        asm volatile("" : "+s"(A) :: "memory");
        int G = gridDim.x, bx = blockIdx.x, wave = wave0;
        asm volatile("" : "+s"(G), "+s"(bx), "+s"(wave));
#define IDS() int lane; asm volatile("v_mbcnt_lo_u32_b32 %0, -1, 0\n\tv_mbcnt_hi_u32_b32 %0, -1, %0" : "=v"(lane)); const int tid = wave * 64 + lane; (void)tid
        const WS W = make_ws(A->ws);
        if (ph == 0) { IDS(); mods_phase(bx, G, A, W, lds, tid, lane, wave); convert_phase(bx, G, A, W.wt, 0, lds, lane, wave); }
        else if (ph == N_PHASES - 1) { IDS(); final_norm_phase(bx, G, A->out, A->in[I_GFINAL], lane, wave); }
        else {
            const int l = (ph - 1) / PH_PER_LAYER, s = (ph - 1) % PH_PER_LAYER; const bool last = (l == DEPTH - 1);
            if ((s == 1 && l == 0) || (s == 13 && last)) continue;
            const float* mods_l = W.mods + (size_t)l * 9 * 9216;
            const bf16* WTL = (l & 1) ? W.wt2 : W.wt;
            const float* xlat = A->out; const float* xctx = W.xrctx;
            int gk = 0, gl = l; bool gctx = false;
            if (s == 3) gk = 1; else if (s == 4) { gk = 1; gctx = true; } else if (s == 11) gk = 2; else if (s == 12 && !last) { gk = 2; gctx = true; }
            else if (s == 15) gk = 3; else if (s == 0 && l > 0) { gk = 3; gctx = true; gl = l - 1; }
            const int nk = (s == 0 || s == 1) ? 1 : ((s == 4 || s == 5) ? 2 : ((s == 12 || s == 13) ? 3 : 0));
            const bool split = gk != 0 && gctx && G > 2 * NCTXB;
            if (gk != 0 && (!gctx || !split || bx < NCTXB)) { IDS();
                const float* mods_g = W.mods + (size_t)gl * 9 * 9216; const bf16* WTG = (gl & 1) ? W.wt2 : W.wt;
                pg8::Gemm g{gk == 2 ? W.H : W.ACT, WTG + (gk == 1 ? WT_DOWN1 : gk == 2 ? WT_OUT : WT_DOWN2), gctx ? MCTX : MLAT, D, gk == 2 ? D : DFF};
                pg8::StaticOrder S; S.init(g.M, g.N, (gctx && split) ? NCTXB : G, bx, gctx ? MLAT / 256 : 0);
                const bool first = (gl == 0 && gk == 1);
                EpiResid E{first ? A->in[I_X] : xlat, first ? A->in[I_CTX] : xctx, A->out, W.xrctx, mods_g + (gk == 1 ? 2 : gk == 2 ? 5 : 8) * 1024, gk == 2 ? 1.0f : 0.5f};
                pg8::gemm_phase<EpiResid, pg8::StaticOrder, true, true>(lds, g, S, E, tid);
            }
            if (nk != 0 && !(split && bx < NCTXB)) { IDS();
                const bool l0 = (l == 0 && s == 0);
                const bool ctxrows = (s == 1 || s == 5 || s == 13);
                const int row_lo = ctxrows ? MLAT : 0, row_hi = (ctxrows || l0) ? MTOT : MLAT;
                const float* gsrc = nk == 1 ? A->in[I_GFFN1] + l * D : (nk == 2 ? A->in[I_GMIX] + l * D : A->in[I_GFFN2] + l * D);
                norm_phase(split ? bx - NCTXB : bx, split ? G - NCTXB : G, l0 ? A->in[I_X] : xlat, l0 ? A->in[I_CTX] : xctx, gsrc, mods_l, (nk - 1) * 3, (nk - 1) * 3 + 1, W.H, row_lo, row_hi, lane, wave);
            }
            if (s == 2 || s == 14) { IDS();
                pg8::Gemm g{W.H, WTL + (s == 2 ? WT_GU1 : WT_GU2), (s == 14 && last) ? MLAT : MTOT, 2 * DFF, D}; pg8::StaticOrder S; S.init(g.M, g.N, G, bx);
                EpiSwiGLU E{W.ACT};
                pg8::gemm_phase<EpiSwiGLU, pg8::StaticOrder, true, true>(lds, g, S, E, tid);
            } else if (s == 6) { IDS();
                pg8::Gemm g{W.H, WTL + WT_IN, MTOT, INCP, D}; pg8::StaticOrder S; S.init(g.M, g.N, G, bx);
                EpiP E{W.P, INCP};
                pg8::gemm_phase<EpiP, pg8::StaticOrder, true, true>(lds, g, S, E, tid);
            } else if (s == 7) { IDS();
                pre_phase(bx, G, A, W, l, lds, tid, lane, wave);
            } else if (s == 8) { IDS();
                int Kl = LORA_K, Nl = LORA_N; asm volatile("" : "+s"(Kl), "+s"(Nl));
                pg8::Gemm g{(const bf16*)((const unsigned char*)W.H + HB_AP), WTL + WT_LORA, MTOT, Nl, Kl}; pg8::StaticOrder S; S.init(g.M, g.N, G, bx);
                EpiLora E{A->in[I_W0] + l * 2 * RW, A->in[I_A0] + l * 2 * RW, A->in[I_KA] + l * RW, (const bf16*)((const unsigned char*)W.H + HB_KT), W.sc_kk, W.scb, W.P, l & 1};
                pg8::gemm_phase<EpiLora, pg8::StaticOrder, true, true>(lds, g, S, E, tid);
            } else if (s == 9) { IDS();
                for (int u = bx; u < 240; u += G) {
                    if (u < 192) rwkv_scan_phase(W, l, u, lds, tid, lane, wave); else lru_scan_phase(A, W, l, u - 192, lds, tid, lane, wave);
                    __syncthreads();
                }
                if (!last) {
                    if (G > 240) { if (bx >= 240) convert_phase(bx - 240, G - 240, A, ((l + 1) & 1) ? W.wt2 : W.wt, l + 1, lds, lane, wave); }
                    else convert_phase(bx, G, A, ((l + 1) & 1) ? W.wt2 : W.wt, l + 1, lds, lane, wave);
                }
            } else if (s == 10) { IDS();
                post_phase(bx, G, A, W, l, lds, tid, lane, wave);
            }
        }
#ifdef PROBE_REP_S
        if (ph > 0 && ph < N_PHASES - 1 && ((ph - 1) % PH_PER_LAYER) == PROBE_REP_S && !rep_done) { rep_done = true; grid.sync(); --ph; continue; }
        rep_done = false;
#endif
        if (ph + 1 < ph_hi) { if (ph == ph_lo) grid.sync(); else xcd_barrier(xbar); }
    }
}

#ifndef MK_MULTI
#define MK_MULTI 0
#endif
extern "C" void kernel_launch(void* const* d_in, const int* in_sizes, int n_in, void* d_out, int out_size, void* d_ws, size_t ws_size, hipStream_t stream) {
    static int grid = 0;
    if (grid == 0) {
        if (n_in != N_IN || out_size != MLAT * D || ws_size < WS_END) { fprintf(stderr, "kernel_launch: unexpected shapes (n_in %d out %d ws %zu)\n", n_in, out_size, ws_size); grid = -1; return; }
        int dev = 0, cus = 0, per_cu = 0;
        (void)hipGetDevice(&dev); (void)hipDeviceGetAttribute(&cus, hipDeviceAttributeMultiprocessorCount, dev);
        if (hipFuncSetAttribute((const void*)fwd_megakernel, hipFuncAttributeMaxDynamicSharedMemorySize, LDS_BYTES) != hipSuccess) { fprintf(stderr, "kernel_launch: hipFuncSetAttribute failed\n"); grid = -1; return; }
        if (hipOccupancyMaxActiveBlocksPerMultiprocessor(&per_cu, (const void*)fwd_megakernel, NTHR, LDS_BYTES) != hipSuccess || per_cu < 1) { fprintf(stderr, "kernel_launch: occupancy query says %d\n", per_cu); per_cu = 1; }
        (void)hipGetLastError();
        grid = cus * 1;
        if (grid <= 0) grid = 256;
    }
    if (grid < 0) return;
    if (hipMemsetAsync((unsigned char*)d_ws + WS_BAR, 0, WS_BAR_BYTES, stream) != hipSuccess) { fprintf(stderr, "kernel_launch: memset of the barrier words failed\n"); return; }
    Args a{};
    for (int i = 0; i < N_IN; ++i) a.in[i] = (const float*)d_in[i];
    a.out = (float*)d_out; a.ws = (unsigned char*)d_ws;
#if MK_MULTI
    for (int ph = 0; ph < N_PHASES; ++ph) { a.ph_lo = ph; a.ph_hi = ph + 1; hipLaunchKernelGGL(fwd_megakernel, dim3(grid), dim3(NTHR), LDS_BYTES, stream, a); }
#else
    a.ph_lo = 0; a.ph_hi = N_PHASES;
    void* args[] = {&a};
    hipError_t e = hipLaunchCooperativeKernel((const void*)fwd_megakernel, dim3(grid), dim3(NTHR), args, LDS_BYTES, stream);
    if (e != hipSuccess) fprintf(stderr, "kernel_launch: cooperative launch failed: %s (grid %d)\n", hipGetErrorString(e), grid);
#endif
}
```
